# Optimizing an MI355X kernel written in HIP

```python
import jax, jax.numpy as jnp
from jax import lax
import numpy as np

D_MODEL = 2048
BATCH = 2
SEQ = 16384
DEPTH = 2

CHUNK = 64
Q_BLOCK = 128
HEAD_DIM = 128
D_MIX = D_MODEL
RET_HEADS = D_MIX // 4 // HEAD_DIM
FOX_HEADS = D_MIX // 2 // HEAD_DIM
MLSTM_HEADS = D_MIX // 4 // HEAD_DIM
RET_W = RET_HEADS * HEAD_DIM
FOX_W = FOX_HEADS * HEAD_DIM
MLSTM_W = MLSTM_HEADS * HEAD_DIM
CONV_WIDTH = 4
D_FF = 4 * D_MODEL
ROPE_BASE = 10000.0
NORM_EPS = 1e-6
N_MOD = 6
IN_SIZES = [RET_W] * 4 + [FOX_W] * 3 + [FOX_HEADS] + [MLSTM_W] * 4 + [MLSTM_HEADS, MLSTM_HEADS]
D_IN = sum(IN_SIZES)
IN_SPLIT_IDX = [int(i) for i in np.cumsum(IN_SIZES)[:-1]]

kernel_name = "hymba_retention_fox_mlstm_trunk"


def rmsnorm(x, w):
    x32 = x.astype(jnp.float32)
    y = x32 * lax.rsqrt(jnp.mean(x32 * x32, axis=-1, keepdims=True) + NORM_EPS)
    return (y * w.astype(jnp.float32)).astype(x.dtype)


def head_norm(y):
    B, S, H, d = y.shape
    y32 = y.astype(jnp.float32)
    mu = jnp.mean(y32, axis=-1, keepdims=True)
    var = jnp.mean(jnp.square(y32 - mu), axis=-1, keepdims=True)
    return ((y32 - mu) * lax.rsqrt(var + NORM_EPS)).reshape(B, S, H * d).astype(y.dtype)


def rotary(t, positions):
    d = t.shape[-1]
    inv_freq = ROPE_BASE ** (-jnp.arange(0, d, 2, dtype=jnp.float32) / d)
    ang = positions.astype(jnp.float32)[:, :, None] * inv_freq
    cos = jnp.cos(ang)[:, :, None, :]
    sin = jnp.sin(ang)[:, :, None, :]
    t32 = t.astype(jnp.float32)
    t1, t2 = t32[..., : d // 2], t32[..., d // 2:]
    return jnp.concatenate([t1 * cos - t2 * sin, t2 * cos + t1 * sin], axis=-1).astype(t.dtype)


def to_chunks(t):
    B, S, H, d = t.shape
    return t.reshape(B, S // CHUNK, CHUNK, H, d).transpose(1, 0, 3, 2, 4)


def from_chunks(t):
    NC, B, H, L, d = t.shape
    return t.transpose(1, 0, 3, 2, 4).reshape(B, NC * L, H, d)


def gate_chunks(g):
    B, S, H = g.shape
    return g.reshape(B, S // CHUNK, CHUNK, H).transpose(1, 0, 3, 2)


def causal_conv(x, w, b):
    K, C = w.shape
    y = lax.conv_general_dilated(x, w[:, None, :].astype(x.dtype), window_strides=(1,),
                                 padding=[(K - 1, 0)], dimension_numbers=('NWC', 'WIO', 'NWC'),
                                 feature_group_count=C)
    return y + b.astype(x.dtype)


def retention(q, k, v, positions):
    B, S, H, d = q.shape
    q = rotary(q, positions)
    k = rotary(k, positions) * (d ** -0.5)
    log_gamma = jnp.log(1.0 - 2.0 ** (-5.0 - jnp.arange(H, dtype=jnp.float32)))
    idx = jnp.arange(CHUNK, dtype=jnp.float32)
    rel = idx[:, None] - idx[None, :]
    intra_decay = jnp.where(rel >= 0, jnp.exp(jnp.maximum(rel, 0.0)[None] * log_gamma[:, None, None]), 0.0)
    q_decay = jnp.exp((idx + 1.0)[None, :] * log_gamma[:, None])[..., None]
    k_decay = jnp.exp((CHUNK - 1.0 - idx)[None, :] * log_gamma[:, None])[..., None]
    chunk_decay = jnp.exp(CHUNK * log_gamma)[:, None, None]

    def step(state, inp):
        qi, ki, vi = inp
        scores = jnp.einsum('bhld,bhmd->bhlm', qi, ki) * intra_decay
        intra = jnp.einsum('bhlm,bhmd->bhld', scores, vi)
        inter = jnp.einsum('bhld,bhde->bhle', qi * q_decay, state)
        new_state = state * chunk_decay + jnp.einsum('bhmd,bhme->bhde', ki * k_decay, vi)
        return new_state, intra + inter

    state0 = jnp.zeros((B, H, d, d), jnp.float32)
    _, out = lax.scan(step, state0, (to_chunks(q), to_chunks(k), to_chunks(v)))
    return from_chunks(out).astype(q.dtype)


def forgetting_attention(q, k, v, f_logit):
    B, S, H, d = q.shape
    cum = jnp.cumsum(jax.nn.log_sigmoid(f_logit.astype(jnp.float32)), axis=1).transpose(0, 2, 1)
    q_h = q.transpose(0, 2, 1, 3) * (d ** -0.5)
    k_h = k.transpose(0, 2, 1, 3)
    v_h = v.transpose(0, 2, 1, 3)
    nb = S // Q_BLOCK
    qb = q_h.reshape(B, H, nb, Q_BLOCK, d).transpose(2, 0, 1, 3, 4)
    cb = cum.reshape(B, H, nb, Q_BLOCK).transpose(2, 0, 1, 3)
    qpos = jnp.arange(S).reshape(nb, Q_BLOCK)
    kpos = jnp.arange(S)

    def block(inp):
        qi, ci, pi = inp
        logits = jnp.einsum('bhqd,bhkd->bhqk', qi, k_h).astype(jnp.float32) + ci[..., None] - cum[:, :, None, :]
        logits = jnp.where((pi[:, None] >= kpos[None, :])[None, None], logits, -jnp.inf)
        p = jax.nn.softmax(logits, axis=-1)
        return jnp.einsum('bhqk,bhkd->bhqd', p.astype(v_h.dtype), v_h)

    out = lax.map(block, (qb, cb, qpos))
    return out.transpose(1, 0, 3, 2, 4).reshape(B, S, H, d)


def mlstm(q, k, v, i_logit, f_logit):
    B, S, H, d = q.shape
    k = k * (d ** -0.5)
    ic = gate_chunks(i_logit.astype(jnp.float32))
    lfc = gate_chunks(jax.nn.log_sigmoid(f_logit.astype(jnp.float32)))
    causal = jnp.tril(jnp.ones((CHUNK, CHUNK), dtype=bool))

    def step(carry, inp):
        C, n, m = carry
        qi, ki, vi, ii, lfi = inp
        b = jnp.cumsum(lfi, axis=-1)
        D = jnp.where(causal, b[..., :, None] - b[..., None, :] + ii[..., None, :], -jnp.inf)
        inter_log = b + m[..., None]
        m_q = jnp.maximum(inter_log, jnp.max(D, axis=-1))
        w_intra = jnp.exp(D - m_q[..., None])
        w_inter = jnp.exp(inter_log - m_q)
        s = jnp.einsum('bhlk,bhmk->bhlm', qi, ki) * w_intra
        num = jnp.einsum('bhlm,bhmv->bhlv', s, vi) + w_inter[..., None] * jnp.einsum('bhlk,bhkv->bhlv', qi, C)
        den = jnp.sum(s, axis=-1) + w_inter * jnp.einsum('bhlk,bhk->bhl', qi, n)
        h = num / jnp.maximum(jnp.abs(den), jnp.exp(-m_q))[..., None]
        b_last = b[..., -1]
        k_log = b_last[..., None] - b + ii
        m_new = jnp.maximum(b_last + m, jnp.max(k_log, axis=-1))
        wk = jnp.exp(k_log - m_new[..., None])
        carry_scale = jnp.exp(b_last + m - m_new)
        C_new = carry_scale[..., None, None] * C + jnp.einsum('bhl,bhlk,bhlv->bhkv', wk, ki, vi)
        n_new = carry_scale[..., None] * n + jnp.einsum('bhl,bhlk->bhk', wk, ki)
        return (C_new, n_new, m_new), h

    carry0 = (jnp.zeros((B, H, d, d), jnp.float32), jnp.zeros((B, H, d), jnp.float32),
              jnp.zeros((B, H), jnp.float32))
    _, out = lax.scan(step, carry0, (to_chunks(q), to_chunks(k), to_chunks(v), ic, lfc))
    return from_chunks(out).astype(q.dtype)


def hybrid_mixer(h, positions, w_in, conv_w, conv_b, fox_f_bias, mlstm_i_bias, mlstm_f_bias,
                 merge_scale, w_out):
    B, S, _ = h.shape
    heads = lambda t, H: t.reshape(B, S, H, HEAD_DIM)
    proj = h @ w_in
    (rq, rk, rv, rg, fq, fk, fv, ff, mq, mk, mv, mo, mi, mf) = jnp.split(proj, IN_SPLIT_IDX, axis=-1)
    y_ret = head_norm(retention(heads(rq, RET_HEADS), heads(rk, RET_HEADS), heads(rv, RET_HEADS), positions))
    y_ret = y_ret * jax.nn.silu(rg)
    y_fox = head_norm(forgetting_attention(heads(fq, FOX_HEADS), heads(fk, FOX_HEADS), heads(fv, FOX_HEADS),
                                           ff + fox_f_bias))
    mqk = jax.nn.silu(causal_conv(jnp.concatenate([mq, mk], axis=-1), conv_w, conv_b))
    mq, mk = jnp.split(mqk, 2, axis=-1)
    y_m = head_norm(mlstm(heads(mq, MLSTM_HEADS), heads(mk, MLSTM_HEADS), heads(mv, MLSTM_HEADS),
                          mi + mlstm_i_bias, mf + mlstm_f_bias))
    y_m = y_m * jax.nn.sigmoid(mo)
    y = jnp.concatenate([y_ret, y_fox, y_m], axis=-1) * merge_scale
    return y @ w_out


def setup_inputs(seed: int = 0) -> dict:
    key = jax.random.key(seed)
    ks = jax.random.split(key, 20)
    nrm = lambda k, shape, scale: jax.random.normal(k, shape, jnp.float32) * scale
    x = nrm(ks[0], (BATCH, SEQ, D_MODEL), 1.0)
    c = nrm(ks[1], (BATCH, D_MODEL), 1.0)
    offsets = jax.random.randint(ks[2], (BATCH, 1), 0, 1024) * CHUNK
    positions = (offsets + jnp.arange(SEQ)[None, :]).astype(jnp.int32)
    return {
        "x": x,
        "c": c,
        "positions": positions,
        "ada_w": nrm(ks[3], (DEPTH, D_MODEL, N_MOD * D_MODEL), 0.5 * D_MODEL ** -0.5),
        "ada_b": nrm(ks[4], (DEPTH, N_MOD * D_MODEL), 0.02),
        "norm_mix_w": 1.0 + nrm(ks[5], (DEPTH, D_MODEL), 0.02),
        "norm_mlp_w": 1.0 + nrm(ks[6], (DEPTH, D_MODEL), 0.02),
        "w_in": nrm(ks[7], (DEPTH, D_MODEL, D_IN), D_MODEL ** -0.5),
        "conv_w": nrm(ks[8], (DEPTH, CONV_WIDTH, 2 * MLSTM_W), CONV_WIDTH ** -0.5),
        "conv_b": nrm(ks[9], (DEPTH, 2 * MLSTM_W), 0.02),
        "fox_f_bias": jax.random.uniform(ks[10], (DEPTH, FOX_HEADS), jnp.float32, 1.0, 4.0),
        "mlstm_i_bias": nrm(ks[11], (DEPTH, MLSTM_HEADS), 0.1),
        "mlstm_f_bias": jax.random.uniform(ks[12], (DEPTH, MLSTM_HEADS), jnp.float32, 3.0, 6.0),
        "merge_scale": 1.0 + nrm(ks[13], (DEPTH, D_MIX), 0.02),
        "w_out": nrm(ks[14], (DEPTH, D_MIX, D_MODEL), D_MIX ** -0.5),
        "w_ff1": nrm(ks[15], (DEPTH, D_MODEL, D_FF), D_MODEL ** -0.5),
        "w_ff2": nrm(ks[16], (DEPTH, D_FF, D_MODEL), D_FF ** -0.5),
        "final_norm_w": 1.0 + nrm(ks[17], (D_MODEL,), 0.02),
    }


def reference(x, c, positions, ada_w, ada_b, norm_mix_w, norm_mlp_w, w_in, conv_w, conv_b,
              fox_f_bias, mlstm_i_bias, mlstm_f_bias, merge_scale, w_out, w_ff1, w_ff2, final_norm_w):
    cond = jax.nn.silu(c)
    for layer in range(DEPTH):
        mod = (cond @ ada_w[layer] + ada_b[layer])[:, None, :]
        sh_a, sc_a, g_a, sh_m, sc_m, g_m = jnp.split(mod, N_MOD, axis=-1)
        h = rmsnorm(x, norm_mix_w[layer]) * (1.0 + sc_a) + sh_a
        x = x + g_a * hybrid_mixer(h, positions, w_in[layer], conv_w[layer], conv_b[layer],
                                   fox_f_bias[layer], mlstm_i_bias[layer], mlstm_f_bias[layer],
                                   merge_scale[layer], w_out[layer])
        h = rmsnorm(x, norm_mlp_w[layer]) * (1.0 + sc_m) + sh_m
        x = x + g_m * (jnp.square(jax.nn.relu(h @ w_ff1[layer])) @ w_ff2[layer])
    return rmsnorm(x, final_norm_w)
```

```cpp
#include <hip/hip_runtime.h>
#include <hip/hip_bf16.h>
#include <hip/hip_cooperative_groups.h>
#include <cstdio>
#include <cstdint>
namespace cg = cooperative_groups;

constexpr int NB = 2, SEQ = 16384, DM = 2048, MROWS = NB * SEQ, DIN = 7184, NINP = 7168, DFF = 8192, HD = 128, NMOD = 6 * DM;
constexpr int NSLOT = 56;
constexpr float NORM_EPS = 1e-6f;
constexpr float KSCALE = 0.08838834764831845f;

__device__ __forceinline__ int lz_tid() { const int w = __builtin_amdgcn_readfirstlane((int)threadIdx.x >> 6); int l; asm volatile("v_mbcnt_lo_u32_b32 %0, -1, 0\n\tv_mbcnt_hi_u32_b32 %0, -1, %0" : "=v"(l));
    int t = w * 64 + l; asm volatile("" : "+v"(t)); return t; }
__device__ __forceinline__ int lz_bid() { int b = blockIdx.x; asm volatile("" : "+s"(b)); return b; }

namespace pg8 {
#define PG8_LAS __attribute__((address_space(3)))
typedef unsigned short bf16_t;
typedef short bf16x8 __attribute__((ext_vector_type(8)));
typedef float f32x4 __attribute__((ext_vector_type(4)));
typedef unsigned u32x4 __attribute__((ext_vector_type(4)));
constexpr int BM = 256, BK = 64, HALF = 128, HTB = HALF * BK * 2  , STAGE_BYTES = 8 * HTB, NXCD = 8, WGM = 4;

__host__ __device__ __forceinline__ int lds_byte(int r, int c) { const int st = (r >> 4) * 2 + (c >> 5), rr = r & 15, cc = c & 31, ob = rr * 64 + cc * 2; return st * 1024 + (ob ^ (((ob >> 9) & 1) << 5)); }
__host__ __device__ __forceinline__ void stage_rc(int b, int& R, int& C) { const int st = b / 1024, sb = b % 1024, swz = sb ^ (((sb >> 9) & 1) << 5); R = (st >> 1) * 16 + swz / 64; C = (st & 1) * 32 + (swz % 64) / 2; }
__host__ __device__ __forceinline__ int perm32(int rho) { const int n = rho >> 4, i = rho & 15; return 8 * (i >> 2) + 4 * n + (i & 3); }

struct Unit { int pm, pn; };
struct Gemm { const bf16_t* A; const bf16_t* Bt; int M, N, K; };

struct StaticOrder {
    int nM, nN, nwg, G, c;
    __host__ __device__ void init(int M, int N, int G_, int c_) { nM = M / BM; nN = N / BM; nwg = nM * nN; G = G_; c = c_; }
    __host__ __device__ bool next(int i, Unit& u) const {
        const long L = (long)i * G + c; if (L >= nwg) return false;
        int wgid = (int)L; { const int q = nwg / NXCD, r = nwg % NXCD, xcd = wgid % NXCD, off = wgid / NXCD; wgid = (xcd < r ? xcd * (q + 1) : r * (q + 1) + (xcd - r) * q) + off; }
        const int nig = WGM * nN, gid = wgid / nig, fm = gid * WGM, gsz = (nM - fm) < WGM ? (nM - fm) : WGM;
        u.pm = fm + ((wgid % nig) % gsz); u.pn = (wgid % nig) / gsz; return true;
    }
    __device__ __forceinline__ void a_ready(const Unit&) const {}
    __device__ __forceinline__ void done(const Unit&) const {}
};

__device__ __forceinline__ unsigned cvt_pk_bf16(float lo, float hi) { unsigned r; asm volatile("v_cvt_pk_bf16_f32 %0, %1, %2" : "=v"(r) : "v"(lo), "v"(hi)); return r; }

typedef float epf2_t __attribute__((ext_vector_type(2))); typedef __bf16 epb2_t __attribute__((ext_vector_type(2)));
__device__ __forceinline__ unsigned cvt_pk_c(float lo, float hi) { epf2_t v = {lo, hi}; epb2_t b = __builtin_convertvector(v, epb2_t); return __builtin_bit_cast(unsigned, b); }
struct EpiIn {
    static constexpr bool PERM = true, AFTER_DRAIN = false;
    bf16_t* P; float* gates;
    __device__ __forceinline__ void operator()(const f32x4 (&acc)[2][2][4][2], const Unit& u, int wr, int wc, int fr, int fq) const {
        const int row0 = u.pm * BM + wr * 64 + fr;
#pragma unroll
        for (int bj = 0; bj < 2; ++bj) {
            const int g = 2 * u.pn + bj;
            if (g < 56) {
                bf16_t* base = P + ((size_t)g * MROWS + row0) * 128 + wc * 32 + 8 * fq;
#pragma unroll
                for (int ai = 0; ai < 2; ++ai)
#pragma unroll
                    for (int m = 0; m < 4; ++m) { const f32x4 v0 = acc[ai][bj][m][0], v1 = acc[ai][bj][m][1];
                        u32x4 w; w.x = cvt_pk_c(v0[0], v0[1]); w.y = cvt_pk_c(v0[2], v0[3]); w.z = cvt_pk_c(v1[0], v1[1]); w.w = cvt_pk_c(v1[2], v1[3]);
                        __builtin_nontemporal_store(w, (u32x4*)(base + (size_t)(ai * HALF + m * 16) * 128)); }
            } else if (g == 56) {
                if (wc == 0 && fq < 2) { float* gp = gates + (size_t)row0 * 16 + 8 * fq;
#pragma unroll
                    for (int ai = 0; ai < 2; ++ai)
#pragma unroll
                        for (int m = 0; m < 4; ++m) { *(f32x4*)(gp + (size_t)(ai * HALF + m * 16) * 16) = acc[ai][bj][m][0]; *(f32x4*)(gp + (size_t)(ai * HALF + m * 16) * 16 + 4) = acc[ai][bj][m][1]; } }
            }
        }
    }
};
struct EpiRes {
    static constexpr bool PERM = true, AFTER_DRAIN = false;
    const float* base; float* out; const float* gvec;
    __device__ __forceinline__ void operator()(const f32x4 (&acc)[2][2][4][2], const Unit& u, int wr, int wc, int fr, int fq) const {
        const int row0 = u.pm * BM + wr * 64 + fr; const int b = (u.pm * BM) / SEQ; const float* gv = gvec + (size_t)b * NMOD;
#pragma unroll
        for (int bj = 0; bj < 2; ++bj) { const int c = u.pn * BM + bj * HALF + wc * 32 + 8 * fq;
            const f32x4 g0 = *(const f32x4*)(gv + c), g1 = *(const f32x4*)(gv + c + 4);
#pragma unroll
            for (int ai = 0; ai < 2; ++ai)
#pragma unroll
                for (int m = 0; m < 4; ++m) { const size_t off = (size_t)(row0 + ai * HALF + m * 16) * DM + c;
                    const f32x4 x0 = *(const f32x4*)(base + off), x1 = *(const f32x4*)(base + off + 4);
                    __builtin_nontemporal_store(x0 + g0 * acc[ai][bj][m][0], (f32x4*)(out + off)); __builtin_nontemporal_store(x1 + g1 * acc[ai][bj][m][1], (f32x4*)(out + off + 4)); } }
    }
};
struct EpiRelu2 {
    static constexpr bool PERM = true, AFTER_DRAIN = false;
    bf16_t* O; int ldc;
    __device__ __forceinline__ void operator()(const f32x4 (&acc)[2][2][4][2], const Unit& u, int wr, int wc, int fr, int fq) const {
        const int row0 = u.pm * BM + wr * 64 + fr;
#pragma unroll
        for (int bj = 0; bj < 2; ++bj) { bf16_t* base = O + (size_t)row0 * ldc + u.pn * BM + bj * HALF + wc * 32 + 8 * fq;
#pragma unroll
            for (int ai = 0; ai < 2; ++ai)
#pragma unroll
                for (int m = 0; m < 4; ++m) { f32x4 v0 = acc[ai][bj][m][0], v1 = acc[ai][bj][m][1];
#pragma unroll
                    for (int i = 0; i < 4; ++i) { const float a = v0[i] > 0.f ? v0[i] : 0.f, b = v1[i] > 0.f ? v1[i] : 0.f; v0[i] = a * a; v1[i] = b * b; }
                    u32x4 w; w.x = cvt_pk_c(v0[0], v0[1]); w.y = cvt_pk_c(v0[2], v0[3]); w.z = cvt_pk_c(v1[0], v1[1]); w.w = cvt_pk_c(v1[2], v1[3]);
                    __builtin_nontemporal_store(w, (u32x4*)(base + (size_t)(ai * HALF + m * 16) * ldc)); } }
    }
};

template <class Epi, class Sched, bool ALIGN_EPI = false, bool SP2 = false>
__device__ __forceinline__ void gemm_phase(PG8_LAS unsigned char* lds, const Gemm g, const Sched& S, const Epi& E) {
    const int tid = lz_tid(), wid = __builtin_amdgcn_readfirstlane(tid >> 6), lane = tid & 63, wr = wid >> 2, wc = wid & 3, fr = lane & 15, fq = lane >> 4;
    const int K = g.K, nt = K / BK;
    unsigned voffA[2], voffB[2];
#pragma unroll
    for (int i = 0; i < 2; ++i) { int R, C; stage_rc(tid * 16 + i * 8192, R, C); const int Rb = Epi::PERM ? ((R & ~31) + perm32(R & 31)) : R;
        voffA[i] = (unsigned)(R * K + C) * 2u; voffB[i] = (unsigned)(Rb * K + C) * 2u; }
    const size_t kstep = (size_t)(BK * 2);
    const size_t hstep = (size_t)HALF * K * 2;
    const size_t tstep = 2 * hstep;
    const unsigned ldsw = (unsigned)wid * 1024u;
    const int aoff = lds_byte(wr * 64 + fr, fq * 8), boff = lds_byte(wc * 32 + fr, fq * 8);
#define PG8_SA(b, h) (((b) * 2 + (h)) * HTB)
#define PG8_SB(b, h) ((4 + (b) * 2 + (h)) * HTB)
#define PG8_STAGE(bufoff, gbase, voff) do { _Pragma("unroll") for (int _i = 0; _i < 2; ++_i) \
        __builtin_amdgcn_global_load_lds((const unsigned*)((const char*)(gbase) + (voff)[_i]), (PG8_LAS unsigned*)(lds + (bufoff) + ldsw + _i * 8192), 16, 0, 0); } while (0)
#define PG8_LDA(dst, b, h) do { _Pragma("unroll") for (int m = 0; m < 4; ++m) _Pragma("unroll") for (int k = 0; k < 2; ++k) dst[m][k] = *(const PG8_LAS bf16x8*)(lds + PG8_SA(b, h) + aoff + m * 2048 + k * 1024); } while (0)
#define PG8_LDB(dst, b, h) do { _Pragma("unroll") for (int n = 0; n < 2; ++n) _Pragma("unroll") for (int k = 0; k < 2; ++k) dst[n][k] = *(const PG8_LAS bf16x8*)(lds + PG8_SB(b, h) + boff + n * 2048 + k * 1024); } while (0)
#define PG8_MMA(ai, bj, At, Bt) do { __builtin_amdgcn_s_setprio(1); _Pragma("unroll") for (int m = 0; m < 4; ++m) _Pragma("unroll") for (int n = 0; n < 2; ++n) _Pragma("unroll") for (int k = 0; k < 2; ++k) \
        acc[ai][bj][m][n] = __builtin_amdgcn_mfma_f32_16x16x32_bf16(Bt[n][k], At[m][k], acc[ai][bj][m][n], 0, 0, 0); __builtin_amdgcn_s_setprio(0); } while (0)
#define PG8_WAIT_V(n) asm volatile("s_waitcnt vmcnt(" #n ")" ::: "memory")
#define PG8_WAIT_L(n) asm volatile("s_waitcnt lgkmcnt(" #n ")" ::: "memory")
#define PG8_BAR __builtin_amdgcn_s_barrier()
#define PG8_SCHED __builtin_amdgcn_sched_barrier(0)
    Unit cur, nxt; int ui = 0;
    if (!S.next(0, cur)) return;
    f32x4 acc[2][2][4][2];
#pragma unroll
    for (int a = 0; a < 2; ++a)
#pragma unroll
        for (int b = 0; b < 2; ++b)
#pragma unroll
            for (int m = 0; m < 4; ++m)
#pragma unroll
                for (int n = 0; n < 2; ++n) acc[a][b][m][n] = (f32x4){0.f, 0.f, 0.f, 0.f};
    bf16x8 At[4][2], B0[2][2], B1[2][2];
    const char* cA = (const char*)g.A + (size_t)cur.pm * tstep; const char* cB = (const char*)g.Bt + (size_t)cur.pn * tstep;
    S.a_ready(cur);
    if constexpr (SP2) {
        PG8_STAGE(PG8_SB(0, 0), cB, voffB); PG8_STAGE(PG8_SB(0, 1), cB + hstep, voffB); PG8_STAGE(PG8_SA(0, 0), cA, voffA); PG8_STAGE(PG8_SA(0, 1), cA + hstep, voffA);
        if (wr == 1) PG8_BAR;
        PG8_WAIT_V(2); PG8_BAR;
        PG8_STAGE(PG8_SB(1, 0), cB + kstep, voffB); PG8_STAGE(PG8_SA(1, 0), cA + kstep, voffA); PG8_STAGE(PG8_SB(1, 1), cB + hstep + kstep, voffB);
        PG8_WAIT_V(6); PG8_BAR;
    } else {
        PG8_STAGE(PG8_SB(0, 0), cB, voffB); PG8_STAGE(PG8_SA(0, 0), cA, voffA); PG8_STAGE(PG8_SB(0, 1), cB + hstep, voffB); PG8_STAGE(PG8_SA(0, 1), cA + hstep, voffA);
        if (wr == 1) PG8_BAR;
        PG8_WAIT_V(4); PG8_BAR;
        PG8_STAGE(PG8_SB(1, 0), cB + kstep, voffB); PG8_STAGE(PG8_SA(1, 0), cA + kstep, voffA); PG8_STAGE(PG8_SB(1, 1), cB + hstep + kstep, voffB);
        PG8_WAIT_V(6); PG8_BAR;
    }
    for (;;) {
        const bool has_next = S.next(ui + 1, nxt);
        const char* nA = has_next ? (const char*)g.A + (size_t)nxt.pm * tstep : cA; const char* nB = has_next ? (const char*)g.Bt + (size_t)nxt.pn * tstep : cB;
        for (int t = 0; t < nt; t += 2) {
            const bool last = (t == nt - 2);
            const char* a1 = cA + (size_t)(t + 1) * kstep;
            const char* a2 = last ? nA : cA + (size_t)(t + 2) * kstep; const char* b2 = last ? nB : cB + (size_t)(t + 2) * kstep;
            const char* a3 = a2 + kstep; const char* b3 = b2 + kstep;
            if (last && has_next) S.a_ready(nxt);
            if constexpr (SP2) {
            PG8_LDB(B0, 0, 0); PG8_LDB(B1, 0, 1); PG8_SCHED; PG8_LDA(At, 0, 0); PG8_STAGE(PG8_SA(1, 1), a1 + hstep, voffA);
            PG8_WAIT_V(8); PG8_WAIT_L(0); PG8_BAR; PG8_MMA(0, 0, At, B0); PG8_MMA(0, 1, At, B1); PG8_BAR; PG8_SCHED;
            PG8_LDA(At, 0, 1); PG8_STAGE(PG8_SB(0, 0), b2, voffB); PG8_STAGE(PG8_SB(0, 1), b2 + hstep, voffB); PG8_STAGE(PG8_SA(0, 0), a2, voffA);
            PG8_WAIT_V(8); PG8_WAIT_L(0); PG8_BAR; PG8_MMA(1, 0, At, B0); PG8_MMA(1, 1, At, B1); PG8_BAR; PG8_SCHED;
            PG8_LDB(B0, 1, 0); PG8_LDB(B1, 1, 1); PG8_SCHED; PG8_LDA(At, 1, 0); PG8_STAGE(PG8_SA(0, 1), a2 + hstep, voffA);
            PG8_WAIT_V(8); PG8_WAIT_L(0); PG8_BAR; PG8_MMA(0, 0, At, B0); PG8_MMA(0, 1, At, B1); PG8_BAR; PG8_SCHED;
            PG8_LDA(At, 1, 1); PG8_STAGE(PG8_SB(1, 0), b3, voffB); PG8_STAGE(PG8_SB(1, 1), b3 + hstep, voffB); PG8_STAGE(PG8_SA(1, 0), a3, voffA);
            PG8_WAIT_V(8); PG8_WAIT_L(0); PG8_BAR; PG8_MMA(1, 0, At, B0); PG8_MMA(1, 1, At, B1); PG8_BAR; PG8_SCHED;
            } else {
            PG8_LDB(B0, 0, 0); PG8_SCHED; PG8_LDA(At, 0, 0); PG8_STAGE(PG8_SA(1, 1), a1 + hstep, voffA);
            PG8_WAIT_L(8); PG8_BAR; PG8_WAIT_L(0); PG8_MMA(0, 0, At, B0); PG8_BAR; PG8_SCHED;
            PG8_LDB(B1, 0, 1); PG8_STAGE(PG8_SB(0, 0), b2, voffB);
            PG8_BAR; PG8_WAIT_L(0); PG8_MMA(0, 1, At, B1); PG8_BAR;
            PG8_LDA(At, 0, 1); PG8_STAGE(PG8_SA(0, 0), a2, voffA);
            PG8_BAR; PG8_WAIT_L(0); PG8_MMA(1, 0, At, B0); PG8_BAR; PG8_SCHED;
            PG8_STAGE(PG8_SB(0, 1), b2 + hstep, voffB);
            PG8_WAIT_V(6); PG8_BAR; PG8_MMA(1, 1, At, B1); PG8_BAR;
            PG8_LDB(B0, 1, 0); PG8_SCHED; PG8_LDA(At, 1, 0); PG8_STAGE(PG8_SA(0, 1), a2 + hstep, voffA);
            PG8_WAIT_L(8); PG8_BAR; PG8_WAIT_L(0); PG8_MMA(0, 0, At, B0); PG8_BAR; PG8_SCHED;
            PG8_LDB(B1, 1, 1); PG8_STAGE(PG8_SB(1, 0), b3, voffB);
            PG8_BAR; PG8_WAIT_L(0); PG8_MMA(0, 1, At, B1); PG8_BAR;
            PG8_LDA(At, 1, 1); PG8_STAGE(PG8_SA(1, 0), a3, voffA);
            PG8_BAR; PG8_WAIT_L(0); PG8_MMA(1, 0, At, B0); PG8_BAR; PG8_SCHED;
            PG8_STAGE(PG8_SB(1, 1), b3 + hstep, voffB);
            PG8_WAIT_V(6); PG8_BAR; PG8_MMA(1, 1, At, B1); PG8_BAR;
            }
        }
        if constexpr (ALIGN_EPI) { if (wr == 0) PG8_BAR; }
        if constexpr (!Epi::AFTER_DRAIN) { E(acc, cur, wr, wc, fr, fq); S.done(cur); }
        if (!has_next) break;
#pragma unroll
        for (int a = 0; a < 2; ++a)
#pragma unroll
            for (int b = 0; b < 2; ++b)
#pragma unroll
                for (int m = 0; m < 4; ++m)
#pragma unroll
                    for (int n = 0; n < 2; ++n) acc[a][b][m][n] = (f32x4){0.f, 0.f, 0.f, 0.f};
        cur = nxt; cA = nA; cB = nB; ++ui;
        if constexpr (ALIGN_EPI) { if (wr == 1) PG8_BAR; }
    }
    PG8_WAIT_V(0);
    if constexpr (!ALIGN_EPI) { if (wr == 0) PG8_BAR; }
    PG8_BAR;
    if constexpr (Epi::AFTER_DRAIN) { E.fused(acc, cur, wr, wc, fr, fq, lds, wid, lane); S.done(cur); }
#undef PG8_SA
#undef PG8_SB
#undef PG8_STAGE
#undef PG8_LDA
#undef PG8_LDB
#undef PG8_MMA
#undef PG8_WAIT_V
#undef PG8_WAIT_L
#undef PG8_BAR
#undef PG8_SCHED
}
}
namespace fox {
constexpr int D = 128; constexpr float THR = 8.f; constexpr bool WSKIP = false; constexpr int OSTR = 2048;
constexpr float SCALE = 0.08838834764831845f;
constexpr int NW = 8, QBLK = 32, KVBLK = 64, QB = NW * QBLK;
constexpr int SHM_V = KVBLK * D * 2, SHM_K = KVBLK * D * 2;
constexpr int LDS_CB = 2 * SHM_V + 2 * SHM_K + NW * 64 * 4; constexpr int LDS_BYTES = LDS_CB + 2 * 64 * 4;

using bf16 = __hip_bfloat16;
typedef short bf16x8 __attribute__((ext_vector_type(8)));
typedef short s16x4 __attribute__((ext_vector_type(4)));
typedef float f32x16 __attribute__((ext_vector_type(16)));
typedef float f32x4 __attribute__((ext_vector_type(4)));
typedef unsigned u32x4 __attribute__((ext_vector_type(4)));
template <class A, class Bt> struct same_t { static constexpr bool v = false; };
template <class A> struct same_t<A, A> { static constexpr bool v = true; };

#define KSWZ(row, colB) ((row) * 256 + ((colB) ^ (((row) & 7) << 4)))
#define SBAR() __builtin_amdgcn_sched_barrier(0)
__device__ __forceinline__ int v_st(int k, int c) { const int kk = (k & ~0xC) | ((k & 4) << 1) | ((k & 8) >> 1); return ((kk >> 3) * 4 + (c >> 5)) * 512 + ((kk & 7) * 32 + (c & 31)) * 2; }
__device__ __forceinline__ int v_rd_base(int lane) { return ((lane & 3) << 3) | (((lane >> 2) & 3) << 6) | (((lane >> 4) & 1) << 5) | (((lane >> 5) & 1) << 8); }
constexpr int v_rd_off(int d0, int ks, int half) { return d0 * 512 + ks * 4096 + half * 2048; }
__device__ __forceinline__ int crow(int r, int hi) { return (r & 3) + 8 * (r >> 2) + 4 * hi; }
__device__ __forceinline__ unsigned cvtpk(float lo, float hi) {
    unsigned r; asm volatile("v_cvt_pk_bf16_f32 %0, %1, %2" : "=v"(r) : "v"(lo), "v"(hi)); return r;
}
__device__ __forceinline__ bf16x8 pack8(f32x4 a, f32x4 b) {
    u32x4 w = {cvtpk(a[0], a[1]), cvtpk(a[2], a[3]), cvtpk(b[0], b[1]), cvtpk(b[2], b[3])};
    return *reinterpret_cast<bf16x8*>(&w);
}
template <class T> __device__ __forceinline__ bf16x8 load8(const T* p) {
    if constexpr (same_t<T, float>::v) { return pack8(*(const f32x4*)p, *(const f32x4*)(p + 4)); }
    else { return *reinterpret_cast<const bf16x8*>(p); }
}
__device__ __forceinline__ void mask_tile(f32x16& p0, f32x16& p1, int dq, unsigned W) {
    const float NEG = -__builtin_inff();
#pragma unroll
    for (int r = 0; r < 16; ++r) {
        const int c = (r & 3) + 8 * (r >> 2);
        if ((unsigned)(dq - c) >= W) p0[r] = NEG;
        if ((unsigned)(dq - c - 32) >= W) p1[r] = NEG;
    }
}
__device__ __forceinline__ void partialSM(f32x16& p0, f32x16& p1, float& m_reg, float& mn, float& alpha) {
    float pmax = p0[0]; for (int r = 1; r < 16; ++r) pmax = fmaxf(pmax, p0[r]); for (int r = 0; r < 16; ++r) pmax = fmaxf(pmax, p1[r]);
    { auto rr = __builtin_amdgcn_permlane32_swap(__float_as_uint(pmax), __float_as_uint(pmax), false, false);
      pmax = fmaxf(__uint_as_float(rr[0]), __uint_as_float(rr[1])); }
    constexpr float C2 = 1.4426950408889634f * SCALE;
    if (__builtin_expect(__all((pmax - m_reg) * SCALE <= THR), 1)) { mn = m_reg; alpha = 1.f; }
    else { mn = fmaxf(m_reg, pmax); alpha = __builtin_amdgcn_exp2f((m_reg - mn) * C2); m_reg = mn; }
    const float mnL = -mn * C2;
    for (int r = 0; r < 16; ++r) p0[r] = fmaf(p0[r], C2, mnL); for (int r = 0; r < 16; ++r) p1[r] = fmaf(p1[r], C2, mnL);
    for (int r = 0; r < 16; ++r) p0[r] = __builtin_amdgcn_exp2f(p0[r]);
}
__device__ __forceinline__ void finishSM(f32x16& p0, f32x16& p1, float alpha, float& l_reg, bf16x8& pa0, bf16x8& pa1, bf16x8& pa2, bf16x8& pa3) {
    for (int r = 0; r < 16; ++r) p1[r] = __builtin_amdgcn_exp2f(p1[r]);
    float ps = 0; for (int r = 0; r < 16; ++r) ps += p0[r]; for (int r = 0; r < 16; ++r) ps += p1[r];
    { auto rr = __builtin_amdgcn_permlane32_swap(__float_as_uint(ps), __float_as_uint(ps), false, false);
      ps = __uint_as_float(rr[0]) + __uint_as_float(rr[1]); }
    l_reg = l_reg * alpha + ps;
#define PK4(P, B_, OUT) do { unsigned a0 = cvtpk(P[B_+0], P[B_+1]), a1 = cvtpk(P[B_+2], P[B_+3]);                          \
        unsigned b0 = cvtpk(P[B_+4], P[B_+5]), b1 = cvtpk(P[B_+6], P[B_+7]);                                             \
        auto r0 = __builtin_amdgcn_permlane32_swap(a0, b0, false, false); auto r1 = __builtin_amdgcn_permlane32_swap(a1, b1, false, false); \
        u32x4 w = {r0[0], r1[0], r0[1], r1[1]}; OUT = *reinterpret_cast<bf16x8*>(&w); } while (0)
    PK4(p0, 0, pa0); PK4(p0, 8, pa1); PK4(p1, 0, pa2); PK4(p1, 8, pa3);
#undef PK4
}
template <int KB, bool SK>
__device__ __forceinline__ void qkt(f32x16& p0, f32x16& p1, const char* K_lds, const float* cb, int r32, int hi, const bf16x8* qr, bool act) {
    if (SK && !act) { const float NEG = -__builtin_inff();
#pragma unroll
        for (int r = 0; r < 16; ++r) { p0[r] = NEG; p1[r] = NEG; } return; }
    { const float* cbp = cb + KB * 64 + 4 * hi;
#pragma unroll
      for (int g = 0; g < 4; ++g) { const f32x4 t0 = *(const f32x4*)(cbp + 8 * g), t1 = *(const f32x4*)(cbp + 32 + 8 * g);
        p0[4*g] = t0[0]; p0[4*g+1] = t0[1]; p0[4*g+2] = t0[2]; p0[4*g+3] = t0[3]; p1[4*g] = t1[0]; p1[4*g+1] = t1[1]; p1[4*g+2] = t1[2]; p1[4*g+3] = t1[3]; } }
    const char* kb[4];
#pragma unroll
    for (int dd = 0; dd < 4; ++dd) kb[dd] = K_lds + KB * SHM_K + KSWZ(r32, (dd * 16 + hi * 8) * 2);
#pragma unroll
    for (int d0 = 0; d0 < 8; ++d0) { const char* a = kb[d0 & 3] + (d0 >> 2) * 128;
        bf16x8 b0 = *reinterpret_cast<const bf16x8*>(a);
        bf16x8 b1 = *reinterpret_cast<const bf16x8*>(a + 32 * 256);
        p0 = __builtin_amdgcn_mfma_f32_32x32x16_bf16(b0, qr[d0], p0, 0, 0, 0);
        p1 = __builtin_amdgcn_mfma_f32_32x32x16_bf16(b1, qr[d0], p1, 0, 0, 0); }
}
template <int VB, bool SK>
__device__ __forceinline__ void pv_tile(f32x16* o, int vb0, bf16x8 pa0, bf16x8 pa1, bf16x8 pa2, bf16x8 pa3, bool act) {
    if (SK && !act) return;
#define TRRD(dst, off) asm volatile("ds_read_b64_tr_b16 %0, %1 offset:%2" : "=&v"(dst) : "v"(vb0), "i"(off) : "memory")
#define PV_D0(d0) do { s16x4 l0, l1, l2, l3, h0, h1, h2, h3; constexpr int b_ = VB * SHM_V + v_rd_off(d0, 0, 0);     \
        TRRD(l0, b_); TRRD(h0, b_ + 2048); TRRD(l1, b_ + 4096); TRRD(h1, b_ + 6144); TRRD(l2, b_ + 8192); TRRD(h2, b_ + 10240); TRRD(l3, b_ + 12288); TRRD(h3, b_ + 14336); \
        asm volatile("s_waitcnt lgkmcnt(0)" ::: "memory"); SBAR();                 \
        o[d0] = __builtin_amdgcn_mfma_f32_32x32x16_bf16(pa0, (bf16x8){l0[0], l0[1], l0[2], l0[3], h0[0], h0[1], h0[2], h0[3]}, o[d0], 0, 0, 0);   \
        o[d0] = __builtin_amdgcn_mfma_f32_32x32x16_bf16(pa1, (bf16x8){l1[0], l1[1], l1[2], l1[3], h1[0], h1[1], h1[2], h1[3]}, o[d0], 0, 0, 0);   \
        o[d0] = __builtin_amdgcn_mfma_f32_32x32x16_bf16(pa2, (bf16x8){l2[0], l2[1], l2[2], l2[3], h2[0], h2[1], h2[2], h2[3]}, o[d0], 0, 0, 0);   \
        o[d0] = __builtin_amdgcn_mfma_f32_32x32x16_bf16(pa3, (bf16x8){l3[0], l3[1], l3[2], l3[3], h3[0], h3[1], h3[2], h3[3]}, o[d0], 0, 0, 0); } while (0)
    PV_D0(0); PV_D0(1); PV_D0(2); PV_D0(3);
#undef PV_D0
#undef TRRD
}

template <class TIn, class TOut> struct BlockRef { const TIn* Q; TOut* O; const float* MS; unsigned K, V, C; int P0; int JLO; };
__device__ __forceinline__ bf16x8 bl128(__amdgpu_buffer_rsrc_t rs, unsigned vo, unsigned so) { return __builtin_bit_cast(bf16x8, __builtin_amdgcn_raw_buffer_load_b128(rs, (int)vo, (int)so, 0)); }
__device__ __forceinline__ float bl32(__amdgpu_buffer_rsrc_t rs, unsigned vo, unsigned so) { return __builtin_bit_cast(float, __builtin_amdgcn_raw_buffer_load_b32(rs, (int)vo, (int)so, 0)); }
template <class TIn> struct Seam {
    bf16x8 qr[8];
    bf16x8 st_v0, st_v1, st_k0, st_k1; f32x4 sf0, sf1, sf2, sf3; float st_c;
    f32x4 tq[16];
};
__device__ __forceinline__ int swa_jlo(int P0, int W) { const int lowk = P0 - W + 1; return lowk > 0 ? lowk / KVBLK : 0; }
#define ROW(p, k0, rr) ((p) + (unsigned)(((k0) + (rr)) * D + sc))
#define VMW() asm volatile("s_waitcnt vmcnt(0)" ::: "memory")
#define VMWN(n) asm volatile("s_waitcnt vmcnt(%0)" :: "i"(n) : "memory")
#define SLOAD_H(Kp, Vp, Cp, k0) do { if (tid < 64) S.st_c = bl32(rs, (unsigned)tid * 4u, (Cp) + (unsigned)(k0) * 4u); \
        S.st_v0 = bl128(rs, vo_st, (Vp) + (unsigned)(k0) * 256u); S.st_v1 = bl128(rs, vo_st, (Vp) + (unsigned)(k0) * 256u + 8192u); \
        S.st_k0 = bl128(rs, vo_st, (Kp) + (unsigned)(k0) * 256u); S.st_k1 = bl128(rs, vo_st, (Kp) + (unsigned)(k0) * 256u + 8192u); } while (0)
#define SWRITE_HK(bf) do { if (tid < 64) cb_l[(bf) * 64 + tid] = S.st_c;  *(bf16x8*)(K_lds + (bf) * SHM_K + kws) = S.st_k0; *(bf16x8*)(K_lds + (bf) * SHM_K + kws + 32 * 256) = S.st_k1; } while (0)
#define SWRITE_HV(bf) do { *(bf16x8*)(V_lds + (bf) * SHM_V + vst0) = S.st_v0; *(bf16x8*)(V_lds + (bf) * SHM_V + vst1) = S.st_v1; } while (0)
#define SWRITE_H(bf) do { SWRITE_HV(bf); SWRITE_HK(bf); } while (0)
#define SLOAD_F(p, k0) do { S.sf0 = *(const f32x4*)ROW(p, k0, sr); S.sf1 = *(const f32x4*)(ROW(p, k0, sr) + 4);                \
                            S.sf2 = *(const f32x4*)ROW(p, k0, 32 + sr); S.sf3 = *(const f32x4*)(ROW(p, k0, 32 + sr) + 4); } while (0)
#define SWRITE_KF(bf) do { *(bf16x8*)(K_lds + (bf) * SHM_K + kws) = pack8(S.sf0, S.sf1); *(bf16x8*)(K_lds + (bf) * SHM_K + kws + 32 * 256) = pack8(S.sf2, S.sf3); } while (0)
#define SWRITE_VF(bf) do { *(bf16x8*)(V_lds + (bf) * SHM_V + vst0) = pack8(S.sf0, S.sf1); *(bf16x8*)(V_lds + (bf) * SHM_V + vst1) = pack8(S.sf2, S.sf3); } while (0)
template <class TIn, class TOut>
__device__ __forceinline__ void causal_swa_prime(const BlockRef<TIn, TOut>& cur, int W, char* lds, Seam<TIn>& S, __amdgpu_buffer_rsrc_t rs) {
    constexpr bool F32 = same_t<TIn, float>::v;
    const int tid = lz_tid(), wid = __builtin_amdgcn_readfirstlane(tid >> 6), lane = tid & 63, r32 = lane & 31, hi = lane >> 5;
    const int sr = tid >> 4, sc = (tid & 15) * 8, kws = KSWZ(sr, sc * 2); char* K_lds = lds + 2 * SHM_V; float* cb_l = (float*)(lds + LDS_CB); const unsigned vo_st = (unsigned)(sr * D + sc) * 2u;
    const int kb0 = swa_jlo(cur.P0, W) * KVBLK;
    for (int d0 = 0; d0 < 8; ++d0) S.qr[d0] = load8<TIn>(cur.Q + (unsigned)((wid * QBLK + r32) * D + d0 * 16 + hi * 8));
    if constexpr (F32) { SLOAD_F((const float*)cur.K, kb0); VMW(); SWRITE_KF(0); SBAR(); SLOAD_F((const float*)cur.V, kb0); }
    else { SLOAD_H(cur.K, cur.V, cur.C, kb0); VMW(); SWRITE_HK(0); }
    __syncthreads();
}
template <class TIn, class TOut>
__device__ __forceinline__ void causal_swa_block(const BlockRef<TIn, TOut>& cur, const BlockRef<TIn, TOut>& nxt, int skv, int W, char* lds, Seam<TIn>& S, __amdgpu_buffer_rsrc_t rs) {
    constexpr bool F32 = same_t<TIn, float>::v;
    const int tid = lz_tid(), wid = __builtin_amdgcn_readfirstlane(tid >> 6), lane = tid & 63, r32 = lane & 31, hi = lane >> 5;
    const int j_lo = swa_jlo(cur.P0, W);
    int j_hi = (cur.P0 + QB - 1) / KVBLK + 1; if (j_hi > skv / KVBLK) j_hi = skv / KVBLK;
    const int NT = j_hi - j_lo;
    const int kbn = swa_jlo(nxt.P0, W) * KVBLK;
    const int qlo = cur.P0 + wid * QBLK, qm = qlo + r32 - 4 * hi;
    char* V_lds = lds; char* K_lds = lds + 2 * SHM_V; float* cb_l = (float*)(lds + LDS_CB);
    float* ws = (float*)(lds + 2 * SHM_V + 2 * SHM_K) + wid * 64; float* li_l = ws, * al_l = ws + 32;
    float m_reg = -1e30f, l_reg = 0; f32x16 o[4] = {};
    const unsigned vo_st = (unsigned)((tid >> 4) * D + (tid & 15) * 8) * 2u; const int sr = tid >> 4, sc = (tid & 15) * 8, vst0 = v_st(sr, sc), vst1 = v_st(32 + sr, sc), kws = KSWZ(sr, sc * 2);
    const int vb0 = (int)(uintptr_t)V_lds + v_rd_base(lane);
    const unsigned Kh = cur.K, Vh = cur.V, Ch = cur.C;
#define RESC(a) do { if (__any((a) < 1.f)) { if (hi == 0) al_l[r32] = (a); asm volatile("s_waitcnt lgkmcnt(0)" ::: "memory");              \
                     for (int d_ = 0; d_ < 4; ++d_) for (int r = 0; r < 16; ++r) o[d_][r] *= al_l[crow(r, hi)]; } } while (0)
#define KBASE(t) ((j_lo + (t)) * KVBLK)
#define ACT(t) (KBASE(t) <= qlo + QBLK - 1 && KBASE(t) + KVBLK - 1 >= qlo - W + 1)
#define MASKT(P0_, P1_, t) do { const int kb_ = KBASE(t); if ((!SK || ACT(t)) && (kb_ + KVBLK - 1 > qlo || kb_ <= qlo + QBLK - 1 - W)) mask_tile(P0_, P1_, qm - kb_, (unsigned)W); } while (0)
    constexpr int NQL = F32 ? 16 : 8;
    constexpr bool SK = WSKIP && !F32;
#define SEAM_K0() do { VMWN(NQL); if constexpr (F32) { SWRITE_KF(0); SBAR(); SLOAD_F((const float*)nxt.V, kbn); } else { SWRITE_HK(0); } SBAR(); } while (0)
    f32x16 pA0, pA1, pB0, pB1; float mnA, mnB, alA, alB; bf16x8 pa0, pa1, pa2, pa3;
    if constexpr (F32) { VMW(); SWRITE_VF(0); SBAR(); } else { SWRITE_HV(0); SBAR(); }
    if (NT > 1) { if constexpr (F32) SLOAD_F((const float*)Kh, KBASE(1)); else SLOAD_H(Kh, Vh, Ch, KBASE(1)); }
    SBAR(); qkt<0, SK>(pA0, pA1, K_lds, cb_l, r32, hi, S.qr, ACT(0));
    if constexpr (F32) { if (NT > 1) { VMW(); SWRITE_KF(1); SBAR(); SLOAD_F((const float*)Vh, KBASE(1)); } }
    MASKT(pA0, pA1, 0); partialSM(pA0, pA1, m_reg, mnA, alA);
    if (NT > 1) { VMW(); if constexpr (F32) { SWRITE_VF(1); SBAR(); if (NT > 2) SLOAD_F((const float*)Kh, KBASE(2)); } else SWRITE_H(1); }
    __syncthreads();
#define HALF_STEP(PX0, PX1, mnX, alX, PY0, PY1, alY, t, KB, VB, SB) do {                                                      \
        SBAR(); qkt<KB, SK>(PX0, PX1, K_lds, cb_l, r32, hi, S.qr, ACT(t));                                             \
        finishSM(PY0, PY1, alY, l_reg, pa0, pa1, pa2, pa3); SBAR();                                                           \
        if ((t) + 1 < NT) { if constexpr (F32) { VMW(); SWRITE_KF(SB); SBAR(); SLOAD_F((const float*)Vh, KBASE((t) + 1)); }  \
                            else { SLOAD_H(Kh, Vh, Ch, KBASE((t) + 1)); } SBAR(); }                                               \
        pv_tile<VB, SK>(o, vb0, pa0, pa1, pa2, pa3, ACT((t) - 1)); MASKT(PX0, PX1, (t)); partialSM(PX0, PX1, m_reg, mnX, alX);                                        \
        __syncthreads();                                                                                                      \
        if ((t) + 1 < NT) { VMW(); if constexpr (F32) { SWRITE_VF(SB); SBAR(); if ((t) + 2 < NT) SLOAD_F((const float*)Kh, KBASE((t) + 2)); } \
                            else { SWRITE_H(SB); } }                                                                          \
        RESC(alX); __syncthreads(); } while (0)
    for (int t = 1; t + 1 < NT; t += 2) {
        HALF_STEP(pB0, pB1, mnB, alB, pA0, pA1, alA, t, 1, 0, 0);
        HALF_STEP(pA0, pA1, mnA, alA, pB0, pB1, alB, t + 1, 0, 1, 1);
    }
    const bool even = (NT & 1) == 0;
    if (even) { SBAR(); qkt<1, SK>(pB0, pB1, K_lds, cb_l, r32, hi, S.qr, ACT(NT - 1)); SBAR(); }
#define QROW(e) (nxt.Q + (size_t)(wid * QBLK + r32) * D + ((e) >> 1) * 16 + hi * 8 + ((e) & 1) * 4)
    if constexpr (F32) { SLOAD_F((const float*)nxt.K, kbn); SBAR();
#pragma unroll
        for (int e = 0; e < 8; ++e) S.tq[e] = *(const f32x4*)QROW(e); }
    else { SLOAD_H(nxt.K, nxt.V, nxt.C, kbn); SBAR();
#pragma unroll
        for (int d0 = 0; d0 < 8; ++d0) S.qr[d0] = load8<TIn>(nxt.Q + (unsigned)((wid * QBLK + r32) * D + d0 * 16 + hi * 8)); }
    SBAR();
    finishSM(pA0, pA1, alA, l_reg, pa0, pa1, pa2, pa3); SBAR();
    if constexpr (F32) {
#pragma unroll
        for (int e = 8; e < 16; ++e) S.tq[e] = *(const f32x4*)QROW(e); SBAR(); }
#undef QROW
    pv_tile<0, SK>(o, vb0, pa0, pa1, pa2, pa3, ACT(even ? NT - 2 : NT - 1));
    if (even) { MASKT(pB0, pB1, NT - 1); partialSM(pB0, pB1, m_reg, mnB, alB); __syncthreads(); RESC(alB);
        finishSM(pB0, pB1, alB, l_reg, pa0, pa1, pa2, pa3); SBAR(); pv_tile<1, SK>(o, vb0, pa0, pa1, pa2, pa3, ACT(NT - 1)); }
    SBAR(); SEAM_K0();
    if (hi == 0) li_l[r32] = l_reg; asm volatile("s_waitcnt lgkmcnt(0)" ::: "memory");
    float rli[16];
#pragma unroll
    for (int r = 0; r < 16; ++r) rli[r] = __builtin_amdgcn_rcpf(li_l[crow(r, hi)]);
    TOut* Ow = cur.O + (size_t)(wid * QBLK) * OSTR;
    { float msv[4];
#pragma unroll
      for (int d0 = 0; d0 < 4; ++d0) msv[d0] = cur.MS[d0 * 32 + r32];
#pragma unroll
      for (int r = 0; r < 16; ++r) { const int orow = crow(r, hi);
        float v0 = o[0][r] * rli[r], v1 = o[1][r] * rli[r], v2 = o[2][r] * rli[r], v3 = o[3][r] * rli[r];
        float sm = (v0 + v1) + (v2 + v3);
#pragma unroll
        for (int off = 1; off < 32; off <<= 1) sm += __shfl_xor(sm, off);
        const float mu = sm * (1.0f / 128.0f);
        v0 -= mu; v1 -= mu; v2 -= mu; v3 -= mu;
        float sq = (v0 * v0 + v1 * v1) + (v2 * v2 + v3 * v3);
#pragma unroll
        for (int off = 1; off < 32; off <<= 1) sq += __shfl_xor(sq, off);
        const float rstd = 1.0f / sqrtf(sq * (1.0f / 128.0f) + 1e-6f);
        float vv[4] = {v0 * rstd * msv[0], v1 * rstd * msv[1], v2 * rstd * msv[2], v3 * rstd * msv[3]};
#pragma unroll
        for (int d0 = 0; d0 < 4; ++d0) { const float v = vv[d0]; const float vn = __shfl_xor(v, 1);
            if ((r32 & 1) == 0) *(unsigned*)(Ow + (unsigned)(orow * OSTR + d0 * 32 + r32)) = cvtpk(v, vn); } } }
    if constexpr (F32) {
#pragma unroll
        for (int d0 = 0; d0 < 8; ++d0) S.qr[d0] = pack8(S.tq[2 * d0], S.tq[2 * d0 + 1]); }
    __syncthreads();
#undef RESC
#undef KBASE
#undef ACT
#undef MASKT
#undef SEAM_K0
#undef HALF_STEP
}
#undef ROW
#undef VMW
#undef VMWN
#undef SLOAD_H
#undef SWRITE_HK
#undef SWRITE_HV
#undef SWRITE_H
#undef SLOAD_F
#undef SWRITE_KF
#undef SWRITE_VF
#undef SBAR
}

#define LAS __attribute__((address_space(3)))
typedef unsigned short bf16r;
typedef unsigned v4u __attribute__((ext_vector_type(4)));
typedef unsigned v2u __attribute__((ext_vector_type(2)));
typedef float v4f __attribute__((ext_vector_type(4)));
typedef float v16f __attribute__((ext_vector_type(16)));
typedef short v8s __attribute__((ext_vector_type(8)));
typedef short v4s __attribute__((ext_vector_type(4)));

#define XB_TMO      128
#define XB_XCNT(j)  (256  + 64 * (j))
#define XB_XSUB(j)  (1280 + 64 * (j))
#define XB_XGEN(j)  (2304 + 64 * (j))
#define XB_TOP      3328
#define XB_TOPGEN   3392
#define XCD_BAR_WORDS 3456
#define XB_SPIN_CAP (1u << 18)

__device__ __forceinline__ unsigned xb_ld(unsigned* p)              { return __hip_atomic_load(p, __ATOMIC_RELAXED, __HIP_MEMORY_SCOPE_AGENT); }
__device__ __forceinline__ unsigned xb_add(unsigned* p, unsigned v) { return __hip_atomic_fetch_add(p, v, __ATOMIC_RELAXED, __HIP_MEMORY_SCOPE_AGENT); }
__device__ __forceinline__ unsigned xb_xcc_id() { return (unsigned)__builtin_amdgcn_s_getreg((3 << 11) | 20) & 0xFu; }
#define XB_SPIN(cond, bar) do { unsigned _sp = 0; while (cond) { __builtin_amdgcn_s_sleep(1); \
    if ((++_sp & 255u) == 0u) { if (xb_ld(&(bar)[XB_TMO])) break; if (_sp > XB_SPIN_CAP) { atomicAdd(&(bar)[XB_TMO], 1u); break; } } } } while (0)

struct XcdBarrier {
    unsigned* bar; unsigned x;
    volatile LAS unsigned* st;
};

__device__ __forceinline__ XcdBarrier xcd_barrier_post(unsigned* bar, volatile LAS unsigned* st) {
    XcdBarrier b; b.bar = bar; b.x = xb_xcc_id(); b.st = st;
    if (lz_tid() == 0) (void)xb_add(&bar[XB_XCNT(b.x)], 1u);
    return b;
}
__device__ __forceinline__ void xcd_barrier_complete(unsigned* bar, unsigned x, unsigned& nloc, unsigned& nx) {
    const unsigned G = gridDim.x * gridDim.y * gridDim.z;
    unsigned sum, cnt, mine, sp = 0u;
    for (;;) {
        sum = 0u; cnt = 0u; mine = 0u;
#pragma unroll
        for (unsigned j = 0; j < 16; ++j) { const unsigned c = xb_ld(&bar[XB_XCNT(j)]); sum += c; cnt += (c > 0u) ? 1u : 0u; mine = (j == x) ? c : mine; }
        if (sum == G) break;
        __builtin_amdgcn_s_sleep(1);
        if ((++sp & 255u) == 0u) { if (xb_ld(&bar[XB_TMO])) break; if (sp > XB_SPIN_CAP) { atomicAdd(&bar[XB_TMO], 1u); break; } }
    }
    nloc = mine > 0u ? mine : 1u; nx = cnt > 0u ? cnt : 1u;
}

__device__ __forceinline__ void xcd_barrier(const XcdBarrier& b) {
    asm volatile("s_waitcnt vmcnt(0)" ::: "memory");
    __syncthreads();
    if (lz_tid() == 0) {
        unsigned* bar = b.bar;
        __builtin_amdgcn_s_waitcnt(0);
        unsigned nloc = b.st[0], nx = b.st[1];
        if (nloc == 0u) { xcd_barrier_complete(bar, b.x, nloc, nx); b.st[0] = nloc; b.st[1] = nx; }
        const unsigned old = xb_add(&bar[XB_XSUB(b.x)], 1u);
        const unsigned gen = old / nloc;
        if (old + 1u == (gen + 1u) * nloc) {
            __builtin_amdgcn_fence(__ATOMIC_RELEASE, "agent");
            asm volatile("s_waitcnt vmcnt(0)" ::: "memory");
            const unsigned og = xb_add(&bar[XB_TOP], 1u);
            const unsigned tg = og / nx;
            if (og + 1u == (tg + 1u) * nx) xb_add(&bar[XB_TOPGEN], 1u);
            else XB_SPIN(xb_ld(&bar[XB_TOPGEN]) == tg, bar);
            __builtin_amdgcn_fence(__ATOMIC_ACQUIRE, "agent");
            xb_add(&bar[XB_XGEN(b.x)], 1u);
            asm volatile("s_waitcnt vmcnt(0)" ::: "memory");
        } else {
            XB_SPIN(xb_ld(&bar[XB_XGEN(b.x)]) == gen, bar);
            __builtin_amdgcn_fence(__ATOMIC_ACQUIRE, "agent");
            asm volatile("s_waitcnt vmcnt(0)" ::: "memory");
        }
    }
    __syncthreads();
}

constexpr size_t MiB = 1u << 20;
constexpr size_t WS_QK2 = 14336, WS_QCTR = 15360;
constexpr size_t WS_JT = 20480;
constexpr size_t WS_WG = 1 * MiB, WG_BYTES = 32 * DM * 2;
constexpr size_t WS_MOD = 64 * 1024;
constexpr size_t WS_WIN = 2 * MiB, WIN_BYTES = (size_t)NINP * DM * 2;
constexpr size_t WS_WOUT = 60 * MiB, WOUT_BYTES = (size_t)DM * DM * 2;
constexpr size_t WS_WFF1 = 76 * MiB, WFF_BYTES = (size_t)DFF * DM * 2;
constexpr size_t WS_WFF2 = 140 * MiB;
constexpr size_t WS_H = 204 * MiB;
constexpr size_t WS_P = 332 * MiB;
constexpr size_t WS_Y = 780 * MiB;
constexpr size_t WS_HID = WS_P;
constexpr size_t WS_GATES = 908 * MiB;
constexpr size_t WS_CNEG = 910 * MiB;
constexpr size_t WS_MA = 911 * MiB, WS_MCM = WS_MA + 512 * 1024, WS_MB = WS_MCM + 512 * 1024;
constexpr size_t WS_MPREV = 913 * MiB;
constexpr size_t WS_UN = 914 * MiB;
constexpr size_t WS_MQC = 916 * MiB;
constexpr size_t WS_END = 980 * MiB;
static_assert(WS_WIN + 2 * WIN_BYTES <= WS_WOUT && WS_HID + (size_t)MROWS * DFF * 2 <= WS_Y + (size_t)MROWS * DM * 2 && WS_MQC + (size_t)8 * MROWS * 128 * 2 <= WS_END, "ws map");

constexpr int LDS_BYTES = 147456;

__device__ __forceinline__ float wave_sum(float v) {
#pragma unroll
    for (int o = 1; o < 64; o <<= 1) v += __shfl_xor(v, o);
    return v;
}
typedef float pkf2_t __attribute__((ext_vector_type(2))); typedef __bf16 pkb2_t __attribute__((ext_vector_type(2)));
__device__ __forceinline__ unsigned pk2(float lo, float hi) { pkf2_t v = {lo, hi}; pkb2_t b = __builtin_convertvector(v, pkb2_t); return __builtin_bit_cast(unsigned, b); }
__device__ __forceinline__ float bflo(unsigned w) { return __uint_as_float(w << 16); }
__device__ __forceinline__ float bfhi(unsigned w) { return __uint_as_float(w & 0xffff0000u); }
__device__ __forceinline__ float bf1(bf16r h) { return __uint_as_float((unsigned)h << 16); }
__device__ __forceinline__ float log_sigmoid(float x) { return fminf(x, 0.f) - log1pf(expf(-fabsf(x))); }
__device__ __forceinline__ float swap_add(float v) { auto rr = __builtin_amdgcn_permlane32_swap(__float_as_uint(v), __float_as_uint(v), false, false); return __uint_as_float(rr[0]) + __uint_as_float(rr[1]); }

struct Args { const void* in[18]; float* out; unsigned char* ws; int ph_lo, ph_hi; };
typedef const __attribute__((address_space(4))) Args CArgs;
__device__ __forceinline__ CArgs* fresh_args() { CArgs* p = (CArgs*)__builtin_amdgcn_kernarg_segment_ptr(); asm volatile("" : "+s"(p)); return p; }

__device__ __forceinline__ int win_src(int n) { return n < 5120 ? n : n + 8; }
__device__ __forceinline__ int wg_src(int n) { return n < 8 ? 5120 + n : (n < 16 ? 7176 + (n - 8) : -1); }
template <int MAP>
__device__ __forceinline__ void transpose_item(const float* W, int K, int N, bf16r* WT, LAS float* scr, int item, int nblk, int lane) {
    const int kb = item / nblk, nb = item % nblk, k0 = 64 * kb, n0 = 32 * nb;
    int sc = n0 + (lane & 31); if (MAP == 1) sc = win_src(sc); else if (MAP == 2) sc = wg_src(sc);
#ifdef OLD_P0
#pragma unroll 8
    for (int i = 0; i < 32; ++i) { const int kk = 2 * i + (lane >> 5); scr[kk * 33 + (lane & 31)] = sc >= 0 ? W[(size_t)(k0 + kk) * N + sc] : 0.f; }
#else
    float tv[32];
#pragma unroll
    for (int i = 0; i < 32; ++i) { const int kk = 2 * i + (lane >> 5); tv[i] = sc >= 0 ? W[(size_t)(k0 + kk) * N + sc] : 0.f; }
#pragma unroll
    for (int i = 0; i < 32; ++i) { const int kk = 2 * i + (lane >> 5); scr[kk * 33 + (lane & 31)] = tv[i]; }
#endif
    asm volatile("s_waitcnt lgkmcnt(0)" ::: "memory");
    const int c = lane & 7;
#pragma unroll
    for (int j = 0; j < 4; ++j) { const int n = (lane >> 3) + 8 * j; const LAS float* s = scr + (8 * c) * 33 + n;
        v4u o; o.x = pk2(s[0 * 33], s[1 * 33]); o.y = pk2(s[2 * 33], s[3 * 33]); o.z = pk2(s[4 * 33], s[5 * 33]); o.w = pk2(s[6 * 33], s[7 * 33]);
        *(v4u*)(WT + (size_t)(n0 + n) * K + k0 + 8 * c) = o; }
    asm volatile("s_waitcnt lgkmcnt(0)" ::: "memory");
}
__device__ __forceinline__ void p0_phase(CArgs& a, LAS unsigned char* lds) {
    const int tid = lz_tid(), lane = tid & 63, wave = tid >> 6, G = gridDim.x;
    unsigned char* ws = a.ws;
    { LAS float* cond = (LAS float*)lds; LAS float* red = (LAS float*)(lds + 16384);
      const float* c = (const float*)a.in[1]; const float* ada_w = (const float*)a.in[3]; const float* ada_b = (const float*)a.in[4]; float* MOD = (float*)(ws + WS_MOD);
      for (int i = tid; i < NB * DM; i += 512) { const float cv = c[i]; cond[i] = cv / (1.f + expf(-cv)); }
      __syncthreads();
      for (int item = lz_bid(); item < 2 * (NMOD / 64); item += G) {
          const int layer = item / (NMOD / 64), cgp = item % (NMOD / 64), col = cgp * 64 + lane, kq = wave;
          const float* W = ada_w + (size_t)layer * DM * NMOD + col;
          float a0 = 0.f, a1 = 0.f;
#ifdef OLD_P0
#pragma unroll 8
#else
#pragma unroll 32
#endif
          for (int k = kq * 256; k < kq * 256 + 256; ++k) { const float w = W[(size_t)k * NMOD]; a0 += cond[k] * w; a1 += cond[DM + k] * w; }
          red[(kq * 2 + 0) * 64 + lane] = a0; red[(kq * 2 + 1) * 64 + lane] = a1;
          __syncthreads();
          if (tid < 128) { const int b = tid >> 6; float s = 0.f;
#pragma unroll
              for (int q = 0; q < 8; ++q) s += red[(q * 2 + b) * 64 + lane];
              MOD[(size_t)(layer * NB + b) * NMOD + cgp * 64 + lane] = s + ada_b[(size_t)layer * NMOD + cgp * 64 + lane]; }
          __syncthreads();
      } }
    { LAS float* scr = (LAS float*)(lds + wave * 16384);
      const int gw = lz_bid() * 8 + wave, NGW = G * 8;
      constexpr int I_IN = (DM / 64) * (NINP / 32), I_OUT = (DM / 64) * (DM / 32), I_F1 = (DM / 64) * (DFF / 32), I_F2 = (DFF / 64) * (DM / 32), I_G = DM / 64, I_L = I_IN + I_OUT + I_F1 + I_F2 + I_G;
      for (int it = gw; it < 2 * I_L; it += NGW) {
          const int layer = it / I_L; int r = it % I_L;
          if (r < I_IN) { transpose_item<1>((const float*)a.in[7] + (size_t)layer * DM * DIN, DM, DIN, (bf16r*)(ws + WS_WIN + layer * WIN_BYTES), scr, r, NINP / 32, lane); continue; } r -= I_IN;
          if (r < I_G) { transpose_item<2>((const float*)a.in[7] + (size_t)layer * DM * DIN, DM, DIN, (bf16r*)(ws + WS_WG + layer * WG_BYTES), scr, r, 1, lane); continue; } r -= I_G;
          if (r < I_OUT) { transpose_item<0>((const float*)a.in[14] + (size_t)layer * DM * DM, DM, DM, (bf16r*)(ws + WS_WOUT + layer * WOUT_BYTES), scr, r, DM / 32, lane); continue; } r -= I_OUT;
          if (r < I_F1) { transpose_item<0>((const float*)a.in[15] + (size_t)layer * DM * DFF, DM, DFF, (bf16r*)(ws + WS_WFF1 + layer * WFF_BYTES), scr, r, DFF / 32, lane); continue; } r -= I_F1;
          transpose_item<0>((const float*)a.in[16] + (size_t)layer * DFF * DM, DFF, DM, (bf16r*)(ws + WS_WFF2 + layer * WFF_BYTES), scr, r, DM / 32, lane);
      } }
}

__device__ __forceinline__ void gate_gemm(const bf16r* H, const bf16r* WG, float* gates) {
    const int tid = lz_tid(), lane = tid & 63, wave = __builtin_amdgcn_readfirstlane(tid >> 6), r32 = lane & 31, hi = lane >> 5;
    if (wave >= 4) return;
    for (int rb = lz_bid(); rb < MROWS / 128; rb += gridDim.x) {
        const int r0 = rb * 128 + wave * 32;
        const bf16r* ap = H + (size_t)(r0 + r32) * DM + 8 * hi; const bf16r* bp = WG + (size_t)r32 * DM + 8 * hi;
        v16f acc = {};
#pragma unroll 16
        for (int ks = 0; ks < DM / 16; ++ks) { const v8s af = *(const v8s*)(ap + ks * 16), bf = *(const v8s*)(bp + ks * 16); acc = __builtin_amdgcn_mfma_f32_32x32x16_bf16(af, bf, acc, 0, 0, 0); }
        if (r32 < 16) {
#pragma unroll
            for (int r = 0; r < 16; ++r) gates[(size_t)(r0 + (r & 3) + 8 * (r >> 2) + 4 * hi) * 16 + r32] = acc[r]; }
    }
}

__device__ __forceinline__ void norm_phase(const float* x, const float* w, const float* sh, const float* sc, bf16r* H) {
    const int lane = lz_tid() & 63, gw = lz_bid() * 8 + (lz_tid() >> 6), NGW = gridDim.x * 8;
    v4f nx[8];
    if (gw < MROWS) { const v4f* xr0 = (const v4f*)(x + (size_t)gw * DM) + lane;
#pragma unroll
        for (int j = 0; j < 8; ++j) nx[j] = xr0[64 * j]; }
    for (int m = gw; m < MROWS; m += NGW) {
        const int b = m / SEQ;
        v4f v[8]; float s = 0.f;
#pragma unroll
        for (int j = 0; j < 8; ++j) v[j] = nx[j];
        if (m + NGW < MROWS) { const v4f* xr1 = (const v4f*)(x + (size_t)(m + NGW) * DM) + lane;
#pragma unroll
            for (int j = 0; j < 8; ++j) nx[j] = xr1[64 * j]; }
#pragma unroll
        for (int j = 0; j < 8; ++j) s += (v[j].x * v[j].x + v[j].y * v[j].y) + (v[j].z * v[j].z + v[j].w * v[j].w);
        const float rstd = 1.0f / sqrtf(wave_sum(s) * (1.f / DM) + NORM_EPS);
        v2u* o = (v2u*)(H + (size_t)m * DM) + lane;
#pragma unroll
        for (int j = 0; j < 8; ++j) { const int c = 4 * lane + 256 * j;
            const v4f wv = *(const v4f*)(w + c), sv = *(const v4f*)(sc + (size_t)b * NMOD + c), hv = *(const v4f*)(sh + (size_t)b * NMOD + c);
            const v4f y = v[j] * rstd * wv * (sv + 1.0f) + hv;
            v2u p; p.x = pk2(y.x, y.y); p.y = pk2(y.z, y.w); o[64 * j] = p; }
    }
}
__device__ __forceinline__ void final_norm_phase(float* x, const float* w) {
    const int lane = lz_tid() & 63, gw = lz_bid() * 8 + (lz_tid() >> 6), NGW = gridDim.x * 8;
    v4f nx[8];
    if (gw < MROWS) { const v4f* xr0 = (const v4f*)(x + (size_t)gw * DM) + lane;
#pragma unroll
        for (int j = 0; j < 8; ++j) nx[j] = xr0[64 * j]; }
    for (int m = gw; m < MROWS; m += NGW) {
        v4f* xr = (v4f*)(x + (size_t)m * DM) + lane;
        v4f v[8]; float s = 0.f;
#pragma unroll
        for (int j = 0; j < 8; ++j) v[j] = nx[j];
        if (m + NGW < MROWS) { const v4f* xr1 = (const v4f*)(x + (size_t)(m + NGW) * DM) + lane;
#pragma unroll
            for (int j = 0; j < 8; ++j) nx[j] = xr1[64 * j]; }
#pragma unroll
        for (int j = 0; j < 8; ++j) s += (v[j].x * v[j].x + v[j].y * v[j].y) + (v[j].z * v[j].z + v[j].w * v[j].w);
        const float rstd = 1.0f / sqrtf(wave_sum(s) * (1.f / DM) + NORM_EPS);
#pragma unroll
        for (int j = 0; j < 8; ++j) { const v4f wv = *(const v4f*)(w + 4 * lane + 256 * j); xr[64 * j] = v[j] * rstd * wv; }
    }
}

__device__ __forceinline__ void fox_cumsum_item(CArgs& a, int layer, int item, LAS unsigned char* lds) {
    const int tid = lz_tid(), b = item >> 3, h = item & 7;
    const float* gates = (const float*)(a.ws + WS_GATES); float* cneg = (float*)(a.ws + WS_CNEG) + (size_t)item * SEQ;
    const float bias = ((const float*)a.in[10])[layer * 8 + h];
    LAS double* tot = (LAS double*)lds;
    double sum = 0.0;
    const float* gp = gates + ((size_t)b * SEQ + (size_t)tid * 32) * 16 + h;
#pragma unroll 4
    for (int i = 0; i < 32; ++i) sum += (double)log_sigmoid(gp[i * 16] + bias);
    tot[tid] = sum;
    __syncthreads();
    if (tid == 0) { double run = 0.0; for (int i = 0; i < 512; ++i) { const double t = tot[i]; tot[i] = run; run += t; } }
    __syncthreads();
    double run = tot[tid];
#pragma unroll 2
    for (int i = 0; i < 32; i += 4) { v4f o;
        run += (double)log_sigmoid(gp[(i + 0) * 16] + bias); o.x = (float)(-run * 11.313708498984761);
        run += (double)log_sigmoid(gp[(i + 1) * 16] + bias); o.y = (float)(-run * 11.313708498984761);
        run += (double)log_sigmoid(gp[(i + 2) * 16] + bias); o.z = (float)(-run * 11.313708498984761);
        run += (double)log_sigmoid(gp[(i + 3) * 16] + bias); o.w = (float)(-run * 11.313708498984761);
        *(v4f*)(cneg + tid * 32 + i) = o; }
    __syncthreads();
}
__device__ __forceinline__ void mlstm_scan_item(CArgs& a, int layer, int item, LAS unsigned char* lds) {
    const int tid = lz_tid(), lane = tid & 63, wave = tid >> 6, b = item >> 2, h = item & 3;
    const float* gates = (const float*)(a.ws + WS_GATES);
    float* MA = (float*)(a.ws + WS_MA) + (size_t)item * SEQ; float* MCM = (float*)(a.ws + WS_MCM) + (size_t)item * SEQ; float* MBv = (float*)(a.ws + WS_MB) + (size_t)item * SEQ;
    float* MPREV = (float*)(a.ws + WS_MPREV) + item * 256;
    const float ib = ((const float*)a.in[11])[layer * 4 + h], fb = ((const float*)a.in[12])[layer * 4 + h];
    LAS float* Bc = (LAS float*)lds; LAS float* Ac = Bc + 256;
#pragma unroll 4
    for (int c = wave; c < 256; c += 8) {
        const size_t m = (size_t)b * SEQ + c * 64 + lane;
        const float ig = gates[m * 16 + 8 + h] + ib, fg = gates[m * 16 + 12 + h] + fb;
        float bb = log_sigmoid(fg);
#pragma unroll
        for (int o = 1; o < 64; o <<= 1) { const float t = __shfl_up(bb, o); if (lane >= o) bb += t; }
        const float av = ig - bb; float cm = av;
#pragma unroll
        for (int o = 1; o < 64; o <<= 1) { const float t = __shfl_up(cm, o); if (lane >= o) cm = fmaxf(cm, t); }
        MA[c * 64 + lane] = av; MCM[c * 64 + lane] = cm; MBv[c * 64 + lane] = bb;
        if (lane == 63) { Bc[c] = bb; Ac[c] = cm; }
    }
    __syncthreads();
    if (tid == 0) { float mm = 0.f; for (int c = 0; c < 256; ++c) { MPREV[c] = mm; mm = Bc[c] + fmaxf(mm, Ac[c]); } }
    __syncthreads();
}
__device__ __forceinline__ void prep_phase(CArgs& a, int layer, LAS unsigned char* lds) {
    const int tid = lz_tid(), bid = lz_bid(), G = gridDim.x;
    if (bid < 16) { fox_cumsum_item(a, layer, bid, lds); return; }
    if (bid < 24) { mlstm_scan_item(a, layer, bid - 16, lds); return; }
    const int wk = bid - 24, NWK = G - 24;
    bf16r* P = (bf16r*)(a.ws + WS_P);
    { const int jg = tid & 7; double invf[8];
#pragma unroll
      for (int i = 0; i < 8; ++i) { double r = 1.0, bs = 0.8659643233600653; int e = 8 * jg + i;
#pragma unroll
          for (int q = 0; q < 6; ++q) { if (e & 1) r *= bs; bs *= bs; e >>= 1; }
          invf[i] = r * 0.15915494309189535; }
      const int* positions = (const int*)a.in[2];
      for (int it0 = wk; it0 < 8 * MROWS / 64; it0 += 4 * NWK) {
          v4u A[4], Bv[4]; bf16r* pp[4]; int mm[4], sl[4];
#pragma unroll
          for (int q = 0; q < 4; ++q) { const int it = it0 + q * NWK; const bool ok = it < 8 * MROWS / 64; const int grow = (ok ? it : wk) * 64 + (tid >> 3); sl[q] = ok ? grow / MROWS : -1; mm[q] = grow % MROWS;
              pp[q] = P + ((size_t)(grow / MROWS) * MROWS + mm[q]) * 128 + 8 * jg; A[q] = *(const v4u*)pp[q]; Bv[q] = *(const v4u*)(pp[q] + 64); }
#pragma unroll
          for (int q = 0; q < 4; ++q) { if (sl[q] < 0) continue;
              const double pos = (double)positions[mm[q]]; const float sc = sl[q] >= 4 ? KSCALE : 1.0f;
              float t1[8] = {bflo(A[q].x), bfhi(A[q].x), bflo(A[q].y), bfhi(A[q].y), bflo(A[q].z), bfhi(A[q].z), bflo(A[q].w), bfhi(A[q].w)};
              float t2[8] = {bflo(Bv[q].x), bfhi(Bv[q].x), bflo(Bv[q].y), bfhi(Bv[q].y), bflo(Bv[q].z), bfhi(Bv[q].z), bflo(Bv[q].w), bfhi(Bv[q].w)};
              float o1[8], o2[8];
#pragma unroll
              for (int i = 0; i < 8; ++i) { const double rev = pos * invf[i]; const float fr = (float)(rev - floor(rev));
                  const float sn = __builtin_amdgcn_sinf(fr) * sc, cs = __builtin_amdgcn_cosf(fr) * sc;
                  o1[i] = t1[i] * cs - t2[i] * sn; o2[i] = t2[i] * cs + t1[i] * sn; }
              v4u oa, ob; oa.x = pk2(o1[0], o1[1]); oa.y = pk2(o1[2], o1[3]); oa.z = pk2(o1[4], o1[5]); oa.w = pk2(o1[6], o1[7]);
              ob.x = pk2(o2[0], o2[1]); ob.y = pk2(o2[2], o2[3]); ob.z = pk2(o2[4], o2[5]); ob.w = pk2(o2[6], o2[7]);
              *(v4u*)pp[q] = oa; *(v4u*)(pp[q] + 64) = ob; }
      } }
    { const int slot = wk % 8, sub = wk / 8, nsub = (NWK - slot + 7) / 8, cgp = tid & 15;
      const float* cw = (const float*)a.in[8] + (size_t)layer * 4 * 1024 + slot * 128 + 8 * cgp; const float* cbv = (const float*)a.in[9] + (size_t)layer * 1024 + slot * 128 + 8 * cgp;
      float w[4][8], bsv[8];
#pragma unroll
      for (int j = 0; j < 4; ++j)
#pragma unroll
          for (int i = 0; i < 8; ++i) w[j][i] = cw[j * 1024 + i];
#pragma unroll
      for (int i = 0; i < 8; ++i) bsv[i] = cbv[i];
      const bf16r* __restrict__ src = P + (size_t)(40 + slot) * MROWS * 128 + 8 * cgp; bf16r* __restrict__ dst = (bf16r*)(a.ws + WS_MQC) + (size_t)slot * MROWS * 128 + 8 * cgp;
      const float sc = slot >= 4 ? KSCALE : 1.0f;
#pragma unroll 2
      for (int rb = sub; rb < MROWS / 32; rb += nsub) {
          const int row = rb * 32 + (tid >> 4), s = row % SEQ;
          float acc[8];
#pragma unroll
          for (int i = 0; i < 8; ++i) acc[i] = bsv[i];
#pragma unroll
          for (int j = 0; j < 4; ++j) { if (s - 3 + j >= 0) { const v4u X = *(const v4u*)(src + (size_t)(row - 3 + j) * 128);
              acc[0] += w[j][0] * bflo(X.x); acc[1] += w[j][1] * bfhi(X.x); acc[2] += w[j][2] * bflo(X.y); acc[3] += w[j][3] * bfhi(X.y);
              acc[4] += w[j][4] * bflo(X.z); acc[5] += w[j][5] * bfhi(X.z); acc[6] += w[j][6] * bflo(X.w); acc[7] += w[j][7] * bfhi(X.w); } }
#pragma unroll
          for (int i = 0; i < 8; ++i) acc[i] = acc[i] / (1.f + expf(-acc[i])) * sc;
          v4u o; o.x = pk2(acc[0], acc[1]); o.y = pk2(acc[2], acc[3]); o.z = pk2(acc[4], acc[5]); o.w = pk2(acc[6], acc[7]);
          *(v4u*)(dst + (size_t)row * 128) = o;
      } }
    { const int slot = wk % 16, sub = wk / 16, nsub = (NWK - slot + 15) / 16, c16 = tid & 15;
      const bf16r* src = P + (size_t)(16 + slot) * MROWS * 128 + 8 * c16;
      float mx0 = 0.f, mx1 = 0.f;
#pragma unroll 8
      for (int rb = sub; rb < MROWS / 32; rb += nsub) {
          const int row = rb * 32 + (tid >> 4); const v4u X = *(const v4u*)(src + (size_t)row * 128);
          const float x0 = bflo(X.x), x1 = bfhi(X.x), x2 = bflo(X.y), x3 = bfhi(X.y), x4 = bflo(X.z), x5 = bfhi(X.z), x6 = bflo(X.w), x7 = bfhi(X.w);
          float s = (x0 * x0 + x1 * x1) + (x2 * x2 + x3 * x3) + (x4 * x4 + x5 * x5) + (x6 * x6 + x7 * x7);
          s += __shfl_xor(s, 1); s += __shfl_xor(s, 2); s += __shfl_xor(s, 4); s += __shfl_xor(s, 8);
          if (row < SEQ) mx0 = fmaxf(mx0, s); else mx1 = fmaxf(mx1, s);
      }
#pragma unroll
      for (int o = 1; o < 64; o <<= 1) { mx0 = fmaxf(mx0, __shfl_xor(mx0, o)); mx1 = fmaxf(mx1, __shfl_xor(mx1, o)); }
      if ((tid & 63) == 0) { unsigned* QK2 = (unsigned*)(a.ws + WS_QK2) + layer * 32;
          __hip_atomic_fetch_max(QK2 + slot, __float_as_uint(mx0 * 1.02f), __ATOMIC_RELAXED, __HIP_MEMORY_SCOPE_AGENT);
          __hip_atomic_fetch_max(QK2 + 16 + slot, __float_as_uint(mx1 * 1.02f), __ATOMIC_RELAXED, __HIP_MEMORY_SCOPE_AGENT); }
    }
}

__device__ __forceinline__ int cv_st(int k, int c) { const int kk = (k & ~0xC) | ((k & 4) << 1) | ((k & 8) >> 1); return ((kk >> 3) * 4 + (c >> 5)) * 512 + ((kk & 7) * 32 + (c & 31)) * 2; }
__device__ __forceinline__ int cv_rd_base(int lane) { return ((lane & 3) << 3) | (((lane >> 2) & 3) << 6) | (((lane >> 4) & 1) << 5) | (((lane >> 5) & 1) << 8); }
__device__ __forceinline__ int ccrow(int r, int hi) { return (r & 3) + 8 * (r >> 2) + 4 * hi; }
#define CFRAG(dst, vb, ks) do { v4s l_, h_; asm volatile("ds_read_b64_tr_b16 %0, %1 offset:%2" : "=&v"(l_) : "v"(vb), "i"((ks) * 4096) : "memory"); \
        asm volatile("ds_read_b64_tr_b16 %0, %1 offset:%2" : "=&v"(h_) : "v"(vb), "i"((ks) * 4096 + 2048) : "memory"); asm volatile("s_waitcnt lgkmcnt(0)" ::: "memory"); \
        dst = (v8s){l_[0], l_[1], l_[2], l_[3], h_[0], h_[1], h_[2], h_[3]}; } while (0)

struct ChunkItem { int mixer, bh, b, h, c, row0; };
__device__ __forceinline__ ChunkItem chunk_decode(int idx) { ChunkItem it; it.mixer = idx / 2048; const int rem = idx % 2048; it.bh = rem / 256; it.b = it.bh >> 2; it.h = it.bh & 3; it.c = rem % 256; it.row0 = it.b * SEQ + it.c * 64; return it; }
__device__ __forceinline__ float ret_lg(int h) { return log2f(1.0f - exp2f(-5.0f - (float)h)); }

__device__ __forceinline__ void m1_phase(CArgs& a, LAS unsigned char* lds) {
    const int tid = lz_tid(), lane = tid & 63, wave = __builtin_amdgcn_readfirstlane(tid >> 6), r32 = lane & 31, hi = lane >> 5;
    const bf16r* P = (const bf16r*)(a.ws + WS_P); const bf16r* MQC = (const bf16r*)(a.ws + WS_MQC); bf16r* US = (bf16r*)(a.ws + WS_H);
    LAS unsigned char* KT = lds; LAS unsigned char* VT = lds + 16384; LAS float* wt = (LAS float*)(lds + 32768); LAS float* red = (LAS float*)(lds + 33024);
    const int sr = tid >> 4, sc = (tid & 15) * 8;
    for (int idx = lz_bid(); idx < 4096; idx += gridDim.x) {
        const ChunkItem it = chunk_decode(idx);
        const bf16r* ksrc = (it.mixer == 0 ? P + (size_t)(4 + it.h) * MROWS * 128 : MQC + (size_t)(4 + it.h) * MROWS * 128) + (size_t)it.row0 * 128;
        const bf16r* vsrc = P + (size_t)((it.mixer == 0 ? 8 : 48) + it.h) * MROWS * 128 + (size_t)it.row0 * 128;
        if (tid < 64) { float w;
            if (it.mixer == 0) w = exp2f((float)(63 - tid) * ret_lg(it.h));
            else { const float* MA = (const float*)(a.ws + WS_MA) + (size_t)it.bh * SEQ + it.c * 64; const float* MCM = (const float*)(a.ws + WS_MCM) + (size_t)it.bh * SEQ + it.c * 64;
                   const float mp = ((const float*)(a.ws + WS_MPREV))[it.bh * 256 + it.c]; w = expf(MA[tid] - fmaxf(mp, MCM[63])); }
            wt[tid] = w; }
        const v4u k0 = *(const v4u*)(ksrc + (size_t)sr * 128 + sc), k1 = *(const v4u*)(ksrc + (size_t)(32 + sr) * 128 + sc);
        const v4u v0 = *(const v4u*)(vsrc + (size_t)sr * 128 + sc), v1 = *(const v4u*)(vsrc + (size_t)(32 + sr) * 128 + sc);
        __syncthreads();
        const float w0 = wt[sr], w1 = wt[32 + sr];
        float a0[8] = {bflo(k0.x) * w0, bfhi(k0.x) * w0, bflo(k0.y) * w0, bfhi(k0.y) * w0, bflo(k0.z) * w0, bfhi(k0.z) * w0, bflo(k0.w) * w0, bfhi(k0.w) * w0};
        float a1[8] = {bflo(k1.x) * w1, bfhi(k1.x) * w1, bflo(k1.y) * w1, bfhi(k1.y) * w1, bflo(k1.z) * w1, bfhi(k1.z) * w1, bflo(k1.w) * w1, bfhi(k1.w) * w1};
        { v4u o; o.x = pk2(a0[0], a0[1]); o.y = pk2(a0[2], a0[3]); o.z = pk2(a0[4], a0[5]); o.w = pk2(a0[6], a0[7]); *(LAS v4u*)(KT + cv_st(sr, sc)) = o;
          o.x = pk2(a1[0], a1[1]); o.y = pk2(a1[2], a1[3]); o.z = pk2(a1[4], a1[5]); o.w = pk2(a1[6], a1[7]); *(LAS v4u*)(KT + cv_st(32 + sr, sc)) = o;
          *(LAS v4u*)(VT + cv_st(sr, sc)) = v0; *(LAS v4u*)(VT + cv_st(32 + sr, sc)) = v1; }
        if (it.mixer == 1) {
#pragma unroll
            for (int i = 0; i < 8; ++i) { float s = a0[i] + a1[i]; s += __shfl_xor(s, 16); s += __shfl_xor(s, 32); if (lane < 16) red[wave * 128 + sc + i] = s; }
        }
        __syncthreads();
        if (it.mixer == 1 && tid < 128) { float s = 0.f;
#pragma unroll
            for (int q = 0; q < 8; ++q) s += red[q * 128 + tid];
            ((float*)(a.ws + WS_UN))[((size_t)it.bh * 256 + it.c) * 128 + tid] = s; }
        const int db = wave >> 1;
        const int kvb = (int)(uintptr_t)KT + cv_rd_base(lane) + db * 512;
        v8s kf[4]; CFRAG(kf[0], kvb, 0); CFRAG(kf[1], kvb, 1); CFRAG(kf[2], kvb, 2); CFRAG(kf[3], kvb, 3);
#pragma unroll
        for (int e2 = 0; e2 < 2; ++e2) { const int eb = (wave & 1) * 2 + e2; const int vvb = (int)(uintptr_t)VT + cv_rd_base(lane) + eb * 512;
            v8s vf[4]; CFRAG(vf[0], vvb, 0); CFRAG(vf[1], vvb, 1); CFRAG(vf[2], vvb, 2); CFRAG(vf[3], vvb, 3);
            v16f acc = {};
#pragma unroll
            for (int ks = 0; ks < 4; ++ks) acc = __builtin_amdgcn_mfma_f32_32x32x16_bf16(kf[ks], vf[ks], acc, 0, 0, 0);
            bf16r* dst = US + (size_t)idx * 16384 + (size_t)(eb * 32 + r32) * 128 + db * 32 + 4 * hi;
#pragma unroll
            for (int g = 0; g < 4; ++g) { v2u o; o.x = pk2(acc[4 * g], acc[4 * g + 1]); o.y = pk2(acc[4 * g + 2], acc[4 * g + 3]); *(v2u*)(dst + 8 * g) = o; } }
        __syncthreads();
    }
}

#ifndef M2U
#define M2U 32
#endif
__device__ __forceinline__ void m2_phase(CArgs& a, LAS unsigned char* lds) {
    const int tid = lz_tid();
    unsigned* US = (unsigned*)(a.ws + WS_H); LAS float* coef = (LAS float*)lds;
    const float* MCM = (const float*)(a.ws + WS_MCM); const float* MPREV = (const float*)(a.ws + WS_MPREV);
    for (int blk = lz_bid(); blk < 16 * 8192 / 512; blk += gridDim.x) {
        const int chain = blk / 16, mixer = chain >> 3, bh = chain & 7;
        __syncthreads();
        if (tid < 256) { float cf;
            if (mixer == 0) cf = exp2f(64.0f * ret_lg(bh & 3));
            else { const float mp = MPREV[bh * 256 + tid]; cf = expf(mp - fmaxf(mp, MCM[(size_t)bh * SEQ + tid * 64 + 63])); }
            coef[tid] = cf; }
        __syncthreads();
        unsigned* p = US + (size_t)chain * 256 * 8192 + (blk % 16) * 512 + tid;
        float s0 = 0.f, s1 = 0.f;
        for (int c = 0; c < 256; c += M2U) { unsigned u[M2U];
#pragma unroll
            for (int i = 0; i < M2U; ++i) u[i] = p[(size_t)(c + i) * 8192];
#pragma unroll
            for (int i = 0; i < M2U; ++i) { const float cf = coef[c + i]; p[(size_t)(c + i) * 8192] = pk2(s0, s1); s0 = s0 * cf + bflo(u[i]); s1 = s1 * cf + bfhi(u[i]); } }
    }
    float* UN = (float*)(a.ws + WS_UN);
    for (int bh = lz_bid(); bh < 8; bh += gridDim.x) {
        __syncthreads();
        if (tid < 256) { const float mp = MPREV[bh * 256 + tid]; coef[tid] = expf(mp - fmaxf(mp, MCM[(size_t)bh * SEQ + tid * 64 + 63])); }
        __syncthreads();
        if (tid < 128) { float* p = UN + (size_t)bh * 256 * 128 + tid; float s = 0.f;
            for (int c = 0; c < 256; c += 16) { float u[16];
#pragma unroll
                for (int i2 = 0; i2 < 16; ++i2) u[i2] = p[(c + i2) * 128];
#pragma unroll
                for (int i2 = 0; i2 < 16; ++i2) { p[(c + i2) * 128] = s; s = s * coef[c + i2] + u[i2]; } } }
    }
}

__device__ __forceinline__ void m3_phase(CArgs& a, int layer, LAS unsigned char* lds) {
    const int tid = lz_tid(), lane = tid & 63, wave = __builtin_amdgcn_readfirstlane(tid >> 6), r32 = lane & 31, hi = lane >> 5;
    const bf16r* P = (const bf16r*)(a.ws + WS_P); const bf16r* MQC = (const bf16r*)(a.ws + WS_MQC); const bf16r* US = (const bf16r*)(a.ws + WS_H);
    bf16r* Y = (bf16r*)(a.ws + WS_Y); const float* msc = (const float*)a.in[13] + (size_t)layer * DM;
    LAS unsigned char* VT = lds; LAS float* OT = (LAS float*)(lds + 16384);
    LAS float* sa = (LAS float*)(lds + 16384 + 64 * 132 * 4); LAS float* sg = sa + 64; LAS float* swi = sg + 64; LAS float* semq = swi + 64; LAS float* sn = semq + 64; LAS float* fw = sn + 128;
    const int sr = tid >> 4, sc = (tid & 15) * 8;
    const int lb = wave & 1, eb = wave >> 1, l = lb * 32 + r32;
    for (int idx = lz_bid(); idx < 4096; idx += gridDim.x) {
        const ChunkItem it = chunk_decode(idx);
        const bf16r* qsrc = (it.mixer == 0 ? P + (size_t)it.h * MROWS * 128 : MQC + (size_t)it.h * MROWS * 128) + (size_t)it.row0 * 128;
        const bf16r* ksrc = (it.mixer == 0 ? P + (size_t)(4 + it.h) * MROWS * 128 : MQC + (size_t)(4 + it.h) * MROWS * 128) + (size_t)it.row0 * 128;
        const bf16r* vsrc = P + (size_t)((it.mixer == 0 ? 8 : 48) + it.h) * MROWS * 128 + (size_t)it.row0 * 128;
        const bf16r* gsrc = P + (size_t)((it.mixer == 0 ? 12 : 52) + it.h) * MROWS * 128 + (size_t)it.row0 * 128;
        const bf16r* St = US + (size_t)idx * 16384;
        const float lg = ret_lg(it.h);
        if (it.mixer == 1) {
            if (tid < 64) { const size_t o = (size_t)it.bh * SEQ + it.c * 64 + tid; const float mp = ((const float*)(a.ws + WS_MPREV))[it.bh * 256 + it.c];
                const float av = ((const float*)(a.ws + WS_MA))[o], cm = ((const float*)(a.ws + WS_MCM))[o], bb = ((const float*)(a.ws + WS_MB))[o];
                const float g = fmaxf(mp, cm); sa[tid] = av; sg[tid] = g; swi[tid] = expf(mp - g); semq[tid] = expf(-(bb + g)); }
            else if (tid < 192) sn[tid - 64] = ((const float*)(a.ws + WS_UN))[((size_t)it.bh * 256 + it.c) * 128 + tid - 64];
        }
        { const v4u v0 = *(const v4u*)(vsrc + (size_t)sr * 128 + sc), v1 = *(const v4u*)(vsrc + (size_t)(32 + sr) * 128 + sc);
          *(LAS v4u*)(VT + cv_st(sr, sc)) = v0; *(LAS v4u*)(VT + cv_st(32 + sr, sc)) = v1; }
        v8s qr[8];
#pragma unroll
        for (int d0 = 0; d0 < 8; ++d0) qr[d0] = *(const v8s*)(qsrc + (size_t)l * 128 + d0 * 16 + hi * 8);
        __syncthreads();
        v16f p0 = {}, p1 = {};
#pragma unroll
        for (int d0 = 0; d0 < 8; ++d0) { const v8s kf = *(const v8s*)(ksrc + (size_t)r32 * 128 + d0 * 16 + hi * 8); p0 = __builtin_amdgcn_mfma_f32_32x32x16_bf16(kf, qr[d0], p0, 0, 0, 0); }
        if (lb == 1) {
#pragma unroll
            for (int d0 = 0; d0 < 8; ++d0) { const v8s kf = *(const v8s*)(ksrc + (size_t)(32 + r32) * 128 + d0 * 16 + hi * 8); p1 = __builtin_amdgcn_mfma_f32_32x32x16_bf16(kf, qr[d0], p1, 0, 0, 0); }
        }
        float rs = 0.f;
        int ll = l; asm volatile("" : "+v"(ll));
        if (it.mixer == 0) {
#pragma unroll
            for (int r = 0; r < 16; ++r) { const int m0 = ccrow(r, hi), m1 = m0 + 32;
                p0[r] = (m0 <= ll) ? p0[r] * exp2f((float)(ll - m0) * lg) : 0.f; p1[r] = (m1 <= ll) ? p1[r] * exp2f((float)(ll - m1) * lg) : 0.f; }
        } else { const float gl = sg[l];
#pragma unroll
            for (int r = 0; r < 16; ++r) { const int m0 = ccrow(r, hi), m1 = m0 + 32;
                p0[r] = (m0 <= ll) ? p0[r] * expf(sa[m0] - gl) : 0.f; p1[r] = (m1 <= ll) ? p1[r] * expf(sa[m1] - gl) : 0.f; rs += p0[r] + p1[r]; }
            rs = swap_add(rs);
        }
        v8s pa0, pa1, pa2, pa3;
#define CPK4(Pv, B_, OUT) do { unsigned a0_ = pk2(Pv[B_+0], Pv[B_+1]), a1_ = pk2(Pv[B_+2], Pv[B_+3]), b0_ = pk2(Pv[B_+4], Pv[B_+5]), b1_ = pk2(Pv[B_+6], Pv[B_+7]); \
        auto r0_ = __builtin_amdgcn_permlane32_swap(a0_, b0_, false, false); auto r1_ = __builtin_amdgcn_permlane32_swap(a1_, b1_, false, false); \
        v4u w_ = {r0_[0], r1_[0], r0_[1], r1_[1]}; OUT = *reinterpret_cast<v8s*>(&w_); } while (0)
        CPK4(p0, 0, pa0); CPK4(p0, 8, pa1); CPK4(p1, 0, pa2); CPK4(p1, 8, pa3);
#undef CPK4
        const int vvb = (int)(uintptr_t)VT + cv_rd_base(lane) + eb * 512;
        v16f oi = {}, ox = {};
        { v8s vf; CFRAG(vf, vvb, 0); oi = __builtin_amdgcn_mfma_f32_32x32x16_bf16(pa0, vf, oi, 0, 0, 0); CFRAG(vf, vvb, 1); oi = __builtin_amdgcn_mfma_f32_32x32x16_bf16(pa1, vf, oi, 0, 0, 0);
          CFRAG(vf, vvb, 2); oi = __builtin_amdgcn_mfma_f32_32x32x16_bf16(pa2, vf, oi, 0, 0, 0); CFRAG(vf, vvb, 3); oi = __builtin_amdgcn_mfma_f32_32x32x16_bf16(pa3, vf, oi, 0, 0, 0); }
#pragma unroll
        for (int d0 = 0; d0 < 8; ++d0) { const v8s sf = *(const v8s*)(St + (size_t)(eb * 32 + r32) * 128 + d0 * 16 + hi * 8); ox = __builtin_amdgcn_mfma_f32_32x32x16_bf16(qr[d0], sf, ox, 0, 0, 0); }
        float fa, fb;
        if (it.mixer == 0) { fa = 1.f; fb = exp2f((float)(l + 1) * lg); }
        else { float qn = 0.f;
#pragma unroll
            for (int d0 = 0; d0 < 8; ++d0)
#pragma unroll
                for (int i = 0; i < 8; ++i) qn += bf1((bf16r)qr[d0][i]) * sn[d0 * 16 + hi * 8 + i];
            qn = swap_add(qn);
            const float wi = swi[l]; const float den = rs + wi * qn; const float dn = fmaxf(fabsf(den), semq[l]); fa = 1.0f / dn; fb = wi / dn; }
        LAS float* fww = fw + wave * 64;
        if (hi == 0) { fww[r32] = fa; fww[32 + r32] = fb; }
        asm volatile("s_waitcnt lgkmcnt(0)" ::: "memory");
#pragma unroll
        for (int r = 0; r < 16; ++r) { const int lr = ccrow(r, hi); OT[(lb * 32 + lr) * 132 + eb * 32 + r32] = fww[lr] * oi[r] + fww[32 + lr] * ox[r]; }
        __syncthreads();
        const int colbase = (it.mixer == 0 ? 0 : 1536) + it.h * 128;
        { const int row = wave * 8 + (lane >> 3), seg = lane & 7;
          const v4u gA = *(const v4u*)(gsrc + (size_t)row * 128 + seg * 16), gB = *(const v4u*)(gsrc + (size_t)row * 128 + seg * 16 + 8);
          float v[16];
#pragma unroll
          for (int q = 0; q < 4; ++q) { const v4f t = *(LAS v4f*)(OT + row * 132 + seg * 16 + 4 * q); v[4 * q] = t.x; v[4 * q + 1] = t.y; v[4 * q + 2] = t.z; v[4 * q + 3] = t.w; }
          float s = 0.f;
#pragma unroll
          for (int q = 0; q < 16; ++q) s += v[q];
          s += __shfl_xor(s, 1); s += __shfl_xor(s, 2); s += __shfl_xor(s, 4);
          const float mu = s * (1.f / 128.f); float sq = 0.f;
#pragma unroll
          for (int q = 0; q < 16; ++q) { v[q] -= mu; sq += v[q] * v[q]; }
          sq += __shfl_xor(sq, 1); sq += __shfl_xor(sq, 2); sq += __shfl_xor(sq, 4);
          const float rstd = 1.0f / sqrtf(sq * (1.f / 128.f) + NORM_EPS);
          float g[16] = {bflo(gA.x), bfhi(gA.x), bflo(gA.y), bfhi(gA.y), bflo(gA.z), bfhi(gA.z), bflo(gA.w), bfhi(gA.w), bflo(gB.x), bfhi(gB.x), bflo(gB.y), bfhi(gB.y), bflo(gB.z), bfhi(gB.z), bflo(gB.w), bfhi(gB.w)};
          const float* mp = msc + colbase + seg * 16;
#pragma unroll
          for (int q = 0; q < 16; ++q) { const float e = expf(-g[q]); const float gate = (it.mixer == 0) ? g[q] / (1.f + e) : 1.f / (1.f + e); v[q] = v[q] * rstd * gate * mp[q]; }
          v4u oA, oB; oA.x = pk2(v[0], v[1]); oA.y = pk2(v[2], v[3]); oA.z = pk2(v[4], v[5]); oA.w = pk2(v[6], v[7]); oB.x = pk2(v[8], v[9]); oB.y = pk2(v[10], v[11]); oB.z = pk2(v[12], v[13]); oB.w = pk2(v[14], v[15]);
          bf16r* yp = Y + (size_t)(it.row0 + row) * DM + colbase + seg * 16;
          *(v4u*)yp = oA; *(v4u*)(yp + 8) = oB; }
        __syncthreads();
    }
}

__device__ __forceinline__ fox::BlockRef<fox::bf16, fox::bf16> fox_ref(CArgs& a, int layer, int bh, int qb, int jlo) {
    const int b = bh >> 3, h = bh & 7; const fox::bf16* P = (const fox::bf16*)(a.ws + WS_P);
    fox::BlockRef<fox::bf16, fox::bf16> r;
    r.Q = P + ((size_t)(16 + h) * MROWS + (size_t)b * SEQ + (size_t)qb * 256) * 128;
    r.K = (unsigned)(WS_P + ((size_t)(24 + h) * MROWS + (size_t)b * SEQ) * 256); r.V = (unsigned)(WS_P + ((size_t)(32 + h) * MROWS + (size_t)b * SEQ) * 256);
    r.O = (fox::bf16*)(a.ws + WS_Y) + ((size_t)b * SEQ + (size_t)qb * 256) * DM + 512 + h * 128;
    r.C = (unsigned)(WS_CNEG + (size_t)bh * SEQ * 4); r.MS = (const float*)a.in[13] + (size_t)layer * DM + 512 + h * 128; const int j4 = jlo >> 2;
    r.P0 = (qb - j4) * 256; r.JLO = j4 * 4;
    r.K += (unsigned)j4 * 256u * 256u; r.V += (unsigned)j4 * 256u * 256u; r.C += (unsigned)j4 * 1024u;
    return r;
}
__device__ __forceinline__ void fox_table_phase(CArgs& a, int layer) {
    const int tid = lz_tid(), lane = tid & 63, u = lz_bid() * 8 + (tid >> 6);
    if (u >= 1024) return;
    const float* QK2 = (const float*)(a.ws + WS_QK2) + layer * 32; const float* CN = (const float*)(a.ws + WS_CNEG);
    const int bh = u & 15, qb = 63 - (u >> 4), b = bh >> 3, h = bh & 7;
    const float qkmax = sqrtf(QK2[b * 16 + h] * QK2[b * 16 + 8 + h]);
    const float* cn = CN + (size_t)bh * SEQ; const float thresh = cn[qb * 256] - (2.0f * qkmax + 1245.0f);
    int cnt = 0;
#pragma unroll
    for (int t = 0; t < 4; ++t) { const int tile = lane + 64 * t; const bool skip = (tile < qb * 4) && (cn[tile * 64 + 63] < thresh); cnt += __popcll(__ballot(skip)); }
    if (lane == 0) ((int*)(a.ws + WS_JT))[layer * 1024 + u] = cnt;
}
__device__ __forceinline__ void fox_phase(CArgs& a, int layer, char* lds, int rep = 0) {
    using BR = fox::BlockRef<fox::bf16, fox::bf16>;
    constexpr int W = 1 << 30, total = 1024;
    const int tid = lz_tid(), lane = tid & 63;
    volatile unsigned* sbuf = (volatile unsigned*)(lds + 69632);
    unsigned* qctr = (unsigned*)(a.ws + WS_QCTR) + layer * 64 + rep * 128;
    const int* JT = (const int*)(a.ws + WS_JT) + layer * 1024;
#define FOX_GRAB(U) do { if (tid == 0) sbuf[0] = __hip_atomic_fetch_add(qctr, 1u, __ATOMIC_RELAXED, __HIP_MEMORY_SCOPE_AGENT); __syncthreads(); U = __builtin_amdgcn_readfirstlane((int)sbuf[0]); __syncthreads(); } while (0)
#define FOX_MAKE(R, U) do { const int bh_ = (U) & 15, qb_ = 63 - ((U) >> 4); R = fox_ref(a, layer, bh_, qb_, __builtin_amdgcn_readfirstlane(JT[(U)])); } while (0)
    int u; FOX_GRAB(u); if (u >= total) return;
    BR cur; FOX_MAKE(cur, u);
    fox::Seam<fox::bf16> S;
    const __amdgpu_buffer_rsrc_t rs = __builtin_amdgcn_make_buffer_rsrc((void*)a.ws, 0, -1, 0x00020000);
    fox::causal_swa_prime<fox::bf16, fox::bf16>(cur, W, lds, S, rs);
    for (;;) {
        int un; FOX_GRAB(un); const bool last = un >= total;
        BR nxt = cur; if (!last) FOX_MAKE(nxt, un);
        fox::causal_swa_block<fox::bf16, fox::bf16>(cur, nxt, SEQ, W, lds, S, rs);
        if (last) break;
        cur = nxt;
    }
#undef FOX_GRAB
#undef FOX_MAKE
}

#ifdef NANPROBE
constexpr size_t WS_FLAGS = 32 * 1024;
__device__ __forceinline__ void probe_f32(const float* p, size_t n, unsigned* flag) { bool bad = false;
    for (size_t i = (size_t)lz_bid() * 512 + lz_tid(); i < n; i += (size_t)gridDim.x * 512) { const unsigned u = __float_as_uint(p[i]); if ((u & 0x7f800000u) == 0x7f800000u) bad = true; }
    if (bad) *flag = 1u; }
__device__ __forceinline__ void probe_bf16(const unsigned short* p, size_t n, unsigned* flag) { bool bad = false;
    for (size_t i = (size_t)lz_bid() * 512 + lz_tid(); i < n; i += (size_t)gridDim.x * 512) { const unsigned u = p[i]; if ((u & 0x7f80u) == 0x7f80u) bad = true; }
    if (bad) *flag = 1u; }
#define PROBE_F32(p, n, k) probe_f32((const float*)(p), (n), (unsigned*)(ws + WS_FLAGS) + (k))
#define PROBE_BF16(p, n, k) probe_bf16((const unsigned short*)(p), (n), (unsigned*)(ws + WS_FLAGS) + (k))
#else
#define PROBE_F32(p, n, k) do {} while (0)
#define PROBE_BF16(p, n, k) do {} while (0)
#endif
#ifndef PHMASK
#define PHMASK 0xfff
#endif
#define EN(k) ((PHMASK >> (k)) & 1)
#define IN(k) (lo <= (k) && (k) < hi)
#ifdef TWICE_SYNC
#define SEAM() do { if (IN(ph) && IN(ph + 1)) { grid.sync(); grid.sync(); grid.sync(); } ++ph; } while (0)
#else
#define SEAM() do { if (IN(ph) && IN(ph + 1)) { if (ph == 0) grid.sync(); else xcd_barrier(xbar); } ++ph; } while (0)
#endif
#define a (*fresh_args())
#define ws (a.ws)
#define MOD ((const float*)(ws + WS_MOD))
template <int layer>
__device__ __forceinline__ void layer_phases(int& ph, const int lo, const int hi, cg::grid_group& grid, const XcdBarrier& xbar, LAS unsigned char* lds, unsigned char* lds_raw) {

        const float* mod = MOD + (size_t)layer * NB * NMOD;
        const float* xin = layer == 0 ? (const float*)a.in[0] : a.out;
        if (EN(1) && IN(ph)) norm_phase(xin, (const float*)a.in[5] + (size_t)layer * DM, mod, mod + DM, (bf16r*)(ws + WS_H));
#ifdef TWICE_NORM
        if (IN(ph)) norm_phase(xin, (const float*)a.in[5] + (size_t)layer * DM, mod, mod + DM, (bf16r*)(ws + WS_H));
#endif
        SEAM();
        if (EN(2) && IN(ph)) { pg8::Gemm g{(const pg8::bf16_t*)(ws + WS_H), (const pg8::bf16_t*)(ws + WS_WIN + layer * WIN_BYTES), MROWS, NINP, DM}; pg8::StaticOrder S; S.init(MROWS, NINP, gridDim.x, lz_bid());
            pg8::EpiIn E{(pg8::bf16_t*)(ws + WS_P), (float*)(ws + WS_GATES)};
            pg8::gemm_phase<pg8::EpiIn, pg8::StaticOrder, true, true>(lds, g, S, E);
            gate_gemm((const bf16r*)(ws + WS_H), (const bf16r*)(ws + WS_WG + layer * WG_BYTES), (float*)(ws + WS_GATES));
#ifdef TWICE_IN
            __syncthreads(); pg8::gemm_phase<pg8::EpiIn, pg8::StaticOrder, true, true>(lds, g, S, E);
#endif
        }
        SEAM();
        if (EN(3) && IN(ph)) prep_phase(a, layer, lds);
#ifdef TWICE_INPREP
        if (IN(ph)) { xcd_barrier(xbar);
            { pg8::Gemm g{(const pg8::bf16_t*)(ws + WS_H), (const pg8::bf16_t*)(ws + WS_WIN + layer * WIN_BYTES), MROWS, NINP, DM}; pg8::StaticOrder S; S.init(MROWS, NINP, gridDim.x, lz_bid());
              pg8::EpiIn E{(pg8::bf16_t*)(ws + WS_P), (float*)(ws + WS_GATES)};
              pg8::gemm_phase<pg8::EpiIn, pg8::StaticOrder, true, true>(lds, g, S, E); }
            xcd_barrier(xbar); prep_phase(a, layer, lds); }
#endif
        SEAM();
        PROBE_F32(ws + WS_GATES, (size_t)MROWS * 16, 1 + 10 * layer); PROBE_F32(ws + WS_CNEG, (size_t)NB * 8 * SEQ, 2 + 10 * layer); PROBE_F32(ws + WS_MA, (size_t)3 * NB * 4 * SEQ, 3 + 10 * layer); PROBE_BF16(ws + WS_P, (size_t)56 * MROWS * 128, 4 + 10 * layer); PROBE_BF16(ws + WS_MQC, (size_t)8 * MROWS * 128, 5 + 10 * layer);
        if (IN(ph)) { fox_table_phase(a, layer); if (EN(4)) m1_phase(a, lds);
#if 0
#ifdef TWICE_FOX
            __syncthreads(); fox_phase(a, layer, (char*)lds_raw);
#endif
#endif
#ifdef TWICE_M1
            __syncthreads(); m1_phase(a, lds);
#endif
        }
        SEAM();
#ifdef NANPROBE
        PROBE_BF16(ws + WS_H, (size_t)MROWS * DM, 20 + layer); PROBE_F32(ws + WS_UN, (size_t)NB * 4 * 256 * 128, 22 + layer); PROBE_F32(ws + WS_MPREV, (size_t)NB * 4 * 256, 24 + layer); grid.sync();
#endif
        if (IN(ph)) { if (EN(6)) m2_phase(a, lds); __syncthreads(); if (EN(5)) fox_phase(a, layer, (char*)lds_raw);
#ifdef TWICE_FOX
            __syncthreads(); fox_phase(a, layer, (char*)lds_raw, 1);
#endif
        }
        SEAM();
        if (EN(7) && IN(ph)) m3_phase(a, layer, lds);
#ifdef TWICE_M3
        if (IN(ph)) { __syncthreads(); m3_phase(a, layer, lds); }
#endif
        SEAM();
        PROBE_BF16(ws + WS_H, (size_t)MROWS * DM, 6 + 10 * layer); PROBE_BF16(ws + WS_Y, (size_t)MROWS * DM, 7 + 10 * layer);
        if (EN(8) && IN(ph)) { pg8::Gemm g{(const pg8::bf16_t*)(ws + WS_Y), (const pg8::bf16_t*)(ws + WS_WOUT + layer * WOUT_BYTES), MROWS, DM, DM}; pg8::StaticOrder S; S.init(MROWS, DM, gridDim.x, lz_bid());
            pg8::EpiRes E{xin, a.out, mod + 2 * DM};
            pg8::gemm_phase<pg8::EpiRes, pg8::StaticOrder, true, true>(lds, g, S, E); }
        SEAM();
        PROBE_F32(a.out, (size_t)MROWS * DM, 8 + 10 * layer);
        if (EN(1) && IN(ph)) norm_phase(a.out, (const float*)a.in[6] + (size_t)layer * DM, mod + 3 * DM, mod + 4 * DM, (bf16r*)(ws + WS_H));
#ifdef TWICE_NORM
        if (IN(ph)) norm_phase(a.out, (const float*)a.in[6] + (size_t)layer * DM, mod + 3 * DM, mod + 4 * DM, (bf16r*)(ws + WS_H));
#endif
        SEAM();
        if (EN(9) && IN(ph)) { pg8::Gemm g{(const pg8::bf16_t*)(ws + WS_H), (const pg8::bf16_t*)(ws + WS_WFF1 + layer * WFF_BYTES), MROWS, DFF, DM}; pg8::StaticOrder S; S.init(MROWS, DFF, gridDim.x, lz_bid());
            pg8::EpiRelu2 E{(pg8::bf16_t*)(ws + WS_HID), DFF};
            pg8::gemm_phase<pg8::EpiRelu2, pg8::StaticOrder, true, true>(lds, g, S, E);
#ifdef TWICE_FF1
            __syncthreads(); pg8::gemm_phase<pg8::EpiRelu2, pg8::StaticOrder, true, true>(lds, g, S, E);
#endif
        }
        SEAM();
        if (EN(10) && IN(ph)) { pg8::Gemm g{(const pg8::bf16_t*)(ws + WS_HID), (const pg8::bf16_t*)(ws + WS_WFF2 + layer * WFF_BYTES), MROWS, DM, DFF}; pg8::StaticOrder S; S.init(MROWS, DM, gridDim.x, lz_bid());
            pg8::EpiRes E{a.out, a.out, mod + 5 * DM};
            pg8::gemm_phase<pg8::EpiRes, pg8::StaticOrder, true, true>(lds, g, S, E); }
        SEAM();
        PROBE_F32(a.out, (size_t)MROWS * DM, 9 + 10 * layer);
    }
__global__ void __launch_bounds__(512, 2) trunk_fwd(Args a_unused) {
    extern __shared__ __attribute__((aligned(16))) unsigned char lds_raw[];
    LAS unsigned char* lds = (LAS unsigned char*)lds_raw;
    cg::grid_group grid = cg::this_grid();
    int lo, hi; { CArgs& a0 = *fresh_args(); lo = a0.ph_lo; hi = a0.ph_hi; } int ph = 0;
    volatile LAS unsigned* xst = (volatile LAS unsigned*)(lds + 139264);
    if (lz_tid() < 2) xst[lz_tid()] = 0u;
    __syncthreads();
    if (lz_bid() == 0) { unsigned* z = (unsigned*)ws; for (int i = lz_tid(); i < 4096; i += 512) z[i] = 0u; }
#ifdef NANPROBE
    if (lz_bid() == 0 && lz_tid() < 32) ((unsigned*)(ws + WS_FLAGS))[lz_tid()] = 0u;
#endif
    if (EN(0) && IN(ph)) p0_phase(a, lds);
#ifdef TWICE_P0
    if (IN(ph)) { __syncthreads(); p0_phase(a, lds); }
#endif
    if (IN(ph) && IN(ph + 1)) grid.sync();
    ++ph;
    const XcdBarrier xbar = xcd_barrier_post((unsigned*)ws, xst);
    layer_phases<0>(ph, lo, hi, grid, xbar, lds, lds_raw);
    layer_phases<1>(ph, lo, hi, grid, xbar, lds, lds_raw);
    if (EN(11) && IN(ph)) final_norm_phase(a.out, (const float*)a.in[17]);
#ifdef NANPROBE
    { grid.sync(); float code = 0.f; const unsigned* fl = (const unsigned*)(ws + WS_FLAGS);
      const int order[16] = {1, 2, 3, 4, 5, 24, 20, 22, 6, 7, 8, 9, 11, 12, 13, 14};
      for (int q = 15; q >= 0; --q) if (fl[order[q]]) code = (float)order[q] * 1.0e6f;
      float* o = a.out; for (size_t i = (size_t)lz_bid() * 512 + lz_tid(); i < (size_t)MROWS * DM; i += (size_t)gridDim.x * 512) o[i] = (i == 0) ? code : 0.f; }
#endif
#ifdef DBG_OFF_MIB
    { grid.sync();
      const unsigned short* src = (const unsigned short*)(ws + (size_t)DBG_OFF_MIB * MiB); const size_t n = (size_t)DBG_MIB * MiB / 2; float* o = a.out;
      for (size_t i = (size_t)lz_bid() * 512 + lz_tid(); i < (size_t)MROWS * DM; i += (size_t)gridDim.x * 512) { const size_t k = (4 * i) % n;
          o[i] = (float)src[k] + 3.f * (float)src[k + 1] + 5.f * (float)src[k + 2] + 7.f * (float)src[k + 3]; } }
#endif
#undef IN
#undef SEAM
#undef a
#undef ws
#undef MOD
}

#ifndef MK_PER_PHASE
#define MK_PER_PHASE 0
#endif
extern "C" void kernel_launch(void* const* d_in, const int* in_sizes, int n_in, void* d_out, int out_size, void* d_ws, size_t ws_size, hipStream_t stream) {
    static int grid = 0;
    if (grid == 0) {
        if (n_in != 18 || in_sizes[0] != MROWS * DM || out_size != MROWS * DM || ws_size < WS_END) { fprintf(stderr, "kernel_launch: unexpected shapes (n_in %d, in0 %d, out %d, ws %zu)\n", n_in, n_in > 0 ? in_sizes[0] : -1, out_size, ws_size); grid = -1; return; }
        int dev = 0, cus = 0, per_cu = 0;
        if (hipGetDevice(&dev) != hipSuccess || hipDeviceGetAttribute(&cus, hipDeviceAttributeMultiprocessorCount, dev) != hipSuccess) { grid = -1; return; }
        if (hipFuncSetAttribute((const void*)trunk_fwd, hipFuncAttributeMaxDynamicSharedMemorySize, LDS_BYTES) != hipSuccess) { fprintf(stderr, "kernel_launch: hipFuncSetAttribute failed\n"); grid = -1; return; }
        if (hipOccupancyMaxActiveBlocksPerMultiprocessor(&per_cu, (const void*)trunk_fwd, 512, LDS_BYTES) != hipSuccess || per_cu < 1) { fprintf(stderr, "kernel_launch: occupancy query says %d\n", per_cu); per_cu = 1; }
        (void)hipGetLastError();
        grid = cus;
    }
    if (grid < 0) return;
    Args a{};
    for (int i = 0; i < 18; ++i) a.in[i] = d_in[i];
    a.out = (float*)d_out; a.ws = (unsigned char*)d_ws;
    constexpr int NPH = 1 + 2 * 10 + 1;
#if MK_PER_PHASE
    for (int p = 0; p < NPH; ++p) { a.ph_lo = p; a.ph_hi = p + 1; hipLaunchKernelGGL(trunk_fwd, dim3(grid), dim3(512), LDS_BYTES, stream, a); }
#else
#ifdef DBG_HI
    a.ph_lo = 0; a.ph_hi = DBG_HI;
#else
    a.ph_lo = 0; a.ph_hi = NPH;
#endif
    void* args[] = {&a};
    hipError_t e = hipLaunchCooperativeKernel((const void*)trunk_fwd, dim3(grid), dim3(512), args, LDS_BYTES, stream);
    if (e != hipSuccess) fprintf(stderr, "kernel_launch: cooperative launch failed: %s (grid %d)\n", hipGetErrorString(e), grid);
#endif
}
```

```cpp
#include <hip/hip_runtime.h>
#include <hip/hip_bf16.h>
#include <hip/hip_cooperative_groups.h>
#include <cstdio>
#include <cstdint>
namespace cg = cooperative_groups;

constexpr int NB = 2, SEQ = 16384, DM = 2048, MROWS = NB * SEQ, DIN = 7184, NINP = 7168, DFF = 8192, HD = 128, NMOD = 6 * DM;
constexpr int NSLOT = 56;
constexpr float NORM_EPS = 1e-6f;
constexpr float KSCALE = 0.08838834764831845f;

__device__ __forceinline__ int lz_tid() { const int w = __builtin_amdgcn_readfirstlane((int)threadIdx.x >> 6); int l; asm volatile("v_mbcnt_lo_u32_b32 %0, -1, 0\n\tv_mbcnt_hi_u32_b32 %0, -1, %0" : "=v"(l));
    int t = w * 64 + l; asm volatile("" : "+v"(t)); return t; }
__device__ __forceinline__ int lz_bid() { int b = blockIdx.x; asm volatile("" : "+s"(b)); return b; }

namespace pg8 {
#define PG8_LAS __attribute__((address_space(3)))
typedef unsigned short bf16_t;
typedef short bf16x8 __attribute__((ext_vector_type(8)));
typedef float f32x4 __attribute__((ext_vector_type(4)));
typedef unsigned u32x4 __attribute__((ext_vector_type(4)));
constexpr int BM = 256, BK = 64, HALF = 128, HTB = HALF * BK * 2  , STAGE_BYTES = 8 * HTB, NXCD = 8, WGM = 4;

__host__ __device__ __forceinline__ int lds_byte(int r, int c) { const int st = (r >> 4) * 2 + (c >> 5), rr = r & 15, cc = c & 31, ob = rr * 64 + cc * 2; return st * 1024 + (ob ^ (((ob >> 9) & 1) << 5)); }
__host__ __device__ __forceinline__ void stage_rc(int b, int& R, int& C) { const int st = b / 1024, sb = b % 1024, swz = sb ^ (((sb >> 9) & 1) << 5); R = (st >> 1) * 16 + swz / 64; C = (st & 1) * 32 + (swz % 64) / 2; }
__host__ __device__ __forceinline__ int perm32(int rho) { const int n = rho >> 4, i = rho & 15; return 8 * (i >> 2) + 4 * n + (i & 3); }

struct Unit { int pm, pn; };
struct Gemm { const bf16_t* A; const bf16_t* Bt; int M, N, K; };

struct StaticOrder {
    int nM, nN, nwg, G, c;
    __host__ __device__ void init(int M, int N, int G_, int c_) { nM = M / BM; nN = N / BM; nwg = nM * nN; G = G_; c = c_; }
    __host__ __device__ bool next(int i, Unit& u) const {
        const long L = (long)i * G + c; if (L >= nwg) return false;
        int wgid = (int)L; { const int q = nwg / NXCD, r = nwg % NXCD, xcd = wgid % NXCD, off = wgid / NXCD; wgid = (xcd < r ? xcd * (q + 1) : r * (q + 1) + (xcd - r) * q) + off; }
        const int nig = WGM * nN, gid = wgid / nig, fm = gid * WGM, gsz = (nM - fm) < WGM ? (nM - fm) : WGM;
        u.pm = fm + ((wgid % nig) % gsz); u.pn = (wgid % nig) / gsz; return true;
    }
    __device__ __forceinline__ void a_ready(const Unit&) const {}
    __device__ __forceinline__ void done(const Unit&) const {}
};

__device__ __forceinline__ unsigned cvt_pk_bf16(float lo, float hi) { unsigned r; asm volatile("v_cvt_pk_bf16_f32 %0, %1, %2" : "=v"(r) : "v"(lo), "v"(hi)); return r; }

typedef float epf2_t __attribute__((ext_vector_type(2))); typedef __bf16 epb2_t __attribute__((ext_vector_type(2)));
__device__ __forceinline__ unsigned cvt_pk_c(float lo, float hi) { epf2_t v = {lo, hi}; epb2_t b = __builtin_convertvector(v, epb2_t); return __builtin_bit_cast(unsigned, b); }
struct EpiIn {
    static constexpr bool PERM = true, AFTER_DRAIN = false;
    bf16_t* P; float* gates;
    __device__ __forceinline__ void operator()(const f32x4 (&acc)[2][2][4][2], const Unit& u, int wr, int wc, int fr, int fq) const {
        const int row0 = u.pm * BM + wr * 64 + fr;
#pragma unroll
        for (int bj = 0; bj < 2; ++bj) {
            const int g = 2 * u.pn + bj;
            if (g < 56) {
                bf16_t* base = P + ((size_t)g * MROWS + row0) * 128 + wc * 32 + 8 * fq;
#pragma unroll
                for (int ai = 0; ai < 2; ++ai)
#pragma unroll
                    for (int m = 0; m < 4; ++m) { const f32x4 v0 = acc[ai][bj][m][0], v1 = acc[ai][bj][m][1];
                        u32x4 w; w.x = cvt_pk_c(v0[0], v0[1]); w.y = cvt_pk_c(v0[2], v0[3]); w.z = cvt_pk_c(v1[0], v1[1]); w.w = cvt_pk_c(v1[2], v1[3]);
                        *(u32x4*)(base + (size_t)(ai * HALF + m * 16) * 128) = w; }
            } else if (g == 56) {
                if (wc == 0 && fq < 2) { float* gp = gates + (size_t)row0 * 16 + 8 * fq;
#pragma unroll
                    for (int ai = 0; ai < 2; ++ai)
#pragma unroll
                        for (int m = 0; m < 4; ++m) { *(f32x4*)(gp + (size_t)(ai * HALF + m * 16) * 16) = acc[ai][bj][m][0]; *(f32x4*)(gp + (size_t)(ai * HALF + m * 16) * 16 + 4) = acc[ai][bj][m][1]; } }
            }
        }
    }
};
struct EpiRes {
    static constexpr bool PERM = true, AFTER_DRAIN = false;
    const float* base; float* out; const float* gvec;
    __device__ __forceinline__ void operator()(const f32x4 (&acc)[2][2][4][2], const Unit& u, int wr, int wc, int fr, int fq) const {
        const int row0 = u.pm * BM + wr * 64 + fr; const int b = (u.pm * BM) / SEQ; const float* gv = gvec + (size_t)b * NMOD;
#pragma unroll
        for (int bj = 0; bj < 2; ++bj) { const int c = u.pn * BM + bj * HALF + wc * 32 + 8 * fq;
            const f32x4 g0 = *(const f32x4*)(gv + c), g1 = *(const f32x4*)(gv + c + 4);
#pragma unroll
            for (int ai = 0; ai < 2; ++ai)
#pragma unroll
                for (int m = 0; m < 4; ++m) { const size_t off = (size_t)(row0 + ai * HALF + m * 16) * DM + c;
                    const f32x4 x0 = *(const f32x4*)(base + off), x1 = *(const f32x4*)(base + off + 4);
                    *(f32x4*)(out + off) = x0 + g0 * acc[ai][bj][m][0]; *(f32x4*)(out + off + 4) = x1 + g1 * acc[ai][bj][m][1]; } }
    }
};
struct EpiRelu2 {
    static constexpr bool PERM = true, AFTER_DRAIN = false;
    bf16_t* O; int ldc;
    __device__ __forceinline__ void operator()(const f32x4 (&acc)[2][2][4][2], const Unit& u, int wr, int wc, int fr, int fq) const {
        const int row0 = u.pm * BM + wr * 64 + fr;
#pragma unroll
        for (int bj = 0; bj < 2; ++bj) { bf16_t* base = O + (size_t)row0 * ldc + u.pn * BM + bj * HALF + wc * 32 + 8 * fq;
#pragma unroll
            for (int ai = 0; ai < 2; ++ai)
#pragma unroll
                for (int m = 0; m < 4; ++m) { f32x4 v0 = acc[ai][bj][m][0], v1 = acc[ai][bj][m][1];
#pragma unroll
                    for (int i = 0; i < 4; ++i) { const float a = v0[i] > 0.f ? v0[i] : 0.f, b = v1[i] > 0.f ? v1[i] : 0.f; v0[i] = a * a; v1[i] = b * b; }
                    u32x4 w; w.x = cvt_pk_c(v0[0], v0[1]); w.y = cvt_pk_c(v0[2], v0[3]); w.z = cvt_pk_c(v1[0], v1[1]); w.w = cvt_pk_c(v1[2], v1[3]);
                    *(u32x4*)(base + (size_t)(ai * HALF + m * 16) * ldc) = w; } }
    }
};

template <class Epi, class Sched, bool ALIGN_EPI = false, bool SP2 = false>
__device__ __forceinline__ void gemm_phase(PG8_LAS unsigned char* lds, const Gemm g, const Sched& S, const Epi& E) {
    const int tid = lz_tid(), wid = __builtin_amdgcn_readfirstlane(tid >> 6), lane = tid & 63, wr = wid >> 2, wc = wid & 3, fr = lane & 15, fq = lane >> 4;
    const int K = g.K, nt = K / BK;
    unsigned voffA[2], voffB[2];
#pragma unroll
    for (int i = 0; i < 2; ++i) { int R, C; stage_rc(tid * 16 + i * 8192, R, C); const int Rb = Epi::PERM ? ((R & ~31) + perm32(R & 31)) : R;
        voffA[i] = (unsigned)(R * K + C) * 2u; voffB[i] = (unsigned)(Rb * K + C) * 2u; }
    const size_t kstep = (size_t)(BK * 2);
    const size_t hstep = (size_t)HALF * K * 2;
    const size_t tstep = 2 * hstep;
    const unsigned ldsw = (unsigned)wid * 1024u;
    const int aoff = lds_byte(wr * 64 + fr, fq * 8), boff = lds_byte(wc * 32 + fr, fq * 8);
#define PG8_SA(b, h) (((b) * 2 + (h)) * HTB)
#define PG8_SB(b, h) ((4 + (b) * 2 + (h)) * HTB)
#define PG8_STAGE(bufoff, gbase, voff) do { _Pragma("unroll") for (int _i = 0; _i < 2; ++_i) \
        __builtin_amdgcn_global_load_lds((const unsigned*)((const char*)(gbase) + (voff)[_i]), (PG8_LAS unsigned*)(lds + (bufoff) + ldsw + _i * 8192), 16, 0, 0); } while (0)
#define PG8_LDA(dst, b, h) do { _Pragma("unroll") for (int m = 0; m < 4; ++m) _Pragma("unroll") for (int k = 0; k < 2; ++k) dst[m][k] = *(const PG8_LAS bf16x8*)(lds + PG8_SA(b, h) + aoff + m * 2048 + k * 1024); } while (0)
#define PG8_LDB(dst, b, h) do { _Pragma("unroll") for (int n = 0; n < 2; ++n) _Pragma("unroll") for (int k = 0; k < 2; ++k) dst[n][k] = *(const PG8_LAS bf16x8*)(lds + PG8_SB(b, h) + boff + n * 2048 + k * 1024); } while (0)
#define PG8_MMA(ai, bj, At, Bt) do { __builtin_amdgcn_s_setprio(1); _Pragma("unroll") for (int m = 0; m < 4; ++m) _Pragma("unroll") for (int n = 0; n < 2; ++n) _Pragma("unroll") for (int k = 0; k < 2; ++k) \
        acc[ai][bj][m][n] = __builtin_amdgcn_mfma_f32_16x16x32_bf16(Bt[n][k], At[m][k], acc[ai][bj][m][n], 0, 0, 0); __builtin_amdgcn_s_setprio(0); } while (0)
#define PG8_WAIT_V(n) asm volatile("s_waitcnt vmcnt(" #n ")" ::: "memory")
#define PG8_WAIT_L(n) asm volatile("s_waitcnt lgkmcnt(" #n ")" ::: "memory")
#define PG8_BAR __builtin_amdgcn_s_barrier()
#define PG8_SCHED __builtin_amdgcn_sched_barrier(0)
    Unit cur, nxt; int ui = 0;
    if (!S.next(0, cur)) return;
    f32x4 acc[2][2][4][2];
#pragma unroll
    for (int a = 0; a < 2; ++a)
#pragma unroll
        for (int b = 0; b < 2; ++b)
#pragma unroll
            for (int m = 0; m < 4; ++m)
#pragma unroll
                for (int n = 0; n < 2; ++n) acc[a][b][m][n] = (f32x4){0.f, 0.f, 0.f, 0.f};
    bf16x8 At[4][2], B0[2][2], B1[2][2];
    const char* cA = (const char*)g.A + (size_t)cur.pm * tstep; const char* cB = (const char*)g.Bt + (size_t)cur.pn * tstep;
    S.a_ready(cur);
    if constexpr (SP2) {
        PG8_STAGE(PG8_SB(0, 0), cB, voffB); PG8_STAGE(PG8_SB(0, 1), cB + hstep, voffB); PG8_STAGE(PG8_SA(0, 0), cA, voffA); PG8_STAGE(PG8_SA(0, 1), cA + hstep, voffA);
        if (wr == 1) PG8_BAR;
        PG8_WAIT_V(2); PG8_BAR;
        PG8_STAGE(PG8_SB(1, 0), cB + kstep, voffB); PG8_STAGE(PG8_SA(1, 0), cA + kstep, voffA); PG8_STAGE(PG8_SB(1, 1), cB + hstep + kstep, voffB);
        PG8_WAIT_V(6); PG8_BAR;
    } else {
        PG8_STAGE(PG8_SB(0, 0), cB, voffB); PG8_STAGE(PG8_SA(0, 0), cA, voffA); PG8_STAGE(PG8_SB(0, 1), cB + hstep, voffB); PG8_STAGE(PG8_SA(0, 1), cA + hstep, voffA);
        if (wr == 1) PG8_BAR;
        PG8_WAIT_V(4); PG8_BAR;
        PG8_STAGE(PG8_SB(1, 0), cB + kstep, voffB); PG8_STAGE(PG8_SA(1, 0), cA + kstep, voffA); PG8_STAGE(PG8_SB(1, 1), cB + hstep + kstep, voffB);
        PG8_WAIT_V(6); PG8_BAR;
    }
    for (;;) {
        const bool has_next = S.next(ui + 1, nxt);
        const char* nA = has_next ? (const char*)g.A + (size_t)nxt.pm * tstep : cA; const char* nB = has_next ? (const char*)g.Bt + (size_t)nxt.pn * tstep : cB;
        for (int t = 0; t < nt; t += 2) {
            const bool last = (t == nt - 2);
            const char* a1 = cA + (size_t)(t + 1) * kstep;
            const char* a2 = last ? nA : cA + (size_t)(t + 2) * kstep; const char* b2 = last ? nB : cB + (size_t)(t + 2) * kstep;
            const char* a3 = a2 + kstep; const char* b3 = b2 + kstep;
            if (last && has_next) S.a_ready(nxt);
            if constexpr (SP2) {
            PG8_LDB(B0, 0, 0); PG8_LDB(B1, 0, 1); PG8_SCHED; PG8_LDA(At, 0, 0); PG8_STAGE(PG8_SA(1, 1), a1 + hstep, voffA);
            PG8_WAIT_V(8); PG8_WAIT_L(0); PG8_BAR; PG8_MMA(0, 0, At, B0); PG8_MMA(0, 1, At, B1); PG8_BAR; PG8_SCHED;
            PG8_LDA(At, 0, 1); PG8_STAGE(PG8_SB(0, 0), b2, voffB); PG8_STAGE(PG8_SB(0, 1), b2 + hstep, voffB); PG8_STAGE(PG8_SA(0, 0), a2, voffA);
            PG8_WAIT_V(8); PG8_WAIT_L(0); PG8_BAR; PG8_MMA(1, 0, At, B0); PG8_MMA(1, 1, At, B1); PG8_BAR; PG8_SCHED;
            PG8_LDB(B0, 1, 0); PG8_LDB(B1, 1, 1); PG8_SCHED; PG8_LDA(At, 1, 0); PG8_STAGE(PG8_SA(0, 1), a2 + hstep, voffA);
            PG8_WAIT_V(8); PG8_WAIT_L(0); PG8_BAR; PG8_MMA(0, 0, At, B0); PG8_MMA(0, 1, At, B1); PG8_BAR; PG8_SCHED;
            PG8_LDA(At, 1, 1); PG8_STAGE(PG8_SB(1, 0), b3, voffB); PG8_STAGE(PG8_SB(1, 1), b3 + hstep, voffB); PG8_STAGE(PG8_SA(1, 0), a3, voffA);
            PG8_WAIT_V(8); PG8_WAIT_L(0); PG8_BAR; PG8_MMA(1, 0, At, B0); PG8_MMA(1, 1, At, B1); PG8_BAR; PG8_SCHED;
            } else {
            PG8_LDB(B0, 0, 0); PG8_SCHED; PG8_LDA(At, 0, 0); PG8_STAGE(PG8_SA(1, 1), a1 + hstep, voffA);
            PG8_WAIT_L(8); PG8_BAR; PG8_WAIT_L(0); PG8_MMA(0, 0, At, B0); PG8_BAR; PG8_SCHED;
            PG8_LDB(B1, 0, 1); PG8_STAGE(PG8_SB(0, 0), b2, voffB);
            PG8_BAR; PG8_WAIT_L(0); PG8_MMA(0, 1, At, B1); PG8_BAR;
            PG8_LDA(At, 0, 1); PG8_STAGE(PG8_SA(0, 0), a2, voffA);
            PG8_BAR; PG8_WAIT_L(0); PG8_MMA(1, 0, At, B0); PG8_BAR; PG8_SCHED;
            PG8_STAGE(PG8_SB(0, 1), b2 + hstep, voffB);
            PG8_WAIT_V(6); PG8_BAR; PG8_MMA(1, 1, At, B1); PG8_BAR;
            PG8_LDB(B0, 1, 0); PG8_SCHED; PG8_LDA(At, 1, 0); PG8_STAGE(PG8_SA(0, 1), a2 + hstep, voffA);
            PG8_WAIT_L(8); PG8_BAR; PG8_WAIT_L(0); PG8_MMA(0, 0, At, B0); PG8_BAR; PG8_SCHED;
            PG8_LDB(B1, 1, 1); PG8_STAGE(PG8_SB(1, 0), b3, voffB);
            PG8_BAR; PG8_WAIT_L(0); PG8_MMA(0, 1, At, B1); PG8_BAR;
            PG8_LDA(At, 1, 1); PG8_STAGE(PG8_SA(1, 0), a3, voffA);
            PG8_BAR; PG8_WAIT_L(0); PG8_MMA(1, 0, At, B0); PG8_BAR; PG8_SCHED;
            PG8_STAGE(PG8_SB(1, 1), b3 + hstep, voffB);
            PG8_WAIT_V(6); PG8_BAR; PG8_MMA(1, 1, At, B1); PG8_BAR;
            }
        }
        if constexpr (ALIGN_EPI) { if (wr == 0) PG8_BAR; }
        if constexpr (!Epi::AFTER_DRAIN) { E(acc, cur, wr, wc, fr, fq); S.done(cur); }
        if (!has_next) break;
#pragma unroll
        for (int a = 0; a < 2; ++a)
#pragma unroll
            for (int b = 0; b < 2; ++b)
#pragma unroll
                for (int m = 0; m < 4; ++m)
#pragma unroll
                    for (int n = 0; n < 2; ++n) acc[a][b][m][n] = (f32x4){0.f, 0.f, 0.f, 0.f};
        cur = nxt; cA = nA; cB = nB; ++ui;
        if constexpr (ALIGN_EPI) { if (wr == 1) PG8_BAR; }
    }
    PG8_WAIT_V(0);
    if constexpr (!ALIGN_EPI) { if (wr == 0) PG8_BAR; }
    PG8_BAR;
    if constexpr (Epi::AFTER_DRAIN) { E.fused(acc, cur, wr, wc, fr, fq, lds, wid, lane); S.done(cur); }
#undef PG8_SA
#undef PG8_SB
#undef PG8_STAGE
#undef PG8_LDA
#undef PG8_LDB
#undef PG8_MMA
#undef PG8_WAIT_V
#undef PG8_WAIT_L
#undef PG8_BAR
#undef PG8_SCHED
}
}
namespace fox {
constexpr int D = 128; constexpr float THR = 8.f; constexpr bool WSKIP = false; constexpr int OSTR = 2048;
constexpr float SCALE = 0.08838834764831845f;
constexpr int NW = 8, QBLK = 32, KVBLK = 64, QB = NW * QBLK;
constexpr int SHM_V = KVBLK * D * 2, SHM_K = KVBLK * D * 2;
constexpr int LDS_CB = 2 * SHM_V + 2 * SHM_K + NW * 64 * 4; constexpr int LDS_BYTES = LDS_CB + 2 * 64 * 4;

using bf16 = __hip_bfloat16;
typedef short bf16x8 __attribute__((ext_vector_type(8)));
typedef short s16x4 __attribute__((ext_vector_type(4)));
typedef float f32x16 __attribute__((ext_vector_type(16)));
typedef float f32x4 __attribute__((ext_vector_type(4)));
typedef unsigned u32x4 __attribute__((ext_vector_type(4)));
template <class A, class Bt> struct same_t { static constexpr bool v = false; };
template <class A> struct same_t<A, A> { static constexpr bool v = true; };

#define KSWZ(row, colB) ((row) * 256 + ((colB) ^ (((row) & 7) << 4)))
#define SBAR() __builtin_amdgcn_sched_barrier(0)
__device__ __forceinline__ int v_st(int k, int c) { const int kk = (k & ~0xC) | ((k & 4) << 1) | ((k & 8) >> 1); return ((kk >> 3) * 4 + (c >> 5)) * 512 + ((kk & 7) * 32 + (c & 31)) * 2; }
__device__ __forceinline__ int v_rd_base(int lane) { return ((lane & 3) << 3) | (((lane >> 2) & 3) << 6) | (((lane >> 4) & 1) << 5) | (((lane >> 5) & 1) << 8); }
constexpr int v_rd_off(int d0, int ks, int half) { return d0 * 512 + ks * 4096 + half * 2048; }
__device__ __forceinline__ int crow(int r, int hi) { return (r & 3) + 8 * (r >> 2) + 4 * hi; }
__device__ __forceinline__ unsigned cvtpk(float lo, float hi) {
    unsigned r; asm volatile("v_cvt_pk_bf16_f32 %0, %1, %2" : "=v"(r) : "v"(lo), "v"(hi)); return r;
}
__device__ __forceinline__ bf16x8 pack8(f32x4 a, f32x4 b) {
    u32x4 w = {cvtpk(a[0], a[1]), cvtpk(a[2], a[3]), cvtpk(b[0], b[1]), cvtpk(b[2], b[3])};
    return *reinterpret_cast<bf16x8*>(&w);
}
template <class T> __device__ __forceinline__ bf16x8 load8(const T* p) {
    if constexpr (same_t<T, float>::v) { return pack8(*(const f32x4*)p, *(const f32x4*)(p + 4)); }
    else { return *reinterpret_cast<const bf16x8*>(p); }
}
__device__ __forceinline__ void mask_tile(f32x16& p0, f32x16& p1, int dq, unsigned W) {
    const float NEG = -__builtin_inff();
#pragma unroll
    for (int r = 0; r < 16; ++r) {
        const int c = (r & 3) + 8 * (r >> 2);
        if ((unsigned)(dq - c) >= W) p0[r] = NEG;
        if ((unsigned)(dq - c - 32) >= W) p1[r] = NEG;
    }
}
__device__ __forceinline__ void partialSM(f32x16& p0, f32x16& p1, float& m_reg, float& mn, float& alpha) {
    float pmax = p0[0]; for (int r = 1; r < 16; ++r) pmax = fmaxf(pmax, p0[r]); for (int r = 0; r < 16; ++r) pmax = fmaxf(pmax, p1[r]);
    { auto rr = __builtin_amdgcn_permlane32_swap(__float_as_uint(pmax), __float_as_uint(pmax), false, false);
      pmax = fmaxf(__uint_as_float(rr[0]), __uint_as_float(rr[1])); }
    constexpr float C2 = 1.4426950408889634f * SCALE;
    if (__builtin_expect(__all((pmax - m_reg) * SCALE <= THR), 1)) { mn = m_reg; alpha = 1.f; }
    else { mn = fmaxf(m_reg, pmax); alpha = __builtin_amdgcn_exp2f((m_reg - mn) * C2); m_reg = mn; }
    const float mnL = -mn * C2;
    for (int r = 0; r < 16; ++r) p0[r] = fmaf(p0[r], C2, mnL); for (int r = 0; r < 16; ++r) p1[r] = fmaf(p1[r], C2, mnL);
    for (int r = 0; r < 16; ++r) p0[r] = __builtin_amdgcn_exp2f(p0[r]);
}
__device__ __forceinline__ void finishSM(f32x16& p0, f32x16& p1, float alpha, float& l_reg, bf16x8& pa0, bf16x8& pa1, bf16x8& pa2, bf16x8& pa3) {
    for (int r = 0; r < 16; ++r) p1[r] = __builtin_amdgcn_exp2f(p1[r]);
    float ps = 0; for (int r = 0; r < 16; ++r) ps += p0[r]; for (int r = 0; r < 16; ++r) ps += p1[r];
    { auto rr = __builtin_amdgcn_permlane32_swap(__float_as_uint(ps), __float_as_uint(ps), false, false);
      ps = __uint_as_float(rr[0]) + __uint_as_float(rr[1]); }
    l_reg = l_reg * alpha + ps;
#define PK4(P, B_, OUT) do { unsigned a0 = cvtpk(P[B_+0], P[B_+1]), a1 = cvtpk(P[B_+2], P[B_+3]);                          \
        unsigned b0 = cvtpk(P[B_+4], P[B_+5]), b1 = cvtpk(P[B_+6], P[B_+7]);                                             \
        auto r0 = __builtin_amdgcn_permlane32_swap(a0, b0, false, false); auto r1 = __builtin_amdgcn_permlane32_swap(a1, b1, false, false); \
        u32x4 w = {r0[0], r1[0], r0[1], r1[1]}; OUT = *reinterpret_cast<bf16x8*>(&w); } while (0)
    PK4(p0, 0, pa0); PK4(p0, 8, pa1); PK4(p1, 0, pa2); PK4(p1, 8, pa3);
#undef PK4
}
template <int KB, bool SK>
__device__ __forceinline__ void qkt(f32x16& p0, f32x16& p1, const char* K_lds, const float* cb, int r32, int hi, const bf16x8* qr, bool act) {
    if (SK && !act) { const float NEG = -__builtin_inff();
#pragma unroll
        for (int r = 0; r < 16; ++r) { p0[r] = NEG; p1[r] = NEG; } return; }
    { const float* cbp = cb + KB * 64 + 4 * hi;
#pragma unroll
      for (int g = 0; g < 4; ++g) { const f32x4 t0 = *(const f32x4*)(cbp + 8 * g), t1 = *(const f32x4*)(cbp + 32 + 8 * g);
        p0[4*g] = t0[0]; p0[4*g+1] = t0[1]; p0[4*g+2] = t0[2]; p0[4*g+3] = t0[3]; p1[4*g] = t1[0]; p1[4*g+1] = t1[1]; p1[4*g+2] = t1[2]; p1[4*g+3] = t1[3]; } }
    const char* kb[4];
#pragma unroll
    for (int dd = 0; dd < 4; ++dd) kb[dd] = K_lds + KB * SHM_K + KSWZ(r32, (dd * 16 + hi * 8) * 2);
#pragma unroll
    for (int d0 = 0; d0 < 8; ++d0) { const char* a = kb[d0 & 3] + (d0 >> 2) * 128;
        bf16x8 b0 = *reinterpret_cast<const bf16x8*>(a);
        bf16x8 b1 = *reinterpret_cast<const bf16x8*>(a + 32 * 256);
        p0 = __builtin_amdgcn_mfma_f32_32x32x16_bf16(b0, qr[d0], p0, 0, 0, 0);
        p1 = __builtin_amdgcn_mfma_f32_32x32x16_bf16(b1, qr[d0], p1, 0, 0, 0); }
}
template <int VB, bool SK>
__device__ __forceinline__ void pv_tile(f32x16* o, int vb0, bf16x8 pa0, bf16x8 pa1, bf16x8 pa2, bf16x8 pa3, bool act) {
    if (SK && !act) return;
#define TRRD(dst, off) asm volatile("ds_read_b64_tr_b16 %0, %1 offset:%2" : "=&v"(dst) : "v"(vb0), "i"(off) : "memory")
#define PV_D0(d0) do { s16x4 l0, l1, l2, l3, h0, h1, h2, h3; constexpr int b_ = VB * SHM_V + v_rd_off(d0, 0, 0);     \
        TRRD(l0, b_); TRRD(h0, b_ + 2048); TRRD(l1, b_ + 4096); TRRD(h1, b_ + 6144); TRRD(l2, b_ + 8192); TRRD(h2, b_ + 10240); TRRD(l3, b_ + 12288); TRRD(h3, b_ + 14336); \
        asm volatile("s_waitcnt lgkmcnt(0)" ::: "memory"); SBAR();                 \
        o[d0] = __builtin_amdgcn_mfma_f32_32x32x16_bf16(pa0, (bf16x8){l0[0], l0[1], l0[2], l0[3], h0[0], h0[1], h0[2], h0[3]}, o[d0], 0, 0, 0);   \
        o[d0] = __builtin_amdgcn_mfma_f32_32x32x16_bf16(pa1, (bf16x8){l1[0], l1[1], l1[2], l1[3], h1[0], h1[1], h1[2], h1[3]}, o[d0], 0, 0, 0);   \
        o[d0] = __builtin_amdgcn_mfma_f32_32x32x16_bf16(pa2, (bf16x8){l2[0], l2[1], l2[2], l2[3], h2[0], h2[1], h2[2], h2[3]}, o[d0], 0, 0, 0);   \
        o[d0] = __builtin_amdgcn_mfma_f32_32x32x16_bf16(pa3, (bf16x8){l3[0], l3[1], l3[2], l3[3], h3[0], h3[1], h3[2], h3[3]}, o[d0], 0, 0, 0); } while (0)
    PV_D0(0); PV_D0(1); PV_D0(2); PV_D0(3);
#undef PV_D0
#undef TRRD
}

template <class TIn, class TOut> struct BlockRef { const TIn* Q; TOut* O; const float* MS; unsigned K, V, C; int P0; int JLO; };
__device__ __forceinline__ bf16x8 bl128(__amdgpu_buffer_rsrc_t rs, unsigned vo, unsigned so) { return __builtin_bit_cast(bf16x8, __builtin_amdgcn_raw_buffer_load_b128(rs, (int)vo, (int)so, 0)); }
__device__ __forceinline__ float bl32(__amdgpu_buffer_rsrc_t rs, unsigned vo, unsigned so) { return __builtin_bit_cast(float, __builtin_amdgcn_raw_buffer_load_b32(rs, (int)vo, (int)so, 0)); }
template <class TIn> struct Seam {
    bf16x8 qr[8];
    bf16x8 st_v0, st_v1, st_k0, st_k1; f32x4 sf0, sf1, sf2, sf3; float st_c;
    f32x4 tq[16];
};
__device__ __forceinline__ int swa_jlo(int P0, int W) { const int lowk = P0 - W + 1; return lowk > 0 ? lowk / KVBLK : 0; }
#define ROW(p, k0, rr) ((p) + (unsigned)(((k0) + (rr)) * D + sc))
#define VMW() asm volatile("s_waitcnt vmcnt(0)" ::: "memory")
#define VMWN(n) asm volatile("s_waitcnt vmcnt(%0)" :: "i"(n) : "memory")
#define SLOAD_H(Kp, Vp, Cp, k0) do { if (tid < 64) S.st_c = bl32(rs, (unsigned)tid * 4u, (Cp) + (unsigned)(k0) * 4u); \
        S.st_v0 = bl128(rs, vo_st, (Vp) + (unsigned)(k0) * 256u); S.st_v1 = bl128(rs, vo_st, (Vp) + (unsigned)(k0) * 256u + 8192u); \
        S.st_k0 = bl128(rs, vo_st, (Kp) + (unsigned)(k0) * 256u); S.st_k1 = bl128(rs, vo_st, (Kp) + (unsigned)(k0) * 256u + 8192u); } while (0)
#define SWRITE_HK(bf) do { if (tid < 64) cb_l[(bf) * 64 + tid] = S.st_c;  *(bf16x8*)(K_lds + (bf) * SHM_K + kws) = S.st_k0; *(bf16x8*)(K_lds + (bf) * SHM_K + kws + 32 * 256) = S.st_k1; } while (0)
#define SWRITE_HV(bf) do { *(bf16x8*)(V_lds + (bf) * SHM_V + vst0) = S.st_v0; *(bf16x8*)(V_lds + (bf) * SHM_V + vst1) = S.st_v1; } while (0)
#define SWRITE_H(bf) do { SWRITE_HV(bf); SWRITE_HK(bf); } while (0)
#define SLOAD_F(p, k0) do { S.sf0 = *(const f32x4*)ROW(p, k0, sr); S.sf1 = *(const f32x4*)(ROW(p, k0, sr) + 4);                \
                            S.sf2 = *(const f32x4*)ROW(p, k0, 32 + sr); S.sf3 = *(const f32x4*)(ROW(p, k0, 32 + sr) + 4); } while (0)
#define SWRITE_KF(bf) do { *(bf16x8*)(K_lds + (bf) * SHM_K + kws) = pack8(S.sf0, S.sf1); *(bf16x8*)(K_lds + (bf) * SHM_K + kws + 32 * 256) = pack8(S.sf2, S.sf3); } while (0)
#define SWRITE_VF(bf) do { *(bf16x8*)(V_lds + (bf) * SHM_V + vst0) = pack8(S.sf0, S.sf1); *(bf16x8*)(V_lds + (bf) * SHM_V + vst1) = pack8(S.sf2, S.sf3); } while (0)
template <class TIn, class TOut>
__device__ __forceinline__ void causal_swa_prime(const BlockRef<TIn, TOut>& cur, int W, char* lds, Seam<TIn>& S, __amdgpu_buffer_rsrc_t rs) {
    constexpr bool F32 = same_t<TIn, float>::v;
    const int tid = lz_tid(), wid = __builtin_amdgcn_readfirstlane(tid >> 6), lane = tid & 63, r32 = lane & 31, hi = lane >> 5;
    const int sr = tid >> 4, sc = (tid & 15) * 8, kws = KSWZ(sr, sc * 2); char* K_lds = lds + 2 * SHM_V; float* cb_l = (float*)(lds + LDS_CB); const unsigned vo_st = (unsigned)(sr * D + sc) * 2u;
    const int kb0 = swa_jlo(cur.P0, W) * KVBLK;
    for (int d0 = 0; d0 < 8; ++d0) S.qr[d0] = load8<TIn>(cur.Q + (unsigned)((wid * QBLK + r32) * D + d0 * 16 + hi * 8));
    if constexpr (F32) { SLOAD_F((const float*)cur.K, kb0); VMW(); SWRITE_KF(0); SBAR(); SLOAD_F((const float*)cur.V, kb0); }
    else { SLOAD_H(cur.K, cur.V, cur.C, kb0); VMW(); SWRITE_HK(0); }
    __syncthreads();
}
template <class TIn, class TOut>
__device__ __forceinline__ void causal_swa_block(const BlockRef<TIn, TOut>& cur, const BlockRef<TIn, TOut>& nxt, int skv, int W, char* lds, Seam<TIn>& S, __amdgpu_buffer_rsrc_t rs) {
    constexpr bool F32 = same_t<TIn, float>::v;
    const int tid = lz_tid(), wid = __builtin_amdgcn_readfirstlane(tid >> 6), lane = tid & 63, r32 = lane & 31, hi = lane >> 5;
    const int j_lo = swa_jlo(cur.P0, W);
    int j_hi = (cur.P0 + QB - 1) / KVBLK + 1; if (j_hi > skv / KVBLK) j_hi = skv / KVBLK;
    const int NT = j_hi - j_lo;
    const int kbn = swa_jlo(nxt.P0, W) * KVBLK;
    const int qlo = cur.P0 + wid * QBLK, qm = qlo + r32 - 4 * hi;
    char* V_lds = lds; char* K_lds = lds + 2 * SHM_V; float* cb_l = (float*)(lds + LDS_CB);
    float* ws = (float*)(lds + 2 * SHM_V + 2 * SHM_K) + wid * 64; float* li_l = ws, * al_l = ws + 32;
    float m_reg = -1e30f, l_reg = 0; f32x16 o[4] = {};
    const unsigned vo_st = (unsigned)((tid >> 4) * D + (tid & 15) * 8) * 2u; const int sr = tid >> 4, sc = (tid & 15) * 8, vst0 = v_st(sr, sc), vst1 = v_st(32 + sr, sc), kws = KSWZ(sr, sc * 2);
    const int vb0 = (int)(uintptr_t)V_lds + v_rd_base(lane);
    const unsigned Kh = cur.K, Vh = cur.V, Ch = cur.C;
#define RESC(a) do { if (__any((a) < 1.f)) { if (hi == 0) al_l[r32] = (a); asm volatile("s_waitcnt lgkmcnt(0)" ::: "memory");              \
                     for (int d_ = 0; d_ < 4; ++d_) for (int r = 0; r < 16; ++r) o[d_][r] *= al_l[crow(r, hi)]; } } while (0)
#define KBASE(t) ((j_lo + (t)) * KVBLK)
#define ACT(t) (KBASE(t) <= qlo + QBLK - 1 && KBASE(t) + KVBLK - 1 >= qlo - W + 1)
#define MASKT(P0_, P1_, t) do { const int kb_ = KBASE(t); if ((!SK || ACT(t)) && (kb_ + KVBLK - 1 > qlo || kb_ <= qlo + QBLK - 1 - W)) mask_tile(P0_, P1_, qm - kb_, (unsigned)W); } while (0)
    constexpr int NQL = F32 ? 16 : 8;
    constexpr bool SK = WSKIP && !F32;
#define SEAM_K0() do { VMWN(NQL); if constexpr (F32) { SWRITE_KF(0); SBAR(); SLOAD_F((const float*)nxt.V, kbn); } else { SWRITE_HK(0); } SBAR(); } while (0)
    f32x16 pA0, pA1, pB0, pB1; float mnA, mnB, alA, alB; bf16x8 pa0, pa1, pa2, pa3;
    if constexpr (F32) { VMW(); SWRITE_VF(0); SBAR(); } else { SWRITE_HV(0); SBAR(); }
    if (NT > 1) { if constexpr (F32) SLOAD_F((const float*)Kh, KBASE(1)); else SLOAD_H(Kh, Vh, Ch, KBASE(1)); }
    SBAR(); qkt<0, SK>(pA0, pA1, K_lds, cb_l, r32, hi, S.qr, ACT(0));
    if constexpr (F32) { if (NT > 1) { VMW(); SWRITE_KF(1); SBAR(); SLOAD_F((const float*)Vh, KBASE(1)); } }
    MASKT(pA0, pA1, 0); partialSM(pA0, pA1, m_reg, mnA, alA);
    if (NT > 1) { VMW(); if constexpr (F32) { SWRITE_VF(1); SBAR(); if (NT > 2) SLOAD_F((const float*)Kh, KBASE(2)); } else SWRITE_H(1); }
    __syncthreads();
#define HALF_STEP(PX0, PX1, mnX, alX, PY0, PY1, alY, t, KB, VB, SB) do {                                                      \
        SBAR(); qkt<KB, SK>(PX0, PX1, K_lds, cb_l, r32, hi, S.qr, ACT(t));                                             \
        finishSM(PY0, PY1, alY, l_reg, pa0, pa1, pa2, pa3); SBAR();                                                           \
        if ((t) + 1 < NT) { if constexpr (F32) { VMW(); SWRITE_KF(SB); SBAR(); SLOAD_F((const float*)Vh, KBASE((t) + 1)); }  \
                            else { SLOAD_H(Kh, Vh, Ch, KBASE((t) + 1)); } SBAR(); }                                               \
        pv_tile<VB, SK>(o, vb0, pa0, pa1, pa2, pa3, ACT((t) - 1)); MASKT(PX0, PX1, (t)); partialSM(PX0, PX1, m_reg, mnX, alX);                                        \
        __syncthreads();                                                                                                      \
        if ((t) + 1 < NT) { VMW(); if constexpr (F32) { SWRITE_VF(SB); SBAR(); if ((t) + 2 < NT) SLOAD_F((const float*)Kh, KBASE((t) + 2)); } \
                            else { SWRITE_H(SB); } }                                                                          \
        RESC(alX); __syncthreads(); } while (0)
    for (int t = 1; t + 1 < NT; t += 2) {
        HALF_STEP(pB0, pB1, mnB, alB, pA0, pA1, alA, t, 1, 0, 0);
        HALF_STEP(pA0, pA1, mnA, alA, pB0, pB1, alB, t + 1, 0, 1, 1);
    }
    const bool even = (NT & 1) == 0;
    if (even) { SBAR(); qkt<1, SK>(pB0, pB1, K_lds, cb_l, r32, hi, S.qr, ACT(NT - 1)); SBAR(); }
#define QROW(e) (nxt.Q + (size_t)(wid * QBLK + r32) * D + ((e) >> 1) * 16 + hi * 8 + ((e) & 1) * 4)
    if constexpr (F32) { SLOAD_F((const float*)nxt.K, kbn); SBAR();
#pragma unroll
        for (int e = 0; e < 8; ++e) S.tq[e] = *(const f32x4*)QROW(e); }
    else { SLOAD_H(nxt.K, nxt.V, nxt.C, kbn); SBAR();
#pragma unroll
        for (int d0 = 0; d0 < 8; ++d0) S.qr[d0] = load8<TIn>(nxt.Q + (unsigned)((wid * QBLK + r32) * D + d0 * 16 + hi * 8)); }
    SBAR();
    finishSM(pA0, pA1, alA, l_reg, pa0, pa1, pa2, pa3); SBAR();
    if constexpr (F32) {
#pragma unroll
        for (int e = 8; e < 16; ++e) S.tq[e] = *(const f32x4*)QROW(e); SBAR(); }
#undef QROW
    pv_tile<0, SK>(o, vb0, pa0, pa1, pa2, pa3, ACT(even ? NT - 2 : NT - 1));
    if (even) { MASKT(pB0, pB1, NT - 1); partialSM(pB0, pB1, m_reg, mnB, alB); __syncthreads(); RESC(alB);
        finishSM(pB0, pB1, alB, l_reg, pa0, pa1, pa2, pa3); SBAR(); pv_tile<1, SK>(o, vb0, pa0, pa1, pa2, pa3, ACT(NT - 1)); }
    SBAR(); SEAM_K0();
    if (hi == 0) li_l[r32] = l_reg; asm volatile("s_waitcnt lgkmcnt(0)" ::: "memory");
    float rli[16];
#pragma unroll
    for (int r = 0; r < 16; ++r) rli[r] = __builtin_amdgcn_rcpf(li_l[crow(r, hi)]);
    TOut* Ow = cur.O + (size_t)(wid * QBLK) * OSTR;
    { float msv[4];
#pragma unroll
      for (int d0 = 0; d0 < 4; ++d0) msv[d0] = cur.MS[d0 * 32 + r32];
#pragma unroll
      for (int r = 0; r < 16; ++r) { const int orow = crow(r, hi);
        float v0 = o[0][r] * rli[r], v1 = o[1][r] * rli[r], v2 = o[2][r] * rli[r], v3 = o[3][r] * rli[r];
        float sm = (v0 + v1) + (v2 + v3);
#pragma unroll
        for (int off = 1; off < 32; off <<= 1) sm += __shfl_xor(sm, off);
        const float mu = sm * (1.0f / 128.0f);
        v0 -= mu; v1 -= mu; v2 -= mu; v3 -= mu;
        float sq = (v0 * v0 + v1 * v1) + (v2 * v2 + v3 * v3);
#pragma unroll
        for (int off = 1; off < 32; off <<= 1) sq += __shfl_xor(sq, off);
        const float rstd = 1.0f / sqrtf(sq * (1.0f / 128.0f) + 1e-6f);
        float vv[4] = {v0 * rstd * msv[0], v1 * rstd * msv[1], v2 * rstd * msv[2], v3 * rstd * msv[3]};
#pragma unroll
        for (int d0 = 0; d0 < 4; ++d0) { const float v = vv[d0]; const float vn = __shfl_xor(v, 1);
            if ((r32 & 1) == 0) *(unsigned*)(Ow + (unsigned)(orow * OSTR + d0 * 32 + r32)) = cvtpk(v, vn); } } }
    if constexpr (F32) {
#pragma unroll
        for (int d0 = 0; d0 < 8; ++d0) S.qr[d0] = pack8(S.tq[2 * d0], S.tq[2 * d0 + 1]); }
    __syncthreads();
#undef RESC
#undef KBASE
#undef ACT
#undef MASKT
#undef SEAM_K0
#undef HALF_STEP
}
#undef ROW
#undef VMW
#undef VMWN
#undef SLOAD_H
#undef SWRITE_HK
#undef SWRITE_HV
#undef SWRITE_H
#undef SLOAD_F
#undef SWRITE_KF
#undef SWRITE_VF
#undef SBAR
}

#define LAS __attribute__((address_space(3)))
typedef unsigned short bf16r;
typedef unsigned v4u __attribute__((ext_vector_type(4)));
typedef unsigned v2u __attribute__((ext_vector_type(2)));
typedef float v4f __attribute__((ext_vector_type(4)));
typedef float v16f __attribute__((ext_vector_type(16)));
typedef short v8s __attribute__((ext_vector_type(8)));
typedef short v4s __attribute__((ext_vector_type(4)));

#define XB_TMO      128
#define XB_XCNT(j)  (256  + 64 * (j))
#define XB_XSUB(j)  (1280 + 64 * (j))
#define XB_XGEN(j)  (2304 + 64 * (j))
#define XB_TOP      3328
#define XB_TOPGEN   3392
#define XCD_BAR_WORDS 3456
#define XB_SPIN_CAP (1u << 18)

__device__ __forceinline__ unsigned xb_ld(unsigned* p)              { return __hip_atomic_load(p, __ATOMIC_RELAXED, __HIP_MEMORY_SCOPE_AGENT); }
__device__ __forceinline__ unsigned xb_add(unsigned* p, unsigned v) { return __hip_atomic_fetch_add(p, v, __ATOMIC_RELAXED, __HIP_MEMORY_SCOPE_AGENT); }
__device__ __forceinline__ unsigned xb_xcc_id() { return (unsigned)__builtin_amdgcn_s_getreg((3 << 11) | 20) & 0xFu; }
#define XB_SPIN(cond, bar) do { unsigned _sp = 0; while (cond) { __builtin_amdgcn_s_sleep(1); \
    if ((++_sp & 255u) == 0u) { if (xb_ld(&(bar)[XB_TMO])) break; if (_sp > XB_SPIN_CAP) { atomicAdd(&(bar)[XB_TMO], 1u); break; } } } } while (0)

struct XcdBarrier {
    unsigned* bar; unsigned x;
    volatile LAS unsigned* st;
};

__device__ __forceinline__ XcdBarrier xcd_barrier_post(unsigned* bar, volatile LAS unsigned* st) {
    XcdBarrier b; b.bar = bar; b.x = xb_xcc_id(); b.st = st;
    if (lz_tid() == 0) (void)xb_add(&bar[XB_XCNT(b.x)], 1u);
    return b;
}
__device__ __forceinline__ void xcd_barrier_complete(unsigned* bar, unsigned x, unsigned& nloc, unsigned& nx) {
    const unsigned G = gridDim.x * gridDim.y * gridDim.z;
    unsigned sum, cnt, mine, sp = 0u;
    for (;;) {
        sum = 0u; cnt = 0u; mine = 0u;
#pragma unroll
        for (unsigned j = 0; j < 16; ++j) { const unsigned c = xb_ld(&bar[XB_XCNT(j)]); sum += c; cnt += (c > 0u) ? 1u : 0u; mine = (j == x) ? c : mine; }
        if (sum == G) break;
        __builtin_amdgcn_s_sleep(1);
        if ((++sp & 255u) == 0u) { if (xb_ld(&bar[XB_TMO])) break; if (sp > XB_SPIN_CAP) { atomicAdd(&bar[XB_TMO], 1u); break; } }
    }
    nloc = mine > 0u ? mine : 1u; nx = cnt > 0u ? cnt : 1u;
}

__device__ __forceinline__ void xcd_barrier(const XcdBarrier& b) {
    asm volatile("s_waitcnt vmcnt(0)" ::: "memory");
    __syncthreads();
    if (lz_tid() == 0) {
        unsigned* bar = b.bar;
        __builtin_amdgcn_s_waitcnt(0);
        unsigned nloc = b.st[0], nx = b.st[1];
        if (nloc == 0u) { xcd_barrier_complete(bar, b.x, nloc, nx); b.st[0] = nloc; b.st[1] = nx; }
        const unsigned old = xb_add(&bar[XB_XSUB(b.x)], 1u);
        const unsigned gen = old / nloc;
        if (old + 1u == (gen + 1u) * nloc) {
            __builtin_amdgcn_fence(__ATOMIC_RELEASE, "agent");
            asm volatile("s_waitcnt vmcnt(0)" ::: "memory");
            const unsigned og = xb_add(&bar[XB_TOP], 1u);
            const unsigned tg = og / nx;
            if (og + 1u == (tg + 1u) * nx) xb_add(&bar[XB_TOPGEN], 1u);
            else XB_SPIN(xb_ld(&bar[XB_TOPGEN]) == tg, bar);
            __builtin_amdgcn_fence(__ATOMIC_ACQUIRE, "agent");
            xb_add(&bar[XB_XGEN(b.x)], 1u);
            asm volatile("s_waitcnt vmcnt(0)" ::: "memory");
        } else {
            XB_SPIN(xb_ld(&bar[XB_XGEN(b.x)]) == gen, bar);
            __builtin_amdgcn_fence(__ATOMIC_ACQUIRE, "agent");
            asm volatile("s_waitcnt vmcnt(0)" ::: "memory");
        }
    }
    __syncthreads();
}

constexpr size_t MiB = 1u << 20;
constexpr size_t WS_QK2 = 14336, WS_QCTR = 15360;
constexpr size_t WS_JT = 20480;
constexpr size_t WS_WG = 1 * MiB, WG_BYTES = 32 * DM * 2;
constexpr size_t WS_MOD = 64 * 1024;
constexpr size_t WS_WIN = 2 * MiB, WIN_BYTES = (size_t)NINP * DM * 2;
constexpr size_t WS_WOUT = 60 * MiB, WOUT_BYTES = (size_t)DM * DM * 2;
constexpr size_t WS_WFF1 = 76 * MiB, WFF_BYTES = (size_t)DFF * DM * 2;
constexpr size_t WS_WFF2 = 140 * MiB;
constexpr size_t WS_H = 204 * MiB;
constexpr size_t WS_P = 332 * MiB;
constexpr size_t WS_Y = 780 * MiB;
constexpr size_t WS_HID = WS_P;
constexpr size_t WS_GATES = 908 * MiB;
constexpr size_t WS_CNEG = 910 * MiB;
constexpr size_t WS_MA = 911 * MiB, WS_MCM = WS_MA + 512 * 1024, WS_MB = WS_MCM + 512 * 1024;
constexpr size_t WS_MPREV = 913 * MiB;
constexpr size_t WS_UN = 914 * MiB;
constexpr size_t WS_MQC = 916 * MiB;
constexpr size_t WS_END = 980 * MiB;
static_assert(WS_WIN + 2 * WIN_BYTES <= WS_WOUT && WS_HID + (size_t)MROWS * DFF * 2 <= WS_Y + (size_t)MROWS * DM * 2 && WS_MQC + (size_t)8 * MROWS * 128 * 2 <= WS_END, "ws map");

constexpr int LDS_BYTES = 147456;

__device__ __forceinline__ float wave_sum(float v) {
#pragma unroll
    for (int o = 1; o < 64; o <<= 1) v += __shfl_xor(v, o);
    return v;
}
typedef float pkf2_t __attribute__((ext_vector_type(2))); typedef __bf16 pkb2_t __attribute__((ext_vector_type(2)));
__device__ __forceinline__ unsigned pk2(float lo, float hi) { pkf2_t v = {lo, hi}; pkb2_t b = __builtin_convertvector(v, pkb2_t); return __builtin_bit_cast(unsigned, b); }
__device__ __forceinline__ float bflo(unsigned w) { return __uint_as_float(w << 16); }
__device__ __forceinline__ float bfhi(unsigned w) { return __uint_as_float(w & 0xffff0000u); }
__device__ __forceinline__ float bf1(bf16r h) { return __uint_as_float((unsigned)h << 16); }
__device__ __forceinline__ float log_sigmoid(float x) { return fminf(x, 0.f) - log1pf(expf(-fabsf(x))); }
__device__ __forceinline__ float swap_add(float v) { auto rr = __builtin_amdgcn_permlane32_swap(__float_as_uint(v), __float_as_uint(v), false, false); return __uint_as_float(rr[0]) + __uint_as_float(rr[1]); }

struct Args { const void* in[18]; float* out; unsigned char* ws; int ph_lo, ph_hi; };
typedef const __attribute__((address_space(4))) Args CArgs;
__device__ __forceinline__ CArgs* fresh_args() { CArgs* p = (CArgs*)__builtin_amdgcn_kernarg_segment_ptr(); asm volatile("" : "+s"(p)); return p; }

__device__ __forceinline__ int win_src(int n) { return n < 5120 ? n : n + 8; }
__device__ __forceinline__ int wg_src(int n) { return n < 8 ? 5120 + n : (n < 16 ? 7176 + (n - 8) : -1); }
template <int MAP>
__device__ __forceinline__ void transpose_item(const float* W, int K, int N, bf16r* WT, LAS float* scr, int item, int nblk, int lane) {
    const int kb = item / nblk, nb = item % nblk, k0 = 64 * kb, n0 = 32 * nb;
    int sc = n0 + (lane & 31); if (MAP == 1) sc = win_src(sc); else if (MAP == 2) sc = wg_src(sc);
#ifdef OLD_P0
#pragma unroll 8
    for (int i = 0; i < 32; ++i) { const int kk = 2 * i + (lane >> 5); scr[kk * 33 + (lane & 31)] = sc >= 0 ? W[(size_t)(k0 + kk) * N + sc] : 0.f; }
#else
    float tv[32];
#pragma unroll
    for (int i = 0; i < 32; ++i) { const int kk = 2 * i + (lane >> 5); tv[i] = sc >= 0 ? W[(size_t)(k0 + kk) * N + sc] : 0.f; }
#pragma unroll
    for (int i = 0; i < 32; ++i) { const int kk = 2 * i + (lane >> 5); scr[kk * 33 + (lane & 31)] = tv[i]; }
#endif
    asm volatile("s_waitcnt lgkmcnt(0)" ::: "memory");
    const int c = lane & 7;
#pragma unroll
    for (int j = 0; j < 4; ++j) { const int n = (lane >> 3) + 8 * j; const LAS float* s = scr + (8 * c) * 33 + n;
        v4u o; o.x = pk2(s[0 * 33], s[1 * 33]); o.y = pk2(s[2 * 33], s[3 * 33]); o.z = pk2(s[4 * 33], s[5 * 33]); o.w = pk2(s[6 * 33], s[7 * 33]);
        *(v4u*)(WT + (size_t)(n0 + n) * K + k0 + 8 * c) = o; }
    asm volatile("s_waitcnt lgkmcnt(0)" ::: "memory");
}
__device__ __forceinline__ void p0_phase(CArgs& a, LAS unsigned char* lds) {
    const int tid = lz_tid(), lane = tid & 63, wave = tid >> 6, G = gridDim.x;
    unsigned char* ws = a.ws;
    { LAS float* cond = (LAS float*)lds; LAS float* red = (LAS float*)(lds + 16384);
      const float* c = (const float*)a.in[1]; const float* ada_w = (const float*)a.in[3]; const float* ada_b = (const float*)a.in[4]; float* MOD = (float*)(ws + WS_MOD);
      for (int i = tid; i < NB * DM; i += 512) { const float cv = c[i]; cond[i] = cv / (1.f + expf(-cv)); }
      __syncthreads();
      for (int item = lz_bid(); item < 2 * (NMOD / 32); item += G) {
          const int layer = item / (NMOD / 32), cgp = item % (NMOD / 32), c32 = tid & 31, col = cgp * 32 + c32, kq = tid >> 5;
          const float* W = ada_w + (size_t)layer * DM * NMOD + col;
          float a0 = 0.f, a1 = 0.f;
#pragma unroll 32
          for (int k = kq * 128; k < kq * 128 + 128; ++k) { const float w = W[(size_t)k * NMOD]; a0 += cond[k] * w; a1 += cond[DM + k] * w; }
          red[(kq * 2 + 0) * 32 + c32] = a0; red[(kq * 2 + 1) * 32 + c32] = a1;
          __syncthreads();
          if (tid < 64) { const int b = tid >> 5; float s = 0.f;
#pragma unroll
              for (int q = 0; q < 16; ++q) s += red[(q * 2 + b) * 32 + c32];
              MOD[(size_t)(layer * NB + b) * NMOD + cgp * 32 + c32] = s + ada_b[(size_t)layer * NMOD + cgp * 32 + c32]; }
          __syncthreads();
      } }
    { LAS float* scr = (LAS float*)(lds + wave * 16384);
      const int gw = lz_bid() * 8 + wave, NGW = G * 8;
      constexpr int I_IN = (DM / 64) * (NINP / 32), I_OUT = (DM / 64) * (DM / 32), I_F1 = (DM / 64) * (DFF / 32), I_F2 = (DFF / 64) * (DM / 32), I_G = DM / 64, I_L = I_IN + I_OUT + I_F1 + I_F2 + I_G;
      for (int it = gw; it < 2 * I_L; it += NGW) {
          const int layer = it / I_L; int r = it % I_L;
          if (r < I_IN) { transpose_item<1>((const float*)a.in[7] + (size_t)layer * DM * DIN, DM, DIN, (bf16r*)(ws + WS_WIN + layer * WIN_BYTES), scr, r, NINP / 32, lane); continue; } r -= I_IN;
          if (r < I_G) { transpose_item<2>((const float*)a.in[7] + (size_t)layer * DM * DIN, DM, DIN, (bf16r*)(ws + WS_WG + layer * WG_BYTES), scr, r, 1, lane); continue; } r -= I_G;
          if (r < I_OUT) { transpose_item<0>((const float*)a.in[14] + (size_t)layer * DM * DM, DM, DM, (bf16r*)(ws + WS_WOUT + layer * WOUT_BYTES), scr, r, DM / 32, lane); continue; } r -= I_OUT;
          if (r < I_F1) { transpose_item<0>((const float*)a.in[15] + (size_t)layer * DM * DFF, DM, DFF, (bf16r*)(ws + WS_WFF1 + layer * WFF_BYTES), scr, r, DFF / 32, lane); continue; } r -= I_F1;
          transpose_item<0>((const float*)a.in[16] + (size_t)layer * DFF * DM, DFF, DM, (bf16r*)(ws + WS_WFF2 + layer * WFF_BYTES), scr, r, DM / 32, lane);
      } }
}

__device__ __forceinline__ void gate_gemm(const bf16r* H, const bf16r* WG, float* gates) {
    const int tid = lz_tid(), lane = tid & 63, wave = __builtin_amdgcn_readfirstlane(tid >> 6), r32 = lane & 31, hi = lane >> 5;
    if (wave >= 4) return;
    for (int rb = lz_bid(); rb < MROWS / 128; rb += gridDim.x) {
        const int r0 = rb * 128 + wave * 32;
        const bf16r* ap = H + (size_t)(r0 + r32) * DM + 8 * hi; const bf16r* bp = WG + (size_t)r32 * DM + 8 * hi;
        v16f acc = {};
#pragma unroll 16
        for (int ks = 0; ks < DM / 16; ++ks) { const v8s af = *(const v8s*)(ap + ks * 16), bf = *(const v8s*)(bp + ks * 16); acc = __builtin_amdgcn_mfma_f32_32x32x16_bf16(af, bf, acc, 0, 0, 0); }
        if (r32 < 16) {
#pragma unroll
            for (int r = 0; r < 16; ++r) gates[(size_t)(r0 + (r & 3) + 8 * (r >> 2) + 4 * hi) * 16 + r32] = acc[r]; }
    }
}

__device__ __forceinline__ void norm_phase(const float* x, const float* w, const float* sh, const float* sc, bf16r* H) {
    const int lane = lz_tid() & 63, gw = lz_bid() * 8 + (lz_tid() >> 6), NGW = gridDim.x * 8;
    v4f nx[8];
    if (gw < MROWS) { const v4f* xr0 = (const v4f*)(x + (size_t)gw * DM) + lane;
#pragma unroll
        for (int j = 0; j < 8; ++j) nx[j] = xr0[64 * j]; }
    for (int m = gw; m < MROWS; m += NGW) {
        const int b = m / SEQ;
        v4f v[8]; float s = 0.f;
#pragma unroll
        for (int j = 0; j < 8; ++j) v[j] = nx[j];
        if (m + NGW < MROWS) { const v4f* xr1 = (const v4f*)(x + (size_t)(m + NGW) * DM) + lane;
#pragma unroll
            for (int j = 0; j < 8; ++j) nx[j] = xr1[64 * j]; }
#pragma unroll
        for (int j = 0; j < 8; ++j) s += (v[j].x * v[j].x + v[j].y * v[j].y) + (v[j].z * v[j].z + v[j].w * v[j].w);
        const float rstd = 1.0f / sqrtf(wave_sum(s) * (1.f / DM) + NORM_EPS);
        v2u* o = (v2u*)(H + (size_t)m * DM) + lane;
#pragma unroll
        for (int j = 0; j < 8; ++j) { const int c = 4 * lane + 256 * j;
            const v4f wv = *(const v4f*)(w + c), sv = *(const v4f*)(sc + (size_t)b * NMOD + c), hv = *(const v4f*)(sh + (size_t)b * NMOD + c);
            const v4f y = v[j] * rstd * wv * (sv + 1.0f) + hv;
            v2u p; p.x = pk2(y.x, y.y); p.y = pk2(y.z, y.w); o[64 * j] = p; }
    }
}
__device__ __forceinline__ void final_norm_phase(float* x, const float* w) {
    const int lane = lz_tid() & 63, gw = lz_bid() * 8 + (lz_tid() >> 6), NGW = gridDim.x * 8;
    v4f nx[8];
    if (gw < MROWS) { const v4f* xr0 = (const v4f*)(x + (size_t)gw * DM) + lane;
#pragma unroll
        for (int j = 0; j < 8; ++j) nx[j] = xr0[64 * j]; }
    for (int m = gw; m < MROWS; m += NGW) {
        v4f* xr = (v4f*)(x + (size_t)m * DM) + lane;
        v4f v[8]; float s = 0.f;
#pragma unroll
        for (int j = 0; j < 8; ++j) v[j] = nx[j];
        if (m + NGW < MROWS) { const v4f* xr1 = (const v4f*)(x + (size_t)(m + NGW) * DM) + lane;
#pragma unroll
            for (int j = 0; j < 8; ++j) nx[j] = xr1[64 * j]; }
#pragma unroll
        for (int j = 0; j < 8; ++j) s += (v[j].x * v[j].x + v[j].y * v[j].y) + (v[j].z * v[j].z + v[j].w * v[j].w);
        const float rstd = 1.0f / sqrtf(wave_sum(s) * (1.f / DM) + NORM_EPS);
#pragma unroll
        for (int j = 0; j < 8; ++j) { const v4f wv = *(const v4f*)(w + 4 * lane + 256 * j); xr[64 * j] = v[j] * rstd * wv; }
    }
}

__device__ __forceinline__ void fox_cumsum_item(CArgs& a, int layer, int item, LAS unsigned char* lds) {
    const int tid = lz_tid(), b = item >> 3, h = item & 7;
    const float* gates = (const float*)(a.ws + WS_GATES); float* cneg = (float*)(a.ws + WS_CNEG) + (size_t)item * SEQ;
    const float bias = ((const float*)a.in[10])[layer * 8 + h];
    LAS double* tot = (LAS double*)lds;
    double sum = 0.0;
    const float* gp = gates + ((size_t)b * SEQ + (size_t)tid * 32) * 16 + h;
#pragma unroll 4
    for (int i = 0; i < 32; ++i) sum += (double)log_sigmoid(gp[i * 16] + bias);
    tot[tid] = sum;
    __syncthreads();
    if (tid == 0) { double run = 0.0; for (int i = 0; i < 512; ++i) { const double t = tot[i]; tot[i] = run; run += t; } }
    __syncthreads();
    double run = tot[tid];
#pragma unroll 2
    for (int i = 0; i < 32; i += 4) { v4f o;
        run += (double)log_sigmoid(gp[(i + 0) * 16] + bias); o.x = (float)(-run * 11.313708498984761);
        run += (double)log_sigmoid(gp[(i + 1) * 16] + bias); o.y = (float)(-run * 11.313708498984761);
        run += (double)log_sigmoid(gp[(i + 2) * 16] + bias); o.z = (float)(-run * 11.313708498984761);
        run += (double)log_sigmoid(gp[(i + 3) * 16] + bias); o.w = (float)(-run * 11.313708498984761);
        *(v4f*)(cneg + tid * 32 + i) = o; }
    __syncthreads();
}
__device__ __forceinline__ void mlstm_scan_item(CArgs& a, int layer, int item, LAS unsigned char* lds) {
    const int tid = lz_tid(), lane = tid & 63, wave = tid >> 6, b = item >> 2, h = item & 3;
    const float* gates = (const float*)(a.ws + WS_GATES);
    float* MA = (float*)(a.ws + WS_MA) + (size_t)item * SEQ; float* MCM = (float*)(a.ws + WS_MCM) + (size_t)item * SEQ; float* MBv = (float*)(a.ws + WS_MB) + (size_t)item * SEQ;
    float* MPREV = (float*)(a.ws + WS_MPREV) + item * 256;
    const float ib = ((const float*)a.in[11])[layer * 4 + h], fb = ((const float*)a.in[12])[layer * 4 + h];
    LAS float* Bc = (LAS float*)lds; LAS float* Ac = Bc + 256;
#pragma unroll 4
    for (int c = wave; c < 256; c += 8) {
        const size_t m = (size_t)b * SEQ + c * 64 + lane;
        const float ig = gates[m * 16 + 8 + h] + ib, fg = gates[m * 16 + 12 + h] + fb;
        float bb = log_sigmoid(fg);
#pragma unroll
        for (int o = 1; o < 64; o <<= 1) { const float t = __shfl_up(bb, o); if (lane >= o) bb += t; }
        const float av = ig - bb; float cm = av;
#pragma unroll
        for (int o = 1; o < 64; o <<= 1) { const float t = __shfl_up(cm, o); if (lane >= o) cm = fmaxf(cm, t); }
        MA[c * 64 + lane] = av; MCM[c * 64 + lane] = cm; MBv[c * 64 + lane] = bb;
        if (lane == 63) { Bc[c] = bb; Ac[c] = cm; }
    }
    __syncthreads();
    if (tid == 0) { float mm = 0.f; for (int c = 0; c < 256; ++c) { MPREV[c] = mm; mm = Bc[c] + fmaxf(mm, Ac[c]); } }
    __syncthreads();
}
__device__ __forceinline__ void prep_phase(CArgs& a, int layer, LAS unsigned char* lds) {
    const int tid = lz_tid(), bid = lz_bid(), G = gridDim.x;
    if (bid < 16) { fox_cumsum_item(a, layer, bid, lds); return; }
    if (bid < 24) { mlstm_scan_item(a, layer, bid - 16, lds); return; }
    const int wk = bid - 24, NWK = G - 24;
    bf16r* P = (bf16r*)(a.ws + WS_P);
    { const int jg = tid & 7; double invf[8];
#pragma unroll
      for (int i = 0; i < 8; ++i) { double r = 1.0, bs = 0.8659643233600653; int e = 8 * jg + i;
#pragma unroll
          for (int q = 0; q < 6; ++q) { if (e & 1) r *= bs; bs *= bs; e >>= 1; }
          invf[i] = r * 0.15915494309189535; }
      const int* positions = (const int*)a.in[2];
      for (int it0 = wk; it0 < 8 * MROWS / 64; it0 += 4 * NWK) {
          v4u A[4], Bv[4]; bf16r* pp[4]; int mm[4], sl[4];
#pragma unroll
          for (int q = 0; q < 4; ++q) { const int it = it0 + q * NWK; const bool ok = it < 8 * MROWS / 64; const int grow = (ok ? it : wk) * 64 + (tid >> 3); sl[q] = ok ? grow / MROWS : -1; mm[q] = grow % MROWS;
              pp[q] = P + ((size_t)(grow / MROWS) * MROWS + mm[q]) * 128 + 8 * jg; A[q] = *(const v4u*)pp[q]; Bv[q] = *(const v4u*)(pp[q] + 64); }
#pragma unroll
          for (int q = 0; q < 4; ++q) { if (sl[q] < 0) continue;
              const double pos = (double)positions[mm[q]]; const float sc = sl[q] >= 4 ? KSCALE : 1.0f;
              float t1[8] = {bflo(A[q].x), bfhi(A[q].x), bflo(A[q].y), bfhi(A[q].y), bflo(A[q].z), bfhi(A[q].z), bflo(A[q].w), bfhi(A[q].w)};
              float t2[8] = {bflo(Bv[q].x), bfhi(Bv[q].x), bflo(Bv[q].y), bfhi(Bv[q].y), bflo(Bv[q].z), bfhi(Bv[q].z), bflo(Bv[q].w), bfhi(Bv[q].w)};
              float o1[8], o2[8];
#pragma unroll
              for (int i = 0; i < 8; ++i) { const double rev = pos * invf[i]; const float fr = (float)(rev - floor(rev));
                  const float sn = __builtin_amdgcn_sinf(fr) * sc, cs = __builtin_amdgcn_cosf(fr) * sc;
                  o1[i] = t1[i] * cs - t2[i] * sn; o2[i] = t2[i] * cs + t1[i] * sn; }
              v4u oa, ob; oa.x = pk2(o1[0], o1[1]); oa.y = pk2(o1[2], o1[3]); oa.z = pk2(o1[4], o1[5]); oa.w = pk2(o1[6], o1[7]);
              ob.x = pk2(o2[0], o2[1]); ob.y = pk2(o2[2], o2[3]); ob.z = pk2(o2[4], o2[5]); ob.w = pk2(o2[6], o2[7]);
              *(v4u*)pp[q] = oa; *(v4u*)(pp[q] + 64) = ob; }
      } }
    { const int slot = wk % 8, sub = wk / 8, nsub = (NWK - slot + 7) / 8, cgp = tid & 15;
      const float* cw = (const float*)a.in[8] + (size_t)layer * 4 * 1024 + slot * 128 + 8 * cgp; const float* cbv = (const float*)a.in[9] + (size_t)layer * 1024 + slot * 128 + 8 * cgp;
      float w[4][8], bsv[8];
#pragma unroll
      for (int j = 0; j < 4; ++j)
#pragma unroll
          for (int i = 0; i < 8; ++i) w[j][i] = cw[j * 1024 + i];
#pragma unroll
      for (int i = 0; i < 8; ++i) bsv[i] = cbv[i];
      const bf16r* __restrict__ src = P + (size_t)(40 + slot) * MROWS * 128 + 8 * cgp; bf16r* __restrict__ dst = (bf16r*)(a.ws + WS_MQC) + (size_t)slot * MROWS * 128 + 8 * cgp;
      const float sc = slot >= 4 ? KSCALE : 1.0f;
#pragma unroll 2
      for (int rb = sub; rb < MROWS / 32; rb += nsub) {
          const int row = rb * 32 + (tid >> 4), s = row % SEQ;
          float acc[8];
#pragma unroll
          for (int i = 0; i < 8; ++i) acc[i] = bsv[i];
#pragma unroll
          for (int j = 0; j < 4; ++j) { if (s - 3 + j >= 0) { const v4u X = *(const v4u*)(src + (size_t)(row - 3 + j) * 128);
              acc[0] += w[j][0] * bflo(X.x); acc[1] += w[j][1] * bfhi(X.x); acc[2] += w[j][2] * bflo(X.y); acc[3] += w[j][3] * bfhi(X.y);
              acc[4] += w[j][4] * bflo(X.z); acc[5] += w[j][5] * bfhi(X.z); acc[6] += w[j][6] * bflo(X.w); acc[7] += w[j][7] * bfhi(X.w); } }
#pragma unroll
          for (int i = 0; i < 8; ++i) acc[i] = acc[i] / (1.f + expf(-acc[i])) * sc;
          v4u o; o.x = pk2(acc[0], acc[1]); o.y = pk2(acc[2], acc[3]); o.z = pk2(acc[4], acc[5]); o.w = pk2(acc[6], acc[7]);
          *(v4u*)(dst + (size_t)row * 128) = o;
      } }
    { const int slot = wk % 16, sub = wk / 16, nsub = (NWK - slot + 15) / 16, c16 = tid & 15;
      const bf16r* src = P + (size_t)(16 + slot) * MROWS * 128 + 8 * c16;
      float mx0 = 0.f, mx1 = 0.f;
#pragma unroll 8
      for (int rb = sub; rb < MROWS / 32; rb += nsub) {
          const int row = rb * 32 + (tid >> 4); const v4u X = *(const v4u*)(src + (size_t)row * 128);
          const float x0 = bflo(X.x), x1 = bfhi(X.x), x2 = bflo(X.y), x3 = bfhi(X.y), x4 = bflo(X.z), x5 = bfhi(X.z), x6 = bflo(X.w), x7 = bfhi(X.w);
          float s = (x0 * x0 + x1 * x1) + (x2 * x2 + x3 * x3) + (x4 * x4 + x5 * x5) + (x6 * x6 + x7 * x7);
          s += __shfl_xor(s, 1); s += __shfl_xor(s, 2); s += __shfl_xor(s, 4); s += __shfl_xor(s, 8);
          if (row < SEQ) mx0 = fmaxf(mx0, s); else mx1 = fmaxf(mx1, s);
      }
#pragma unroll
      for (int o = 1; o < 64; o <<= 1) { mx0 = fmaxf(mx0, __shfl_xor(mx0, o)); mx1 = fmaxf(mx1, __shfl_xor(mx1, o)); }
      if ((tid & 63) == 0) { unsigned* QK2 = (unsigned*)(a.ws + WS_QK2) + layer * 32;
          __hip_atomic_fetch_max(QK2 + slot, __float_as_uint(mx0 * 1.02f), __ATOMIC_RELAXED, __HIP_MEMORY_SCOPE_AGENT);
          __hip_atomic_fetch_max(QK2 + 16 + slot, __float_as_uint(mx1 * 1.02f), __ATOMIC_RELAXED, __HIP_MEMORY_SCOPE_AGENT); }
    }
}

__device__ __forceinline__ int cv_st(int k, int c) { const int kk = (k & ~0xC) | ((k & 4) << 1) | ((k & 8) >> 1); return ((kk >> 3) * 4 + (c >> 5)) * 512 + ((kk & 7) * 32 + (c & 31)) * 2; }
__device__ __forceinline__ int cv_rd_base(int lane) { return ((lane & 3) << 3) | (((lane >> 2) & 3) << 6) | (((lane >> 4) & 1) << 5) | (((lane >> 5) & 1) << 8); }
__device__ __forceinline__ int ccrow(int r, int hi) { return (r & 3) + 8 * (r >> 2) + 4 * hi; }
#define CFRAG(dst, vb, ks) do { v4s l_, h_; asm volatile("ds_read_b64_tr_b16 %0, %1 offset:%2" : "=&v"(l_) : "v"(vb), "i"((ks) * 4096) : "memory"); \
        asm volatile("ds_read_b64_tr_b16 %0, %1 offset:%2" : "=&v"(h_) : "v"(vb), "i"((ks) * 4096 + 2048) : "memory"); asm volatile("s_waitcnt lgkmcnt(0)" ::: "memory"); \
        dst = (v8s){l_[0], l_[1], l_[2], l_[3], h_[0], h_[1], h_[2], h_[3]}; } while (0)

struct ChunkItem { int mixer, bh, b, h, c, row0; };
__device__ __forceinline__ ChunkItem chunk_decode(int idx) { ChunkItem it; it.mixer = idx / 2048; const int rem = idx % 2048; it.bh = rem / 256; it.b = it.bh >> 2; it.h = it.bh & 3; it.c = rem % 256; it.row0 = it.b * SEQ + it.c * 64; return it; }
__device__ __forceinline__ float ret_lg(int h) { return log2f(1.0f - exp2f(-5.0f - (float)h)); }

__device__ __forceinline__ void m1_phase(CArgs& a, LAS unsigned char* lds) {
    const int tid = lz_tid(), lane = tid & 63, wave = __builtin_amdgcn_readfirstlane(tid >> 6), r32 = lane & 31, hi = lane >> 5;
    const bf16r* P = (const bf16r*)(a.ws + WS_P); const bf16r* MQC = (const bf16r*)(a.ws + WS_MQC); bf16r* US = (bf16r*)(a.ws + WS_H);
    LAS unsigned char* KT = lds; LAS unsigned char* VT = lds + 16384; LAS float* wt = (LAS float*)(lds + 32768); LAS float* red = (LAS float*)(lds + 33024);
    const int sr = tid >> 4, sc = (tid & 15) * 8;
    for (int idx = lz_bid(); idx < 4096; idx += gridDim.x) {
        const ChunkItem it = chunk_decode(idx);
        const bf16r* ksrc = (it.mixer == 0 ? P + (size_t)(4 + it.h) * MROWS * 128 : MQC + (size_t)(4 + it.h) * MROWS * 128) + (size_t)it.row0 * 128;
        const bf16r* vsrc = P + (size_t)((it.mixer == 0 ? 8 : 48) + it.h) * MROWS * 128 + (size_t)it.row0 * 128;
        if (tid < 64) { float w;
            if (it.mixer == 0) w = exp2f((float)(63 - tid) * ret_lg(it.h));
            else { const float* MA = (const float*)(a.ws + WS_MA) + (size_t)it.bh * SEQ + it.c * 64; const float* MCM = (const float*)(a.ws + WS_MCM) + (size_t)it.bh * SEQ + it.c * 64;
                   const float mp = ((const float*)(a.ws + WS_MPREV))[it.bh * 256 + it.c]; w = expf(MA[tid] - fmaxf(mp, MCM[63])); }
            wt[tid] = w; }
        const v4u k0 = *(const v4u*)(ksrc + (size_t)sr * 128 + sc), k1 = *(const v4u*)(ksrc + (size_t)(32 + sr) * 128 + sc);
        const v4u v0 = *(const v4u*)(vsrc + (size_t)sr * 128 + sc), v1 = *(const v4u*)(vsrc + (size_t)(32 + sr) * 128 + sc);
        __syncthreads();
        const float w0 = wt[sr], w1 = wt[32 + sr];
        float a0[8] = {bflo(k0.x) * w0, bfhi(k0.x) * w0, bflo(k0.y) * w0, bfhi(k0.y) * w0, bflo(k0.z) * w0, bfhi(k0.z) * w0, bflo(k0.w) * w0, bfhi(k0.w) * w0};
        float a1[8] = {bflo(k1.x) * w1, bfhi(k1.x) * w1, bflo(k1.y) * w1, bfhi(k1.y) * w1, bflo(k1.z) * w1, bfhi(k1.z) * w1, bflo(k1.w) * w1, bfhi(k1.w) * w1};
        { v4u o; o.x = pk2(a0[0], a0[1]); o.y = pk2(a0[2], a0[3]); o.z = pk2(a0[4], a0[5]); o.w = pk2(a0[6], a0[7]); *(LAS v4u*)(KT + cv_st(sr, sc)) = o;
          o.x = pk2(a1[0], a1[1]); o.y = pk2(a1[2], a1[3]); o.z = pk2(a1[4], a1[5]); o.w = pk2(a1[6], a1[7]); *(LAS v4u*)(KT + cv_st(32 + sr, sc)) = o;
          *(LAS v4u*)(VT + cv_st(sr, sc)) = v0; *(LAS v4u*)(VT + cv_st(32 + sr, sc)) = v1; }
        if (it.mixer == 1) {
#pragma unroll
            for (int i = 0; i < 8; ++i) { float s = a0[i] + a1[i]; s += __shfl_xor(s, 16); s += __shfl_xor(s, 32); if (lane < 16) red[wave * 128 + sc + i] = s; }
        }
        __syncthreads();
        if (it.mixer == 1 && tid < 128) { float s = 0.f;
#pragma unroll
            for (int q = 0; q < 8; ++q) s += red[q * 128 + tid];
            ((float*)(a.ws + WS_UN))[((size_t)it.bh * 256 + it.c) * 128 + tid] = s; }
        const int db = wave >> 1;
        const int kvb = (int)(uintptr_t)KT + cv_rd_base(lane) + db * 512;
        v8s kf[4]; CFRAG(kf[0], kvb, 0); CFRAG(kf[1], kvb, 1); CFRAG(kf[2], kvb, 2); CFRAG(kf[3], kvb, 3);
#pragma unroll
        for (int e2 = 0; e2 < 2; ++e2) { const int eb = (wave & 1) * 2 + e2; const int vvb = (int)(uintptr_t)VT + cv_rd_base(lane) + eb * 512;
            v8s vf[4]; CFRAG(vf[0], vvb, 0); CFRAG(vf[1], vvb, 1); CFRAG(vf[2], vvb, 2); CFRAG(vf[3], vvb, 3);
            v16f acc = {};
#pragma unroll
            for (int ks = 0; ks < 4; ++ks) acc = __builtin_amdgcn_mfma_f32_32x32x16_bf16(kf[ks], vf[ks], acc, 0, 0, 0);
            bf16r* dst = US + (size_t)idx * 16384 + (size_t)(eb * 32 + r32) * 128 + db * 32 + 4 * hi;
#pragma unroll
            for (int g = 0; g < 4; ++g) { v2u o; o.x = pk2(acc[4 * g], acc[4 * g + 1]); o.y = pk2(acc[4 * g + 2], acc[4 * g + 3]); *(v2u*)(dst + 8 * g) = o; } }
        __syncthreads();
    }
}

#ifndef M2U
#define M2U 32
#endif
__device__ __forceinline__ void m2_phase(CArgs& a, LAS unsigned char* lds) {
    const int tid = lz_tid();
    unsigned* US = (unsigned*)(a.ws + WS_H); LAS float* coef = (LAS float*)lds;
    const float* MCM = (const float*)(a.ws + WS_MCM); const float* MPREV = (const float*)(a.ws + WS_MPREV);
    for (int blk = lz_bid(); blk < 16 * 8192 / 512; blk += gridDim.x) {
        const int chain = blk / 16, mixer = chain >> 3, bh = chain & 7;
        __syncthreads();
        if (tid < 256) { float cf;
            if (mixer == 0) cf = exp2f(64.0f * ret_lg(bh & 3));
            else { const float mp = MPREV[bh * 256 + tid]; cf = expf(mp - fmaxf(mp, MCM[(size_t)bh * SEQ + tid * 64 + 63])); }
            coef[tid] = cf; }
        __syncthreads();
        unsigned* p = US + (size_t)chain * 256 * 8192 + (blk % 16) * 512 + tid;
        float s0 = 0.f, s1 = 0.f;
        for (int c = 0; c < 256; c += M2U) { unsigned u[M2U];
#pragma unroll
            for (int i = 0; i < M2U; ++i) u[i] = p[(size_t)(c + i) * 8192];
#pragma unroll
            for (int i = 0; i < M2U; ++i) { const float cf = coef[c + i]; p[(size_t)(c + i) * 8192] = pk2(s0, s1); s0 = s0 * cf + bflo(u[i]); s1 = s1 * cf + bfhi(u[i]); } }
    }
    float* UN = (float*)(a.ws + WS_UN);
    for (int bh = lz_bid(); bh < 8; bh += gridDim.x) {
        __syncthreads();
        if (tid < 256) { const float mp = MPREV[bh * 256 + tid]; coef[tid] = expf(mp - fmaxf(mp, MCM[(size_t)bh * SEQ + tid * 64 + 63])); }
        __syncthreads();
        if (tid < 128) { float* p = UN + (size_t)bh * 256 * 128 + tid; float s = 0.f;
            for (int c = 0; c < 256; c += 16) { float u[16];
#pragma unroll
                for (int i2 = 0; i2 < 16; ++i2) u[i2] = p[(c + i2) * 128];
#pragma unroll
                for (int i2 = 0; i2 < 16; ++i2) { p[(c + i2) * 128] = s; s = s * coef[c + i2] + u[i2]; } } }
    }
}

__device__ __forceinline__ void m3_phase(CArgs& a, int layer, LAS unsigned char* lds) {
    const int tid = lz_tid(), lane = tid & 63, wave = __builtin_amdgcn_readfirstlane(tid >> 6), r32 = lane & 31, hi = lane >> 5;
    const bf16r* P = (const bf16r*)(a.ws + WS_P); const bf16r* MQC = (const bf16r*)(a.ws + WS_MQC); const bf16r* US = (const bf16r*)(a.ws + WS_H);
    bf16r* Y = (bf16r*)(a.ws + WS_Y); const float* msc = (const float*)a.in[13] + (size_t)layer * DM;
    LAS unsigned char* VT = lds; LAS float* OT = (LAS float*)(lds + 16384);
    LAS float* sa = (LAS float*)(lds + 16384 + 64 * 132 * 4); LAS float* sg = sa + 64; LAS float* swi = sg + 64; LAS float* semq = swi + 64; LAS float* sn = semq + 64; LAS float* fw = sn + 128;
    const int sr = tid >> 4, sc = (tid & 15) * 8;
    const int lb = wave & 1, eb = wave >> 1, l = lb * 32 + r32;
    for (int idx = lz_bid(); idx < 4096; idx += gridDim.x) {
        const ChunkItem it = chunk_decode(idx);
        const bf16r* qsrc = (it.mixer == 0 ? P + (size_t)it.h * MROWS * 128 : MQC + (size_t)it.h * MROWS * 128) + (size_t)it.row0 * 128;
        const bf16r* ksrc = (it.mixer == 0 ? P + (size_t)(4 + it.h) * MROWS * 128 : MQC + (size_t)(4 + it.h) * MROWS * 128) + (size_t)it.row0 * 128;
        const bf16r* vsrc = P + (size_t)((it.mixer == 0 ? 8 : 48) + it.h) * MROWS * 128 + (size_t)it.row0 * 128;
        const bf16r* gsrc = P + (size_t)((it.mixer == 0 ? 12 : 52) + it.h) * MROWS * 128 + (size_t)it.row0 * 128;
        const bf16r* St = US + (size_t)idx * 16384;
        const float lg = ret_lg(it.h);
        if (it.mixer == 1) {
            if (tid < 64) { const size_t o = (size_t)it.bh * SEQ + it.c * 64 + tid; const float mp = ((const float*)(a.ws + WS_MPREV))[it.bh * 256 + it.c];
                const float av = ((const float*)(a.ws + WS_MA))[o], cm = ((const float*)(a.ws + WS_MCM))[o], bb = ((const float*)(a.ws + WS_MB))[o];
                const float g = fmaxf(mp, cm); sa[tid] = av; sg[tid] = g; swi[tid] = expf(mp - g); semq[tid] = expf(-(bb + g)); }
            else if (tid < 192) sn[tid - 64] = ((const float*)(a.ws + WS_UN))[((size_t)it.bh * 256 + it.c) * 128 + tid - 64];
        }
        { const v4u v0 = *(const v4u*)(vsrc + (size_t)sr * 128 + sc), v1 = *(const v4u*)(vsrc + (size_t)(32 + sr) * 128 + sc);
          *(LAS v4u*)(VT + cv_st(sr, sc)) = v0; *(LAS v4u*)(VT + cv_st(32 + sr, sc)) = v1; }
        v8s qr[8];
#pragma unroll
        for (int d0 = 0; d0 < 8; ++d0) qr[d0] = *(const v8s*)(qsrc + (size_t)l * 128 + d0 * 16 + hi * 8);
        __syncthreads();
        v16f p0 = {}, p1 = {};
#pragma unroll
        for (int d0 = 0; d0 < 8; ++d0) { const v8s kf = *(const v8s*)(ksrc + (size_t)r32 * 128 + d0 * 16 + hi * 8); p0 = __builtin_amdgcn_mfma_f32_32x32x16_bf16(kf, qr[d0], p0, 0, 0, 0); }
        if (lb == 1) {
#pragma unroll
            for (int d0 = 0; d0 < 8; ++d0) { const v8s kf = *(const v8s*)(ksrc + (size_t)(32 + r32) * 128 + d0 * 16 + hi * 8); p1 = __builtin_amdgcn_mfma_f32_32x32x16_bf16(kf, qr[d0], p1, 0, 0, 0); }
        }
        float rs = 0.f;
        int ll = l; asm volatile("" : "+v"(ll));
        if (it.mixer == 0) {
#pragma unroll
            for (int r = 0; r < 16; ++r) { const int m0 = ccrow(r, hi), m1 = m0 + 32;
                p0[r] = (m0 <= ll) ? p0[r] * exp2f((float)(ll - m0) * lg) : 0.f; p1[r] = (m1 <= ll) ? p1[r] * exp2f((float)(ll - m1) * lg) : 0.f; }
        } else { const float gl = sg[l];
#pragma unroll
            for (int r = 0; r < 16; ++r) { const int m0 = ccrow(r, hi), m1 = m0 + 32;
                p0[r] = (m0 <= ll) ? p0[r] * expf(sa[m0] - gl) : 0.f; p1[r] = (m1 <= ll) ? p1[r] * expf(sa[m1] - gl) : 0.f; rs += p0[r] + p1[r]; }
            rs = swap_add(rs);
        }
        v8s pa0, pa1, pa2, pa3;
#define CPK4(Pv, B_, OUT) do { unsigned a0_ = pk2(Pv[B_+0], Pv[B_+1]), a1_ = pk2(Pv[B_+2], Pv[B_+3]), b0_ = pk2(Pv[B_+4], Pv[B_+5]), b1_ = pk2(Pv[B_+6], Pv[B_+7]); \
        auto r0_ = __builtin_amdgcn_permlane32_swap(a0_, b0_, false, false); auto r1_ = __builtin_amdgcn_permlane32_swap(a1_, b1_, false, false); \
        v4u w_ = {r0_[0], r1_[0], r0_[1], r1_[1]}; OUT = *reinterpret_cast<v8s*>(&w_); } while (0)
        CPK4(p0, 0, pa0); CPK4(p0, 8, pa1); CPK4(p1, 0, pa2); CPK4(p1, 8, pa3);
#undef CPK4
        const int vvb = (int)(uintptr_t)VT + cv_rd_base(lane) + eb * 512;
        v16f oi = {}, ox = {};
        { v8s vf; CFRAG(vf, vvb, 0); oi = __builtin_amdgcn_mfma_f32_32x32x16_bf16(pa0, vf, oi, 0, 0, 0); CFRAG(vf, vvb, 1); oi = __builtin_amdgcn_mfma_f32_32x32x16_bf16(pa1, vf, oi, 0, 0, 0);
          CFRAG(vf, vvb, 2); oi = __builtin_amdgcn_mfma_f32_32x32x16_bf16(pa2, vf, oi, 0, 0, 0); CFRAG(vf, vvb, 3); oi = __builtin_amdgcn_mfma_f32_32x32x16_bf16(pa3, vf, oi, 0, 0, 0); }
#pragma unroll
        for (int d0 = 0; d0 < 8; ++d0) { const v8s sf = *(const v8s*)(St + (size_t)(eb * 32 + r32) * 128 + d0 * 16 + hi * 8); ox = __builtin_amdgcn_mfma_f32_32x32x16_bf16(qr[d0], sf, ox, 0, 0, 0); }
        float fa, fb;
        if (it.mixer == 0) { fa = 1.f; fb = exp2f((float)(l + 1) * lg); }
        else { float qn = 0.f;
#pragma unroll
            for (int d0 = 0; d0 < 8; ++d0)
#pragma unroll
                for (int i = 0; i < 8; ++i) qn += bf1((bf16r)qr[d0][i]) * sn[d0 * 16 + hi * 8 + i];
            qn = swap_add(qn);
            const float wi = swi[l]; const float den = rs + wi * qn; const float dn = fmaxf(fabsf(den), semq[l]); fa = 1.0f / dn; fb = wi / dn; }
        LAS float* fww = fw + wave * 64;
        if (hi == 0) { fww[r32] = fa; fww[32 + r32] = fb; }
        asm volatile("s_waitcnt lgkmcnt(0)" ::: "memory");
#pragma unroll
        for (int r = 0; r < 16; ++r) { const int lr = ccrow(r, hi); OT[(lb * 32 + lr) * 132 + eb * 32 + r32] = fww[lr] * oi[r] + fww[32 + lr] * ox[r]; }
        __syncthreads();
        const int colbase = (it.mixer == 0 ? 0 : 1536) + it.h * 128;
        { const int row = wave * 8 + (lane >> 3), seg = lane & 7;
          const v4u gA = *(const v4u*)(gsrc + (size_t)row * 128 + seg * 16), gB = *(const v4u*)(gsrc + (size_t)row * 128 + seg * 16 + 8);
          float v[16];
#pragma unroll
          for (int q = 0; q < 4; ++q) { const v4f t = *(LAS v4f*)(OT + row * 132 + seg * 16 + 4 * q); v[4 * q] = t.x; v[4 * q + 1] = t.y; v[4 * q + 2] = t.z; v[4 * q + 3] = t.w; }
          float s = 0.f;
#pragma unroll
          for (int q = 0; q < 16; ++q) s += v[q];
          s += __shfl_xor(s, 1); s += __shfl_xor(s, 2); s += __shfl_xor(s, 4);
          const float mu = s * (1.f / 128.f); float sq = 0.f;
#pragma unroll
          for (int q = 0; q < 16; ++q) { v[q] -= mu; sq += v[q] * v[q]; }
          sq += __shfl_xor(sq, 1); sq += __shfl_xor(sq, 2); sq += __shfl_xor(sq, 4);
          const float rstd = 1.0f / sqrtf(sq * (1.f / 128.f) + NORM_EPS);
          float g[16] = {bflo(gA.x), bfhi(gA.x), bflo(gA.y), bfhi(gA.y), bflo(gA.z), bfhi(gA.z), bflo(gA.w), bfhi(gA.w), bflo(gB.x), bfhi(gB.x), bflo(gB.y), bfhi(gB.y), bflo(gB.z), bfhi(gB.z), bflo(gB.w), bfhi(gB.w)};
          const float* mp = msc + colbase + seg * 16;
#pragma unroll
          for (int q = 0; q < 16; ++q) { const float e = expf(-g[q]); const float gate = (it.mixer == 0) ? g[q] / (1.f + e) : 1.f / (1.f + e); v[q] = v[q] * rstd * gate * mp[q]; }
          v4u oA, oB; oA.x = pk2(v[0], v[1]); oA.y = pk2(v[2], v[3]); oA.z = pk2(v[4], v[5]); oA.w = pk2(v[6], v[7]); oB.x = pk2(v[8], v[9]); oB.y = pk2(v[10], v[11]); oB.z = pk2(v[12], v[13]); oB.w = pk2(v[14], v[15]);
          bf16r* yp = Y + (size_t)(it.row0 + row) * DM + colbase + seg * 16;
          *(v4u*)yp = oA; *(v4u*)(yp + 8) = oB; }
        __syncthreads();
    }
}

__device__ __forceinline__ fox::BlockRef<fox::bf16, fox::bf16> fox_ref(CArgs& a, int layer, int bh, int qb, int jlo) {
    const int b = bh >> 3, h = bh & 7; const fox::bf16* P = (const fox::bf16*)(a.ws + WS_P);
    fox::BlockRef<fox::bf16, fox::bf16> r;
    r.Q = P + ((size_t)(16 + h) * MROWS + (size_t)b * SEQ + (size_t)qb * 256) * 128;
    r.K = (unsigned)(WS_P + ((size_t)(24 + h) * MROWS + (size_t)b * SEQ) * 256); r.V = (unsigned)(WS_P + ((size_t)(32 + h) * MROWS + (size_t)b * SEQ) * 256);
    r.O = (fox::bf16*)(a.ws + WS_Y) + ((size_t)b * SEQ + (size_t)qb * 256) * DM + 512 + h * 128;
    r.C = (unsigned)(WS_CNEG + (size_t)bh * SEQ * 4); r.MS = (const float*)a.in[13] + (size_t)layer * DM + 512 + h * 128; const int j4 = jlo >> 2;
    r.P0 = (qb - j4) * 256; r.JLO = j4 * 4;
    r.K += (unsigned)j4 * 256u * 256u; r.V += (unsigned)j4 * 256u * 256u; r.C += (unsigned)j4 * 1024u;
    return r;
}
__device__ __forceinline__ void fox_table_phase(CArgs& a, int layer) {
    const int tid = lz_tid(), lane = tid & 63, u = lz_bid() * 8 + (tid >> 6);
    if (u >= 1024) return;
    const float* QK2 = (const float*)(a.ws + WS_QK2) + layer * 32; const float* CN = (const float*)(a.ws + WS_CNEG);
    const int bh = u & 15, qb = 63 - (u >> 4), b = bh >> 3, h = bh & 7;
    const float qkmax = sqrtf(QK2[b * 16 + h] * QK2[b * 16 + 8 + h]);
    const float* cn = CN + (size_t)bh * SEQ; const float thresh = cn[qb * 256] - (2.0f * qkmax + 1245.0f);
    int cnt = 0;
#pragma unroll
    for (int t = 0; t < 4; ++t) { const int tile = lane + 64 * t; const bool skip = (tile < qb * 4) && (cn[tile * 64 + 63] < thresh); cnt += __popcll(__ballot(skip)); }
    if (lane == 0) ((int*)(a.ws + WS_JT))[layer * 1024 + u] = cnt;
}
__device__ __forceinline__ void fox_phase(CArgs& a, int layer, char* lds, int rep = 0) {
    using BR = fox::BlockRef<fox::bf16, fox::bf16>;
    constexpr int W = 1 << 30, total = 1024;
    const int tid = lz_tid(), lane = tid & 63;
    volatile unsigned* sbuf = (volatile unsigned*)(lds + 69632);
    unsigned* qctr = (unsigned*)(a.ws + WS_QCTR) + layer * 64 + rep * 128;
    const int* JT = (const int*)(a.ws + WS_JT) + layer * 1024;
#define FOX_GRAB(U) do { if (tid == 0) sbuf[0] = __hip_atomic_fetch_add(qctr, 1u, __ATOMIC_RELAXED, __HIP_MEMORY_SCOPE_AGENT); __syncthreads(); U = __builtin_amdgcn_readfirstlane((int)sbuf[0]); __syncthreads(); } while (0)
#define FOX_MAKE(R, U) do { const int bh_ = (U) & 15, qb_ = 63 - ((U) >> 4); R = fox_ref(a, layer, bh_, qb_, __builtin_amdgcn_readfirstlane(JT[(U)])); } while (0)
    int u; FOX_GRAB(u); if (u >= total) return;
    BR cur; FOX_MAKE(cur, u);
    fox::Seam<fox::bf16> S;
    const __amdgpu_buffer_rsrc_t rs = __builtin_amdgcn_make_buffer_rsrc((void*)a.ws, 0, -1, 0x00020000);
    fox::causal_swa_prime<fox::bf16, fox::bf16>(cur, W, lds, S, rs);
    for (;;) {
        int un; FOX_GRAB(un); const bool last = un >= total;
        BR nxt = cur; if (!last) FOX_MAKE(nxt, un);
        fox::causal_swa_block<fox::bf16, fox::bf16>(cur, nxt, SEQ, W, lds, S, rs);
        if (last) break;
        cur = nxt;
    }
#undef FOX_GRAB
#undef FOX_MAKE
}

#ifdef NANPROBE
constexpr size_t WS_FLAGS = 32 * 1024;
__device__ __forceinline__ void probe_f32(const float* p, size_t n, unsigned* flag) { bool bad = false;
    for (size_t i = (size_t)lz_bid() * 512 + lz_tid(); i < n; i += (size_t)gridDim.x * 512) { const unsigned u = __float_as_uint(p[i]); if ((u & 0x7f800000u) == 0x7f800000u) bad = true; }
    if (bad) *flag = 1u; }
__device__ __forceinline__ void probe_bf16(const unsigned short* p, size_t n, unsigned* flag) { bool bad = false;
    for (size_t i = (size_t)lz_bid() * 512 + lz_tid(); i < n; i += (size_t)gridDim.x * 512) { const unsigned u = p[i]; if ((u & 0x7f80u) == 0x7f80u) bad = true; }
    if (bad) *flag = 1u; }
#define PROBE_F32(p, n, k) probe_f32((const float*)(p), (n), (unsigned*)(ws + WS_FLAGS) + (k))
#define PROBE_BF16(p, n, k) probe_bf16((const unsigned short*)(p), (n), (unsigned*)(ws + WS_FLAGS) + (k))
#else
#define PROBE_F32(p, n, k) do {} while (0)
#define PROBE_BF16(p, n, k) do {} while (0)
#endif
#ifndef PHMASK
#define PHMASK 0xfff
#endif
#define EN(k) ((PHMASK >> (k)) & 1)
#define IN(k) (lo <= (k) && (k) < hi)
#ifdef TWICE_SYNC
#define SEAM() do { if (IN(ph) && IN(ph + 1)) { grid.sync(); grid.sync(); grid.sync(); } ++ph; } while (0)
#else
#define SEAM() do { if (IN(ph) && IN(ph + 1)) { if (ph == 0) grid.sync(); else xcd_barrier(xbar); } ++ph; } while (0)
#endif
#define a (*fresh_args())
#define ws (a.ws)
#define MOD ((const float*)(ws + WS_MOD))
template <int layer>
__device__ __forceinline__ void layer_phases(int& ph, const int lo, const int hi, cg::grid_group& grid, const XcdBarrier& xbar, LAS unsigned char* lds, unsigned char* lds_raw) {

        const float* mod = MOD + (size_t)layer * NB * NMOD;
        const float* xin = layer == 0 ? (const float*)a.in[0] : a.out;
        if (EN(1) && IN(ph)) norm_phase(xin, (const float*)a.in[5] + (size_t)layer * DM, mod, mod + DM, (bf16r*)(ws + WS_H));
#ifdef TWICE_NORM
        if (IN(ph)) norm_phase(xin, (const float*)a.in[5] + (size_t)layer * DM, mod, mod + DM, (bf16r*)(ws + WS_H));
#endif
        SEAM();
        if (EN(2) && IN(ph)) { pg8::Gemm g{(const pg8::bf16_t*)(ws + WS_H), (const pg8::bf16_t*)(ws + WS_WIN + layer * WIN_BYTES), MROWS, NINP, DM}; pg8::StaticOrder S; S.init(MROWS, NINP, gridDim.x, lz_bid());
            pg8::EpiIn E{(pg8::bf16_t*)(ws + WS_P), (float*)(ws + WS_GATES)};
            pg8::gemm_phase<pg8::EpiIn, pg8::StaticOrder, true, true>(lds, g, S, E);
            gate_gemm((const bf16r*)(ws + WS_H), (const bf16r*)(ws + WS_WG + layer * WG_BYTES), (float*)(ws + WS_GATES));
#ifdef TWICE_IN
            __syncthreads(); pg8::gemm_phase<pg8::EpiIn, pg8::StaticOrder, true, true>(lds, g, S, E);
#endif
        }
        SEAM();
        if (EN(3) && IN(ph)) prep_phase(a, layer, lds);
#ifdef TWICE_INPREP
        if (IN(ph)) { xcd_barrier(xbar);
            { pg8::Gemm g{(const pg8::bf16_t*)(ws + WS_H), (const pg8::bf16_t*)(ws + WS_WIN + layer * WIN_BYTES), MROWS, NINP, DM}; pg8::StaticOrder S; S.init(MROWS, NINP, gridDim.x, lz_bid());
              pg8::EpiIn E{(pg8::bf16_t*)(ws + WS_P), (float*)(ws + WS_GATES)};
              pg8::gemm_phase<pg8::EpiIn, pg8::StaticOrder, true, true>(lds, g, S, E); }
            xcd_barrier(xbar); prep_phase(a, layer, lds); }
#endif
        SEAM();
        PROBE_F32(ws + WS_GATES, (size_t)MROWS * 16, 1 + 10 * layer); PROBE_F32(ws + WS_CNEG, (size_t)NB * 8 * SEQ, 2 + 10 * layer); PROBE_F32(ws + WS_MA, (size_t)3 * NB * 4 * SEQ, 3 + 10 * layer); PROBE_BF16(ws + WS_P, (size_t)56 * MROWS * 128, 4 + 10 * layer); PROBE_BF16(ws + WS_MQC, (size_t)8 * MROWS * 128, 5 + 10 * layer);
        if (IN(ph)) { fox_table_phase(a, layer); if (EN(4)) m1_phase(a, lds);
#if 0
#ifdef TWICE_FOX
            __syncthreads(); fox_phase(a, layer, (char*)lds_raw);
#endif
#endif
#ifdef TWICE_M1
            __syncthreads(); m1_phase(a, lds);
#endif
        }
        SEAM();
#ifdef NANPROBE
        PROBE_BF16(ws + WS_H, (size_t)MROWS * DM, 20 + layer); PROBE_F32(ws + WS_UN, (size_t)NB * 4 * 256 * 128, 22 + layer); PROBE_F32(ws + WS_MPREV, (size_t)NB * 4 * 256, 24 + layer); grid.sync();
#endif
        if (IN(ph)) { if (EN(6)) m2_phase(a, lds); __syncthreads(); if (EN(5)) fox_phase(a, layer, (char*)lds_raw);
#ifdef TWICE_FOX
            __syncthreads(); fox_phase(a, layer, (char*)lds_raw, 1);
#endif
        }
        SEAM();
        if (EN(7) && IN(ph)) m3_phase(a, layer, lds);
#ifdef TWICE_M3
        if (IN(ph)) { __syncthreads(); m3_phase(a, layer, lds); }
#endif
        SEAM();
        PROBE_BF16(ws + WS_H, (size_t)MROWS * DM, 6 + 10 * layer); PROBE_BF16(ws + WS_Y, (size_t)MROWS * DM, 7 + 10 * layer);
        if (EN(8) && IN(ph)) { pg8::Gemm g{(const pg8::bf16_t*)(ws + WS_Y), (const pg8::bf16_t*)(ws + WS_WOUT + layer * WOUT_BYTES), MROWS, DM, DM}; pg8::StaticOrder S; S.init(MROWS, DM, gridDim.x, lz_bid());
            pg8::EpiRes E{xin, a.out, mod + 2 * DM};
            pg8::gemm_phase<pg8::EpiRes, pg8::StaticOrder, true, true>(lds, g, S, E); }
        SEAM();
        PROBE_F32(a.out, (size_t)MROWS * DM, 8 + 10 * layer);
        if (EN(1) && IN(ph)) norm_phase(a.out, (const float*)a.in[6] + (size_t)layer * DM, mod + 3 * DM, mod + 4 * DM, (bf16r*)(ws + WS_H));
#ifdef TWICE_NORM
        if (IN(ph)) norm_phase(a.out, (const float*)a.in[6] + (size_t)layer * DM, mod + 3 * DM, mod + 4 * DM, (bf16r*)(ws + WS_H));
#endif
        SEAM();
        if (EN(9) && IN(ph)) { pg8::Gemm g{(const pg8::bf16_t*)(ws + WS_H), (const pg8::bf16_t*)(ws + WS_WFF1 + layer * WFF_BYTES), MROWS, DFF, DM}; pg8::StaticOrder S; S.init(MROWS, DFF, gridDim.x, lz_bid());
            pg8::EpiRelu2 E{(pg8::bf16_t*)(ws + WS_HID), DFF};
            pg8::gemm_phase<pg8::EpiRelu2, pg8::StaticOrder, true, true>(lds, g, S, E);
#ifdef TWICE_FF1
            __syncthreads(); pg8::gemm_phase<pg8::EpiRelu2, pg8::StaticOrder, true, true>(lds, g, S, E);
#endif
        }
        SEAM();
        if (EN(10) && IN(ph)) { pg8::Gemm g{(const pg8::bf16_t*)(ws + WS_HID), (const pg8::bf16_t*)(ws + WS_WFF2 + layer * WFF_BYTES), MROWS, DM, DFF}; pg8::StaticOrder S; S.init(MROWS, DM, gridDim.x, lz_bid());
            pg8::EpiRes E{a.out, a.out, mod + 5 * DM};
            pg8::gemm_phase<pg8::EpiRes, pg8::StaticOrder, true, true>(lds, g, S, E); }
        SEAM();
        PROBE_F32(a.out, (size_t)MROWS * DM, 9 + 10 * layer);
    }
__global__ void __launch_bounds__(512, 2) trunk_fwd(Args a_unused) {
    extern __shared__ __attribute__((aligned(16))) unsigned char lds_raw[];
    LAS unsigned char* lds = (LAS unsigned char*)lds_raw;
    cg::grid_group grid = cg::this_grid();
    int lo, hi; { CArgs& a0 = *fresh_args(); lo = a0.ph_lo; hi = a0.ph_hi; } int ph = 0;
    volatile LAS unsigned* xst = (volatile LAS unsigned*)(lds + 139264);
    if (lz_tid() < 2) xst[lz_tid()] = 0u;
    __syncthreads();
    if (lz_bid() == 0) { unsigned* z = (unsigned*)ws; for (int i = lz_tid(); i < 4096; i += 512) z[i] = 0u; }
#ifdef NANPROBE
    if (lz_bid() == 0 && lz_tid() < 32) ((unsigned*)(ws + WS_FLAGS))[lz_tid()] = 0u;
#endif
    if (EN(0) && IN(ph)) p0_phase(a, lds);
#ifdef TWICE_P0
    if (IN(ph)) { __syncthreads(); p0_phase(a, lds); }
#endif
    if (IN(ph) && IN(ph + 1)) grid.sync();
    ++ph;
    const XcdBarrier xbar = xcd_barrier_post((unsigned*)ws, xst);
    layer_phases<0>(ph, lo, hi, grid, xbar, lds, lds_raw);
    layer_phases<1>(ph, lo, hi, grid, xbar, lds, lds_raw);
    if (EN(11) && IN(ph)) final_norm_phase(a.out, (const float*)a.in[17]);
#ifdef NANPROBE
    { grid.sync(); float code = 0.f; const unsigned* fl = (const unsigned*)(ws + WS_FLAGS);
      const int order[16] = {1, 2, 3, 4, 5, 24, 20, 22, 6, 7, 8, 9, 11, 12, 13, 14};
      for (int q = 15; q >= 0; --q) if (fl[order[q]]) code = (float)order[q] * 1.0e6f;
      float* o = a.out; for (size_t i = (size_t)lz_bid() * 512 + lz_tid(); i < (size_t)MROWS * DM; i += (size_t)gridDim.x * 512) o[i] = (i == 0) ? code : 0.f; }
#endif
#ifdef DBG_OFF_MIB
    { grid.sync();
      const unsigned short* src = (const unsigned short*)(ws + (size_t)DBG_OFF_MIB * MiB); const size_t n = (size_t)DBG_MIB * MiB / 2; float* o = a.out;
      for (size_t i = (size_t)lz_bid() * 512 + lz_tid(); i < (size_t)MROWS * DM; i += (size_t)gridDim.x * 512) { const size_t k = (4 * i) % n;
          o[i] = (float)src[k] + 3.f * (float)src[k + 1] + 5.f * (float)src[k + 2] + 7.f * (float)src[k + 3]; } }
#endif
#undef IN
#undef SEAM
#undef a
#undef ws
#undef MOD
}

#ifndef MK_PER_PHASE
#define MK_PER_PHASE 0
#endif
extern "C" void kernel_launch(void* const* d_in, const int* in_sizes, int n_in, void* d_out, int out_size, void* d_ws, size_t ws_size, hipStream_t stream) {
    static int grid = 0;
    if (grid == 0) {
        if (n_in != 18 || in_sizes[0] != MROWS * DM || out_size != MROWS * DM || ws_size < WS_END) { fprintf(stderr, "kernel_launch: unexpected shapes (n_in %d, in0 %d, out %d, ws %zu)\n", n_in, n_in > 0 ? in_sizes[0] : -1, out_size, ws_size); grid = -1; return; }
        int dev = 0, cus = 0, per_cu = 0;
        if (hipGetDevice(&dev) != hipSuccess || hipDeviceGetAttribute(&cus, hipDeviceAttributeMultiprocessorCount, dev) != hipSuccess) { grid = -1; return; }
        if (hipFuncSetAttribute((const void*)trunk_fwd, hipFuncAttributeMaxDynamicSharedMemorySize, LDS_BYTES) != hipSuccess) { fprintf(stderr, "kernel_launch: hipFuncSetAttribute failed\n"); grid = -1; return; }
        if (hipOccupancyMaxActiveBlocksPerMultiprocessor(&per_cu, (const void*)trunk_fwd, 512, LDS_BYTES) != hipSuccess || per_cu < 1) { fprintf(stderr, "kernel_launch: occupancy query says %d\n", per_cu); per_cu = 1; }
        (void)hipGetLastError();
        grid = cus;
    }
    if (grid < 0) return;
    Args a{};
    for (int i = 0; i < 18; ++i) a.in[i] = d_in[i];
    a.out = (float*)d_out; a.ws = (unsigned char*)d_ws;
    constexpr int NPH = 1 + 2 * 10 + 1;
#if MK_PER_PHASE
    for (int p = 0; p < NPH; ++p) { a.ph_lo = p; a.ph_hi = p + 1; hipLaunchKernelGGL(trunk_fwd, dim3(grid), dim3(512), LDS_BYTES, stream, a); }
#else
#ifdef DBG_HI
    a.ph_lo = 0; a.ph_hi = DBG_HI;
#else
    a.ph_lo = 0; a.ph_hi = NPH;
#endif
    void* args[] = {&a};
    hipError_t e = hipLaunchCooperativeKernel((const void*)trunk_fwd, dim3(grid), dim3(512), args, LDS_BYTES, stream);
    if (e != hipSuccess) fprintf(stderr, "kernel_launch: cooperative launch failed: %s (grid %d)\n", hipGetErrorString(e), grid);
#endif
}
```

```cpp
#include <hip/hip_runtime.h>
#include <hip/hip_bf16.h>
#include <hip/hip_cooperative_groups.h>
#include <cstdio>
#include <cstdint>
namespace cg = cooperative_groups;

constexpr int NB = 2, SEQ = 16384, DM = 2048, MROWS = NB * SEQ, DIN = 7184, NINP = 7168, DFF = 8192, HD = 128, NMOD = 6 * DM;
constexpr int NSLOT = 56;
constexpr float NORM_EPS = 1e-6f;
constexpr float KSCALE = 0.08838834764831845f;

__device__ __forceinline__ int lz_tid() { const int w = __builtin_amdgcn_readfirstlane((int)threadIdx.x >> 6); int l; asm volatile("v_mbcnt_lo_u32_b32 %0, -1, 0\n\tv_mbcnt_hi_u32_b32 %0, -1, %0" : "=v"(l));
    int t = w * 64 + l; asm volatile("" : "+v"(t)); return t; }
__device__ __forceinline__ int lz_bid() { int b = blockIdx.x; asm volatile("" : "+s"(b)); return b; }

namespace pg8 {
#define PG8_LAS __attribute__((address_space(3)))
typedef unsigned short bf16_t;
typedef short bf16x8 __attribute__((ext_vector_type(8)));
typedef float f32x4 __attribute__((ext_vector_type(4)));
typedef unsigned u32x4 __attribute__((ext_vector_type(4)));
constexpr int BM = 256, BK = 64, HALF = 128, HTB = HALF * BK * 2  , STAGE_BYTES = 8 * HTB, NXCD = 8, WGM = 4;

__host__ __device__ __forceinline__ int lds_byte(int r, int c) { const int st = (r >> 4) * 2 + (c >> 5), rr = r & 15, cc = c & 31, ob = rr * 64 + cc * 2; return st * 1024 + (ob ^ (((ob >> 9) & 1) << 5)); }
__host__ __device__ __forceinline__ void stage_rc(int b, int& R, int& C) { const int st = b / 1024, sb = b % 1024, swz = sb ^ (((sb >> 9) & 1) << 5); R = (st >> 1) * 16 + swz / 64; C = (st & 1) * 32 + (swz % 64) / 2; }
__host__ __device__ __forceinline__ int perm32(int rho) { const int n = rho >> 4, i = rho & 15; return 8 * (i >> 2) + 4 * n + (i & 3); }

struct Unit { int pm, pn; };
struct Gemm { const bf16_t* A; const bf16_t* Bt; int M, N, K; };

struct StaticOrder {
    int nM, nN, nwg, G, c;
    __host__ __device__ void init(int M, int N, int G_, int c_) { nM = M / BM; nN = N / BM; nwg = nM * nN; G = G_; c = c_; }
    __host__ __device__ bool next(int i, Unit& u) const {
        const long L = (long)i * G + c; if (L >= nwg) return false;
        int wgid = (int)L; { const int q = nwg / NXCD, r = nwg % NXCD, xcd = wgid % NXCD, off = wgid / NXCD; wgid = (xcd < r ? xcd * (q + 1) : r * (q + 1) + (xcd - r) * q) + off; }
        const int nig = WGM * nN, gid = wgid / nig, fm = gid * WGM, gsz = (nM - fm) < WGM ? (nM - fm) : WGM;
        u.pm = fm + ((wgid % nig) % gsz); u.pn = (wgid % nig) / gsz; return true;
    }
    __device__ __forceinline__ void a_ready(const Unit&) const {}
    __device__ __forceinline__ void done(const Unit&) const {}
};

__device__ __forceinline__ unsigned cvt_pk_bf16(float lo, float hi) { unsigned r; asm volatile("v_cvt_pk_bf16_f32 %0, %1, %2" : "=v"(r) : "v"(lo), "v"(hi)); return r; }

typedef float epf2_t __attribute__((ext_vector_type(2))); typedef __bf16 epb2_t __attribute__((ext_vector_type(2)));
__device__ __forceinline__ unsigned cvt_pk_c(float lo, float hi) { epf2_t v = {lo, hi}; epb2_t b = __builtin_convertvector(v, epb2_t); return __builtin_bit_cast(unsigned, b); }
struct EpiIn {
    static constexpr bool PERM = true, AFTER_DRAIN = false;
    bf16_t* P; float* gates;
    __device__ __forceinline__ void operator()(const f32x4 (&acc)[2][2][4][2], const Unit& u, int wr, int wc, int fr, int fq) const {
        const int row0 = u.pm * BM + wr * 64 + fr;
#pragma unroll
        for (int bj = 0; bj < 2; ++bj) {
            const int g = 2 * u.pn + bj;
            if (g < 56) {
                bf16_t* base = P + ((size_t)g * MROWS + row0) * 128 + wc * 32 + 8 * fq;
#pragma unroll
                for (int ai = 0; ai < 2; ++ai)
#pragma unroll
                    for (int m = 0; m < 4; ++m) { const f32x4 v0 = acc[ai][bj][m][0], v1 = acc[ai][bj][m][1];
                        u32x4 w; w.x = cvt_pk_c(v0[0], v0[1]); w.y = cvt_pk_c(v0[2], v0[3]); w.z = cvt_pk_c(v1[0], v1[1]); w.w = cvt_pk_c(v1[2], v1[3]);
                        *(u32x4*)(base + (size_t)(ai * HALF + m * 16) * 128) = w; }
            } else if (g == 56) {
                if (wc == 0 && fq < 2) { float* gp = gates + (size_t)row0 * 16 + 8 * fq;
#pragma unroll
                    for (int ai = 0; ai < 2; ++ai)
#pragma unroll
                        for (int m = 0; m < 4; ++m) { *(f32x4*)(gp + (size_t)(ai * HALF + m * 16) * 16) = acc[ai][bj][m][0]; *(f32x4*)(gp + (size_t)(ai * HALF + m * 16) * 16 + 4) = acc[ai][bj][m][1]; } }
            }
        }
    }
};
struct EpiRes {
    static constexpr bool PERM = true, AFTER_DRAIN = false;
    const float* base; float* out; const float* gvec;
    __device__ __forceinline__ void operator()(const f32x4 (&acc)[2][2][4][2], const Unit& u, int wr, int wc, int fr, int fq) const {
        const int row0 = u.pm * BM + wr * 64 + fr; const int b = (u.pm * BM) / SEQ; const float* gv = gvec + (size_t)b * NMOD;
#pragma unroll
        for (int bj = 0; bj < 2; ++bj) { const int c = u.pn * BM + bj * HALF + wc * 32 + 8 * fq;
            const f32x4 g0 = *(const f32x4*)(gv + c), g1 = *(const f32x4*)(gv + c + 4);
#pragma unroll
            for (int ai = 0; ai < 2; ++ai)
#pragma unroll
                for (int m = 0; m < 4; ++m) { const size_t off = (size_t)(row0 + ai * HALF + m * 16) * DM + c;
                    const f32x4 x0 = *(const f32x4*)(base + off), x1 = *(const f32x4*)(base + off + 4);
                    *(f32x4*)(out + off) = x0 + g0 * acc[ai][bj][m][0]; *(f32x4*)(out + off + 4) = x1 + g1 * acc[ai][bj][m][1]; } }
    }
};
struct EpiRelu2 {
    static constexpr bool PERM = true, AFTER_DRAIN = false;
    bf16_t* O; int ldc;
    __device__ __forceinline__ void operator()(const f32x4 (&acc)[2][2][4][2], const Unit& u, int wr, int wc, int fr, int fq) const {
        const int row0 = u.pm * BM + wr * 64 + fr;
#pragma unroll
        for (int bj = 0; bj < 2; ++bj) { bf16_t* base = O + (size_t)row0 * ldc + u.pn * BM + bj * HALF + wc * 32 + 8 * fq;
#pragma unroll
            for (int ai = 0; ai < 2; ++ai)
#pragma unroll
                for (int m = 0; m < 4; ++m) { f32x4 v0 = acc[ai][bj][m][0], v1 = acc[ai][bj][m][1];
#pragma unroll
                    for (int i = 0; i < 4; ++i) { const float a = v0[i] > 0.f ? v0[i] : 0.f, b = v1[i] > 0.f ? v1[i] : 0.f; v0[i] = a * a; v1[i] = b * b; }
                    u32x4 w; w.x = cvt_pk_c(v0[0], v0[1]); w.y = cvt_pk_c(v0[2], v0[3]); w.z = cvt_pk_c(v1[0], v1[1]); w.w = cvt_pk_c(v1[2], v1[3]);
                    *(u32x4*)(base + (size_t)(ai * HALF + m * 16) * ldc) = w; } }
    }
};

template <class Epi, class Sched, bool ALIGN_EPI = false, bool SP2 = false>
__device__ __forceinline__ void gemm_phase(PG8_LAS unsigned char* lds, const Gemm g, const Sched& S, const Epi& E) {
    const int tid = lz_tid(), wid = __builtin_amdgcn_readfirstlane(tid >> 6), lane = tid & 63, wr = wid >> 2, wc = wid & 3, fr = lane & 15, fq = lane >> 4;
    const int K = g.K, nt = K / BK;
    unsigned voffA[2], voffB[2];
#pragma unroll
    for (int i = 0; i < 2; ++i) { int R, C; stage_rc(tid * 16 + i * 8192, R, C); const int Rb = Epi::PERM ? ((R & ~31) + perm32(R & 31)) : R;
        voffA[i] = (unsigned)(R * K + C) * 2u; voffB[i] = (unsigned)(Rb * K + C) * 2u; }
    const size_t kstep = (size_t)(BK * 2);
    const size_t hstep = (size_t)HALF * K * 2;
    const size_t tstep = 2 * hstep;
    const unsigned ldsw = (unsigned)wid * 1024u;
    const int aoff = lds_byte(wr * 64 + fr, fq * 8), boff = lds_byte(wc * 32 + fr, fq * 8);
#define PG8_SA(b, h) (((b) * 2 + (h)) * HTB)
#define PG8_SB(b, h) ((4 + (b) * 2 + (h)) * HTB)
#define PG8_STAGE(bufoff, gbase, voff) do { _Pragma("unroll") for (int _i = 0; _i < 2; ++_i) \
        __builtin_amdgcn_global_load_lds((const unsigned*)((const char*)(gbase) + (voff)[_i]), (PG8_LAS unsigned*)(lds + (bufoff) + ldsw + _i * 8192), 16, 0, 0); } while (0)
#define PG8_LDA(dst, b, h) do { _Pragma("unroll") for (int m = 0; m < 4; ++m) _Pragma("unroll") for (int k = 0; k < 2; ++k) dst[m][k] = *(const PG8_LAS bf16x8*)(lds + PG8_SA(b, h) + aoff + m * 2048 + k * 1024); } while (0)
#define PG8_LDB(dst, b, h) do { _Pragma("unroll") for (int n = 0; n < 2; ++n) _Pragma("unroll") for (int k = 0; k < 2; ++k) dst[n][k] = *(const PG8_LAS bf16x8*)(lds + PG8_SB(b, h) + boff + n * 2048 + k * 1024); } while (0)
#define PG8_MMA(ai, bj, At, Bt) do { __builtin_amdgcn_s_setprio(1); _Pragma("unroll") for (int m = 0; m < 4; ++m) _Pragma("unroll") for (int n = 0; n < 2; ++n) _Pragma("unroll") for (int k = 0; k < 2; ++k) \
        acc[ai][bj][m][n] = __builtin_amdgcn_mfma_f32_16x16x32_bf16(Bt[n][k], At[m][k], acc[ai][bj][m][n], 0, 0, 0); __builtin_amdgcn_s_setprio(0); } while (0)
#define PG8_WAIT_V(n) asm volatile("s_waitcnt vmcnt(" #n ")" ::: "memory")
#define PG8_WAIT_L(n) asm volatile("s_waitcnt lgkmcnt(" #n ")" ::: "memory")
#define PG8_BAR __builtin_amdgcn_s_barrier()
#define PG8_SCHED __builtin_amdgcn_sched_barrier(0)
    Unit cur, nxt; int ui = 0;
    if (!S.next(0, cur)) return;
    f32x4 acc[2][2][4][2];
#pragma unroll
    for (int a = 0; a < 2; ++a)
#pragma unroll
        for (int b = 0; b < 2; ++b)
#pragma unroll
            for (int m = 0; m < 4; ++m)
#pragma unroll
                for (int n = 0; n < 2; ++n) acc[a][b][m][n] = (f32x4){0.f, 0.f, 0.f, 0.f};
    bf16x8 At[4][2], B0[2][2], B1[2][2];
    const char* cA = (const char*)g.A + (size_t)cur.pm * tstep; const char* cB = (const char*)g.Bt + (size_t)cur.pn * tstep;
    S.a_ready(cur);
    if constexpr (SP2) {
        PG8_STAGE(PG8_SB(0, 0), cB, voffB); PG8_STAGE(PG8_SB(0, 1), cB + hstep, voffB); PG8_STAGE(PG8_SA(0, 0), cA, voffA); PG8_STAGE(PG8_SA(0, 1), cA + hstep, voffA);
        if (wr == 1) PG8_BAR;
        PG8_WAIT_V(2); PG8_BAR;
        PG8_STAGE(PG8_SB(1, 0), cB + kstep, voffB); PG8_STAGE(PG8_SA(1, 0), cA + kstep, voffA); PG8_STAGE(PG8_SB(1, 1), cB + hstep + kstep, voffB);
        PG8_WAIT_V(6); PG8_BAR;
    } else {
        PG8_STAGE(PG8_SB(0, 0), cB, voffB); PG8_STAGE(PG8_SA(0, 0), cA, voffA); PG8_STAGE(PG8_SB(0, 1), cB + hstep, voffB); PG8_STAGE(PG8_SA(0, 1), cA + hstep, voffA);
        if (wr == 1) PG8_BAR;
        PG8_WAIT_V(4); PG8_BAR;
        PG8_STAGE(PG8_SB(1, 0), cB + kstep, voffB); PG8_STAGE(PG8_SA(1, 0), cA + kstep, voffA); PG8_STAGE(PG8_SB(1, 1), cB + hstep + kstep, voffB);
        PG8_WAIT_V(6); PG8_BAR;
    }
    for (;;) {
        const bool has_next = S.next(ui + 1, nxt);
        const char* nA = has_next ? (const char*)g.A + (size_t)nxt.pm * tstep : cA; const char* nB = has_next ? (const char*)g.Bt + (size_t)nxt.pn * tstep : cB;
        for (int t = 0; t < nt; t += 2) {
            const bool last = (t == nt - 2);
            const char* a1 = cA + (size_t)(t + 1) * kstep;
            const char* a2 = last ? nA : cA + (size_t)(t + 2) * kstep; const char* b2 = last ? nB : cB + (size_t)(t + 2) * kstep;
            const char* a3 = a2 + kstep; const char* b3 = b2 + kstep;
            if (last && has_next) S.a_ready(nxt);
            if constexpr (SP2) {
            PG8_LDB(B0, 0, 0); PG8_LDB(B1, 0, 1); PG8_SCHED; PG8_LDA(At, 0, 0); PG8_STAGE(PG8_SA(1, 1), a1 + hstep, voffA);
            PG8_WAIT_V(8); PG8_WAIT_L(0); PG8_BAR; PG8_MMA(0, 0, At, B0); PG8_MMA(0, 1, At, B1); PG8_BAR; PG8_SCHED;
            PG8_LDA(At, 0, 1); PG8_STAGE(PG8_SB(0, 0), b2, voffB); PG8_STAGE(PG8_SB(0, 1), b2 + hstep, voffB); PG8_STAGE(PG8_SA(0, 0), a2, voffA);
            PG8_WAIT_V(8); PG8_WAIT_L(0); PG8_BAR; PG8_MMA(1, 0, At, B0); PG8_MMA(1, 1, At, B1); PG8_BAR; PG8_SCHED;
            PG8_LDB(B0, 1, 0); PG8_LDB(B1, 1, 1); PG8_SCHED; PG8_LDA(At, 1, 0); PG8_STAGE(PG8_SA(0, 1), a2 + hstep, voffA);
            PG8_WAIT_V(8); PG8_WAIT_L(0); PG8_BAR; PG8_MMA(0, 0, At, B0); PG8_MMA(0, 1, At, B1); PG8_BAR; PG8_SCHED;
            PG8_LDA(At, 1, 1); PG8_STAGE(PG8_SB(1, 0), b3, voffB); PG8_STAGE(PG8_SB(1, 1), b3 + hstep, voffB); PG8_STAGE(PG8_SA(1, 0), a3, voffA);
            PG8_WAIT_V(8); PG8_WAIT_L(0); PG8_BAR; PG8_MMA(1, 0, At, B0); PG8_MMA(1, 1, At, B1); PG8_BAR; PG8_SCHED;
            } else {
            PG8_LDB(B0, 0, 0); PG8_SCHED; PG8_LDA(At, 0, 0); PG8_STAGE(PG8_SA(1, 1), a1 + hstep, voffA);
            PG8_WAIT_L(8); PG8_BAR; PG8_WAIT_L(0); PG8_MMA(0, 0, At, B0); PG8_BAR; PG8_SCHED;
            PG8_LDB(B1, 0, 1); PG8_STAGE(PG8_SB(0, 0), b2, voffB);
            PG8_BAR; PG8_WAIT_L(0); PG8_MMA(0, 1, At, B1); PG8_BAR;
            PG8_LDA(At, 0, 1); PG8_STAGE(PG8_SA(0, 0), a2, voffA);
            PG8_BAR; PG8_WAIT_L(0); PG8_MMA(1, 0, At, B0); PG8_BAR; PG8_SCHED;
            PG8_STAGE(PG8_SB(0, 1), b2 + hstep, voffB);
            PG8_WAIT_V(6); PG8_BAR; PG8_MMA(1, 1, At, B1); PG8_BAR;
            PG8_LDB(B0, 1, 0); PG8_SCHED; PG8_LDA(At, 1, 0); PG8_STAGE(PG8_SA(0, 1), a2 + hstep, voffA);
            PG8_WAIT_L(8); PG8_BAR; PG8_WAIT_L(0); PG8_MMA(0, 0, At, B0); PG8_BAR; PG8_SCHED;
            PG8_LDB(B1, 1, 1); PG8_STAGE(PG8_SB(1, 0), b3, voffB);
            PG8_BAR; PG8_WAIT_L(0); PG8_MMA(0, 1, At, B1); PG8_BAR;
            PG8_LDA(At, 1, 1); PG8_STAGE(PG8_SA(1, 0), a3, voffA);
            PG8_BAR; PG8_WAIT_L(0); PG8_MMA(1, 0, At, B0); PG8_BAR; PG8_SCHED;
            PG8_STAGE(PG8_SB(1, 1), b3 + hstep, voffB);
            PG8_WAIT_V(6); PG8_BAR; PG8_MMA(1, 1, At, B1); PG8_BAR;
            }
        }
        if constexpr (ALIGN_EPI) { if (wr == 0) PG8_BAR; }
        if constexpr (!Epi::AFTER_DRAIN) { E(acc, cur, wr, wc, fr, fq); S.done(cur); }
        if (!has_next) break;
#pragma unroll
        for (int a = 0; a < 2; ++a)
#pragma unroll
            for (int b = 0; b < 2; ++b)
#pragma unroll
                for (int m = 0; m < 4; ++m)
#pragma unroll
                    for (int n = 0; n < 2; ++n) acc[a][b][m][n] = (f32x4){0.f, 0.f, 0.f, 0.f};
        cur = nxt; cA = nA; cB = nB; ++ui;
        if constexpr (ALIGN_EPI) { if (wr == 1) PG8_BAR; }
    }
    PG8_WAIT_V(0);
    if constexpr (!ALIGN_EPI) { if (wr == 0) PG8_BAR; }
    PG8_BAR;
    if constexpr (Epi::AFTER_DRAIN) { E.fused(acc, cur, wr, wc, fr, fq, lds, wid, lane); S.done(cur); }
#undef PG8_SA
#undef PG8_SB
#undef PG8_STAGE
#undef PG8_LDA
#undef PG8_LDB
#undef PG8_MMA
#undef PG8_WAIT_V
#undef PG8_WAIT_L
#undef PG8_BAR
#undef PG8_SCHED
}
}
namespace fox {
constexpr int D = 128; constexpr float THR = 8.f; constexpr bool WSKIP = false; constexpr int OSTR = 2048;
constexpr float SCALE = 0.08838834764831845f;
constexpr int NW = 8, QBLK = 32, KVBLK = 64, QB = NW * QBLK;
constexpr int SHM_V = KVBLK * D * 2, SHM_K = KVBLK * D * 2;
constexpr int LDS_CB = 2 * SHM_V + 2 * SHM_K + NW * 64 * 4; constexpr int LDS_BYTES = LDS_CB + 2 * 64 * 4;

using bf16 = __hip_bfloat16;
typedef short bf16x8 __attribute__((ext_vector_type(8)));
typedef short s16x4 __attribute__((ext_vector_type(4)));
typedef float f32x16 __attribute__((ext_vector_type(16)));
typedef float f32x4 __attribute__((ext_vector_type(4)));
typedef unsigned u32x4 __attribute__((ext_vector_type(4)));
template <class A, class Bt> struct same_t { static constexpr bool v = false; };
template <class A> struct same_t<A, A> { static constexpr bool v = true; };

#define KSWZ(row, colB) ((row) * 256 + ((colB) ^ (((row) & 7) << 4)))
#define SBAR() __builtin_amdgcn_sched_barrier(0)
__device__ __forceinline__ int v_st(int k, int c) { const int kk = (k & ~0xC) | ((k & 4) << 1) | ((k & 8) >> 1); return ((kk >> 3) * 4 + (c >> 5)) * 512 + ((kk & 7) * 32 + (c & 31)) * 2; }
__device__ __forceinline__ int v_rd_base(int lane) { return ((lane & 3) << 3) | (((lane >> 2) & 3) << 6) | (((lane >> 4) & 1) << 5) | (((lane >> 5) & 1) << 8); }
constexpr int v_rd_off(int d0, int ks, int half) { return d0 * 512 + ks * 4096 + half * 2048; }
__device__ __forceinline__ int crow(int r, int hi) { return (r & 3) + 8 * (r >> 2) + 4 * hi; }
__device__ __forceinline__ unsigned cvtpk(float lo, float hi) {
    unsigned r; asm volatile("v_cvt_pk_bf16_f32 %0, %1, %2" : "=v"(r) : "v"(lo), "v"(hi)); return r;
}
__device__ __forceinline__ bf16x8 pack8(f32x4 a, f32x4 b) {
    u32x4 w = {cvtpk(a[0], a[1]), cvtpk(a[2], a[3]), cvtpk(b[0], b[1]), cvtpk(b[2], b[3])};
    return *reinterpret_cast<bf16x8*>(&w);
}
template <class T> __device__ __forceinline__ bf16x8 load8(const T* p) {
    if constexpr (same_t<T, float>::v) { return pack8(*(const f32x4*)p, *(const f32x4*)(p + 4)); }
    else { return *reinterpret_cast<const bf16x8*>(p); }
}
__device__ __forceinline__ void mask_tile(f32x16& p0, f32x16& p1, int dq, unsigned W) {
    const float NEG = -__builtin_inff();
#pragma unroll
    for (int r = 0; r < 16; ++r) {
        const int c = (r & 3) + 8 * (r >> 2);
        if ((unsigned)(dq - c) >= W) p0[r] = NEG;
        if ((unsigned)(dq - c - 32) >= W) p1[r] = NEG;
    }
}
__device__ __forceinline__ void partialSM(f32x16& p0, f32x16& p1, float& m_reg, float& mn, float& alpha) {
    float pmax = p0[0]; for (int r = 1; r < 16; ++r) pmax = fmaxf(pmax, p0[r]); for (int r = 0; r < 16; ++r) pmax = fmaxf(pmax, p1[r]);
    { auto rr = __builtin_amdgcn_permlane32_swap(__float_as_uint(pmax), __float_as_uint(pmax), false, false);
      pmax = fmaxf(__uint_as_float(rr[0]), __uint_as_float(rr[1])); }
    constexpr float C2 = 1.4426950408889634f * SCALE;
    if (__builtin_expect(__all((pmax - m_reg) * SCALE <= THR), 1)) { mn = m_reg; alpha = 1.f; }
    else { mn = fmaxf(m_reg, pmax); alpha = __builtin_amdgcn_exp2f((m_reg - mn) * C2); m_reg = mn; }
    const float mnL = -mn * C2;
    for (int r = 0; r < 16; ++r) p0[r] = fmaf(p0[r], C2, mnL); for (int r = 0; r < 16; ++r) p1[r] = fmaf(p1[r], C2, mnL);
    for (int r = 0; r < 16; ++r) p0[r] = __builtin_amdgcn_exp2f(p0[r]);
}
__device__ __forceinline__ void finishSM(f32x16& p0, f32x16& p1, float alpha, float& l_reg, bf16x8& pa0, bf16x8& pa1, bf16x8& pa2, bf16x8& pa3) {
    for (int r = 0; r < 16; ++r) p1[r] = __builtin_amdgcn_exp2f(p1[r]);
    float ps = 0; for (int r = 0; r < 16; ++r) ps += p0[r]; for (int r = 0; r < 16; ++r) ps += p1[r];
    { auto rr = __builtin_amdgcn_permlane32_swap(__float_as_uint(ps), __float_as_uint(ps), false, false);
      ps = __uint_as_float(rr[0]) + __uint_as_float(rr[1]); }
    l_reg = l_reg * alpha + ps;
#define PK4(P, B_, OUT) do { unsigned a0 = cvtpk(P[B_+0], P[B_+1]), a1 = cvtpk(P[B_+2], P[B_+3]);                          \
        unsigned b0 = cvtpk(P[B_+4], P[B_+5]), b1 = cvtpk(P[B_+6], P[B_+7]);                                             \
        auto r0 = __builtin_amdgcn_permlane32_swap(a0, b0, false, false); auto r1 = __builtin_amdgcn_permlane32_swap(a1, b1, false, false); \
        u32x4 w = {r0[0], r1[0], r0[1], r1[1]}; OUT = *reinterpret_cast<bf16x8*>(&w); } while (0)
    PK4(p0, 0, pa0); PK4(p0, 8, pa1); PK4(p1, 0, pa2); PK4(p1, 8, pa3);
#undef PK4
}
template <int KB, bool SK>
__device__ __forceinline__ void qkt(f32x16& p0, f32x16& p1, const char* K_lds, const float* cb, int r32, int hi, const bf16x8* qr, bool act) {
    if (SK && !act) { const float NEG = -__builtin_inff();
#pragma unroll
        for (int r = 0; r < 16; ++r) { p0[r] = NEG; p1[r] = NEG; } return; }
    { const float* cbp = cb + KB * 64 + 4 * hi;
#pragma unroll
      for (int g = 0; g < 4; ++g) { const f32x4 t0 = *(const f32x4*)(cbp + 8 * g), t1 = *(const f32x4*)(cbp + 32 + 8 * g);
        p0[4*g] = t0[0]; p0[4*g+1] = t0[1]; p0[4*g+2] = t0[2]; p0[4*g+3] = t0[3]; p1[4*g] = t1[0]; p1[4*g+1] = t1[1]; p1[4*g+2] = t1[2]; p1[4*g+3] = t1[3]; } }
    const char* kb[4];
#pragma unroll
    for (int dd = 0; dd < 4; ++dd) kb[dd] = K_lds + KB * SHM_K + KSWZ(r32, (dd * 16 + hi * 8) * 2);
#pragma unroll
    for (int d0 = 0; d0 < 8; ++d0) { const char* a = kb[d0 & 3] + (d0 >> 2) * 128;
        bf16x8 b0 = *reinterpret_cast<const bf16x8*>(a);
        bf16x8 b1 = *reinterpret_cast<const bf16x8*>(a + 32 * 256);
        p0 = __builtin_amdgcn_mfma_f32_32x32x16_bf16(b0, qr[d0], p0, 0, 0, 0);
        p1 = __builtin_amdgcn_mfma_f32_32x32x16_bf16(b1, qr[d0], p1, 0, 0, 0); }
}
template <int VB, bool SK>
__device__ __forceinline__ void pv_tile(f32x16* o, int vb0, bf16x8 pa0, bf16x8 pa1, bf16x8 pa2, bf16x8 pa3, bool act) {
    if (SK && !act) return;
#define TRRD(dst, off) asm volatile("ds_read_b64_tr_b16 %0, %1 offset:%2" : "=&v"(dst) : "v"(vb0), "i"(off) : "memory")
#define PV_D0(d0) do { s16x4 l0, l1, l2, l3, h0, h1, h2, h3; constexpr int b_ = VB * SHM_V + v_rd_off(d0, 0, 0);     \
        TRRD(l0, b_); TRRD(h0, b_ + 2048); TRRD(l1, b_ + 4096); TRRD(h1, b_ + 6144); TRRD(l2, b_ + 8192); TRRD(h2, b_ + 10240); TRRD(l3, b_ + 12288); TRRD(h3, b_ + 14336); \
        asm volatile("s_waitcnt lgkmcnt(0)" ::: "memory"); SBAR();                 \
        o[d0] = __builtin_amdgcn_mfma_f32_32x32x16_bf16(pa0, (bf16x8){l0[0], l0[1], l0[2], l0[3], h0[0], h0[1], h0[2], h0[3]}, o[d0], 0, 0, 0);   \
        o[d0] = __builtin_amdgcn_mfma_f32_32x32x16_bf16(pa1, (bf16x8){l1[0], l1[1], l1[2], l1[3], h1[0], h1[1], h1[2], h1[3]}, o[d0], 0, 0, 0);   \
        o[d0] = __builtin_amdgcn_mfma_f32_32x32x16_bf16(pa2, (bf16x8){l2[0], l2[1], l2[2], l2[3], h2[0], h2[1], h2[2], h2[3]}, o[d0], 0, 0, 0);   \
        o[d0] = __builtin_amdgcn_mfma_f32_32x32x16_bf16(pa3, (bf16x8){l3[0], l3[1], l3[2], l3[3], h3[0], h3[1], h3[2], h3[3]}, o[d0], 0, 0, 0); } while (0)
    PV_D0(0); PV_D0(1); PV_D0(2); PV_D0(3);
#undef PV_D0
#undef TRRD
}

template <class TIn, class TOut> struct BlockRef { const TIn* Q; TOut* O; const float* MS; unsigned K, V, C; int P0; int JLO; };
__device__ __forceinline__ bf16x8 bl128(__amdgpu_buffer_rsrc_t rs, unsigned vo, unsigned so) { return __builtin_bit_cast(bf16x8, __builtin_amdgcn_raw_buffer_load_b128(rs, (int)vo, (int)so, 0)); }
__device__ __forceinline__ float bl32(__amdgpu_buffer_rsrc_t rs, unsigned vo, unsigned so) { return __builtin_bit_cast(float, __builtin_amdgcn_raw_buffer_load_b32(rs, (int)vo, (int)so, 0)); }
template <class TIn> struct Seam {
    bf16x8 qr[8];
    bf16x8 st_v0, st_v1, st_k0, st_k1; f32x4 sf0, sf1, sf2, sf3; float st_c;
    f32x4 tq[16];
};
__device__ __forceinline__ int swa_jlo(int P0, int W) { const int lowk = P0 - W + 1; return lowk > 0 ? lowk / KVBLK : 0; }
#define ROW(p, k0, rr) ((p) + (unsigned)(((k0) + (rr)) * D + sc))
#define VMW() asm volatile("s_waitcnt vmcnt(0)" ::: "memory")
#define VMWN(n) asm volatile("s_waitcnt vmcnt(%0)" :: "i"(n) : "memory")
#define SLOAD_H(Kp, Vp, Cp, k0) do { if (tid < 64) S.st_c = bl32(rs, (unsigned)tid * 4u, (Cp) + (unsigned)(k0) * 4u); \
        S.st_v0 = bl128(rs, vo_st, (Vp) + (unsigned)(k0) * 256u); S.st_v1 = bl128(rs, vo_st, (Vp) + (unsigned)(k0) * 256u + 8192u); \
        S.st_k0 = bl128(rs, vo_st, (Kp) + (unsigned)(k0) * 256u); S.st_k1 = bl128(rs, vo_st, (Kp) + (unsigned)(k0) * 256u + 8192u); } while (0)
#define SWRITE_HK(bf) do { if (tid < 64) cb_l[(bf) * 64 + tid] = S.st_c;  *(bf16x8*)(K_lds + (bf) * SHM_K + kws) = S.st_k0; *(bf16x8*)(K_lds + (bf) * SHM_K + kws + 32 * 256) = S.st_k1; } while (0)
#define SWRITE_HV(bf) do { *(bf16x8*)(V_lds + (bf) * SHM_V + vst0) = S.st_v0; *(bf16x8*)(V_lds + (bf) * SHM_V + vst1) = S.st_v1; } while (0)
#define SWRITE_H(bf) do { SWRITE_HV(bf); SWRITE_HK(bf); } while (0)
#define SLOAD_F(p, k0) do { S.sf0 = *(const f32x4*)ROW(p, k0, sr); S.sf1 = *(const f32x4*)(ROW(p, k0, sr) + 4);                \
                            S.sf2 = *(const f32x4*)ROW(p, k0, 32 + sr); S.sf3 = *(const f32x4*)(ROW(p, k0, 32 + sr) + 4); } while (0)
#define SWRITE_KF(bf) do { *(bf16x8*)(K_lds + (bf) * SHM_K + kws) = pack8(S.sf0, S.sf1); *(bf16x8*)(K_lds + (bf) * SHM_K + kws + 32 * 256) = pack8(S.sf2, S.sf3); } while (0)
#define SWRITE_VF(bf) do { *(bf16x8*)(V_lds + (bf) * SHM_V + vst0) = pack8(S.sf0, S.sf1); *(bf16x8*)(V_lds + (bf) * SHM_V + vst1) = pack8(S.sf2, S.sf3); } while (0)
template <class TIn, class TOut>
__device__ __forceinline__ void causal_swa_prime(const BlockRef<TIn, TOut>& cur, int W, char* lds, Seam<TIn>& S, __amdgpu_buffer_rsrc_t rs) {
    constexpr bool F32 = same_t<TIn, float>::v;
    const int tid = lz_tid(), wid = __builtin_amdgcn_readfirstlane(tid >> 6), lane = tid & 63, r32 = lane & 31, hi = lane >> 5;
    const int sr = tid >> 4, sc = (tid & 15) * 8, kws = KSWZ(sr, sc * 2); char* K_lds = lds + 2 * SHM_V; float* cb_l = (float*)(lds + LDS_CB); const unsigned vo_st = (unsigned)(sr * D + sc) * 2u;
    const int kb0 = swa_jlo(cur.P0, W) * KVBLK;
    for (int d0 = 0; d0 < 8; ++d0) S.qr[d0] = load8<TIn>(cur.Q + (unsigned)((wid * QBLK + r32) * D + d0 * 16 + hi * 8));
    if constexpr (F32) { SLOAD_F((const float*)cur.K, kb0); VMW(); SWRITE_KF(0); SBAR(); SLOAD_F((const float*)cur.V, kb0); }
    else { SLOAD_H(cur.K, cur.V, cur.C, kb0); VMW(); SWRITE_HK(0); }
    __syncthreads();
}
template <class TIn, class TOut>
__device__ __forceinline__ void causal_swa_block(const BlockRef<TIn, TOut>& cur, const BlockRef<TIn, TOut>& nxt, int skv, int W, char* lds, Seam<TIn>& S, __amdgpu_buffer_rsrc_t rs) {
    constexpr bool F32 = same_t<TIn, float>::v;
    const int tid = lz_tid(), wid = __builtin_amdgcn_readfirstlane(tid >> 6), lane = tid & 63, r32 = lane & 31, hi = lane >> 5;
    const int j_lo = swa_jlo(cur.P0, W);
    int j_hi = (cur.P0 + QB - 1) / KVBLK + 1; if (j_hi > skv / KVBLK) j_hi = skv / KVBLK;
    const int NT = j_hi - j_lo;
    const int kbn = swa_jlo(nxt.P0, W) * KVBLK;
    const int qlo = cur.P0 + wid * QBLK, qm = qlo + r32 - 4 * hi;
    char* V_lds = lds; char* K_lds = lds + 2 * SHM_V; float* cb_l = (float*)(lds + LDS_CB);
    float* ws = (float*)(lds + 2 * SHM_V + 2 * SHM_K) + wid * 64; float* li_l = ws, * al_l = ws + 32;
    float m_reg = -1e30f, l_reg = 0; f32x16 o[4] = {};
    const unsigned vo_st = (unsigned)((tid >> 4) * D + (tid & 15) * 8) * 2u; const int sr = tid >> 4, sc = (tid & 15) * 8, vst0 = v_st(sr, sc), vst1 = v_st(32 + sr, sc), kws = KSWZ(sr, sc * 2);
    const int vb0 = (int)(uintptr_t)V_lds + v_rd_base(lane);
    const unsigned Kh = cur.K, Vh = cur.V, Ch = cur.C;
#define RESC(a) do { if (__any((a) < 1.f)) { if (hi == 0) al_l[r32] = (a); asm volatile("s_waitcnt lgkmcnt(0)" ::: "memory");              \
                     for (int d_ = 0; d_ < 4; ++d_) for (int r = 0; r < 16; ++r) o[d_][r] *= al_l[crow(r, hi)]; } } while (0)
#define KBASE(t) ((j_lo + (t)) * KVBLK)
#define ACT(t) (KBASE(t) <= qlo + QBLK - 1 && KBASE(t) + KVBLK - 1 >= qlo - W + 1)
#define MASKT(P0_, P1_, t) do { const int kb_ = KBASE(t); if ((!SK || ACT(t)) && (kb_ + KVBLK - 1 > qlo || kb_ <= qlo + QBLK - 1 - W)) mask_tile(P0_, P1_, qm - kb_, (unsigned)W); } while (0)
    constexpr int NQL = F32 ? 16 : 8;
    constexpr bool SK = WSKIP && !F32;
#define SEAM_K0() do { VMWN(NQL); if constexpr (F32) { SWRITE_KF(0); SBAR(); SLOAD_F((const float*)nxt.V, kbn); } else { SWRITE_HK(0); } SBAR(); } while (0)
    f32x16 pA0, pA1, pB0, pB1; float mnA, mnB, alA, alB; bf16x8 pa0, pa1, pa2, pa3;
    if constexpr (F32) { VMW(); SWRITE_VF(0); SBAR(); } else { SWRITE_HV(0); SBAR(); }
    if (NT > 1) { if constexpr (F32) SLOAD_F((const float*)Kh, KBASE(1)); else SLOAD_H(Kh, Vh, Ch, KBASE(1)); }
    SBAR(); qkt<0, SK>(pA0, pA1, K_lds, cb_l, r32, hi, S.qr, ACT(0));
    if constexpr (F32) { if (NT > 1) { VMW(); SWRITE_KF(1); SBAR(); SLOAD_F((const float*)Vh, KBASE(1)); } }
    MASKT(pA0, pA1, 0); partialSM(pA0, pA1, m_reg, mnA, alA);
    if (NT > 1) { VMW(); if constexpr (F32) { SWRITE_VF(1); SBAR(); if (NT > 2) SLOAD_F((const float*)Kh, KBASE(2)); } else SWRITE_H(1); }
    __syncthreads();
#define HALF_STEP(PX0, PX1, mnX, alX, PY0, PY1, alY, t, KB, VB, SB) do {                                                      \
        SBAR(); qkt<KB, SK>(PX0, PX1, K_lds, cb_l, r32, hi, S.qr, ACT(t));                                             \
        finishSM(PY0, PY1, alY, l_reg, pa0, pa1, pa2, pa3); SBAR();                                                           \
        if ((t) + 1 < NT) { if constexpr (F32) { VMW(); SWRITE_KF(SB); SBAR(); SLOAD_F((const float*)Vh, KBASE((t) + 1)); }  \
                            else { SLOAD_H(Kh, Vh, Ch, KBASE((t) + 1)); } SBAR(); }                                               \
        pv_tile<VB, SK>(o, vb0, pa0, pa1, pa2, pa3, ACT((t) - 1)); MASKT(PX0, PX1, (t)); partialSM(PX0, PX1, m_reg, mnX, alX);                                        \
        __syncthreads();                                                                                                      \
        if ((t) + 1 < NT) { VMW(); if constexpr (F32) { SWRITE_VF(SB); SBAR(); if ((t) + 2 < NT) SLOAD_F((const float*)Kh, KBASE((t) + 2)); } \
                            else { SWRITE_H(SB); } }                                                                          \
        RESC(alX); __syncthreads(); } while (0)
    for (int t = 1; t + 1 < NT; t += 2) {
        HALF_STEP(pB0, pB1, mnB, alB, pA0, pA1, alA, t, 1, 0, 0);
        HALF_STEP(pA0, pA1, mnA, alA, pB0, pB1, alB, t + 1, 0, 1, 1);
    }
    const bool even = (NT & 1) == 0;
    if (even) { SBAR(); qkt<1, SK>(pB0, pB1, K_lds, cb_l, r32, hi, S.qr, ACT(NT - 1)); SBAR(); }
#define QROW(e) (nxt.Q + (size_t)(wid * QBLK + r32) * D + ((e) >> 1) * 16 + hi * 8 + ((e) & 1) * 4)
    if constexpr (F32) { SLOAD_F((const float*)nxt.K, kbn); SBAR();
#pragma unroll
        for (int e = 0; e < 8; ++e) S.tq[e] = *(const f32x4*)QROW(e); }
    else { SLOAD_H(nxt.K, nxt.V, nxt.C, kbn); SBAR();
#pragma unroll
        for (int d0 = 0; d0 < 8; ++d0) S.qr[d0] = load8<TIn>(nxt.Q + (unsigned)((wid * QBLK + r32) * D + d0 * 16 + hi * 8)); }
    SBAR();
    finishSM(pA0, pA1, alA, l_reg, pa0, pa1, pa2, pa3); SBAR();
    if constexpr (F32) {
#pragma unroll
        for (int e = 8; e < 16; ++e) S.tq[e] = *(const f32x4*)QROW(e); SBAR(); }
#undef QROW
    pv_tile<0, SK>(o, vb0, pa0, pa1, pa2, pa3, ACT(even ? NT - 2 : NT - 1));
    if (even) { MASKT(pB0, pB1, NT - 1); partialSM(pB0, pB1, m_reg, mnB, alB); __syncthreads(); RESC(alB);
        finishSM(pB0, pB1, alB, l_reg, pa0, pa1, pa2, pa3); SBAR(); pv_tile<1, SK>(o, vb0, pa0, pa1, pa2, pa3, ACT(NT - 1)); }
    SBAR(); SEAM_K0();
    if (hi == 0) li_l[r32] = l_reg; asm volatile("s_waitcnt lgkmcnt(0)" ::: "memory");
    float rli[16];
#pragma unroll
    for (int r = 0; r < 16; ++r) rli[r] = __builtin_amdgcn_rcpf(li_l[crow(r, hi)]);
    TOut* Ow = cur.O + (size_t)(wid * QBLK) * OSTR;
    { float msv[4];
#pragma unroll
      for (int d0 = 0; d0 < 4; ++d0) msv[d0] = cur.MS[d0 * 32 + r32];
#pragma unroll
      for (int r = 0; r < 16; ++r) { const int orow = crow(r, hi);
        float v0 = o[0][r] * rli[r], v1 = o[1][r] * rli[r], v2 = o[2][r] * rli[r], v3 = o[3][r] * rli[r];
        float sm = (v0 + v1) + (v2 + v3);
#pragma unroll
        for (int off = 1; off < 32; off <<= 1) sm += __shfl_xor(sm, off);
        const float mu = sm * (1.0f / 128.0f);
        v0 -= mu; v1 -= mu; v2 -= mu; v3 -= mu;
        float sq = (v0 * v0 + v1 * v1) + (v2 * v2 + v3 * v3);
#pragma unroll
        for (int off = 1; off < 32; off <<= 1) sq += __shfl_xor(sq, off);
        const float rstd = 1.0f / sqrtf(sq * (1.0f / 128.0f) + 1e-6f);
        float vv[4] = {v0 * rstd * msv[0], v1 * rstd * msv[1], v2 * rstd * msv[2], v3 * rstd * msv[3]};
#pragma unroll
        for (int d0 = 0; d0 < 4; ++d0) { const float v = vv[d0]; const float vn = __shfl_xor(v, 1);
            if ((r32 & 1) == 0) *(unsigned*)(Ow + (unsigned)(orow * OSTR + d0 * 32 + r32)) = cvtpk(v, vn); } } }
    if constexpr (F32) {
#pragma unroll
        for (int d0 = 0; d0 < 8; ++d0) S.qr[d0] = pack8(S.tq[2 * d0], S.tq[2 * d0 + 1]); }
    __syncthreads();
#undef RESC
#undef KBASE
#undef ACT
#undef MASKT
#undef SEAM_K0
#undef HALF_STEP
}
#undef ROW
#undef VMW
#undef VMWN
#undef SLOAD_H
#undef SWRITE_HK
#undef SWRITE_HV
#undef SWRITE_H
#undef SLOAD_F
#undef SWRITE_KF
#undef SWRITE_VF
#undef SBAR
}

#define LAS __attribute__((address_space(3)))
typedef unsigned short bf16r;
typedef unsigned v4u __attribute__((ext_vector_type(4)));
typedef unsigned v2u __attribute__((ext_vector_type(2)));
typedef float v4f __attribute__((ext_vector_type(4)));
typedef float v16f __attribute__((ext_vector_type(16)));
typedef short v8s __attribute__((ext_vector_type(8)));
typedef short v4s __attribute__((ext_vector_type(4)));

#define XB_TMO      128
#define XB_XCNT(j)  (256  + 64 * (j))
#define XB_XSUB(j)  (1280 + 64 * (j))
#define XB_XGEN(j)  (2304 + 64 * (j))
#define XB_TOP      3328
#define XB_TOPGEN   3392
#define XCD_BAR_WORDS 3456
#define XB_SPIN_CAP (1u << 18)

__device__ __forceinline__ unsigned xb_ld(unsigned* p)              { return __hip_atomic_load(p, __ATOMIC_RELAXED, __HIP_MEMORY_SCOPE_AGENT); }
__device__ __forceinline__ unsigned xb_add(unsigned* p, unsigned v) { return __hip_atomic_fetch_add(p, v, __ATOMIC_RELAXED, __HIP_MEMORY_SCOPE_AGENT); }
__device__ __forceinline__ unsigned xb_xcc_id() { return (unsigned)__builtin_amdgcn_s_getreg((3 << 11) | 20) & 0xFu; }
#define XB_SPIN(cond, bar) do { unsigned _sp = 0; while (cond) { __builtin_amdgcn_s_sleep(1); \
    if ((++_sp & 255u) == 0u) { if (xb_ld(&(bar)[XB_TMO])) break; if (_sp > XB_SPIN_CAP) { atomicAdd(&(bar)[XB_TMO], 1u); break; } } } } while (0)

struct XcdBarrier {
    unsigned* bar; unsigned x;
    volatile LAS unsigned* st;
};

__device__ __forceinline__ XcdBarrier xcd_barrier_post(unsigned* bar, volatile LAS unsigned* st) {
    XcdBarrier b; b.bar = bar; b.x = xb_xcc_id(); b.st = st;
    if (lz_tid() == 0) (void)xb_add(&bar[XB_XCNT(b.x)], 1u);
    return b;
}
__device__ __forceinline__ void xcd_barrier_complete(unsigned* bar, unsigned x, unsigned& nloc, unsigned& nx) {
    const unsigned G = gridDim.x * gridDim.y * gridDim.z;
    unsigned sum, cnt, mine, sp = 0u;
    for (;;) {
        sum = 0u; cnt = 0u; mine = 0u;
#pragma unroll
        for (unsigned j = 0; j < 16; ++j) { const unsigned c = xb_ld(&bar[XB_XCNT(j)]); sum += c; cnt += (c > 0u) ? 1u : 0u; mine = (j == x) ? c : mine; }
        if (sum == G) break;
        __builtin_amdgcn_s_sleep(1);
        if ((++sp & 255u) == 0u) { if (xb_ld(&bar[XB_TMO])) break; if (sp > XB_SPIN_CAP) { atomicAdd(&bar[XB_TMO], 1u); break; } }
    }
    nloc = mine > 0u ? mine : 1u; nx = cnt > 0u ? cnt : 1u;
}

__device__ __forceinline__ void xcd_barrier(const XcdBarrier& b) {
    asm volatile("s_waitcnt vmcnt(0)" ::: "memory");
    __syncthreads();
    if (lz_tid() == 0) {
        unsigned* bar = b.bar;
        __builtin_amdgcn_s_waitcnt(0);
        unsigned nloc = b.st[0], nx = b.st[1];
        if (nloc == 0u) { xcd_barrier_complete(bar, b.x, nloc, nx); b.st[0] = nloc; b.st[1] = nx; }
        const unsigned old = xb_add(&bar[XB_XSUB(b.x)], 1u);
        const unsigned gen = old / nloc;
        if (old + 1u == (gen + 1u) * nloc) {
            __builtin_amdgcn_fence(__ATOMIC_RELEASE, "agent");
            asm volatile("s_waitcnt vmcnt(0)" ::: "memory");
            const unsigned og = xb_add(&bar[XB_TOP], 1u);
            const unsigned tg = og / nx;
            if (og + 1u == (tg + 1u) * nx) xb_add(&bar[XB_TOPGEN], 1u);
            else XB_SPIN(xb_ld(&bar[XB_TOPGEN]) == tg, bar);
            __builtin_amdgcn_fence(__ATOMIC_ACQUIRE, "agent");
            xb_add(&bar[XB_XGEN(b.x)], 1u);
            asm volatile("s_waitcnt vmcnt(0)" ::: "memory");
        } else {
            XB_SPIN(xb_ld(&bar[XB_XGEN(b.x)]) == gen, bar);
            __builtin_amdgcn_fence(__ATOMIC_ACQUIRE, "agent");
            asm volatile("s_waitcnt vmcnt(0)" ::: "memory");
        }
    }
    __syncthreads();
}

constexpr size_t MiB = 1u << 20;
constexpr size_t WS_QK2 = 14336, WS_QCTR = 15360;
constexpr size_t WS_JT = 20480;
constexpr size_t WS_WG = 1 * MiB, WG_BYTES = 32 * DM * 2;
constexpr size_t WS_MOD = 64 * 1024;
constexpr size_t WS_WIN = 2 * MiB, WIN_BYTES = (size_t)NINP * DM * 2;
constexpr size_t WS_WOUT = 60 * MiB, WOUT_BYTES = (size_t)DM * DM * 2;
constexpr size_t WS_WFF1 = 76 * MiB, WFF_BYTES = (size_t)DFF * DM * 2;
constexpr size_t WS_WFF2 = 140 * MiB;
constexpr size_t WS_H = 204 * MiB;
constexpr size_t WS_P = 332 * MiB;
constexpr size_t WS_Y = 780 * MiB;
constexpr size_t WS_HID = WS_P;
constexpr size_t WS_GATES = 908 * MiB;
constexpr size_t WS_CNEG = 910 * MiB;
constexpr size_t WS_MA = 911 * MiB, WS_MCM = WS_MA + 512 * 1024, WS_MB = WS_MCM + 512 * 1024;
constexpr size_t WS_MPREV = 913 * MiB;
constexpr size_t WS_UN = 914 * MiB;
constexpr size_t WS_MQC = 916 * MiB;
constexpr size_t WS_END = 980 * MiB;
static_assert(WS_WIN + 2 * WIN_BYTES <= WS_WOUT && WS_HID + (size_t)MROWS * DFF * 2 <= WS_Y + (size_t)MROWS * DM * 2 && WS_MQC + (size_t)8 * MROWS * 128 * 2 <= WS_END, "ws map");

constexpr int LDS_BYTES = 147456;

__device__ __forceinline__ float wave_sum(float v) {
#pragma unroll
    for (int o = 1; o < 64; o <<= 1) v += __shfl_xor(v, o);
    return v;
}
typedef float pkf2_t __attribute__((ext_vector_type(2))); typedef __bf16 pkb2_t __attribute__((ext_vector_type(2)));
__device__ __forceinline__ unsigned pk2(float lo, float hi) { pkf2_t v = {lo, hi}; pkb2_t b = __builtin_convertvector(v, pkb2_t); return __builtin_bit_cast(unsigned, b); }
__device__ __forceinline__ float bflo(unsigned w) { return __uint_as_float(w << 16); }
__device__ __forceinline__ float bfhi(unsigned w) { return __uint_as_float(w & 0xffff0000u); }
__device__ __forceinline__ float bf1(bf16r h) { return __uint_as_float((unsigned)h << 16); }
__device__ __forceinline__ float log_sigmoid(float x) { return fminf(x, 0.f) - log1pf(expf(-fabsf(x))); }
__device__ __forceinline__ float swap_add(float v) { auto rr = __builtin_amdgcn_permlane32_swap(__float_as_uint(v), __float_as_uint(v), false, false); return __uint_as_float(rr[0]) + __uint_as_float(rr[1]); }

struct Args { const void* in[18]; float* out; unsigned char* ws; int ph_lo, ph_hi; };
typedef const __attribute__((address_space(4))) Args CArgs;
__device__ __forceinline__ CArgs* fresh_args() { CArgs* p = (CArgs*)__builtin_amdgcn_kernarg_segment_ptr(); asm volatile("" : "+s"(p)); return p; }

__device__ __forceinline__ int win_src(int n) { return n < 5120 ? n : n + 8; }
__device__ __forceinline__ int wg_src(int n) { return n < 8 ? 5120 + n : (n < 16 ? 7176 + (n - 8) : -1); }
template <int MAP>
__device__ __forceinline__ void transpose_item(const float* W, int K, int N, bf16r* WT, LAS float* scr, int item, int nblk, int lane) {
    const int kb = item / nblk, nb = item % nblk, k0 = 64 * kb, n0 = 32 * nb;
    int sc = n0 + (lane & 31); if (MAP == 1) sc = win_src(sc); else if (MAP == 2) sc = wg_src(sc);
#ifdef OLD_P0
#pragma unroll 8
    for (int i = 0; i < 32; ++i) { const int kk = 2 * i + (lane >> 5); scr[kk * 33 + (lane & 31)] = sc >= 0 ? W[(size_t)(k0 + kk) * N + sc] : 0.f; }
#else
    float tv[32];
#pragma unroll
    for (int i = 0; i < 32; ++i) { const int kk = 2 * i + (lane >> 5); tv[i] = sc >= 0 ? W[(size_t)(k0 + kk) * N + sc] : 0.f; }
#pragma unroll
    for (int i = 0; i < 32; ++i) { const int kk = 2 * i + (lane >> 5); scr[kk * 33 + (lane & 31)] = tv[i]; }
#endif
    asm volatile("s_waitcnt lgkmcnt(0)" ::: "memory");
    const int c = lane & 7;
#pragma unroll
    for (int j = 0; j < 4; ++j) { const int n = (lane >> 3) + 8 * j; const LAS float* s = scr + (8 * c) * 33 + n;
        v4u o; o.x = pk2(s[0 * 33], s[1 * 33]); o.y = pk2(s[2 * 33], s[3 * 33]); o.z = pk2(s[4 * 33], s[5 * 33]); o.w = pk2(s[6 * 33], s[7 * 33]);
        *(v4u*)(WT + (size_t)(n0 + n) * K + k0 + 8 * c) = o; }
    asm volatile("s_waitcnt lgkmcnt(0)" ::: "memory");
}
__device__ __forceinline__ void p0_phase(CArgs& a, LAS unsigned char* lds) {
    const int tid = lz_tid(), lane = tid & 63, wave = tid >> 6, G = gridDim.x;
    unsigned char* ws = a.ws;
    { LAS float* cond = (LAS float*)lds; LAS float* red = (LAS float*)(lds + 16384);
      const float* c = (const float*)a.in[1]; const float* ada_w = (const float*)a.in[3]; const float* ada_b = (const float*)a.in[4]; float* MOD = (float*)(ws + WS_MOD);
      for (int i = tid; i < NB * DM; i += 512) { const float cv = c[i]; cond[i] = cv / (1.f + expf(-cv)); }
      __syncthreads();
      for (int item = lz_bid(); item < 2 * (NMOD / 64); item += G) {
          const int layer = item / (NMOD / 64), cgp = item % (NMOD / 64), col = cgp * 64 + lane, kq = wave;
          const float* W = ada_w + (size_t)layer * DM * NMOD + col;
          float a0 = 0.f, a1 = 0.f;
#ifdef OLD_P0
#pragma unroll 8
#else
#pragma unroll 32
#endif
          for (int k = kq * 256; k < kq * 256 + 256; ++k) { const float w = W[(size_t)k * NMOD]; a0 += cond[k] * w; a1 += cond[DM + k] * w; }
          red[(kq * 2 + 0) * 64 + lane] = a0; red[(kq * 2 + 1) * 64 + lane] = a1;
          __syncthreads();
          if (tid < 128) { const int b = tid >> 6; float s = 0.f;
#pragma unroll
              for (int q = 0; q < 8; ++q) s += red[(q * 2 + b) * 64 + lane];
              MOD[(size_t)(layer * NB + b) * NMOD + cgp * 64 + lane] = s + ada_b[(size_t)layer * NMOD + cgp * 64 + lane]; }
          __syncthreads();
      } }
    { LAS float* scr = (LAS float*)(lds + wave * 16384);
      const int gw = lz_bid() * 8 + wave, NGW = G * 8;
      constexpr int I_IN = (DM / 64) * (NINP / 32), I_OUT = (DM / 64) * (DM / 32), I_F1 = (DM / 64) * (DFF / 32), I_F2 = (DFF / 64) * (DM / 32), I_G = DM / 64, I_L = I_IN + I_OUT + I_F1 + I_F2 + I_G;
      for (int it = gw; it < 2 * I_L; it += NGW) {
          const int layer = it / I_L; int r = it % I_L;
          if (r < I_IN) { transpose_item<1>((const float*)a.in[7] + (size_t)layer * DM * DIN, DM, DIN, (bf16r*)(ws + WS_WIN + layer * WIN_BYTES), scr, r, NINP / 32, lane); continue; } r -= I_IN;
          if (r < I_G) { transpose_item<2>((const float*)a.in[7] + (size_t)layer * DM * DIN, DM, DIN, (bf16r*)(ws + WS_WG + layer * WG_BYTES), scr, r, 1, lane); continue; } r -= I_G;
          if (r < I_OUT) { transpose_item<0>((const float*)a.in[14] + (size_t)layer * DM * DM, DM, DM, (bf16r*)(ws + WS_WOUT + layer * WOUT_BYTES), scr, r, DM / 32, lane); continue; } r -= I_OUT;
          if (r < I_F1) { transpose_item<0>((const float*)a.in[15] + (size_t)layer * DM * DFF, DM, DFF, (bf16r*)(ws + WS_WFF1 + layer * WFF_BYTES), scr, r, DFF / 32, lane); continue; } r -= I_F1;
          transpose_item<0>((const float*)a.in[16] + (size_t)layer * DFF * DM, DFF, DM, (bf16r*)(ws + WS_WFF2 + layer * WFF_BYTES), scr, r, DM / 32, lane);
      } }
}

__device__ __forceinline__ void gate_gemm(const bf16r* H, const bf16r* WG, float* gates) {
    const int tid = lz_tid(), lane = tid & 63, wave = __builtin_amdgcn_readfirstlane(tid >> 6), r32 = lane & 31, hi = lane >> 5;
    if (wave >= 4) return;
    for (int rb = lz_bid(); rb < MROWS / 128; rb += gridDim.x) {
        const int r0 = rb * 128 + wave * 32;
        const bf16r* ap = H + (size_t)(r0 + r32) * DM + 8 * hi; const bf16r* bp = WG + (size_t)r32 * DM + 8 * hi;
        v16f acc = {};
#pragma unroll 16
        for (int ks = 0; ks < DM / 16; ++ks) { const v8s af = *(const v8s*)(ap + ks * 16), bf = *(const v8s*)(bp + ks * 16); acc = __builtin_amdgcn_mfma_f32_32x32x16_bf16(af, bf, acc, 0, 0, 0); }
        if (r32 < 16) {
#pragma unroll
            for (int r = 0; r < 16; ++r) gates[(size_t)(r0 + (r & 3) + 8 * (r >> 2) + 4 * hi) * 16 + r32] = acc[r]; }
    }
}

__device__ __forceinline__ void norm_phase(const float* x, const float* w, const float* sh, const float* sc, bf16r* H) {
    const int lane = lz_tid() & 63, gw = lz_bid() * 8 + (lz_tid() >> 6), NGW = gridDim.x * 8;
    v4f nx[8];
    if (gw < MROWS) { const v4f* xr0 = (const v4f*)(x + (size_t)gw * DM) + lane;
#pragma unroll
        for (int j = 0; j < 8; ++j) nx[j] = xr0[64 * j]; }
    for (int m = gw; m < MROWS; m += NGW) {
        const int b = m / SEQ;
        v4f v[8]; float s = 0.f;
#pragma unroll
        for (int j = 0; j < 8; ++j) v[j] = nx[j];
        if (m + NGW < MROWS) { const v4f* xr1 = (const v4f*)(x + (size_t)(m + NGW) * DM) + lane;
#pragma unroll
            for (int j = 0; j < 8; ++j) nx[j] = xr1[64 * j]; }
#pragma unroll
        for (int j = 0; j < 8; ++j) s += (v[j].x * v[j].x + v[j].y * v[j].y) + (v[j].z * v[j].z + v[j].w * v[j].w);
        const float rstd = 1.0f / sqrtf(wave_sum(s) * (1.f / DM) + NORM_EPS);
        v2u* o = (v2u*)(H + (size_t)m * DM) + lane;
#pragma unroll
        for (int j = 0; j < 8; ++j) { const int c = 4 * lane + 256 * j;
            const v4f wv = *(const v4f*)(w + c), sv = *(const v4f*)(sc + (size_t)b * NMOD + c), hv = *(const v4f*)(sh + (size_t)b * NMOD + c);
            const v4f y = v[j] * rstd * wv * (sv + 1.0f) + hv;
            v2u p; p.x = pk2(y.x, y.y); p.y = pk2(y.z, y.w); o[64 * j] = p; }
    }
}
__device__ __forceinline__ void final_norm_phase(float* x, const float* w) {
    const int lane = lz_tid() & 63, gw = lz_bid() * 8 + (lz_tid() >> 6), NGW = gridDim.x * 8;
    v4f nx[8];
    if (gw < MROWS) { const v4f* xr0 = (const v4f*)(x + (size_t)gw * DM) + lane;
#pragma unroll
        for (int j = 0; j < 8; ++j) nx[j] = xr0[64 * j]; }
    for (int m = gw; m < MROWS; m += NGW) {
        v4f* xr = (v4f*)(x + (size_t)m * DM) + lane;
        v4f v[8]; float s = 0.f;
#pragma unroll
        for (int j = 0; j < 8; ++j) v[j] = nx[j];
        if (m + NGW < MROWS) { const v4f* xr1 = (const v4f*)(x + (size_t)(m + NGW) * DM) + lane;
#pragma unroll
            for (int j = 0; j < 8; ++j) nx[j] = xr1[64 * j]; }
#pragma unroll
        for (int j = 0; j < 8; ++j) s += (v[j].x * v[j].x + v[j].y * v[j].y) + (v[j].z * v[j].z + v[j].w * v[j].w);
        const float rstd = 1.0f / sqrtf(wave_sum(s) * (1.f / DM) + NORM_EPS);
#pragma unroll
        for (int j = 0; j < 8; ++j) { const v4f wv = *(const v4f*)(w + 4 * lane + 256 * j); xr[64 * j] = v[j] * rstd * wv; }
    }
}

__device__ __forceinline__ void fox_cumsum_item(CArgs& a, int layer, int item, LAS unsigned char* lds) {
    const int tid = lz_tid(), b = item >> 3, h = item & 7;
    const float* gates = (const float*)(a.ws + WS_GATES); float* cneg = (float*)(a.ws + WS_CNEG) + (size_t)item * SEQ;
    const float bias = ((const float*)a.in[10])[layer * 8 + h];
    LAS double* tot = (LAS double*)lds;
    double sum = 0.0;
    const float* gp = gates + ((size_t)b * SEQ + (size_t)tid * 32) * 16 + h;
#pragma unroll 4
    for (int i = 0; i < 32; ++i) sum += (double)log_sigmoid(gp[i * 16] + bias);
    tot[tid] = sum;
    __syncthreads();
    if (tid == 0) { double run = 0.0; for (int i = 0; i < 512; ++i) { const double t = tot[i]; tot[i] = run; run += t; } }
    __syncthreads();
    double run = tot[tid];
#pragma unroll 2
    for (int i = 0; i < 32; i += 4) { v4f o;
        run += (double)log_sigmoid(gp[(i + 0) * 16] + bias); o.x = (float)(-run * 11.313708498984761);
        run += (double)log_sigmoid(gp[(i + 1) * 16] + bias); o.y = (float)(-run * 11.313708498984761);
        run += (double)log_sigmoid(gp[(i + 2) * 16] + bias); o.z = (float)(-run * 11.313708498984761);
        run += (double)log_sigmoid(gp[(i + 3) * 16] + bias); o.w = (float)(-run * 11.313708498984761);
        *(v4f*)(cneg + tid * 32 + i) = o; }
    __syncthreads();
}
__device__ __forceinline__ void mlstm_scan_item(CArgs& a, int layer, int item, LAS unsigned char* lds) {
    const int tid = lz_tid(), lane = tid & 63, wave = tid >> 6, b = item >> 2, h = item & 3;
    const float* gates = (const float*)(a.ws + WS_GATES);
    float* MA = (float*)(a.ws + WS_MA) + (size_t)item * SEQ; float* MCM = (float*)(a.ws + WS_MCM) + (size_t)item * SEQ; float* MBv = (float*)(a.ws + WS_MB) + (size_t)item * SEQ;
    float* MPREV = (float*)(a.ws + WS_MPREV) + item * 256;
    const float ib = ((const float*)a.in[11])[layer * 4 + h], fb = ((const float*)a.in[12])[layer * 4 + h];
    LAS float* Bc = (LAS float*)lds; LAS float* Ac = Bc + 256;
#pragma unroll 4
    for (int c = wave; c < 256; c += 8) {
        const size_t m = (size_t)b * SEQ + c * 64 + lane;
        const float ig = gates[m * 16 + 8 + h] + ib, fg = gates[m * 16 + 12 + h] + fb;
        float bb = log_sigmoid(fg);
#pragma unroll
        for (int o = 1; o < 64; o <<= 1) { const float t = __shfl_up(bb, o); if (lane >= o) bb += t; }
        const float av = ig - bb; float cm = av;
#pragma unroll
        for (int o = 1; o < 64; o <<= 1) { const float t = __shfl_up(cm, o); if (lane >= o) cm = fmaxf(cm, t); }
        MA[c * 64 + lane] = av; MCM[c * 64 + lane] = cm; MBv[c * 64 + lane] = bb;
        if (lane == 63) { Bc[c] = bb; Ac[c] = cm; }
    }
    __syncthreads();
    if (tid == 0) { float mm = 0.f; for (int c = 0; c < 256; ++c) { MPREV[c] = mm; mm = Bc[c] + fmaxf(mm, Ac[c]); } }
    __syncthreads();
}
__device__ __forceinline__ void prep_phase(CArgs& a, int layer, LAS unsigned char* lds) {
    const int tid = lz_tid(), bid = lz_bid(), G = gridDim.x;
    if (bid < 16) { fox_cumsum_item(a, layer, bid, lds); return; }
    if (bid < 24) { mlstm_scan_item(a, layer, bid - 16, lds); return; }
    const int wk = bid - 24, NWK = G - 24;
    bf16r* P = (bf16r*)(a.ws + WS_P);
    { const int jg = tid & 7; double invf[8];
#pragma unroll
      for (int i = 0; i < 8; ++i) { double r = 1.0, bs = 0.8659643233600653; int e = 8 * jg + i;
#pragma unroll
          for (int q = 0; q < 6; ++q) { if (e & 1) r *= bs; bs *= bs; e >>= 1; }
          invf[i] = r * 0.15915494309189535; }
      const int* positions = (const int*)a.in[2];
      for (int it0 = wk; it0 < 8 * MROWS / 64; it0 += 4 * NWK) {
          v4u A[4], Bv[4]; bf16r* pp[4]; int mm[4], sl[4];
#pragma unroll
          for (int q = 0; q < 4; ++q) { const int it = it0 + q * NWK; const bool ok = it < 8 * MROWS / 64; const int grow = (ok ? it : wk) * 64 + (tid >> 3); sl[q] = ok ? grow / MROWS : -1; mm[q] = grow % MROWS;
              pp[q] = P + ((size_t)(grow / MROWS) * MROWS + mm[q]) * 128 + 8 * jg; A[q] = *(const v4u*)pp[q]; Bv[q] = *(const v4u*)(pp[q] + 64); }
#pragma unroll
          for (int q = 0; q < 4; ++q) { if (sl[q] < 0) continue;
              const double pos = (double)positions[mm[q]]; const float sc = sl[q] >= 4 ? KSCALE : 1.0f;
              float t1[8] = {bflo(A[q].x), bfhi(A[q].x), bflo(A[q].y), bfhi(A[q].y), bflo(A[q].z), bfhi(A[q].z), bflo(A[q].w), bfhi(A[q].w)};
              float t2[8] = {bflo(Bv[q].x), bfhi(Bv[q].x), bflo(Bv[q].y), bfhi(Bv[q].y), bflo(Bv[q].z), bfhi(Bv[q].z), bflo(Bv[q].w), bfhi(Bv[q].w)};
              float o1[8], o2[8];
#pragma unroll
              for (int i = 0; i < 8; ++i) { const double rev = pos * invf[i]; const float fr = (float)(rev - floor(rev));
                  const float sn = __builtin_amdgcn_sinf(fr) * sc, cs = __builtin_amdgcn_cosf(fr) * sc;
                  o1[i] = t1[i] * cs - t2[i] * sn; o2[i] = t2[i] * cs + t1[i] * sn; }
              v4u oa, ob; oa.x = pk2(o1[0], o1[1]); oa.y = pk2(o1[2], o1[3]); oa.z = pk2(o1[4], o1[5]); oa.w = pk2(o1[6], o1[7]);
              ob.x = pk2(o2[0], o2[1]); ob.y = pk2(o2[2], o2[3]); ob.z = pk2(o2[4], o2[5]); ob.w = pk2(o2[6], o2[7]);
              *(v4u*)pp[q] = oa; *(v4u*)(pp[q] + 64) = ob; }
      } }
    { const int slot = wk % 8, sub = wk / 8, nsub = (NWK - slot + 7) / 8, cgp = tid & 15;
      const float* cw = (const float*)a.in[8] + (size_t)layer * 4 * 1024 + slot * 128 + 8 * cgp; const float* cbv = (const float*)a.in[9] + (size_t)layer * 1024 + slot * 128 + 8 * cgp;
      float w[4][8], bsv[8];
#pragma unroll
      for (int j = 0; j < 4; ++j)
#pragma unroll
          for (int i = 0; i < 8; ++i) w[j][i] = cw[j * 1024 + i];
#pragma unroll
      for (int i = 0; i < 8; ++i) bsv[i] = cbv[i];
      const bf16r* __restrict__ src = P + (size_t)(40 + slot) * MROWS * 128 + 8 * cgp; bf16r* __restrict__ dst = (bf16r*)(a.ws + WS_MQC) + (size_t)slot * MROWS * 128 + 8 * cgp;
      const float sc = slot >= 4 ? KSCALE : 1.0f;
#pragma unroll 2
      for (int rb = sub; rb < MROWS / 32; rb += nsub) {
          const int row = rb * 32 + (tid >> 4), s = row % SEQ;
          float acc[8];
#pragma unroll
          for (int i = 0; i < 8; ++i) acc[i] = bsv[i];
#pragma unroll
          for (int j = 0; j < 4; ++j) { if (s - 3 + j >= 0) { const v4u X = *(const v4u*)(src + (size_t)(row - 3 + j) * 128);
              acc[0] += w[j][0] * bflo(X.x); acc[1] += w[j][1] * bfhi(X.x); acc[2] += w[j][2] * bflo(X.y); acc[3] += w[j][3] * bfhi(X.y);
              acc[4] += w[j][4] * bflo(X.z); acc[5] += w[j][5] * bfhi(X.z); acc[6] += w[j][6] * bflo(X.w); acc[7] += w[j][7] * bfhi(X.w); } }
#pragma unroll
          for (int i = 0; i < 8; ++i) acc[i] = acc[i] / (1.f + expf(-acc[i])) * sc;
          v4u o; o.x = pk2(acc[0], acc[1]); o.y = pk2(acc[2], acc[3]); o.z = pk2(acc[4], acc[5]); o.w = pk2(acc[6], acc[7]);
          *(v4u*)(dst + (size_t)row * 128) = o;
      } }
    { const int slot = wk % 16, sub = wk / 16, nsub = (NWK - slot + 15) / 16, c16 = tid & 15;
      const bf16r* src = P + (size_t)(16 + slot) * MROWS * 128 + 8 * c16;
      float mx0 = 0.f, mx1 = 0.f;
#pragma unroll 8
      for (int rb = sub; rb < MROWS / 32; rb += nsub) {
          const int row = rb * 32 + (tid >> 4); const v4u X = *(const v4u*)(src + (size_t)row * 128);
          const float x0 = bflo(X.x), x1 = bfhi(X.x), x2 = bflo(X.y), x3 = bfhi(X.y), x4 = bflo(X.z), x5 = bfhi(X.z), x6 = bflo(X.w), x7 = bfhi(X.w);
          float s = (x0 * x0 + x1 * x1) + (x2 * x2 + x3 * x3) + (x4 * x4 + x5 * x5) + (x6 * x6 + x7 * x7);
          s += __shfl_xor(s, 1); s += __shfl_xor(s, 2); s += __shfl_xor(s, 4); s += __shfl_xor(s, 8);
          if (row < SEQ) mx0 = fmaxf(mx0, s); else mx1 = fmaxf(mx1, s);
      }
#pragma unroll
      for (int o = 1; o < 64; o <<= 1) { mx0 = fmaxf(mx0, __shfl_xor(mx0, o)); mx1 = fmaxf(mx1, __shfl_xor(mx1, o)); }
      if ((tid & 63) == 0) { unsigned* QK2 = (unsigned*)(a.ws + WS_QK2) + layer * 32;
          __hip_atomic_fetch_max(QK2 + slot, __float_as_uint(mx0 * 1.02f), __ATOMIC_RELAXED, __HIP_MEMORY_SCOPE_AGENT);
          __hip_atomic_fetch_max(QK2 + 16 + slot, __float_as_uint(mx1 * 1.02f), __ATOMIC_RELAXED, __HIP_MEMORY_SCOPE_AGENT); }
    }
}

__device__ __forceinline__ int cv_st(int k, int c) { const int kk = (k & ~0xC) | ((k & 4) << 1) | ((k & 8) >> 1); return ((kk >> 3) * 4 + (c >> 5)) * 512 + ((kk & 7) * 32 + (c & 31)) * 2; }
__device__ __forceinline__ int cv_rd_base(int lane) { return ((lane & 3) << 3) | (((lane >> 2) & 3) << 6) | (((lane >> 4) & 1) << 5) | (((lane >> 5) & 1) << 8); }
__device__ __forceinline__ int ccrow(int r, int hi) { return (r & 3) + 8 * (r >> 2) + 4 * hi; }
#define CFRAG(dst, vb, ks) do { v4s l_, h_; asm volatile("ds_read_b64_tr_b16 %0, %1 offset:%2" : "=&v"(l_) : "v"(vb), "i"((ks) * 4096) : "memory"); \
        asm volatile("ds_read_b64_tr_b16 %0, %1 offset:%2" : "=&v"(h_) : "v"(vb), "i"((ks) * 4096 + 2048) : "memory"); asm volatile("s_waitcnt lgkmcnt(0)" ::: "memory"); \
        dst = (v8s){l_[0], l_[1], l_[2], l_[3], h_[0], h_[1], h_[2], h_[3]}; } while (0)

struct ChunkItem { int mixer, bh, b, h, c, row0; };
__device__ __forceinline__ ChunkItem chunk_decode(int idx) { ChunkItem it; it.mixer = idx / 2048; const int rem = idx % 2048; it.bh = rem / 256; it.b = it.bh >> 2; it.h = it.bh & 3; it.c = rem % 256; it.row0 = it.b * SEQ + it.c * 64; return it; }
__device__ __forceinline__ float ret_lg(int h) { return log2f(1.0f - exp2f(-5.0f - (float)h)); }

__device__ __forceinline__ void m1_phase(CArgs& a, LAS unsigned char* lds) {
    const int tid = lz_tid(), lane = tid & 63, wave = __builtin_amdgcn_readfirstlane(tid >> 6), r32 = lane & 31, hi = lane >> 5;
    const bf16r* P = (const bf16r*)(a.ws + WS_P); const bf16r* MQC = (const bf16r*)(a.ws + WS_MQC); bf16r* US = (bf16r*)(a.ws + WS_H);
    LAS unsigned char* KT = lds; LAS unsigned char* VT = lds + 16384; LAS float* wt = (LAS float*)(lds + 32768); LAS float* red = (LAS float*)(lds + 33024);
    const int sr = tid >> 4, sc = (tid & 15) * 8;
    for (int idx = lz_bid(); idx < 4096; idx += gridDim.x) {
        const ChunkItem it = chunk_decode(idx);
        const bf16r* ksrc = (it.mixer == 0 ? P + (size_t)(4 + it.h) * MROWS * 128 : MQC + (size_t)(4 + it.h) * MROWS * 128) + (size_t)it.row0 * 128;
        const bf16r* vsrc = P + (size_t)((it.mixer == 0 ? 8 : 48) + it.h) * MROWS * 128 + (size_t)it.row0 * 128;
        if (tid < 64) { float w;
            if (it.mixer == 0) w = exp2f((float)(63 - tid) * ret_lg(it.h));
            else { const float* MA = (const float*)(a.ws + WS_MA) + (size_t)it.bh * SEQ + it.c * 64; const float* MCM = (const float*)(a.ws + WS_MCM) + (size_t)it.bh * SEQ + it.c * 64;
                   const float mp = ((const float*)(a.ws + WS_MPREV))[it.bh * 256 + it.c]; w = expf(MA[tid] - fmaxf(mp, MCM[63])); }
            wt[tid] = w; }
        const v4u k0 = *(const v4u*)(ksrc + (size_t)sr * 128 + sc), k1 = *(const v4u*)(ksrc + (size_t)(32 + sr) * 128 + sc);
        const v4u v0 = *(const v4u*)(vsrc + (size_t)sr * 128 + sc), v1 = *(const v4u*)(vsrc + (size_t)(32 + sr) * 128 + sc);
        __syncthreads();
        const float w0 = wt[sr], w1 = wt[32 + sr];
        float a0[8] = {bflo(k0.x) * w0, bfhi(k0.x) * w0, bflo(k0.y) * w0, bfhi(k0.y) * w0, bflo(k0.z) * w0, bfhi(k0.z) * w0, bflo(k0.w) * w0, bfhi(k0.w) * w0};
        float a1[8] = {bflo(k1.x) * w1, bfhi(k1.x) * w1, bflo(k1.y) * w1, bfhi(k1.y) * w1, bflo(k1.z) * w1, bfhi(k1.z) * w1, bflo(k1.w) * w1, bfhi(k1.w) * w1};
        { v4u o; o.x = pk2(a0[0], a0[1]); o.y = pk2(a0[2], a0[3]); o.z = pk2(a0[4], a0[5]); o.w = pk2(a0[6], a0[7]); *(LAS v4u*)(KT + cv_st(sr, sc)) = o;
          o.x = pk2(a1[0], a1[1]); o.y = pk2(a1[2], a1[3]); o.z = pk2(a1[4], a1[5]); o.w = pk2(a1[6], a1[7]); *(LAS v4u*)(KT + cv_st(32 + sr, sc)) = o;
          *(LAS v4u*)(VT + cv_st(sr, sc)) = v0; *(LAS v4u*)(VT + cv_st(32 + sr, sc)) = v1; }
        if (it.mixer == 1) {
#pragma unroll
            for (int i = 0; i < 8; ++i) { float s = a0[i] + a1[i]; s += __shfl_xor(s, 16); s += __shfl_xor(s, 32); if (lane < 16) red[wave * 128 + sc + i] = s; }
        }
        __syncthreads();
        if (it.mixer == 1 && tid < 128) { float s = 0.f;
#pragma unroll
            for (int q = 0; q < 8; ++q) s += red[q * 128 + tid];
            ((float*)(a.ws + WS_UN))[((size_t)it.bh * 256 + it.c) * 128 + tid] = s; }
        const int db = wave >> 1;
        const int kvb = (int)(uintptr_t)KT + cv_rd_base(lane) + db * 512;
        v8s kf[4]; CFRAG(kf[0], kvb, 0); CFRAG(kf[1], kvb, 1); CFRAG(kf[2], kvb, 2); CFRAG(kf[3], kvb, 3);
#pragma unroll
        for (int e2 = 0; e2 < 2; ++e2) { const int eb = (wave & 1) * 2 + e2; const int vvb = (int)(uintptr_t)VT + cv_rd_base(lane) + eb * 512;
            v8s vf[4]; CFRAG(vf[0], vvb, 0); CFRAG(vf[1], vvb, 1); CFRAG(vf[2], vvb, 2); CFRAG(vf[3], vvb, 3);
            v16f acc = {};
#pragma unroll
            for (int ks = 0; ks < 4; ++ks) acc = __builtin_amdgcn_mfma_f32_32x32x16_bf16(kf[ks], vf[ks], acc, 0, 0, 0);
            bf16r* dst = US + (size_t)idx * 16384 + (size_t)(eb * 32 + r32) * 128 + db * 32 + 4 * hi;
#pragma unroll
            for (int g = 0; g < 4; ++g) { v2u o; o.x = pk2(acc[4 * g], acc[4 * g + 1]); o.y = pk2(acc[4 * g + 2], acc[4 * g + 3]); *(v2u*)(dst + 8 * g) = o; } }
        __syncthreads();
    }
}

#ifndef M2U
#define M2U 64
#endif
__device__ __forceinline__ void m2_phase(CArgs& a, LAS unsigned char* lds) {
    const int tid = lz_tid();
    unsigned* US = (unsigned*)(a.ws + WS_H); LAS float* coef = (LAS float*)lds;
    const float* MCM = (const float*)(a.ws + WS_MCM); const float* MPREV = (const float*)(a.ws + WS_MPREV);
    for (int blk = lz_bid(); blk < 16 * 8192 / 512; blk += gridDim.x) {
        const int chain = blk / 16, mixer = chain >> 3, bh = chain & 7;
        __syncthreads();
        if (tid < 256) { float cf;
            if (mixer == 0) cf = exp2f(64.0f * ret_lg(bh & 3));
            else { const float mp = MPREV[bh * 256 + tid]; cf = expf(mp - fmaxf(mp, MCM[(size_t)bh * SEQ + tid * 64 + 63])); }
            coef[tid] = cf; }
        __syncthreads();
        unsigned* p = US + (size_t)chain * 256 * 8192 + (blk % 16) * 512 + tid;
        float s0 = 0.f, s1 = 0.f;
        for (int c = 0; c < 256; c += M2U) { unsigned u[M2U];
#pragma unroll
            for (int i = 0; i < M2U; ++i) u[i] = p[(size_t)(c + i) * 8192];
#pragma unroll
            for (int i = 0; i < M2U; ++i) { const float cf = coef[c + i]; p[(size_t)(c + i) * 8192] = pk2(s0, s1); s0 = s0 * cf + bflo(u[i]); s1 = s1 * cf + bfhi(u[i]); } }
    }
    float* UN = (float*)(a.ws + WS_UN);
    for (int bh = lz_bid(); bh < 8; bh += gridDim.x) {
        __syncthreads();
        if (tid < 256) { const float mp = MPREV[bh * 256 + tid]; coef[tid] = expf(mp - fmaxf(mp, MCM[(size_t)bh * SEQ + tid * 64 + 63])); }
        __syncthreads();
        if (tid < 128) { float* p = UN + (size_t)bh * 256 * 128 + tid; float s = 0.f;
            for (int c = 0; c < 256; c += 16) { float u[16];
#pragma unroll
                for (int i2 = 0; i2 < 16; ++i2) u[i2] = p[(c + i2) * 128];
#pragma unroll
                for (int i2 = 0; i2 < 16; ++i2) { p[(c + i2) * 128] = s; s = s * coef[c + i2] + u[i2]; } } }
    }
}

__device__ __forceinline__ void m3_phase(CArgs& a, int layer, LAS unsigned char* lds) {
    const int tid = lz_tid(), lane = tid & 63, wave = __builtin_amdgcn_readfirstlane(tid >> 6), r32 = lane & 31, hi = lane >> 5;
    const bf16r* P = (const bf16r*)(a.ws + WS_P); const bf16r* MQC = (const bf16r*)(a.ws + WS_MQC); const bf16r* US = (const bf16r*)(a.ws + WS_H);
    bf16r* Y = (bf16r*)(a.ws + WS_Y); const float* msc = (const float*)a.in[13] + (size_t)layer * DM;
    LAS unsigned char* VT = lds; LAS float* OT = (LAS float*)(lds + 16384);
    LAS float* sa = (LAS float*)(lds + 16384 + 64 * 132 * 4); LAS float* sg = sa + 64; LAS float* swi = sg + 64; LAS float* semq = swi + 64; LAS float* sn = semq + 64; LAS float* fw = sn + 128;
    const int sr = tid >> 4, sc = (tid & 15) * 8;
    const int lb = wave & 1, eb = wave >> 1, l = lb * 32 + r32;
    for (int idx = lz_bid(); idx < 4096; idx += gridDim.x) {
        const ChunkItem it = chunk_decode(idx);
        const bf16r* qsrc = (it.mixer == 0 ? P + (size_t)it.h * MROWS * 128 : MQC + (size_t)it.h * MROWS * 128) + (size_t)it.row0 * 128;
        const bf16r* ksrc = (it.mixer == 0 ? P + (size_t)(4 + it.h) * MROWS * 128 : MQC + (size_t)(4 + it.h) * MROWS * 128) + (size_t)it.row0 * 128;
        const bf16r* vsrc = P + (size_t)((it.mixer == 0 ? 8 : 48) + it.h) * MROWS * 128 + (size_t)it.row0 * 128;
        const bf16r* gsrc = P + (size_t)((it.mixer == 0 ? 12 : 52) + it.h) * MROWS * 128 + (size_t)it.row0 * 128;
        const bf16r* St = US + (size_t)idx * 16384;
        const float lg = ret_lg(it.h);
        if (it.mixer == 1) {
            if (tid < 64) { const size_t o = (size_t)it.bh * SEQ + it.c * 64 + tid; const float mp = ((const float*)(a.ws + WS_MPREV))[it.bh * 256 + it.c];
                const float av = ((const float*)(a.ws + WS_MA))[o], cm = ((const float*)(a.ws + WS_MCM))[o], bb = ((const float*)(a.ws + WS_MB))[o];
                const float g = fmaxf(mp, cm); sa[tid] = av; sg[tid] = g; swi[tid] = expf(mp - g); semq[tid] = expf(-(bb + g)); }
            else if (tid < 192) sn[tid - 64] = ((const float*)(a.ws + WS_UN))[((size_t)it.bh * 256 + it.c) * 128 + tid - 64];
        }
        { const v4u v0 = *(const v4u*)(vsrc + (size_t)sr * 128 + sc), v1 = *(const v4u*)(vsrc + (size_t)(32 + sr) * 128 + sc);
          *(LAS v4u*)(VT + cv_st(sr, sc)) = v0; *(LAS v4u*)(VT + cv_st(32 + sr, sc)) = v1; }
        v8s qr[8];
#pragma unroll
        for (int d0 = 0; d0 < 8; ++d0) qr[d0] = *(const v8s*)(qsrc + (size_t)l * 128 + d0 * 16 + hi * 8);
        __syncthreads();
        v16f p0 = {}, p1 = {};
#pragma unroll
        for (int d0 = 0; d0 < 8; ++d0) { const v8s kf = *(const v8s*)(ksrc + (size_t)r32 * 128 + d0 * 16 + hi * 8); p0 = __builtin_amdgcn_mfma_f32_32x32x16_bf16(kf, qr[d0], p0, 0, 0, 0); }
        if (lb == 1) {
#pragma unroll
            for (int d0 = 0; d0 < 8; ++d0) { const v8s kf = *(const v8s*)(ksrc + (size_t)(32 + r32) * 128 + d0 * 16 + hi * 8); p1 = __builtin_amdgcn_mfma_f32_32x32x16_bf16(kf, qr[d0], p1, 0, 0, 0); }
        }
        float rs = 0.f;
        int ll = l; asm volatile("" : "+v"(ll));
        if (it.mixer == 0) {
#pragma unroll
            for (int r = 0; r < 16; ++r) { const int m0 = ccrow(r, hi), m1 = m0 + 32;
                p0[r] = (m0 <= ll) ? p0[r] * exp2f((float)(ll - m0) * lg) : 0.f; p1[r] = (m1 <= ll) ? p1[r] * exp2f((float)(ll - m1) * lg) : 0.f; }
        } else { const float gl = sg[l];
#pragma unroll
            for (int r = 0; r < 16; ++r) { const int m0 = ccrow(r, hi), m1 = m0 + 32;
                p0[r] = (m0 <= ll) ? p0[r] * expf(sa[m0] - gl) : 0.f; p1[r] = (m1 <= ll) ? p1[r] * expf(sa[m1] - gl) : 0.f; rs += p0[r] + p1[r]; }
            rs = swap_add(rs);
        }
        v8s pa0, pa1, pa2, pa3;
#define CPK4(Pv, B_, OUT) do { unsigned a0_ = pk2(Pv[B_+0], Pv[B_+1]), a1_ = pk2(Pv[B_+2], Pv[B_+3]), b0_ = pk2(Pv[B_+4], Pv[B_+5]), b1_ = pk2(Pv[B_+6], Pv[B_+7]); \
        auto r0_ = __builtin_amdgcn_permlane32_swap(a0_, b0_, false, false); auto r1_ = __builtin_amdgcn_permlane32_swap(a1_, b1_, false, false); \
        v4u w_ = {r0_[0], r1_[0], r0_[1], r1_[1]}; OUT = *reinterpret_cast<v8s*>(&w_); } while (0)
        CPK4(p0, 0, pa0); CPK4(p0, 8, pa1); CPK4(p1, 0, pa2); CPK4(p1, 8, pa3);
#undef CPK4
        const int vvb = (int)(uintptr_t)VT + cv_rd_base(lane) + eb * 512;
        v16f oi = {}, ox = {};
        { v8s vf; CFRAG(vf, vvb, 0); oi = __builtin_amdgcn_mfma_f32_32x32x16_bf16(pa0, vf, oi, 0, 0, 0); CFRAG(vf, vvb, 1); oi = __builtin_amdgcn_mfma_f32_32x32x16_bf16(pa1, vf, oi, 0, 0, 0);
          CFRAG(vf, vvb, 2); oi = __builtin_amdgcn_mfma_f32_32x32x16_bf16(pa2, vf, oi, 0, 0, 0); CFRAG(vf, vvb, 3); oi = __builtin_amdgcn_mfma_f32_32x32x16_bf16(pa3, vf, oi, 0, 0, 0); }
#pragma unroll
        for (int d0 = 0; d0 < 8; ++d0) { const v8s sf = *(const v8s*)(St + (size_t)(eb * 32 + r32) * 128 + d0 * 16 + hi * 8); ox = __builtin_amdgcn_mfma_f32_32x32x16_bf16(qr[d0], sf, ox, 0, 0, 0); }
        float fa, fb;
        if (it.mixer == 0) { fa = 1.f; fb = exp2f((float)(l + 1) * lg); }
        else { float qn = 0.f;
#pragma unroll
            for (int d0 = 0; d0 < 8; ++d0)
#pragma unroll
                for (int i = 0; i < 8; ++i) qn += bf1((bf16r)qr[d0][i]) * sn[d0 * 16 + hi * 8 + i];
            qn = swap_add(qn);
            const float wi = swi[l]; const float den = rs + wi * qn; const float dn = fmaxf(fabsf(den), semq[l]); fa = 1.0f / dn; fb = wi / dn; }
        LAS float* fww = fw + wave * 64;
        if (hi == 0) { fww[r32] = fa; fww[32 + r32] = fb; }
        asm volatile("s_waitcnt lgkmcnt(0)" ::: "memory");
#pragma unroll
        for (int r = 0; r < 16; ++r) { const int lr = ccrow(r, hi); OT[(lb * 32 + lr) * 132 + eb * 32 + r32] = fww[lr] * oi[r] + fww[32 + lr] * ox[r]; }
        __syncthreads();
        const int colbase = (it.mixer == 0 ? 0 : 1536) + it.h * 128;
        { const int row = wave * 8 + (lane >> 3), seg = lane & 7;
          const v4u gA = *(const v4u*)(gsrc + (size_t)row * 128 + seg * 16), gB = *(const v4u*)(gsrc + (size_t)row * 128 + seg * 16 + 8);
          float v[16];
#pragma unroll
          for (int q = 0; q < 4; ++q) { const v4f t = *(LAS v4f*)(OT + row * 132 + seg * 16 + 4 * q); v[4 * q] = t.x; v[4 * q + 1] = t.y; v[4 * q + 2] = t.z; v[4 * q + 3] = t.w; }
          float s = 0.f;
#pragma unroll
          for (int q = 0; q < 16; ++q) s += v[q];
          s += __shfl_xor(s, 1); s += __shfl_xor(s, 2); s += __shfl_xor(s, 4);
          const float mu = s * (1.f / 128.f); float sq = 0.f;
#pragma unroll
          for (int q = 0; q < 16; ++q) { v[q] -= mu; sq += v[q] * v[q]; }
          sq += __shfl_xor(sq, 1); sq += __shfl_xor(sq, 2); sq += __shfl_xor(sq, 4);
          const float rstd = 1.0f / sqrtf(sq * (1.f / 128.f) + NORM_EPS);
          float g[16] = {bflo(gA.x), bfhi(gA.x), bflo(gA.y), bfhi(gA.y), bflo(gA.z), bfhi(gA.z), bflo(gA.w), bfhi(gA.w), bflo(gB.x), bfhi(gB.x), bflo(gB.y), bfhi(gB.y), bflo(gB.z), bfhi(gB.z), bflo(gB.w), bfhi(gB.w)};
          const float* mp = msc + colbase + seg * 16;
#pragma unroll
          for (int q = 0; q < 16; ++q) { const float e = expf(-g[q]); const float gate = (it.mixer == 0) ? g[q] / (1.f + e) : 1.f / (1.f + e); v[q] = v[q] * rstd * gate * mp[q]; }
          v4u oA, oB; oA.x = pk2(v[0], v[1]); oA.y = pk2(v[2], v[3]); oA.z = pk2(v[4], v[5]); oA.w = pk2(v[6], v[7]); oB.x = pk2(v[8], v[9]); oB.y = pk2(v[10], v[11]); oB.z = pk2(v[12], v[13]); oB.w = pk2(v[14], v[15]);
          bf16r* yp = Y + (size_t)(it.row0 + row) * DM + colbase + seg * 16;
          *(v4u*)yp = oA; *(v4u*)(yp + 8) = oB; }
        __syncthreads();
    }
}

__device__ __forceinline__ fox::BlockRef<fox::bf16, fox::bf16> fox_ref(CArgs& a, int layer, int bh, int qb, int jlo) {
    const int b = bh >> 3, h = bh & 7; const fox::bf16* P = (const fox::bf16*)(a.ws + WS_P);
    fox::BlockRef<fox::bf16, fox::bf16> r;
    r.Q = P + ((size_t)(16 + h) * MROWS + (size_t)b * SEQ + (size_t)qb * 256) * 128;
    r.K = (unsigned)(WS_P + ((size_t)(24 + h) * MROWS + (size_t)b * SEQ) * 256); r.V = (unsigned)(WS_P + ((size_t)(32 + h) * MROWS + (size_t)b * SEQ) * 256);
    r.O = (fox::bf16*)(a.ws + WS_Y) + ((size_t)b * SEQ + (size_t)qb * 256) * DM + 512 + h * 128;
    r.C = (unsigned)(WS_CNEG + (size_t)bh * SEQ * 4); r.MS = (const float*)a.in[13] + (size_t)layer * DM + 512 + h * 128; const int j4 = jlo >> 2;
    r.P0 = (qb - j4) * 256; r.JLO = j4 * 4;
    r.K += (unsigned)j4 * 256u * 256u; r.V += (unsigned)j4 * 256u * 256u; r.C += (unsigned)j4 * 1024u;
    return r;
}
__device__ __forceinline__ void fox_table_phase(CArgs& a, int layer) {
    const int tid = lz_tid(), lane = tid & 63, u = lz_bid() * 8 + (tid >> 6);
    if (u >= 1024) return;
    const float* QK2 = (const float*)(a.ws + WS_QK2) + layer * 32; const float* CN = (const float*)(a.ws + WS_CNEG);
    const int bh = u & 15, qb = 63 - (u >> 4), b = bh >> 3, h = bh & 7;
    const float qkmax = sqrtf(QK2[b * 16 + h] * QK2[b * 16 + 8 + h]);
    const float* cn = CN + (size_t)bh * SEQ; const float thresh = cn[qb * 256] - (2.0f * qkmax + 1245.0f);
    int cnt = 0;
#pragma unroll
    for (int t = 0; t < 4; ++t) { const int tile = lane + 64 * t; const bool skip = (tile < qb * 4) && (cn[tile * 64 + 63] < thresh); cnt += __popcll(__ballot(skip)); }
    if (lane == 0) ((int*)(a.ws + WS_JT))[layer * 1024 + u] = cnt;
}
__device__ __forceinline__ void fox_phase(CArgs& a, int layer, char* lds, int rep = 0) {
    using BR = fox::BlockRef<fox::bf16, fox::bf16>;
    constexpr int W = 1 << 30, total = 1024;
    const int tid = lz_tid(), lane = tid & 63;
    volatile unsigned* sbuf = (volatile unsigned*)(lds + 69632);
    unsigned* qctr = (unsigned*)(a.ws + WS_QCTR) + layer * 64 + rep * 128;
    const int* JT = (const int*)(a.ws + WS_JT) + layer * 1024;
#define FOX_GRAB(U) do { if (tid == 0) sbuf[0] = __hip_atomic_fetch_add(qctr, 1u, __ATOMIC_RELAXED, __HIP_MEMORY_SCOPE_AGENT); __syncthreads(); U = __builtin_amdgcn_readfirstlane((int)sbuf[0]); __syncthreads(); } while (0)
#define FOX_MAKE(R, U) do { const int bh_ = (U) & 15, qb_ = 63 - ((U) >> 4); R = fox_ref(a, layer, bh_, qb_, __builtin_amdgcn_readfirstlane(JT[(U)])); } while (0)
    int u; FOX_GRAB(u); if (u >= total) return;
    BR cur; FOX_MAKE(cur, u);
    fox::Seam<fox::bf16> S;
    const __amdgpu_buffer_rsrc_t rs = __builtin_amdgcn_make_buffer_rsrc((void*)a.ws, 0, -1, 0x00020000);
    fox::causal_swa_prime<fox::bf16, fox::bf16>(cur, W, lds, S, rs);
    for (;;) {
        int un; FOX_GRAB(un); const bool last = un >= total;
        BR nxt = cur; if (!last) FOX_MAKE(nxt, un);
        fox::causal_swa_block<fox::bf16, fox::bf16>(cur, nxt, SEQ, W, lds, S, rs);
        if (last) break;
        cur = nxt;
    }
#undef FOX_GRAB
#undef FOX_MAKE
}

#ifdef NANPROBE
constexpr size_t WS_FLAGS = 32 * 1024;
__device__ __forceinline__ void probe_f32(const float* p, size_t n, unsigned* flag) { bool bad = false;
    for (size_t i = (size_t)lz_bid() * 512 + lz_tid(); i < n; i += (size_t)gridDim.x * 512) { const unsigned u = __float_as_uint(p[i]); if ((u & 0x7f800000u) == 0x7f800000u) bad = true; }
    if (bad) *flag = 1u; }
__device__ __forceinline__ void probe_bf16(const unsigned short* p, size_t n, unsigned* flag) { bool bad = false;
    for (size_t i = (size_t)lz_bid() * 512 + lz_tid(); i < n; i += (size_t)gridDim.x * 512) { const unsigned u = p[i]; if ((u & 0x7f80u) == 0x7f80u) bad = true; }
    if (bad) *flag = 1u; }
#define PROBE_F32(p, n, k) probe_f32((const float*)(p), (n), (unsigned*)(ws + WS_FLAGS) + (k))
#define PROBE_BF16(p, n, k) probe_bf16((const unsigned short*)(p), (n), (unsigned*)(ws + WS_FLAGS) + (k))
#else
#define PROBE_F32(p, n, k) do {} while (0)
#define PROBE_BF16(p, n, k) do {} while (0)
#endif
#ifndef PHMASK
#define PHMASK 0xfff
#endif
#define EN(k) ((PHMASK >> (k)) & 1)
#define IN(k) (lo <= (k) && (k) < hi)
#ifdef TWICE_SYNC
#define SEAM() do { if (IN(ph) && IN(ph + 1)) { grid.sync(); grid.sync(); grid.sync(); } ++ph; } while (0)
#else
#define SEAM() do { if (IN(ph) && IN(ph + 1)) { if (ph == 0) grid.sync(); else xcd_barrier(xbar); } ++ph; } while (0)
#endif
#define a (*fresh_args())
#define ws (a.ws)
#define MOD ((const float*)(ws + WS_MOD))
template <int layer>
__device__ __forceinline__ void layer_phases(int& ph, const int lo, const int hi, cg::grid_group& grid, const XcdBarrier& xbar, LAS unsigned char* lds, unsigned char* lds_raw) {

        const float* mod = MOD + (size_t)layer * NB * NMOD;
        const float* xin = layer == 0 ? (const float*)a.in[0] : a.out;
        if (EN(1) && IN(ph)) norm_phase(xin, (const float*)a.in[5] + (size_t)layer * DM, mod, mod + DM, (bf16r*)(ws + WS_H));
#ifdef TWICE_NORM
        if (IN(ph)) norm_phase(xin, (const float*)a.in[5] + (size_t)layer * DM, mod, mod + DM, (bf16r*)(ws + WS_H));
#endif
        SEAM();
        if (EN(2) && IN(ph)) { pg8::Gemm g{(const pg8::bf16_t*)(ws + WS_H), (const pg8::bf16_t*)(ws + WS_WIN + layer * WIN_BYTES), MROWS, NINP, DM}; pg8::StaticOrder S; S.init(MROWS, NINP, gridDim.x, lz_bid());
            pg8::EpiIn E{(pg8::bf16_t*)(ws + WS_P), (float*)(ws + WS_GATES)};
            pg8::gemm_phase<pg8::EpiIn, pg8::StaticOrder, true, true>(lds, g, S, E);
            gate_gemm((const bf16r*)(ws + WS_H), (const bf16r*)(ws + WS_WG + layer * WG_BYTES), (float*)(ws + WS_GATES));
#ifdef TWICE_IN
            __syncthreads(); pg8::gemm_phase<pg8::EpiIn, pg8::StaticOrder, true, true>(lds, g, S, E);
#endif
        }
        SEAM();
        if (EN(3) && IN(ph)) prep_phase(a, layer, lds);
#ifdef TWICE_INPREP
        if (IN(ph)) { xcd_barrier(xbar);
            { pg8::Gemm g{(const pg8::bf16_t*)(ws + WS_H), (const pg8::bf16_t*)(ws + WS_WIN + layer * WIN_BYTES), MROWS, NINP, DM}; pg8::StaticOrder S; S.init(MROWS, NINP, gridDim.x, lz_bid());
              pg8::EpiIn E{(pg8::bf16_t*)(ws + WS_P), (float*)(ws + WS_GATES)};
              pg8::gemm_phase<pg8::EpiIn, pg8::StaticOrder, true, true>(lds, g, S, E); }
            xcd_barrier(xbar); prep_phase(a, layer, lds); }
#endif
        SEAM();
        PROBE_F32(ws + WS_GATES, (size_t)MROWS * 16, 1 + 10 * layer); PROBE_F32(ws + WS_CNEG, (size_t)NB * 8 * SEQ, 2 + 10 * layer); PROBE_F32(ws + WS_MA, (size_t)3 * NB * 4 * SEQ, 3 + 10 * layer); PROBE_BF16(ws + WS_P, (size_t)56 * MROWS * 128, 4 + 10 * layer); PROBE_BF16(ws + WS_MQC, (size_t)8 * MROWS * 128, 5 + 10 * layer);
        if (IN(ph)) { fox_table_phase(a, layer); if (EN(4)) m1_phase(a, lds);
#if 0
#ifdef TWICE_FOX
            __syncthreads(); fox_phase(a, layer, (char*)lds_raw);
#endif
#endif
#ifdef TWICE_M1
            __syncthreads(); m1_phase(a, lds);
#endif
        }
        SEAM();
#ifdef NANPROBE
        PROBE_BF16(ws + WS_H, (size_t)MROWS * DM, 20 + layer); PROBE_F32(ws + WS_UN, (size_t)NB * 4 * 256 * 128, 22 + layer); PROBE_F32(ws + WS_MPREV, (size_t)NB * 4 * 256, 24 + layer); grid.sync();
#endif
        if (IN(ph)) { if (EN(6)) m2_phase(a, lds); __syncthreads(); if (EN(5)) fox_phase(a, layer, (char*)lds_raw);
#ifdef TWICE_FOX
            __syncthreads(); fox_phase(a, layer, (char*)lds_raw, 1);
#endif
        }
        SEAM();
        if (EN(7) && IN(ph)) m3_phase(a, layer, lds);
#ifdef TWICE_M3
        if (IN(ph)) { __syncthreads(); m3_phase(a, layer, lds); }
#endif
        SEAM();
        PROBE_BF16(ws + WS_H, (size_t)MROWS * DM, 6 + 10 * layer); PROBE_BF16(ws + WS_Y, (size_t)MROWS * DM, 7 + 10 * layer);
        if (EN(8) && IN(ph)) { pg8::Gemm g{(const pg8::bf16_t*)(ws + WS_Y), (const pg8::bf16_t*)(ws + WS_WOUT + layer * WOUT_BYTES), MROWS, DM, DM}; pg8::StaticOrder S; S.init(MROWS, DM, gridDim.x, lz_bid());
            pg8::EpiRes E{xin, a.out, mod + 2 * DM};
            pg8::gemm_phase<pg8::EpiRes, pg8::StaticOrder, true, true>(lds, g, S, E); }
        SEAM();
        PROBE_F32(a.out, (size_t)MROWS * DM, 8 + 10 * layer);
        if (EN(1) && IN(ph)) norm_phase(a.out, (const float*)a.in[6] + (size_t)layer * DM, mod + 3 * DM, mod + 4 * DM, (bf16r*)(ws + WS_H));
#ifdef TWICE_NORM
        if (IN(ph)) norm_phase(a.out, (const float*)a.in[6] + (size_t)layer * DM, mod + 3 * DM, mod + 4 * DM, (bf16r*)(ws + WS_H));
#endif
        SEAM();
        if (EN(9) && IN(ph)) { pg8::Gemm g{(const pg8::bf16_t*)(ws + WS_H), (const pg8::bf16_t*)(ws + WS_WFF1 + layer * WFF_BYTES), MROWS, DFF, DM}; pg8::StaticOrder S; S.init(MROWS, DFF, gridDim.x, lz_bid());
            pg8::EpiRelu2 E{(pg8::bf16_t*)(ws + WS_HID), DFF};
            pg8::gemm_phase<pg8::EpiRelu2, pg8::StaticOrder, true, true>(lds, g, S, E);
#ifdef TWICE_FF1
            __syncthreads(); pg8::gemm_phase<pg8::EpiRelu2, pg8::StaticOrder, true, true>(lds, g, S, E);
#endif
        }
        SEAM();
        if (EN(10) && IN(ph)) { pg8::Gemm g{(const pg8::bf16_t*)(ws + WS_HID), (const pg8::bf16_t*)(ws + WS_WFF2 + layer * WFF_BYTES), MROWS, DM, DFF}; pg8::StaticOrder S; S.init(MROWS, DM, gridDim.x, lz_bid());
            pg8::EpiRes E{a.out, a.out, mod + 5 * DM};
            pg8::gemm_phase<pg8::EpiRes, pg8::StaticOrder, true, true>(lds, g, S, E); }
        SEAM();
        PROBE_F32(a.out, (size_t)MROWS * DM, 9 + 10 * layer);
    }
__global__ void __launch_bounds__(512, 2) trunk_fwd(Args a_unused) {
    extern __shared__ __attribute__((aligned(16))) unsigned char lds_raw[];
    LAS unsigned char* lds = (LAS unsigned char*)lds_raw;
    cg::grid_group grid = cg::this_grid();
    int lo, hi; { CArgs& a0 = *fresh_args(); lo = a0.ph_lo; hi = a0.ph_hi; } int ph = 0;
    volatile LAS unsigned* xst = (volatile LAS unsigned*)(lds + 139264);
    if (lz_tid() < 2) xst[lz_tid()] = 0u;
    __syncthreads();
    if (lz_bid() == 0) { unsigned* z = (unsigned*)ws; for (int i = lz_tid(); i < 4096; i += 512) z[i] = 0u; }
#ifdef NANPROBE
    if (lz_bid() == 0 && lz_tid() < 32) ((unsigned*)(ws + WS_FLAGS))[lz_tid()] = 0u;
#endif
    if (EN(0) && IN(ph)) p0_phase(a, lds);
#ifdef TWICE_P0
    if (IN(ph)) { __syncthreads(); p0_phase(a, lds); }
#endif
    if (IN(ph) && IN(ph + 1)) grid.sync();
    ++ph;
    const XcdBarrier xbar = xcd_barrier_post((unsigned*)ws, xst);
    layer_phases<0>(ph, lo, hi, grid, xbar, lds, lds_raw);
    layer_phases<1>(ph, lo, hi, grid, xbar, lds, lds_raw);
    if (EN(11) && IN(ph)) final_norm_phase(a.out, (const float*)a.in[17]);
#ifdef NANPROBE
    { grid.sync(); float code = 0.f; const unsigned* fl = (const unsigned*)(ws + WS_FLAGS);
      const int order[16] = {1, 2, 3, 4, 5, 24, 20, 22, 6, 7, 8, 9, 11, 12, 13, 14};
      for (int q = 15; q >= 0; --q) if (fl[order[q]]) code = (float)order[q] * 1.0e6f;
      float* o = a.out; for (size_t i = (size_t)lz_bid() * 512 + lz_tid(); i < (size_t)MROWS * DM; i += (size_t)gridDim.x * 512) o[i] = (i == 0) ? code : 0.f; }
#endif
#ifdef DBG_OFF_MIB
    { grid.sync();
      const unsigned short* src = (const unsigned short*)(ws + (size_t)DBG_OFF_MIB * MiB); const size_t n = (size_t)DBG_MIB * MiB / 2; float* o = a.out;
      for (size_t i = (size_t)lz_bid() * 512 + lz_tid(); i < (size_t)MROWS * DM; i += (size_t)gridDim.x * 512) { const size_t k = (4 * i) % n;
          o[i] = (float)src[k] + 3.f * (float)src[k + 1] + 5.f * (float)src[k + 2] + 7.f * (float)src[k + 3]; } }
#endif
#undef IN
#undef SEAM
#undef a
#undef ws
#undef MOD
}

#ifndef MK_PER_PHASE
#define MK_PER_PHASE 0
#endif
extern "C" void kernel_launch(void* const* d_in, const int* in_sizes, int n_in, void* d_out, int out_size, void* d_ws, size_t ws_size, hipStream_t stream) {
    static int grid = 0;
    if (grid == 0) {
        if (n_in != 18 || in_sizes[0] != MROWS * DM || out_size != MROWS * DM || ws_size < WS_END) { fprintf(stderr, "kernel_launch: unexpected shapes (n_in %d, in0 %d, out %d, ws %zu)\n", n_in, n_in > 0 ? in_sizes[0] : -1, out_size, ws_size); grid = -1; return; }
        int dev = 0, cus = 0, per_cu = 0;
        if (hipGetDevice(&dev) != hipSuccess || hipDeviceGetAttribute(&cus, hipDeviceAttributeMultiprocessorCount, dev) != hipSuccess) { grid = -1; return; }
        if (hipFuncSetAttribute((const void*)trunk_fwd, hipFuncAttributeMaxDynamicSharedMemorySize, LDS_BYTES) != hipSuccess) { fprintf(stderr, "kernel_launch: hipFuncSetAttribute failed\n"); grid = -1; return; }
        if (hipOccupancyMaxActiveBlocksPerMultiprocessor(&per_cu, (const void*)trunk_fwd, 512, LDS_BYTES) != hipSuccess || per_cu < 1) { fprintf(stderr, "kernel_launch: occupancy query says %d\n", per_cu); per_cu = 1; }
        (void)hipGetLastError();
        grid = cus;
    }
    if (grid < 0) return;
    Args a{};
    for (int i = 0; i < 18; ++i) a.in[i] = d_in[i];
    a.out = (float*)d_out; a.ws = (unsigned char*)d_ws;
    constexpr int NPH = 1 + 2 * 10 + 1;
#if MK_PER_PHASE
    for (int p = 0; p < NPH; ++p) { a.ph_lo = p; a.ph_hi = p + 1; hipLaunchKernelGGL(trunk_fwd, dim3(grid), dim3(512), LDS_BYTES, stream, a); }
#else
#ifdef DBG_HI
    a.ph_lo = 0; a.ph_hi = DBG_HI;
#else
    a.ph_lo = 0; a.ph_hi = NPH;
#endif
    void* args[] = {&a};
    hipError_t e = hipLaunchCooperativeKernel((const void*)trunk_fwd, dim3(grid), dim3(512), args, LDS_BYTES, stream);
    if (e != hipSuccess) fprintf(stderr, "kernel_launch: cooperative launch failed: %s (grid %d)\n", hipGetErrorString(e), grid);
#endif
}
```

```cpp
#include <hip/hip_runtime.h>
#include <hip/hip_bf16.h>
#include <hip/hip_cooperative_groups.h>
#include <cstdio>
#include <cstdint>
namespace cg = cooperative_groups;

constexpr int NB = 2, SEQ = 16384, DM = 2048, MROWS = NB * SEQ, DIN = 7184, NINP = 7168, DFF = 8192, HD = 128, NMOD = 6 * DM;
constexpr int NSLOT = 56;
constexpr float NORM_EPS = 1e-6f;
constexpr float KSCALE = 0.08838834764831845f;

__device__ __forceinline__ int lz_tid() { const int w = __builtin_amdgcn_readfirstlane((int)threadIdx.x >> 6); int l; asm volatile("v_mbcnt_lo_u32_b32 %0, -1, 0\n\tv_mbcnt_hi_u32_b32 %0, -1, %0" : "=v"(l));
    int t = w * 64 + l; asm volatile("" : "+v"(t)); return t; }
__device__ __forceinline__ int lz_bid() { int b = blockIdx.x; asm volatile("" : "+s"(b)); return b; }

namespace pg8 {
#define PG8_LAS __attribute__((address_space(3)))
typedef unsigned short bf16_t;
typedef short bf16x8 __attribute__((ext_vector_type(8)));
typedef float f32x4 __attribute__((ext_vector_type(4)));
typedef unsigned u32x4 __attribute__((ext_vector_type(4)));
constexpr int BM = 256, BK = 64, HALF = 128, HTB = HALF * BK * 2  , STAGE_BYTES = 8 * HTB, NXCD = 8, WGM = 4;

__host__ __device__ __forceinline__ int lds_byte(int r, int c) { const int st = (r >> 4) * 2 + (c >> 5), rr = r & 15, cc = c & 31, ob = rr * 64 + cc * 2; return st * 1024 + (ob ^ (((ob >> 9) & 1) << 5)); }
__host__ __device__ __forceinline__ void stage_rc(int b, int& R, int& C) { const int st = b / 1024, sb = b % 1024, swz = sb ^ (((sb >> 9) & 1) << 5); R = (st >> 1) * 16 + swz / 64; C = (st & 1) * 32 + (swz % 64) / 2; }
__host__ __device__ __forceinline__ int perm32(int rho) { const int n = rho >> 4, i = rho & 15; return 8 * (i >> 2) + 4 * n + (i & 3); }

struct Unit { int pm, pn; };
struct Gemm { const bf16_t* A; const bf16_t* Bt; int M, N, K; };

struct StaticOrder {
    int nM, nN, nwg, G, c;
    __host__ __device__ void init(int M, int N, int G_, int c_) { nM = M / BM; nN = N / BM; nwg = nM * nN; G = G_; c = c_; }
    __host__ __device__ bool next(int i, Unit& u) const {
        const long L = (long)i * G + c; if (L >= nwg) return false;
        int wgid = (int)L; { const int q = nwg / NXCD, r = nwg % NXCD, xcd = wgid % NXCD, off = wgid / NXCD; wgid = (xcd < r ? xcd * (q + 1) : r * (q + 1) + (xcd - r) * q) + off; }
        const int nig = WGM * nN, gid = wgid / nig, fm = gid * WGM, gsz = (nM - fm) < WGM ? (nM - fm) : WGM;
        u.pm = fm + ((wgid % nig) % gsz); u.pn = (wgid % nig) / gsz; return true;
    }
    __device__ __forceinline__ void a_ready(const Unit&) const {}
    __device__ __forceinline__ void done(const Unit&) const {}
};

__device__ __forceinline__ unsigned cvt_pk_bf16(float lo, float hi) { unsigned r; asm volatile("v_cvt_pk_bf16_f32 %0, %1, %2" : "=v"(r) : "v"(lo), "v"(hi)); return r; }

typedef float epf2_t __attribute__((ext_vector_type(2))); typedef __bf16 epb2_t __attribute__((ext_vector_type(2)));
__device__ __forceinline__ unsigned cvt_pk_c(float lo, float hi) { epf2_t v = {lo, hi}; epb2_t b = __builtin_convertvector(v, epb2_t); return __builtin_bit_cast(unsigned, b); }
struct EpiIn {
    static constexpr bool PERM = true, AFTER_DRAIN = false;
    bf16_t* P; float* gates;
    __device__ __forceinline__ void operator()(const f32x4 (&acc)[2][2][4][2], const Unit& u, int wr, int wc, int fr, int fq) const {
        const int row0 = u.pm * BM + wr * 64 + fr;
#pragma unroll
        for (int bj = 0; bj < 2; ++bj) {
            const int g = 2 * u.pn + bj;
            if (g < 56) {
                bf16_t* base = P + ((size_t)g * MROWS + row0) * 128 + wc * 32 + 8 * fq;
#pragma unroll
                for (int ai = 0; ai < 2; ++ai)
#pragma unroll
                    for (int m = 0; m < 4; ++m) { const f32x4 v0 = acc[ai][bj][m][0], v1 = acc[ai][bj][m][1];
                        u32x4 w; w.x = cvt_pk_c(v0[0], v0[1]); w.y = cvt_pk_c(v0[2], v0[3]); w.z = cvt_pk_c(v1[0], v1[1]); w.w = cvt_pk_c(v1[2], v1[3]);
                        *(u32x4*)(base + (size_t)(ai * HALF + m * 16) * 128) = w; }
            } else if (g == 56) {
                if (wc == 0 && fq < 2) { float* gp = gates + (size_t)row0 * 16 + 8 * fq;
#pragma unroll
                    for (int ai = 0; ai < 2; ++ai)
#pragma unroll
                        for (int m = 0; m < 4; ++m) { *(f32x4*)(gp + (size_t)(ai * HALF + m * 16) * 16) = acc[ai][bj][m][0]; *(f32x4*)(gp + (size_t)(ai * HALF + m * 16) * 16 + 4) = acc[ai][bj][m][1]; } }
            }
        }
    }
};
struct EpiRes {
    static constexpr bool PERM = true, AFTER_DRAIN = false;
    const float* base; float* out; const float* gvec;
    __device__ __forceinline__ void operator()(const f32x4 (&acc)[2][2][4][2], const Unit& u, int wr, int wc, int fr, int fq) const {
        const int row0 = u.pm * BM + wr * 64 + fr; const int b = (u.pm * BM) / SEQ; const float* gv = gvec + (size_t)b * NMOD;
#pragma unroll
        for (int bj = 0; bj < 2; ++bj) { const int c = u.pn * BM + bj * HALF + wc * 32 + 8 * fq;
            const f32x4 g0 = *(const f32x4*)(gv + c), g1 = *(const f32x4*)(gv + c + 4);
#pragma unroll
            for (int ai = 0; ai < 2; ++ai)
#pragma unroll
                for (int m = 0; m < 4; ++m) { const size_t off = (size_t)(row0 + ai * HALF + m * 16) * DM + c;
                    const f32x4 x0 = *(const f32x4*)(base + off), x1 = *(const f32x4*)(base + off + 4);
                    *(f32x4*)(out + off) = x0 + g0 * acc[ai][bj][m][0]; *(f32x4*)(out + off + 4) = x1 + g1 * acc[ai][bj][m][1]; } }
    }
};
struct EpiRelu2 {
    static constexpr bool PERM = true, AFTER_DRAIN = false;
    bf16_t* O; int ldc;
    __device__ __forceinline__ void operator()(const f32x4 (&acc)[2][2][4][2], const Unit& u, int wr, int wc, int fr, int fq) const {
        const int row0 = u.pm * BM + wr * 64 + fr;
#pragma unroll
        for (int bj = 0; bj < 2; ++bj) { bf16_t* base = O + (size_t)row0 * ldc + u.pn * BM + bj * HALF + wc * 32 + 8 * fq;
#pragma unroll
            for (int ai = 0; ai < 2; ++ai)
#pragma unroll
                for (int m = 0; m < 4; ++m) { f32x4 v0 = acc[ai][bj][m][0], v1 = acc[ai][bj][m][1];
#pragma unroll
                    for (int i = 0; i < 4; ++i) { const float a = v0[i] > 0.f ? v0[i] : 0.f, b = v1[i] > 0.f ? v1[i] : 0.f; v0[i] = a * a; v1[i] = b * b; }
                    u32x4 w; w.x = cvt_pk_c(v0[0], v0[1]); w.y = cvt_pk_c(v0[2], v0[3]); w.z = cvt_pk_c(v1[0], v1[1]); w.w = cvt_pk_c(v1[2], v1[3]);
                    *(u32x4*)(base + (size_t)(ai * HALF + m * 16) * ldc) = w; } }
    }
};

template <class Epi, class Sched, bool ALIGN_EPI = false, bool SP2 = false>
__device__ __forceinline__ void gemm_phase(PG8_LAS unsigned char* lds, const Gemm g, const Sched& S, const Epi& E) {
    const int tid = lz_tid(), wid = __builtin_amdgcn_readfirstlane(tid >> 6), lane = tid & 63, wr = wid >> 2, wc = wid & 3, fr = lane & 15, fq = lane >> 4;
    const int K = g.K, nt = K / BK;
    unsigned voffA[2], voffB[2];
#pragma unroll
    for (int i = 0; i < 2; ++i) { int R, C; stage_rc(tid * 16 + i * 8192, R, C); const int Rb = Epi::PERM ? ((R & ~31) + perm32(R & 31)) : R;
        voffA[i] = (unsigned)(R * K + C) * 2u; voffB[i] = (unsigned)(Rb * K + C) * 2u; }
    const size_t kstep = (size_t)(BK * 2);
    const size_t hstep = (size_t)HALF * K * 2;
    const size_t tstep = 2 * hstep;
    const unsigned ldsw = (unsigned)wid * 1024u;
    const int aoff = lds_byte(wr * 64 + fr, fq * 8), boff = lds_byte(wc * 32 + fr, fq * 8);
#define PG8_SA(b, h) (((b) * 2 + (h)) * HTB)
#define PG8_SB(b, h) ((4 + (b) * 2 + (h)) * HTB)
#define PG8_STAGE(bufoff, gbase, voff) do { _Pragma("unroll") for (int _i = 0; _i < 2; ++_i) \
        __builtin_amdgcn_global_load_lds((const unsigned*)((const char*)(gbase) + (voff)[_i]), (PG8_LAS unsigned*)(lds + (bufoff) + ldsw + _i * 8192), 16, 0, 0); } while (0)
#define PG8_LDA(dst, b, h) do { _Pragma("unroll") for (int m = 0; m < 4; ++m) _Pragma("unroll") for (int k = 0; k < 2; ++k) dst[m][k] = *(const PG8_LAS bf16x8*)(lds + PG8_SA(b, h) + aoff + m * 2048 + k * 1024); } while (0)
#define PG8_LDB(dst, b, h) do { _Pragma("unroll") for (int n = 0; n < 2; ++n) _Pragma("unroll") for (int k = 0; k < 2; ++k) dst[n][k] = *(const PG8_LAS bf16x8*)(lds + PG8_SB(b, h) + boff + n * 2048 + k * 1024); } while (0)
#define PG8_MMA(ai, bj, At, Bt) do { __builtin_amdgcn_s_setprio(1); _Pragma("unroll") for (int m = 0; m < 4; ++m) _Pragma("unroll") for (int n = 0; n < 2; ++n) _Pragma("unroll") for (int k = 0; k < 2; ++k) \
        acc[ai][bj][m][n] = __builtin_amdgcn_mfma_f32_16x16x32_bf16(Bt[n][k], At[m][k], acc[ai][bj][m][n], 0, 0, 0); __builtin_amdgcn_s_setprio(0); } while (0)
#define PG8_WAIT_V(n) asm volatile("s_waitcnt vmcnt(" #n ")" ::: "memory")
#define PG8_WAIT_L(n) asm volatile("s_waitcnt lgkmcnt(" #n ")" ::: "memory")
#define PG8_BAR __builtin_amdgcn_s_barrier()
#define PG8_SCHED __builtin_amdgcn_sched_barrier(0)
    Unit cur, nxt; int ui = 0;
    if (!S.next(0, cur)) return;
    f32x4 acc[2][2][4][2];
#pragma unroll
    for (int a = 0; a < 2; ++a)
#pragma unroll
        for (int b = 0; b < 2; ++b)
#pragma unroll
            for (int m = 0; m < 4; ++m)
#pragma unroll
                for (int n = 0; n < 2; ++n) acc[a][b][m][n] = (f32x4){0.f, 0.f, 0.f, 0.f};
    bf16x8 At[4][2], B0[2][2], B1[2][2];
    const char* cA = (const char*)g.A + (size_t)cur.pm * tstep; const char* cB = (const char*)g.Bt + (size_t)cur.pn * tstep;
    S.a_ready(cur);
    if constexpr (SP2) {
        PG8_STAGE(PG8_SB(0, 0), cB, voffB); PG8_STAGE(PG8_SB(0, 1), cB + hstep, voffB); PG8_STAGE(PG8_SA(0, 0), cA, voffA); PG8_STAGE(PG8_SA(0, 1), cA + hstep, voffA);
        if (wr == 1) PG8_BAR;
        PG8_WAIT_V(2); PG8_BAR;
        PG8_STAGE(PG8_SB(1, 0), cB + kstep, voffB); PG8_STAGE(PG8_SA(1, 0), cA + kstep, voffA); PG8_STAGE(PG8_SB(1, 1), cB + hstep + kstep, voffB);
        PG8_WAIT_V(6); PG8_BAR;
    } else {
        PG8_STAGE(PG8_SB(0, 0), cB, voffB); PG8_STAGE(PG8_SA(0, 0), cA, voffA); PG8_STAGE(PG8_SB(0, 1), cB + hstep, voffB); PG8_STAGE(PG8_SA(0, 1), cA + hstep, voffA);
        if (wr == 1) PG8_BAR;
        PG8_WAIT_V(4); PG8_BAR;
        PG8_STAGE(PG8_SB(1, 0), cB + kstep, voffB); PG8_STAGE(PG8_SA(1, 0), cA + kstep, voffA); PG8_STAGE(PG8_SB(1, 1), cB + hstep + kstep, voffB);
        PG8_WAIT_V(6); PG8_BAR;
    }
    for (;;) {
        const bool has_next = S.next(ui + 1, nxt);
        const char* nA = has_next ? (const char*)g.A + (size_t)nxt.pm * tstep : cA; const char* nB = has_next ? (const char*)g.Bt + (size_t)nxt.pn * tstep : cB;
        for (int t = 0; t < nt; t += 2) {
            const bool last = (t == nt - 2);
            const char* a1 = cA + (size_t)(t + 1) * kstep;
            const char* a2 = last ? nA : cA + (size_t)(t + 2) * kstep; const char* b2 = last ? nB : cB + (size_t)(t + 2) * kstep;
            const char* a3 = a2 + kstep; const char* b3 = b2 + kstep;
            if (last && has_next) S.a_ready(nxt);
            if constexpr (SP2) {
            PG8_LDB(B0, 0, 0); PG8_LDB(B1, 0, 1); PG8_SCHED; PG8_LDA(At, 0, 0); PG8_STAGE(PG8_SA(1, 1), a1 + hstep, voffA);
            PG8_WAIT_V(8); PG8_WAIT_L(0); PG8_BAR; PG8_MMA(0, 0, At, B0); PG8_MMA(0, 1, At, B1); PG8_BAR; PG8_SCHED;
            PG8_LDA(At, 0, 1); PG8_STAGE(PG8_SB(0, 0), b2, voffB); PG8_STAGE(PG8_SB(0, 1), b2 + hstep, voffB); PG8_STAGE(PG8_SA(0, 0), a2, voffA);
            PG8_WAIT_V(8); PG8_WAIT_L(0); PG8_BAR; PG8_MMA(1, 0, At, B0); PG8_MMA(1, 1, At, B1); PG8_BAR; PG8_SCHED;
            PG8_LDB(B0, 1, 0); PG8_LDB(B1, 1, 1); PG8_SCHED; PG8_LDA(At, 1, 0); PG8_STAGE(PG8_SA(0, 1), a2 + hstep, voffA);
            PG8_WAIT_V(8); PG8_WAIT_L(0); PG8_BAR; PG8_MMA(0, 0, At, B0); PG8_MMA(0, 1, At, B1); PG8_BAR; PG8_SCHED;
            PG8_LDA(At, 1, 1); PG8_STAGE(PG8_SB(1, 0), b3, voffB); PG8_STAGE(PG8_SB(1, 1), b3 + hstep, voffB); PG8_STAGE(PG8_SA(1, 0), a3, voffA);
            PG8_WAIT_V(8); PG8_WAIT_L(0); PG8_BAR; PG8_MMA(1, 0, At, B0); PG8_MMA(1, 1, At, B1); PG8_BAR; PG8_SCHED;
            } else {
            PG8_LDB(B0, 0, 0); PG8_SCHED; PG8_LDA(At, 0, 0); PG8_STAGE(PG8_SA(1, 1), a1 + hstep, voffA);
            PG8_WAIT_L(8); PG8_BAR; PG8_WAIT_L(0); PG8_MMA(0, 0, At, B0); PG8_BAR; PG8_SCHED;
            PG8_LDB(B1, 0, 1); PG8_STAGE(PG8_SB(0, 0), b2, voffB);
            PG8_BAR; PG8_WAIT_L(0); PG8_MMA(0, 1, At, B1); PG8_BAR;
            PG8_LDA(At, 0, 1); PG8_STAGE(PG8_SA(0, 0), a2, voffA);
            PG8_BAR; PG8_WAIT_L(0); PG8_MMA(1, 0, At, B0); PG8_BAR; PG8_SCHED;
            PG8_STAGE(PG8_SB(0, 1), b2 + hstep, voffB);
            PG8_WAIT_V(6); PG8_BAR; PG8_MMA(1, 1, At, B1); PG8_BAR;
            PG8_LDB(B0, 1, 0); PG8_SCHED; PG8_LDA(At, 1, 0); PG8_STAGE(PG8_SA(0, 1), a2 + hstep, voffA);
            PG8_WAIT_L(8); PG8_BAR; PG8_WAIT_L(0); PG8_MMA(0, 0, At, B0); PG8_BAR; PG8_SCHED;
            PG8_LDB(B1, 1, 1); PG8_STAGE(PG8_SB(1, 0), b3, voffB);
            PG8_BAR; PG8_WAIT_L(0); PG8_MMA(0, 1, At, B1); PG8_BAR;
            PG8_LDA(At, 1, 1); PG8_STAGE(PG8_SA(1, 0), a3, voffA);
            PG8_BAR; PG8_WAIT_L(0); PG8_MMA(1, 0, At, B0); PG8_BAR; PG8_SCHED;
            PG8_STAGE(PG8_SB(1, 1), b3 + hstep, voffB);
            PG8_WAIT_V(6); PG8_BAR; PG8_MMA(1, 1, At, B1); PG8_BAR;
            }
        }
        if constexpr (ALIGN_EPI) { if (wr == 0) PG8_BAR; }
        if constexpr (!Epi::AFTER_DRAIN) { E(acc, cur, wr, wc, fr, fq); S.done(cur); }
        if (!has_next) break;
#pragma unroll
        for (int a = 0; a < 2; ++a)
#pragma unroll
            for (int b = 0; b < 2; ++b)
#pragma unroll
                for (int m = 0; m < 4; ++m)
#pragma unroll
                    for (int n = 0; n < 2; ++n) acc[a][b][m][n] = (f32x4){0.f, 0.f, 0.f, 0.f};
        cur = nxt; cA = nA; cB = nB; ++ui;
        if constexpr (ALIGN_EPI) { if (wr == 1) PG8_BAR; }
    }
    PG8_WAIT_V(0);
    if constexpr (!ALIGN_EPI) { if (wr == 0) PG8_BAR; }
    PG8_BAR;
    if constexpr (Epi::AFTER_DRAIN) { E.fused(acc, cur, wr, wc, fr, fq, lds, wid, lane); S.done(cur); }
#undef PG8_SA
#undef PG8_SB
#undef PG8_STAGE
#undef PG8_LDA
#undef PG8_LDB
#undef PG8_MMA
#undef PG8_WAIT_V
#undef PG8_WAIT_L
#undef PG8_BAR
#undef PG8_SCHED
}
}
namespace fox {
constexpr int D = 128; constexpr float THR = 16.f; constexpr bool WSKIP = false; constexpr int OSTR = 2048;
constexpr float SCALE = 0.08838834764831845f;
constexpr int NW = 8, QBLK = 32, KVBLK = 64, QB = NW * QBLK;
constexpr int SHM_V = KVBLK * D * 2, SHM_K = KVBLK * D * 2;
constexpr int LDS_CB = 2 * SHM_V + 2 * SHM_K + NW * 64 * 4; constexpr int LDS_BYTES = LDS_CB + 2 * 64 * 4;

using bf16 = __hip_bfloat16;
typedef short bf16x8 __attribute__((ext_vector_type(8)));
typedef short s16x4 __attribute__((ext_vector_type(4)));
typedef float f32x16 __attribute__((ext_vector_type(16)));
typedef float f32x4 __attribute__((ext_vector_type(4)));
typedef unsigned u32x4 __attribute__((ext_vector_type(4)));
template <class A, class Bt> struct same_t { static constexpr bool v = false; };
template <class A> struct same_t<A, A> { static constexpr bool v = true; };

#define KSWZ(row, colB) ((row) * 256 + ((colB) ^ (((row) & 7) << 4)))
#define SBAR() __builtin_amdgcn_sched_barrier(0)
__device__ __forceinline__ int v_st(int k, int c) { const int kk = (k & ~0xC) | ((k & 4) << 1) | ((k & 8) >> 1); return ((kk >> 3) * 4 + (c >> 5)) * 512 + ((kk & 7) * 32 + (c & 31)) * 2; }
__device__ __forceinline__ int v_rd_base(int lane) { return ((lane & 3) << 3) | (((lane >> 2) & 3) << 6) | (((lane >> 4) & 1) << 5) | (((lane >> 5) & 1) << 8); }
constexpr int v_rd_off(int d0, int ks, int half) { return d0 * 512 + ks * 4096 + half * 2048; }
__device__ __forceinline__ int crow(int r, int hi) { return (r & 3) + 8 * (r >> 2) + 4 * hi; }
__device__ __forceinline__ unsigned cvtpk(float lo, float hi) {
    unsigned r; asm volatile("v_cvt_pk_bf16_f32 %0, %1, %2" : "=v"(r) : "v"(lo), "v"(hi)); return r;
}
__device__ __forceinline__ bf16x8 pack8(f32x4 a, f32x4 b) {
    u32x4 w = {cvtpk(a[0], a[1]), cvtpk(a[2], a[3]), cvtpk(b[0], b[1]), cvtpk(b[2], b[3])};
    return *reinterpret_cast<bf16x8*>(&w);
}
template <class T> __device__ __forceinline__ bf16x8 load8(const T* p) {
    if constexpr (same_t<T, float>::v) { return pack8(*(const f32x4*)p, *(const f32x4*)(p + 4)); }
    else { return *reinterpret_cast<const bf16x8*>(p); }
}
__device__ __forceinline__ void mask_tile(f32x16& p0, f32x16& p1, int dq, unsigned W) {
    const float NEG = -__builtin_inff();
#pragma unroll
    for (int r = 0; r < 16; ++r) {
        const int c = (r & 3) + 8 * (r >> 2);
        if ((unsigned)(dq - c) >= W) p0[r] = NEG;
        if ((unsigned)(dq - c - 32) >= W) p1[r] = NEG;
    }
}
__device__ __forceinline__ void partialSM(f32x16& p0, f32x16& p1, float& m_reg, float& mn, float& alpha) {
    float pmax = p0[0]; for (int r = 1; r < 16; ++r) pmax = fmaxf(pmax, p0[r]); for (int r = 0; r < 16; ++r) pmax = fmaxf(pmax, p1[r]);
    { auto rr = __builtin_amdgcn_permlane32_swap(__float_as_uint(pmax), __float_as_uint(pmax), false, false);
      pmax = fmaxf(__uint_as_float(rr[0]), __uint_as_float(rr[1])); }
    constexpr float C2 = 1.4426950408889634f * SCALE;
    if (__builtin_expect(__all((pmax - m_reg) * SCALE <= THR), 1)) { mn = m_reg; alpha = 1.f; }
    else { mn = fmaxf(m_reg, pmax); alpha = __builtin_amdgcn_exp2f((m_reg - mn) * C2); m_reg = mn; }
    const float mnL = -mn * C2;
    for (int r = 0; r < 16; ++r) p0[r] = fmaf(p0[r], C2, mnL); for (int r = 0; r < 16; ++r) p1[r] = fmaf(p1[r], C2, mnL);
    for (int r = 0; r < 16; ++r) p0[r] = __builtin_amdgcn_exp2f(p0[r]);
}
__device__ __forceinline__ void finishSM(f32x16& p0, f32x16& p1, float alpha, float& l_reg, bf16x8& pa0, bf16x8& pa1, bf16x8& pa2, bf16x8& pa3) {
    for (int r = 0; r < 16; ++r) p1[r] = __builtin_amdgcn_exp2f(p1[r]);
    float ps = 0; for (int r = 0; r < 16; ++r) ps += p0[r]; for (int r = 0; r < 16; ++r) ps += p1[r];
    { auto rr = __builtin_amdgcn_permlane32_swap(__float_as_uint(ps), __float_as_uint(ps), false, false);
      ps = __uint_as_float(rr[0]) + __uint_as_float(rr[1]); }
    l_reg = l_reg * alpha + ps;
#define PK4(P, B_, OUT) do { unsigned a0 = cvtpk(P[B_+0], P[B_+1]), a1 = cvtpk(P[B_+2], P[B_+3]);                          \
        unsigned b0 = cvtpk(P[B_+4], P[B_+5]), b1 = cvtpk(P[B_+6], P[B_+7]);                                             \
        auto r0 = __builtin_amdgcn_permlane32_swap(a0, b0, false, false); auto r1 = __builtin_amdgcn_permlane32_swap(a1, b1, false, false); \
        u32x4 w = {r0[0], r1[0], r0[1], r1[1]}; OUT = *reinterpret_cast<bf16x8*>(&w); } while (0)
    PK4(p0, 0, pa0); PK4(p0, 8, pa1); PK4(p1, 0, pa2); PK4(p1, 8, pa3);
#undef PK4
}
template <int KB, bool SK>
__device__ __forceinline__ void qkt(f32x16& p0, f32x16& p1, const char* K_lds, const float* cb, int r32, int hi, const bf16x8* qr, bool act) {
    if (SK && !act) { const float NEG = -__builtin_inff();
#pragma unroll
        for (int r = 0; r < 16; ++r) { p0[r] = NEG; p1[r] = NEG; } return; }
    { const float* cbp = cb + KB * 64 + 4 * hi;
#pragma unroll
      for (int g = 0; g < 4; ++g) { const f32x4 t0 = *(const f32x4*)(cbp + 8 * g), t1 = *(const f32x4*)(cbp + 32 + 8 * g);
        p0[4*g] = t0[0]; p0[4*g+1] = t0[1]; p0[4*g+2] = t0[2]; p0[4*g+3] = t0[3]; p1[4*g] = t1[0]; p1[4*g+1] = t1[1]; p1[4*g+2] = t1[2]; p1[4*g+3] = t1[3]; } }
    const char* kb[4];
#pragma unroll
    for (int dd = 0; dd < 4; ++dd) kb[dd] = K_lds + KB * SHM_K + KSWZ(r32, (dd * 16 + hi * 8) * 2);
#pragma unroll
    for (int d0 = 0; d0 < 8; ++d0) { const char* a = kb[d0 & 3] + (d0 >> 2) * 128;
        bf16x8 b0 = *reinterpret_cast<const bf16x8*>(a);
        bf16x8 b1 = *reinterpret_cast<const bf16x8*>(a + 32 * 256);
        p0 = __builtin_amdgcn_mfma_f32_32x32x16_bf16(b0, qr[d0], p0, 0, 0, 0);
        p1 = __builtin_amdgcn_mfma_f32_32x32x16_bf16(b1, qr[d0], p1, 0, 0, 0); }
}
template <int VB, bool SK>
__device__ __forceinline__ void pv_tile(f32x16* o, int vb0, bf16x8 pa0, bf16x8 pa1, bf16x8 pa2, bf16x8 pa3, bool act) {
    if (SK && !act) return;
#define TRRD(dst, off) asm volatile("ds_read_b64_tr_b16 %0, %1 offset:%2" : "=&v"(dst) : "v"(vb0), "i"(off) : "memory")
#define PV_D0(d0) do { s16x4 l0, l1, l2, l3, h0, h1, h2, h3; constexpr int b_ = VB * SHM_V + v_rd_off(d0, 0, 0);     \
        TRRD(l0, b_); TRRD(h0, b_ + 2048); TRRD(l1, b_ + 4096); TRRD(h1, b_ + 6144); TRRD(l2, b_ + 8192); TRRD(h2, b_ + 10240); TRRD(l3, b_ + 12288); TRRD(h3, b_ + 14336); \
        asm volatile("s_waitcnt lgkmcnt(0)" ::: "memory"); SBAR();                 \
        o[d0] = __builtin_amdgcn_mfma_f32_32x32x16_bf16(pa0, (bf16x8){l0[0], l0[1], l0[2], l0[3], h0[0], h0[1], h0[2], h0[3]}, o[d0], 0, 0, 0);   \
        o[d0] = __builtin_amdgcn_mfma_f32_32x32x16_bf16(pa1, (bf16x8){l1[0], l1[1], l1[2], l1[3], h1[0], h1[1], h1[2], h1[3]}, o[d0], 0, 0, 0);   \
        o[d0] = __builtin_amdgcn_mfma_f32_32x32x16_bf16(pa2, (bf16x8){l2[0], l2[1], l2[2], l2[3], h2[0], h2[1], h2[2], h2[3]}, o[d0], 0, 0, 0);   \
        o[d0] = __builtin_amdgcn_mfma_f32_32x32x16_bf16(pa3, (bf16x8){l3[0], l3[1], l3[2], l3[3], h3[0], h3[1], h3[2], h3[3]}, o[d0], 0, 0, 0); } while (0)
    PV_D0(0); PV_D0(1); PV_D0(2); PV_D0(3);
#undef PV_D0
#undef TRRD
}

template <class TIn, class TOut> struct BlockRef { const TIn* Q; TOut* O; const float* MS; unsigned K, V, C; int P0; int JLO; };
__device__ __forceinline__ bf16x8 bl128(__amdgpu_buffer_rsrc_t rs, unsigned vo, unsigned so) { return __builtin_bit_cast(bf16x8, __builtin_amdgcn_raw_buffer_load_b128(rs, (int)vo, (int)so, 0)); }
__device__ __forceinline__ float bl32(__amdgpu_buffer_rsrc_t rs, unsigned vo, unsigned so) { return __builtin_bit_cast(float, __builtin_amdgcn_raw_buffer_load_b32(rs, (int)vo, (int)so, 0)); }
template <class TIn> struct Seam {
    bf16x8 qr[8];
    bf16x8 st_v0, st_v1, st_k0, st_k1; f32x4 sf0, sf1, sf2, sf3; float st_c;
    f32x4 tq[16];
};
__device__ __forceinline__ int swa_jlo(int P0, int W) { const int lowk = P0 - W + 1; return lowk > 0 ? lowk / KVBLK : 0; }
#define ROW(p, k0, rr) ((p) + (unsigned)(((k0) + (rr)) * D + sc))
#define VMW() asm volatile("s_waitcnt vmcnt(0)" ::: "memory")
#define VMWN(n) asm volatile("s_waitcnt vmcnt(%0)" :: "i"(n) : "memory")
#define SLOAD_H(Kp, Vp, Cp, k0) do { if (tid < 64) S.st_c = bl32(rs, (unsigned)tid * 4u, (Cp) + (unsigned)(k0) * 4u); \
        S.st_v0 = bl128(rs, vo_st, (Vp) + (unsigned)(k0) * 256u); S.st_v1 = bl128(rs, vo_st, (Vp) + (unsigned)(k0) * 256u + 8192u); \
        S.st_k0 = bl128(rs, vo_st, (Kp) + (unsigned)(k0) * 256u); S.st_k1 = bl128(rs, vo_st, (Kp) + (unsigned)(k0) * 256u + 8192u); } while (0)
#define SWRITE_HK(bf) do { if (tid < 64) cb_l[(bf) * 64 + tid] = S.st_c;  *(bf16x8*)(K_lds + (bf) * SHM_K + kws) = S.st_k0; *(bf16x8*)(K_lds + (bf) * SHM_K + kws + 32 * 256) = S.st_k1; } while (0)
#define SWRITE_HV(bf) do { *(bf16x8*)(V_lds + (bf) * SHM_V + vst0) = S.st_v0; *(bf16x8*)(V_lds + (bf) * SHM_V + vst1) = S.st_v1; } while (0)
#define SWRITE_H(bf) do { SWRITE_HV(bf); SWRITE_HK(bf); } while (0)
#define SLOAD_F(p, k0) do { S.sf0 = *(const f32x4*)ROW(p, k0, sr); S.sf1 = *(const f32x4*)(ROW(p, k0, sr) + 4);                \
                            S.sf2 = *(const f32x4*)ROW(p, k0, 32 + sr); S.sf3 = *(const f32x4*)(ROW(p, k0, 32 + sr) + 4); } while (0)
#define SWRITE_KF(bf) do { *(bf16x8*)(K_lds + (bf) * SHM_K + kws) = pack8(S.sf0, S.sf1); *(bf16x8*)(K_lds + (bf) * SHM_K + kws + 32 * 256) = pack8(S.sf2, S.sf3); } while (0)
#define SWRITE_VF(bf) do { *(bf16x8*)(V_lds + (bf) * SHM_V + vst0) = pack8(S.sf0, S.sf1); *(bf16x8*)(V_lds + (bf) * SHM_V + vst1) = pack8(S.sf2, S.sf3); } while (0)
template <class TIn, class TOut>
__device__ __forceinline__ void causal_swa_prime(const BlockRef<TIn, TOut>& cur, int W, char* lds, Seam<TIn>& S, __amdgpu_buffer_rsrc_t rs) {
    constexpr bool F32 = same_t<TIn, float>::v;
    const int tid = lz_tid(), wid = __builtin_amdgcn_readfirstlane(tid >> 6), lane = tid & 63, r32 = lane & 31, hi = lane >> 5;
    const int sr = tid >> 4, sc = (tid & 15) * 8, kws = KSWZ(sr, sc * 2); char* K_lds = lds + 2 * SHM_V; float* cb_l = (float*)(lds + LDS_CB); const unsigned vo_st = (unsigned)(sr * D + sc) * 2u;
    const int kb0 = swa_jlo(cur.P0, W) * KVBLK;
    for (int d0 = 0; d0 < 8; ++d0) S.qr[d0] = load8<TIn>(cur.Q + (unsigned)((wid * QBLK + r32) * D + d0 * 16 + hi * 8));
    if constexpr (F32) { SLOAD_F((const float*)cur.K, kb0); VMW(); SWRITE_KF(0); SBAR(); SLOAD_F((const float*)cur.V, kb0); }
    else { SLOAD_H(cur.K, cur.V, cur.C, kb0); VMW(); SWRITE_HK(0); }
    __syncthreads();
}
template <class TIn, class TOut>
__device__ __forceinline__ void causal_swa_block(const BlockRef<TIn, TOut>& cur, const BlockRef<TIn, TOut>& nxt, int skv, int W, char* lds, Seam<TIn>& S, __amdgpu_buffer_rsrc_t rs) {
    constexpr bool F32 = same_t<TIn, float>::v;
    const int tid = lz_tid(), wid = __builtin_amdgcn_readfirstlane(tid >> 6), lane = tid & 63, r32 = lane & 31, hi = lane >> 5;
    const int j_lo = swa_jlo(cur.P0, W);
    int j_hi = (cur.P0 + QB - 1) / KVBLK + 1; if (j_hi > skv / KVBLK) j_hi = skv / KVBLK;
    const int NT = j_hi - j_lo;
    const int kbn = swa_jlo(nxt.P0, W) * KVBLK;
    const int qlo = cur.P0 + wid * QBLK, qm = qlo + r32 - 4 * hi;
    char* V_lds = lds; char* K_lds = lds + 2 * SHM_V; float* cb_l = (float*)(lds + LDS_CB);
    float* ws = (float*)(lds + 2 * SHM_V + 2 * SHM_K) + wid * 64; float* li_l = ws, * al_l = ws + 32;
    float m_reg = -1e30f, l_reg = 0; f32x16 o[4] = {};
    const unsigned vo_st = (unsigned)((tid >> 4) * D + (tid & 15) * 8) * 2u; const int sr = tid >> 4, sc = (tid & 15) * 8, vst0 = v_st(sr, sc), vst1 = v_st(32 + sr, sc), kws = KSWZ(sr, sc * 2);
    const int vb0 = (int)(uintptr_t)V_lds + v_rd_base(lane);
    const unsigned Kh = cur.K, Vh = cur.V, Ch = cur.C;
#define RESC(a) do { if (__any((a) < 1.f)) { if (hi == 0) al_l[r32] = (a); asm volatile("s_waitcnt lgkmcnt(0)" ::: "memory");              \
                     for (int d_ = 0; d_ < 4; ++d_) for (int r = 0; r < 16; ++r) o[d_][r] *= al_l[crow(r, hi)]; } } while (0)
#define KBASE(t) ((j_lo + (t)) * KVBLK)
#define ACT(t) (KBASE(t) <= qlo + QBLK - 1 && KBASE(t) + KVBLK - 1 >= qlo - W + 1)
#define MASKT(P0_, P1_, t) do { const int kb_ = KBASE(t); if ((!SK || ACT(t)) && (kb_ + KVBLK - 1 > qlo || kb_ <= qlo + QBLK - 1 - W)) mask_tile(P0_, P1_, qm - kb_, (unsigned)W); } while (0)
    constexpr int NQL = F32 ? 16 : 8;
    constexpr bool SK = WSKIP && !F32;
#define SEAM_K0() do { VMWN(NQL); if constexpr (F32) { SWRITE_KF(0); SBAR(); SLOAD_F((const float*)nxt.V, kbn); } else { SWRITE_HK(0); } SBAR(); } while (0)
    f32x16 pA0, pA1, pB0, pB1; float mnA, mnB, alA, alB; bf16x8 pa0, pa1, pa2, pa3;
    if constexpr (F32) { VMW(); SWRITE_VF(0); SBAR(); } else { SWRITE_HV(0); SBAR(); }
    if (NT > 1) { if constexpr (F32) SLOAD_F((const float*)Kh, KBASE(1)); else SLOAD_H(Kh, Vh, Ch, KBASE(1)); }
    SBAR(); qkt<0, SK>(pA0, pA1, K_lds, cb_l, r32, hi, S.qr, ACT(0));
    if constexpr (F32) { if (NT > 1) { VMW(); SWRITE_KF(1); SBAR(); SLOAD_F((const float*)Vh, KBASE(1)); } }
    MASKT(pA0, pA1, 0); partialSM(pA0, pA1, m_reg, mnA, alA);
    if (NT > 1) { VMW(); if constexpr (F32) { SWRITE_VF(1); SBAR(); if (NT > 2) SLOAD_F((const float*)Kh, KBASE(2)); } else SWRITE_H(1); }
    __syncthreads();
#define HALF_STEP(PX0, PX1, mnX, alX, PY0, PY1, alY, t, KB, VB, SB) do {                                                      \
        SBAR(); qkt<KB, SK>(PX0, PX1, K_lds, cb_l, r32, hi, S.qr, ACT(t));                                             \
        finishSM(PY0, PY1, alY, l_reg, pa0, pa1, pa2, pa3); SBAR();                                                           \
        if ((t) + 1 < NT) { if constexpr (F32) { VMW(); SWRITE_KF(SB); SBAR(); SLOAD_F((const float*)Vh, KBASE((t) + 1)); }  \
                            else { SLOAD_H(Kh, Vh, Ch, KBASE((t) + 1)); } SBAR(); }                                               \
        pv_tile<VB, SK>(o, vb0, pa0, pa1, pa2, pa3, ACT((t) - 1)); MASKT(PX0, PX1, (t)); partialSM(PX0, PX1, m_reg, mnX, alX);                                        \
        __syncthreads();                                                                                                      \
        if ((t) + 1 < NT) { VMW(); if constexpr (F32) { SWRITE_VF(SB); SBAR(); if ((t) + 2 < NT) SLOAD_F((const float*)Kh, KBASE((t) + 2)); } \
                            else { SWRITE_H(SB); } }                                                                          \
        RESC(alX); __syncthreads(); } while (0)
    for (int t = 1; t + 1 < NT; t += 2) {
        HALF_STEP(pB0, pB1, mnB, alB, pA0, pA1, alA, t, 1, 0, 0);
        HALF_STEP(pA0, pA1, mnA, alA, pB0, pB1, alB, t + 1, 0, 1, 1);
    }
    const bool even = (NT & 1) == 0;
    if (even) { SBAR(); qkt<1, SK>(pB0, pB1, K_lds, cb_l, r32, hi, S.qr, ACT(NT - 1)); SBAR(); }
#define QROW(e) (nxt.Q + (size_t)(wid * QBLK + r32) * D + ((e) >> 1) * 16 + hi * 8 + ((e) & 1) * 4)
    if constexpr (F32) { SLOAD_F((const float*)nxt.K, kbn); SBAR();
#pragma unroll
        for (int e = 0; e < 8; ++e) S.tq[e] = *(const f32x4*)QROW(e); }
    else { SLOAD_H(nxt.K, nxt.V, nxt.C, kbn); SBAR();
#pragma unroll
        for (int d0 = 0; d0 < 8; ++d0) S.qr[d0] = load8<TIn>(nxt.Q + (unsigned)((wid * QBLK + r32) * D + d0 * 16 + hi * 8)); }
    SBAR();
    finishSM(pA0, pA1, alA, l_reg, pa0, pa1, pa2, pa3); SBAR();
    if constexpr (F32) {
#pragma unroll
        for (int e = 8; e < 16; ++e) S.tq[e] = *(const f32x4*)QROW(e); SBAR(); }
#undef QROW
    pv_tile<0, SK>(o, vb0, pa0, pa1, pa2, pa3, ACT(even ? NT - 2 : NT - 1));
    if (even) { MASKT(pB0, pB1, NT - 1); partialSM(pB0, pB1, m_reg, mnB, alB); __syncthreads(); RESC(alB);
        finishSM(pB0, pB1, alB, l_reg, pa0, pa1, pa2, pa3); SBAR(); pv_tile<1, SK>(o, vb0, pa0, pa1, pa2, pa3, ACT(NT - 1)); }
    SBAR(); SEAM_K0();
    if (hi == 0) li_l[r32] = l_reg; asm volatile("s_waitcnt lgkmcnt(0)" ::: "memory");
    float rli[16];
#pragma unroll
    for (int r = 0; r < 16; ++r) rli[r] = __builtin_amdgcn_rcpf(li_l[crow(r, hi)]);
    TOut* Ow = cur.O + (size_t)(wid * QBLK) * OSTR;
    { float msv[4];
#pragma unroll
      for (int d0 = 0; d0 < 4; ++d0) msv[d0] = cur.MS[d0 * 32 + r32];
#pragma unroll
      for (int r = 0; r < 16; ++r) { const int orow = crow(r, hi);
        float v0 = o[0][r] * rli[r], v1 = o[1][r] * rli[r], v2 = o[2][r] * rli[r], v3 = o[3][r] * rli[r];
        float sm = (v0 + v1) + (v2 + v3);
#pragma unroll
        for (int off = 1; off < 32; off <<= 1) sm += __shfl_xor(sm, off);
        const float mu = sm * (1.0f / 128.0f);
        v0 -= mu; v1 -= mu; v2 -= mu; v3 -= mu;
        float sq = (v0 * v0 + v1 * v1) + (v2 * v2 + v3 * v3);
#pragma unroll
        for (int off = 1; off < 32; off <<= 1) sq += __shfl_xor(sq, off);
        const float rstd = 1.0f / sqrtf(sq * (1.0f / 128.0f) + 1e-6f);
        float vv[4] = {v0 * rstd * msv[0], v1 * rstd * msv[1], v2 * rstd * msv[2], v3 * rstd * msv[3]};
#pragma unroll
        for (int d0 = 0; d0 < 4; ++d0) { const float v = vv[d0]; const float vn = __shfl_xor(v, 1);
            if ((r32 & 1) == 0) *(unsigned*)(Ow + (unsigned)(orow * OSTR + d0 * 32 + r32)) = cvtpk(v, vn); } } }
    if constexpr (F32) {
#pragma unroll
        for (int d0 = 0; d0 < 8; ++d0) S.qr[d0] = pack8(S.tq[2 * d0], S.tq[2 * d0 + 1]); }
    __syncthreads();
#undef RESC
#undef KBASE
#undef ACT
#undef MASKT
#undef SEAM_K0
#undef HALF_STEP
}
#undef ROW
#undef VMW
#undef VMWN
#undef SLOAD_H
#undef SWRITE_HK
#undef SWRITE_HV
#undef SWRITE_H
#undef SLOAD_F
#undef SWRITE_KF
#undef SWRITE_VF
#undef SBAR
}

#define LAS __attribute__((address_space(3)))
typedef unsigned short bf16r;
typedef unsigned v4u __attribute__((ext_vector_type(4)));
typedef unsigned v2u __attribute__((ext_vector_type(2)));
typedef float v4f __attribute__((ext_vector_type(4)));
typedef float v16f __attribute__((ext_vector_type(16)));
typedef short v8s __attribute__((ext_vector_type(8)));
typedef short v4s __attribute__((ext_vector_type(4)));

#define XB_TMO      128
#define XB_XCNT(j)  (256  + 64 * (j))
#define XB_XSUB(j)  (1280 + 64 * (j))
#define XB_XGEN(j)  (2304 + 64 * (j))
#define XB_TOP      3328
#define XB_TOPGEN   3392
#define XCD_BAR_WORDS 3456
#define XB_SPIN_CAP (1u << 18)

__device__ __forceinline__ unsigned xb_ld(unsigned* p)              { return __hip_atomic_load(p, __ATOMIC_RELAXED, __HIP_MEMORY_SCOPE_AGENT); }
__device__ __forceinline__ unsigned xb_add(unsigned* p, unsigned v) { return __hip_atomic_fetch_add(p, v, __ATOMIC_RELAXED, __HIP_MEMORY_SCOPE_AGENT); }
__device__ __forceinline__ unsigned xb_xcc_id() { return (unsigned)__builtin_amdgcn_s_getreg((3 << 11) | 20) & 0xFu; }
#define XB_SPIN(cond, bar) do { unsigned _sp = 0; while (cond) { __builtin_amdgcn_s_sleep(1); \
    if ((++_sp & 255u) == 0u) { if (xb_ld(&(bar)[XB_TMO])) break; if (_sp > XB_SPIN_CAP) { atomicAdd(&(bar)[XB_TMO], 1u); break; } } } } while (0)

struct XcdBarrier {
    unsigned* bar; unsigned x;
    volatile LAS unsigned* st;
};

__device__ __forceinline__ XcdBarrier xcd_barrier_post(unsigned* bar, volatile LAS unsigned* st) {
    XcdBarrier b; b.bar = bar; b.x = xb_xcc_id(); b.st = st;
    if (lz_tid() == 0) (void)xb_add(&bar[XB_XCNT(b.x)], 1u);
    return b;
}
__device__ __forceinline__ void xcd_barrier_complete(unsigned* bar, unsigned x, unsigned& nloc, unsigned& nx) {
    const unsigned G = gridDim.x * gridDim.y * gridDim.z;
    unsigned sum, cnt, mine, sp = 0u;
    for (;;) {
        sum = 0u; cnt = 0u; mine = 0u;
#pragma unroll
        for (unsigned j = 0; j < 16; ++j) { const unsigned c = xb_ld(&bar[XB_XCNT(j)]); sum += c; cnt += (c > 0u) ? 1u : 0u; mine = (j == x) ? c : mine; }
        if (sum == G) break;
        __builtin_amdgcn_s_sleep(1);
        if ((++sp & 255u) == 0u) { if (xb_ld(&bar[XB_TMO])) break; if (sp > XB_SPIN_CAP) { atomicAdd(&bar[XB_TMO], 1u); break; } }
    }
    nloc = mine > 0u ? mine : 1u; nx = cnt > 0u ? cnt : 1u;
}

__device__ __forceinline__ void xcd_barrier(const XcdBarrier& b) {
    asm volatile("s_waitcnt vmcnt(0)" ::: "memory");
    __syncthreads();
    if (lz_tid() == 0) {
        unsigned* bar = b.bar;
        __builtin_amdgcn_s_waitcnt(0);
        unsigned nloc = b.st[0], nx = b.st[1];
        if (nloc == 0u) { xcd_barrier_complete(bar, b.x, nloc, nx); b.st[0] = nloc; b.st[1] = nx; }
        const unsigned old = xb_add(&bar[XB_XSUB(b.x)], 1u);
        const unsigned gen = old / nloc;
        if (old + 1u == (gen + 1u) * nloc) {
            __builtin_amdgcn_fence(__ATOMIC_RELEASE, "agent");
            asm volatile("s_waitcnt vmcnt(0)" ::: "memory");
            const unsigned og = xb_add(&bar[XB_TOP], 1u);
            const unsigned tg = og / nx;
            if (og + 1u == (tg + 1u) * nx) xb_add(&bar[XB_TOPGEN], 1u);
            else XB_SPIN(xb_ld(&bar[XB_TOPGEN]) == tg, bar);
            __builtin_amdgcn_fence(__ATOMIC_ACQUIRE, "agent");
            xb_add(&bar[XB_XGEN(b.x)], 1u);
            asm volatile("s_waitcnt vmcnt(0)" ::: "memory");
        } else {
            XB_SPIN(xb_ld(&bar[XB_XGEN(b.x)]) == gen, bar);
            __builtin_amdgcn_fence(__ATOMIC_ACQUIRE, "agent");
            asm volatile("s_waitcnt vmcnt(0)" ::: "memory");
        }
    }
    __syncthreads();
}

constexpr size_t MiB = 1u << 20;
constexpr size_t WS_QK2 = 14336, WS_QCTR = 15360;
constexpr size_t WS_JT = 20480;
constexpr size_t WS_WG = 1 * MiB, WG_BYTES = 32 * DM * 2;
constexpr size_t WS_MOD = 64 * 1024;
constexpr size_t WS_WIN = 2 * MiB, WIN_BYTES = (size_t)NINP * DM * 2;
constexpr size_t WS_WOUT = 60 * MiB, WOUT_BYTES = (size_t)DM * DM * 2;
constexpr size_t WS_WFF1 = 76 * MiB, WFF_BYTES = (size_t)DFF * DM * 2;
constexpr size_t WS_WFF2 = 140 * MiB;
constexpr size_t WS_H = 204 * MiB;
constexpr size_t WS_P = 332 * MiB;
constexpr size_t WS_Y = 780 * MiB;
constexpr size_t WS_HID = WS_P;
constexpr size_t WS_GATES = 908 * MiB;
constexpr size_t WS_CNEG = 910 * MiB;
constexpr size_t WS_MA = 911 * MiB, WS_MCM = WS_MA + 512 * 1024, WS_MB = WS_MCM + 512 * 1024;
constexpr size_t WS_MPREV = 913 * MiB;
constexpr size_t WS_UN = 914 * MiB;
constexpr size_t WS_MQC = 916 * MiB;
constexpr size_t WS_END = 980 * MiB;
static_assert(WS_WIN + 2 * WIN_BYTES <= WS_WOUT && WS_HID + (size_t)MROWS * DFF * 2 <= WS_Y + (size_t)MROWS * DM * 2 && WS_MQC + (size_t)8 * MROWS * 128 * 2 <= WS_END, "ws map");

constexpr int LDS_BYTES = 147456;

__device__ __forceinline__ float wave_sum(float v) {
#pragma unroll
    for (int o = 1; o < 64; o <<= 1) v += __shfl_xor(v, o);
    return v;
}
typedef float pkf2_t __attribute__((ext_vector_type(2))); typedef __bf16 pkb2_t __attribute__((ext_vector_type(2)));
__device__ __forceinline__ unsigned pk2(float lo, float hi) { pkf2_t v = {lo, hi}; pkb2_t b = __builtin_convertvector(v, pkb2_t); return __builtin_bit_cast(unsigned, b); }
__device__ __forceinline__ float bflo(unsigned w) { return __uint_as_float(w << 16); }
__device__ __forceinline__ float bfhi(unsigned w) { return __uint_as_float(w & 0xffff0000u); }
__device__ __forceinline__ float bf1(bf16r h) { return __uint_as_float((unsigned)h << 16); }
__device__ __forceinline__ float log_sigmoid(float x) { return fminf(x, 0.f) - log1pf(expf(-fabsf(x))); }
__device__ __forceinline__ float swap_add(float v) { auto rr = __builtin_amdgcn_permlane32_swap(__float_as_uint(v), __float_as_uint(v), false, false); return __uint_as_float(rr[0]) + __uint_as_float(rr[1]); }

struct Args { const void* in[18]; float* out; unsigned char* ws; int ph_lo, ph_hi; };
typedef const __attribute__((address_space(4))) Args CArgs;
__device__ __forceinline__ CArgs* fresh_args() { CArgs* p = (CArgs*)__builtin_amdgcn_kernarg_segment_ptr(); asm volatile("" : "+s"(p)); return p; }

__device__ __forceinline__ int win_src(int n) { return n < 5120 ? n : n + 8; }
__device__ __forceinline__ int wg_src(int n) { return n < 8 ? 5120 + n : (n < 16 ? 7176 + (n - 8) : -1); }
template <int MAP>
__device__ __forceinline__ void transpose_item(const float* W, int K, int N, bf16r* WT, LAS float* scr, int item, int nblk, int lane) {
    const int kb = item / nblk, nb = item % nblk, k0 = 64 * kb, n0 = 32 * nb;
    int sc = n0 + (lane & 31); if (MAP == 1) sc = win_src(sc); else if (MAP == 2) sc = wg_src(sc);
#ifdef OLD_P0
#pragma unroll 8
    for (int i = 0; i < 32; ++i) { const int kk = 2 * i + (lane >> 5); scr[kk * 33 + (lane & 31)] = sc >= 0 ? W[(size_t)(k0 + kk) * N + sc] : 0.f; }
#else
    float tv[32];
#pragma unroll
    for (int i = 0; i < 32; ++i) { const int kk = 2 * i + (lane >> 5); tv[i] = sc >= 0 ? W[(size_t)(k0 + kk) * N + sc] : 0.f; }
#pragma unroll
    for (int i = 0; i < 32; ++i) { const int kk = 2 * i + (lane >> 5); scr[kk * 33 + (lane & 31)] = tv[i]; }
#endif
    asm volatile("s_waitcnt lgkmcnt(0)" ::: "memory");
    const int c = lane & 7;
#pragma unroll
    for (int j = 0; j < 4; ++j) { const int n = (lane >> 3) + 8 * j; const LAS float* s = scr + (8 * c) * 33 + n;
        v4u o; o.x = pk2(s[0 * 33], s[1 * 33]); o.y = pk2(s[2 * 33], s[3 * 33]); o.z = pk2(s[4 * 33], s[5 * 33]); o.w = pk2(s[6 * 33], s[7 * 33]);
        *(v4u*)(WT + (size_t)(n0 + n) * K + k0 + 8 * c) = o; }
    asm volatile("s_waitcnt lgkmcnt(0)" ::: "memory");
}
__device__ __forceinline__ void p0_phase(CArgs& a, LAS unsigned char* lds) {
    const int tid = lz_tid(), lane = tid & 63, wave = tid >> 6, G = gridDim.x;
    unsigned char* ws = a.ws;
    { LAS float* cond = (LAS float*)lds; LAS float* red = (LAS float*)(lds + 16384);
      const float* c = (const float*)a.in[1]; const float* ada_w = (const float*)a.in[3]; const float* ada_b = (const float*)a.in[4]; float* MOD = (float*)(ws + WS_MOD);
      for (int i = tid; i < NB * DM; i += 512) { const float cv = c[i]; cond[i] = cv / (1.f + expf(-cv)); }
      __syncthreads();
      for (int item = lz_bid(); item < 2 * (NMOD / 64); item += G) {
          const int layer = item / (NMOD / 64), cgp = item % (NMOD / 64), col = cgp * 64 + lane, kq = wave;
          const float* W = ada_w + (size_t)layer * DM * NMOD + col;
          float a0 = 0.f, a1 = 0.f;
#ifdef OLD_P0
#pragma unroll 8
#else
#pragma unroll 32
#endif
          for (int k = kq * 256; k < kq * 256 + 256; ++k) { const float w = W[(size_t)k * NMOD]; a0 += cond[k] * w; a1 += cond[DM + k] * w; }
          red[(kq * 2 + 0) * 64 + lane] = a0; red[(kq * 2 + 1) * 64 + lane] = a1;
          __syncthreads();
          if (tid < 128) { const int b = tid >> 6; float s = 0.f;
#pragma unroll
              for (int q = 0; q < 8; ++q) s += red[(q * 2 + b) * 64 + lane];
              MOD[(size_t)(layer * NB + b) * NMOD + cgp * 64 + lane] = s + ada_b[(size_t)layer * NMOD + cgp * 64 + lane]; }
          __syncthreads();
      } }
    { LAS float* scr = (LAS float*)(lds + wave * 16384);
      const int gw = lz_bid() * 8 + wave, NGW = G * 8;
      constexpr int I_IN = (DM / 64) * (NINP / 32), I_OUT = (DM / 64) * (DM / 32), I_F1 = (DM / 64) * (DFF / 32), I_F2 = (DFF / 64) * (DM / 32), I_G = DM / 64, I_L = I_IN + I_OUT + I_F1 + I_F2 + I_G;
      for (int it = gw; it < 2 * I_L; it += NGW) {
          const int layer = it / I_L; int r = it % I_L;
          if (r < I_IN) { transpose_item<1>((const float*)a.in[7] + (size_t)layer * DM * DIN, DM, DIN, (bf16r*)(ws + WS_WIN + layer * WIN_BYTES), scr, r, NINP / 32, lane); continue; } r -= I_IN;
          if (r < I_G) { transpose_item<2>((const float*)a.in[7] + (size_t)layer * DM * DIN, DM, DIN, (bf16r*)(ws + WS_WG + layer * WG_BYTES), scr, r, 1, lane); continue; } r -= I_G;
          if (r < I_OUT) { transpose_item<0>((const float*)a.in[14] + (size_t)layer * DM * DM, DM, DM, (bf16r*)(ws + WS_WOUT + layer * WOUT_BYTES), scr, r, DM / 32, lane); continue; } r -= I_OUT;
          if (r < I_F1) { transpose_item<0>((const float*)a.in[15] + (size_t)layer * DM * DFF, DM, DFF, (bf16r*)(ws + WS_WFF1 + layer * WFF_BYTES), scr, r, DFF / 32, lane); continue; } r -= I_F1;
          transpose_item<0>((const float*)a.in[16] + (size_t)layer * DFF * DM, DFF, DM, (bf16r*)(ws + WS_WFF2 + layer * WFF_BYTES), scr, r, DM / 32, lane);
      } }
}

__device__ __forceinline__ void gate_gemm(const bf16r* H, const bf16r* WG, float* gates) {
    const int tid = lz_tid(), lane = tid & 63, wave = __builtin_amdgcn_readfirstlane(tid >> 6), r32 = lane & 31, hi = lane >> 5;
    if (wave >= 4) return;
    for (int rb = lz_bid(); rb < MROWS / 128; rb += gridDim.x) {
        const int r0 = rb * 128 + wave * 32;
        const bf16r* ap = H + (size_t)(r0 + r32) * DM + 8 * hi; const bf16r* bp = WG + (size_t)r32 * DM + 8 * hi;
        v16f acc = {};
#pragma unroll 16
        for (int ks = 0; ks < DM / 16; ++ks) { const v8s af = *(const v8s*)(ap + ks * 16), bf = *(const v8s*)(bp + ks * 16); acc = __builtin_amdgcn_mfma_f32_32x32x16_bf16(af, bf, acc, 0, 0, 0); }
        if (r32 < 16) {
#pragma unroll
            for (int r = 0; r < 16; ++r) gates[(size_t)(r0 + (r & 3) + 8 * (r >> 2) + 4 * hi) * 16 + r32] = acc[r]; }
    }
}

__device__ __forceinline__ void norm_phase(const float* x, const float* w, const float* sh, const float* sc, bf16r* H) {
    const int lane = lz_tid() & 63, gw = lz_bid() * 8 + (lz_tid() >> 6), NGW = gridDim.x * 8;
    v4f nx[8];
    if (gw < MROWS) { const v4f* xr0 = (const v4f*)(x + (size_t)gw * DM) + lane;
#pragma unroll
        for (int j = 0; j < 8; ++j) nx[j] = xr0[64 * j]; }
    for (int m = gw; m < MROWS; m += NGW) {
        const int b = m / SEQ;
        v4f v[8]; float s = 0.f;
#pragma unroll
        for (int j = 0; j < 8; ++j) v[j] = nx[j];
        if (m + NGW < MROWS) { const v4f* xr1 = (const v4f*)(x + (size_t)(m + NGW) * DM) + lane;
#pragma unroll
            for (int j = 0; j < 8; ++j) nx[j] = xr1[64 * j]; }
#pragma unroll
        for (int j = 0; j < 8; ++j) s += (v[j].x * v[j].x + v[j].y * v[j].y) + (v[j].z * v[j].z + v[j].w * v[j].w);
        const float rstd = 1.0f / sqrtf(wave_sum(s) * (1.f / DM) + NORM_EPS);
        v2u* o = (v2u*)(H + (size_t)m * DM) + lane;
#pragma unroll
        for (int j = 0; j < 8; ++j) { const int c = 4 * lane + 256 * j;
            const v4f wv = *(const v4f*)(w + c), sv = *(const v4f*)(sc + (size_t)b * NMOD + c), hv = *(const v4f*)(sh + (size_t)b * NMOD + c);
            const v4f y = v[j] * rstd * wv * (sv + 1.0f) + hv;
            v2u p; p.x = pk2(y.x, y.y); p.y = pk2(y.z, y.w); o[64 * j] = p; }
    }
}
__device__ __forceinline__ void final_norm_phase(float* x, const float* w) {
    const int lane = lz_tid() & 63, gw = lz_bid() * 8 + (lz_tid() >> 6), NGW = gridDim.x * 8;
    v4f nx[8];
    if (gw < MROWS) { const v4f* xr0 = (const v4f*)(x + (size_t)gw * DM) + lane;
#pragma unroll
        for (int j = 0; j < 8; ++j) nx[j] = xr0[64 * j]; }
    for (int m = gw; m < MROWS; m += NGW) {
        v4f* xr = (v4f*)(x + (size_t)m * DM) + lane;
        v4f v[8]; float s = 0.f;
#pragma unroll
        for (int j = 0; j < 8; ++j) v[j] = nx[j];
        if (m + NGW < MROWS) { const v4f* xr1 = (const v4f*)(x + (size_t)(m + NGW) * DM) + lane;
#pragma unroll
            for (int j = 0; j < 8; ++j) nx[j] = xr1[64 * j]; }
#pragma unroll
        for (int j = 0; j < 8; ++j) s += (v[j].x * v[j].x + v[j].y * v[j].y) + (v[j].z * v[j].z + v[j].w * v[j].w);
        const float rstd = 1.0f / sqrtf(wave_sum(s) * (1.f / DM) + NORM_EPS);
#pragma unroll
        for (int j = 0; j < 8; ++j) { const v4f wv = *(const v4f*)(w + 4 * lane + 256 * j); xr[64 * j] = v[j] * rstd * wv; }
    }
}

__device__ __forceinline__ void fox_cumsum_item(CArgs& a, int layer, int item, LAS unsigned char* lds) {
    const int tid = lz_tid(), b = item >> 3, h = item & 7;
    const float* gates = (const float*)(a.ws + WS_GATES); float* cneg = (float*)(a.ws + WS_CNEG) + (size_t)item * SEQ;
    const float bias = ((const float*)a.in[10])[layer * 8 + h];
    LAS double* tot = (LAS double*)lds;
    double sum = 0.0;
    const float* gp = gates + ((size_t)b * SEQ + (size_t)tid * 32) * 16 + h;
#pragma unroll 4
    for (int i = 0; i < 32; ++i) sum += (double)log_sigmoid(gp[i * 16] + bias);
    tot[tid] = sum;
    __syncthreads();
    if (tid == 0) { double run = 0.0; for (int i = 0; i < 512; ++i) { const double t = tot[i]; tot[i] = run; run += t; } }
    __syncthreads();
    double run = tot[tid];
#pragma unroll 2
    for (int i = 0; i < 32; i += 4) { v4f o;
        run += (double)log_sigmoid(gp[(i + 0) * 16] + bias); o.x = (float)(-run * 11.313708498984761);
        run += (double)log_sigmoid(gp[(i + 1) * 16] + bias); o.y = (float)(-run * 11.313708498984761);
        run += (double)log_sigmoid(gp[(i + 2) * 16] + bias); o.z = (float)(-run * 11.313708498984761);
        run += (double)log_sigmoid(gp[(i + 3) * 16] + bias); o.w = (float)(-run * 11.313708498984761);
        *(v4f*)(cneg + tid * 32 + i) = o; }
    __syncthreads();
}
__device__ __forceinline__ void mlstm_scan_item(CArgs& a, int layer, int item, LAS unsigned char* lds) {
    const int tid = lz_tid(), lane = tid & 63, wave = tid >> 6, b = item >> 2, h = item & 3;
    const float* gates = (const float*)(a.ws + WS_GATES);
    float* MA = (float*)(a.ws + WS_MA) + (size_t)item * SEQ; float* MCM = (float*)(a.ws + WS_MCM) + (size_t)item * SEQ; float* MBv = (float*)(a.ws + WS_MB) + (size_t)item * SEQ;
    float* MPREV = (float*)(a.ws + WS_MPREV) + item * 256;
    const float ib = ((const float*)a.in[11])[layer * 4 + h], fb = ((const float*)a.in[12])[layer * 4 + h];
    LAS float* Bc = (LAS float*)lds; LAS float* Ac = Bc + 256;
#pragma unroll 4
    for (int c = wave; c < 256; c += 8) {
        const size_t m = (size_t)b * SEQ + c * 64 + lane;
        const float ig = gates[m * 16 + 8 + h] + ib, fg = gates[m * 16 + 12 + h] + fb;
        float bb = log_sigmoid(fg);
#pragma unroll
        for (int o = 1; o < 64; o <<= 1) { const float t = __shfl_up(bb, o); if (lane >= o) bb += t; }
        const float av = ig - bb; float cm = av;
#pragma unroll
        for (int o = 1; o < 64; o <<= 1) { const float t = __shfl_up(cm, o); if (lane >= o) cm = fmaxf(cm, t); }
        MA[c * 64 + lane] = av; MCM[c * 64 + lane] = cm; MBv[c * 64 + lane] = bb;
        if (lane == 63) { Bc[c] = bb; Ac[c] = cm; }
    }
    __syncthreads();
    if (tid == 0) { float mm = 0.f; for (int c = 0; c < 256; ++c) { MPREV[c] = mm; mm = Bc[c] + fmaxf(mm, Ac[c]); } }
    __syncthreads();
}
__device__ __forceinline__ void prep_phase(CArgs& a, int layer, LAS unsigned char* lds) {
    const int tid = lz_tid(), bid = lz_bid(), G = gridDim.x;
    if (bid < 16) { fox_cumsum_item(a, layer, bid, lds); return; }
    if (bid < 24) { mlstm_scan_item(a, layer, bid - 16, lds); return; }
    const int wk = bid - 24, NWK = G - 24;
    bf16r* P = (bf16r*)(a.ws + WS_P);
    { const int jg = tid & 7; double invf[8];
#pragma unroll
      for (int i = 0; i < 8; ++i) { double r = 1.0, bs = 0.8659643233600653; int e = 8 * jg + i;
#pragma unroll
          for (int q = 0; q < 6; ++q) { if (e & 1) r *= bs; bs *= bs; e >>= 1; }
          invf[i] = r * 0.15915494309189535; }
      const int* positions = (const int*)a.in[2];
      for (int it0 = wk; it0 < 8 * MROWS / 64; it0 += 4 * NWK) {
          v4u A[4], Bv[4]; bf16r* pp[4]; int mm[4], sl[4];
#pragma unroll
          for (int q = 0; q < 4; ++q) { const int it = it0 + q * NWK; const bool ok = it < 8 * MROWS / 64; const int grow = (ok ? it : wk) * 64 + (tid >> 3); sl[q] = ok ? grow / MROWS : -1; mm[q] = grow % MROWS;
              pp[q] = P + ((size_t)(grow / MROWS) * MROWS + mm[q]) * 128 + 8 * jg; A[q] = *(const v4u*)pp[q]; Bv[q] = *(const v4u*)(pp[q] + 64); }
#pragma unroll
          for (int q = 0; q < 4; ++q) { if (sl[q] < 0) continue;
              const double pos = (double)positions[mm[q]]; const float sc = sl[q] >= 4 ? KSCALE : 1.0f;
              float t1[8] = {bflo(A[q].x), bfhi(A[q].x), bflo(A[q].y), bfhi(A[q].y), bflo(A[q].z), bfhi(A[q].z), bflo(A[q].w), bfhi(A[q].w)};
              float t2[8] = {bflo(Bv[q].x), bfhi(Bv[q].x), bflo(Bv[q].y), bfhi(Bv[q].y), bflo(Bv[q].z), bfhi(Bv[q].z), bflo(Bv[q].w), bfhi(Bv[q].w)};
              float o1[8], o2[8];
#pragma unroll
              for (int i = 0; i < 8; ++i) { const double rev = pos * invf[i]; const float fr = (float)(rev - floor(rev));
                  const float sn = __builtin_amdgcn_sinf(fr) * sc, cs = __builtin_amdgcn_cosf(fr) * sc;
                  o1[i] = t1[i] * cs - t2[i] * sn; o2[i] = t2[i] * cs + t1[i] * sn; }
              v4u oa, ob; oa.x = pk2(o1[0], o1[1]); oa.y = pk2(o1[2], o1[3]); oa.z = pk2(o1[4], o1[5]); oa.w = pk2(o1[6], o1[7]);
              ob.x = pk2(o2[0], o2[1]); ob.y = pk2(o2[2], o2[3]); ob.z = pk2(o2[4], o2[5]); ob.w = pk2(o2[6], o2[7]);
              *(v4u*)pp[q] = oa; *(v4u*)(pp[q] + 64) = ob; }
      } }
    { const int slot = wk % 8, sub = wk / 8, nsub = (NWK - slot + 7) / 8, cgp = tid & 15;
      const float* cw = (const float*)a.in[8] + (size_t)layer * 4 * 1024 + slot * 128 + 8 * cgp; const float* cbv = (const float*)a.in[9] + (size_t)layer * 1024 + slot * 128 + 8 * cgp;
      float w[4][8], bsv[8];
#pragma unroll
      for (int j = 0; j < 4; ++j)
#pragma unroll
          for (int i = 0; i < 8; ++i) w[j][i] = cw[j * 1024 + i];
#pragma unroll
      for (int i = 0; i < 8; ++i) bsv[i] = cbv[i];
      const bf16r* __restrict__ src = P + (size_t)(40 + slot) * MROWS * 128 + 8 * cgp; bf16r* __restrict__ dst = (bf16r*)(a.ws + WS_MQC) + (size_t)slot * MROWS * 128 + 8 * cgp;
      const float sc = slot >= 4 ? KSCALE : 1.0f;
#pragma unroll 2
      for (int rb = sub; rb < MROWS / 32; rb += nsub) {
          const int row = rb * 32 + (tid >> 4), s = row % SEQ;
          float acc[8];
#pragma unroll
          for (int i = 0; i < 8; ++i) acc[i] = bsv[i];
#pragma unroll
          for (int j = 0; j < 4; ++j) { if (s - 3 + j >= 0) { const v4u X = *(const v4u*)(src + (size_t)(row - 3 + j) * 128);
              acc[0] += w[j][0] * bflo(X.x); acc[1] += w[j][1] * bfhi(X.x); acc[2] += w[j][2] * bflo(X.y); acc[3] += w[j][3] * bfhi(X.y);
              acc[4] += w[j][4] * bflo(X.z); acc[5] += w[j][5] * bfhi(X.z); acc[6] += w[j][6] * bflo(X.w); acc[7] += w[j][7] * bfhi(X.w); } }
#pragma unroll
          for (int i = 0; i < 8; ++i) acc[i] = acc[i] / (1.f + expf(-acc[i])) * sc;
          v4u o; o.x = pk2(acc[0], acc[1]); o.y = pk2(acc[2], acc[3]); o.z = pk2(acc[4], acc[5]); o.w = pk2(acc[6], acc[7]);
          *(v4u*)(dst + (size_t)row * 128) = o;
      } }
    { const int slot = wk % 16, sub = wk / 16, nsub = (NWK - slot + 15) / 16, c16 = tid & 15;
      const bf16r* src = P + (size_t)(16 + slot) * MROWS * 128 + 8 * c16;
      float mx0 = 0.f, mx1 = 0.f;
#pragma unroll 8
      for (int rb = sub; rb < MROWS / 32; rb += nsub) {
          const int row = rb * 32 + (tid >> 4); const v4u X = *(const v4u*)(src + (size_t)row * 128);
          const float x0 = bflo(X.x), x1 = bfhi(X.x), x2 = bflo(X.y), x3 = bfhi(X.y), x4 = bflo(X.z), x5 = bfhi(X.z), x6 = bflo(X.w), x7 = bfhi(X.w);
          float s = (x0 * x0 + x1 * x1) + (x2 * x2 + x3 * x3) + (x4 * x4 + x5 * x5) + (x6 * x6 + x7 * x7);
          s += __shfl_xor(s, 1); s += __shfl_xor(s, 2); s += __shfl_xor(s, 4); s += __shfl_xor(s, 8);
          if (row < SEQ) mx0 = fmaxf(mx0, s); else mx1 = fmaxf(mx1, s);
      }
#pragma unroll
      for (int o = 1; o < 64; o <<= 1) { mx0 = fmaxf(mx0, __shfl_xor(mx0, o)); mx1 = fmaxf(mx1, __shfl_xor(mx1, o)); }
      if ((tid & 63) == 0) { unsigned* QK2 = (unsigned*)(a.ws + WS_QK2) + layer * 32;
          __hip_atomic_fetch_max(QK2 + slot, __float_as_uint(mx0 * 1.02f), __ATOMIC_RELAXED, __HIP_MEMORY_SCOPE_AGENT);
          __hip_atomic_fetch_max(QK2 + 16 + slot, __float_as_uint(mx1 * 1.02f), __ATOMIC_RELAXED, __HIP_MEMORY_SCOPE_AGENT); }
    }
}

__device__ __forceinline__ int cv_st(int k, int c) { const int kk = (k & ~0xC) | ((k & 4) << 1) | ((k & 8) >> 1); return ((kk >> 3) * 4 + (c >> 5)) * 512 + ((kk & 7) * 32 + (c & 31)) * 2; }
__device__ __forceinline__ int cv_rd_base(int lane) { return ((lane & 3) << 3) | (((lane >> 2) & 3) << 6) | (((lane >> 4) & 1) << 5) | (((lane >> 5) & 1) << 8); }
__device__ __forceinline__ int ccrow(int r, int hi) { return (r & 3) + 8 * (r >> 2) + 4 * hi; }
#define CFRAG(dst, vb, ks) do { v4s l_, h_; asm volatile("ds_read_b64_tr_b16 %0, %1 offset:%2" : "=&v"(l_) : "v"(vb), "i"((ks) * 4096) : "memory"); \
        asm volatile("ds_read_b64_tr_b16 %0, %1 offset:%2" : "=&v"(h_) : "v"(vb), "i"((ks) * 4096 + 2048) : "memory"); asm volatile("s_waitcnt lgkmcnt(0)" ::: "memory"); \
        dst = (v8s){l_[0], l_[1], l_[2], l_[3], h_[0], h_[1], h_[2], h_[3]}; } while (0)

struct ChunkItem { int mixer, bh, b, h, c, row0; };
__device__ __forceinline__ ChunkItem chunk_decode(int idx) { ChunkItem it; it.mixer = idx / 2048; const int rem = idx % 2048; it.bh = rem / 256; it.b = it.bh >> 2; it.h = it.bh & 3; it.c = rem % 256; it.row0 = it.b * SEQ + it.c * 64; return it; }
__device__ __forceinline__ float ret_lg(int h) { return log2f(1.0f - exp2f(-5.0f - (float)h)); }

__device__ __forceinline__ void m1_phase(CArgs& a, LAS unsigned char* lds) {
    const int tid = lz_tid(), lane = tid & 63, wave = __builtin_amdgcn_readfirstlane(tid >> 6), r32 = lane & 31, hi = lane >> 5;
    const bf16r* P = (const bf16r*)(a.ws + WS_P); const bf16r* MQC = (const bf16r*)(a.ws + WS_MQC); bf16r* US = (bf16r*)(a.ws + WS_H);
    LAS unsigned char* KT = lds; LAS unsigned char* VT = lds + 16384; LAS float* wt = (LAS float*)(lds + 32768); LAS float* red = (LAS float*)(lds + 33024);
    const int sr = tid >> 4, sc = (tid & 15) * 8;
    for (int idx = lz_bid(); idx < 4096; idx += gridDim.x) {
        const ChunkItem it = chunk_decode(idx);
        const bf16r* ksrc = (it.mixer == 0 ? P + (size_t)(4 + it.h) * MROWS * 128 : MQC + (size_t)(4 + it.h) * MROWS * 128) + (size_t)it.row0 * 128;
        const bf16r* vsrc = P + (size_t)((it.mixer == 0 ? 8 : 48) + it.h) * MROWS * 128 + (size_t)it.row0 * 128;
        if (tid < 64) { float w;
            if (it.mixer == 0) w = exp2f((float)(63 - tid) * ret_lg(it.h));
            else { const float* MA = (const float*)(a.ws + WS_MA) + (size_t)it.bh * SEQ + it.c * 64; const float* MCM = (const float*)(a.ws + WS_MCM) + (size_t)it.bh * SEQ + it.c * 64;
                   const float mp = ((const float*)(a.ws + WS_MPREV))[it.bh * 256 + it.c]; w = expf(MA[tid] - fmaxf(mp, MCM[63])); }
            wt[tid] = w; }
        const v4u k0 = *(const v4u*)(ksrc + (size_t)sr * 128 + sc), k1 = *(const v4u*)(ksrc + (size_t)(32 + sr) * 128 + sc);
        const v4u v0 = *(const v4u*)(vsrc + (size_t)sr * 128 + sc), v1 = *(const v4u*)(vsrc + (size_t)(32 + sr) * 128 + sc);
        __syncthreads();
        const float w0 = wt[sr], w1 = wt[32 + sr];
        float a0[8] = {bflo(k0.x) * w0, bfhi(k0.x) * w0, bflo(k0.y) * w0, bfhi(k0.y) * w0, bflo(k0.z) * w0, bfhi(k0.z) * w0, bflo(k0.w) * w0, bfhi(k0.w) * w0};
        float a1[8] = {bflo(k1.x) * w1, bfhi(k1.x) * w1, bflo(k1.y) * w1, bfhi(k1.y) * w1, bflo(k1.z) * w1, bfhi(k1.z) * w1, bflo(k1.w) * w1, bfhi(k1.w) * w1};
        { v4u o; o.x = pk2(a0[0], a0[1]); o.y = pk2(a0[2], a0[3]); o.z = pk2(a0[4], a0[5]); o.w = pk2(a0[6], a0[7]); *(LAS v4u*)(KT + cv_st(sr, sc)) = o;
          o.x = pk2(a1[0], a1[1]); o.y = pk2(a1[2], a1[3]); o.z = pk2(a1[4], a1[5]); o.w = pk2(a1[6], a1[7]); *(LAS v4u*)(KT + cv_st(32 + sr, sc)) = o;
          *(LAS v4u*)(VT + cv_st(sr, sc)) = v0; *(LAS v4u*)(VT + cv_st(32 + sr, sc)) = v1; }
        if (it.mixer == 1) {
#pragma unroll
            for (int i = 0; i < 8; ++i) { float s = a0[i] + a1[i]; s += __shfl_xor(s, 16); s += __shfl_xor(s, 32); if (lane < 16) red[wave * 128 + sc + i] = s; }
        }
        __syncthreads();
        if (it.mixer == 1 && tid < 128) { float s = 0.f;
#pragma unroll
            for (int q = 0; q < 8; ++q) s += red[q * 128 + tid];
            ((float*)(a.ws + WS_UN))[((size_t)it.bh * 256 + it.c) * 128 + tid] = s; }
        const int db = wave >> 1;
        const int kvb = (int)(uintptr_t)KT + cv_rd_base(lane) + db * 512;
        v8s kf[4]; CFRAG(kf[0], kvb, 0); CFRAG(kf[1], kvb, 1); CFRAG(kf[2], kvb, 2); CFRAG(kf[3], kvb, 3);
#pragma unroll
        for (int e2 = 0; e2 < 2; ++e2) { const int eb = (wave & 1) * 2 + e2; const int vvb = (int)(uintptr_t)VT + cv_rd_base(lane) + eb * 512;
            v8s vf[4]; CFRAG(vf[0], vvb, 0); CFRAG(vf[1], vvb, 1); CFRAG(vf[2], vvb, 2); CFRAG(vf[3], vvb, 3);
            v16f acc = {};
#pragma unroll
            for (int ks = 0; ks < 4; ++ks) acc = __builtin_amdgcn_mfma_f32_32x32x16_bf16(kf[ks], vf[ks], acc, 0, 0, 0);
            bf16r* dst = US + (size_t)idx * 16384 + (size_t)(eb * 32 + r32) * 128 + db * 32 + 4 * hi;
#pragma unroll
            for (int g = 0; g < 4; ++g) { v2u o; o.x = pk2(acc[4 * g], acc[4 * g + 1]); o.y = pk2(acc[4 * g + 2], acc[4 * g + 3]); *(v2u*)(dst + 8 * g) = o; } }
        __syncthreads();
    }
}

#ifndef M2U
#define M2U 64
#endif
__device__ __forceinline__ void m2_phase(CArgs& a, LAS unsigned char* lds) {
    const int tid = lz_tid();
    unsigned* US = (unsigned*)(a.ws + WS_H); LAS float* coef = (LAS float*)lds;
    const float* MCM = (const float*)(a.ws + WS_MCM); const float* MPREV = (const float*)(a.ws + WS_MPREV);
    for (int blk = lz_bid(); blk < 16 * 8192 / 512; blk += gridDim.x) {
        const int chain = blk / 16, mixer = chain >> 3, bh = chain & 7;
        __syncthreads();
        if (tid < 256) { float cf;
            if (mixer == 0) cf = exp2f(64.0f * ret_lg(bh & 3));
            else { const float mp = MPREV[bh * 256 + tid]; cf = expf(mp - fmaxf(mp, MCM[(size_t)bh * SEQ + tid * 64 + 63])); }
            coef[tid] = cf; }
        __syncthreads();
        unsigned* p = US + (size_t)chain * 256 * 8192 + (blk % 16) * 512 + tid;
        float s0 = 0.f, s1 = 0.f;
        for (int c = 0; c < 256; c += M2U) { unsigned u[M2U];
#pragma unroll
            for (int i = 0; i < M2U; ++i) u[i] = p[(size_t)(c + i) * 8192];
#pragma unroll
            for (int i = 0; i < M2U; ++i) { const float cf = coef[c + i]; p[(size_t)(c + i) * 8192] = pk2(s0, s1); s0 = s0 * cf + bflo(u[i]); s1 = s1 * cf + bfhi(u[i]); } }
    }
    float* UN = (float*)(a.ws + WS_UN);
    for (int bh = lz_bid(); bh < 8; bh += gridDim.x) {
        __syncthreads();
        if (tid < 256) { const float mp = MPREV[bh * 256 + tid]; coef[tid] = expf(mp - fmaxf(mp, MCM[(size_t)bh * SEQ + tid * 64 + 63])); }
        __syncthreads();
        if (tid < 128) { float* p = UN + (size_t)bh * 256 * 128 + tid; float s = 0.f;
            for (int c = 0; c < 256; c += 16) { float u[16];
#pragma unroll
                for (int i2 = 0; i2 < 16; ++i2) u[i2] = p[(c + i2) * 128];
#pragma unroll
                for (int i2 = 0; i2 < 16; ++i2) { p[(c + i2) * 128] = s; s = s * coef[c + i2] + u[i2]; } } }
    }
}

__device__ __forceinline__ void m3_phase(CArgs& a, int layer, LAS unsigned char* lds) {
    const int tid = lz_tid(), lane = tid & 63, wave = __builtin_amdgcn_readfirstlane(tid >> 6), r32 = lane & 31, hi = lane >> 5;
    const bf16r* P = (const bf16r*)(a.ws + WS_P); const bf16r* MQC = (const bf16r*)(a.ws + WS_MQC); const bf16r* US = (const bf16r*)(a.ws + WS_H);
    bf16r* Y = (bf16r*)(a.ws + WS_Y); const float* msc = (const float*)a.in[13] + (size_t)layer * DM;
    LAS unsigned char* VT = lds; LAS float* OT = (LAS float*)(lds + 16384);
    LAS float* sa = (LAS float*)(lds + 16384 + 64 * 132 * 4); LAS float* sg = sa + 64; LAS float* swi = sg + 64; LAS float* semq = swi + 64; LAS float* sn = semq + 64; LAS float* fw = sn + 128;
    const int sr = tid >> 4, sc = (tid & 15) * 8;
    const int lb = wave & 1, eb = wave >> 1, l = lb * 32 + r32;
    for (int idx = lz_bid(); idx < 4096; idx += gridDim.x) {
        const ChunkItem it = chunk_decode(idx);
        const bf16r* qsrc = (it.mixer == 0 ? P + (size_t)it.h * MROWS * 128 : MQC + (size_t)it.h * MROWS * 128) + (size_t)it.row0 * 128;
        const bf16r* ksrc = (it.mixer == 0 ? P + (size_t)(4 + it.h) * MROWS * 128 : MQC + (size_t)(4 + it.h) * MROWS * 128) + (size_t)it.row0 * 128;
        const bf16r* vsrc = P + (size_t)((it.mixer == 0 ? 8 : 48) + it.h) * MROWS * 128 + (size_t)it.row0 * 128;
        const bf16r* gsrc = P + (size_t)((it.mixer == 0 ? 12 : 52) + it.h) * MROWS * 128 + (size_t)it.row0 * 128;
        const bf16r* St = US + (size_t)idx * 16384;
        const float lg = ret_lg(it.h);
        if (it.mixer == 1) {
            if (tid < 64) { const size_t o = (size_t)it.bh * SEQ + it.c * 64 + tid; const float mp = ((const float*)(a.ws + WS_MPREV))[it.bh * 256 + it.c];
                const float av = ((const float*)(a.ws + WS_MA))[o], cm = ((const float*)(a.ws + WS_MCM))[o], bb = ((const float*)(a.ws + WS_MB))[o];
                const float g = fmaxf(mp, cm); sa[tid] = av; sg[tid] = g; swi[tid] = expf(mp - g); semq[tid] = expf(-(bb + g)); }
            else if (tid < 192) sn[tid - 64] = ((const float*)(a.ws + WS_UN))[((size_t)it.bh * 256 + it.c) * 128 + tid - 64];
        }
        { const v4u v0 = *(const v4u*)(vsrc + (size_t)sr * 128 + sc), v1 = *(const v4u*)(vsrc + (size_t)(32 + sr) * 128 + sc);
          *(LAS v4u*)(VT + cv_st(sr, sc)) = v0; *(LAS v4u*)(VT + cv_st(32 + sr, sc)) = v1; }
        v8s qr[8];
#pragma unroll
        for (int d0 = 0; d0 < 8; ++d0) qr[d0] = *(const v8s*)(qsrc + (size_t)l * 128 + d0 * 16 + hi * 8);
        __syncthreads();
        v16f p0 = {}, p1 = {};
#pragma unroll
        for (int d0 = 0; d0 < 8; ++d0) { const v8s kf = *(const v8s*)(ksrc + (size_t)r32 * 128 + d0 * 16 + hi * 8); p0 = __builtin_amdgcn_mfma_f32_32x32x16_bf16(kf, qr[d0], p0, 0, 0, 0); }
        if (lb == 1) {
#pragma unroll
            for (int d0 = 0; d0 < 8; ++d0) { const v8s kf = *(const v8s*)(ksrc + (size_t)(32 + r32) * 128 + d0 * 16 + hi * 8); p1 = __builtin_amdgcn_mfma_f32_32x32x16_bf16(kf, qr[d0], p1, 0, 0, 0); }
        }
        float rs = 0.f;
        int ll = l; asm volatile("" : "+v"(ll));
        if (it.mixer == 0) {
#pragma unroll
            for (int r = 0; r < 16; ++r) { const int m0 = ccrow(r, hi), m1 = m0 + 32;
                p0[r] = (m0 <= ll) ? p0[r] * exp2f((float)(ll - m0) * lg) : 0.f; p1[r] = (m1 <= ll) ? p1[r] * exp2f((float)(ll - m1) * lg) : 0.f; }
        } else { const float gl = sg[l];
#pragma unroll
            for (int r = 0; r < 16; ++r) { const int m0 = ccrow(r, hi), m1 = m0 + 32;
                p0[r] = (m0 <= ll) ? p0[r] * expf(sa[m0] - gl) : 0.f; p1[r] = (m1 <= ll) ? p1[r] * expf(sa[m1] - gl) : 0.f; rs += p0[r] + p1[r]; }
            rs = swap_add(rs);
        }
        v8s pa0, pa1, pa2, pa3;
#define CPK4(Pv, B_, OUT) do { unsigned a0_ = pk2(Pv[B_+0], Pv[B_+1]), a1_ = pk2(Pv[B_+2], Pv[B_+3]), b0_ = pk2(Pv[B_+4], Pv[B_+5]), b1_ = pk2(Pv[B_+6], Pv[B_+7]); \
        auto r0_ = __builtin_amdgcn_permlane32_swap(a0_, b0_, false, false); auto r1_ = __builtin_amdgcn_permlane32_swap(a1_, b1_, false, false); \
        v4u w_ = {r0_[0], r1_[0], r0_[1], r1_[1]}; OUT = *reinterpret_cast<v8s*>(&w_); } while (0)
        CPK4(p0, 0, pa0); CPK4(p0, 8, pa1); CPK4(p1, 0, pa2); CPK4(p1, 8, pa3);
#undef CPK4
        const int vvb = (int)(uintptr_t)VT + cv_rd_base(lane) + eb * 512;
        v16f oi = {}, ox = {};
        { v8s vf; CFRAG(vf, vvb, 0); oi = __builtin_amdgcn_mfma_f32_32x32x16_bf16(pa0, vf, oi, 0, 0, 0); CFRAG(vf, vvb, 1); oi = __builtin_amdgcn_mfma_f32_32x32x16_bf16(pa1, vf, oi, 0, 0, 0);
          CFRAG(vf, vvb, 2); oi = __builtin_amdgcn_mfma_f32_32x32x16_bf16(pa2, vf, oi, 0, 0, 0); CFRAG(vf, vvb, 3); oi = __builtin_amdgcn_mfma_f32_32x32x16_bf16(pa3, vf, oi, 0, 0, 0); }
#pragma unroll
        for (int d0 = 0; d0 < 8; ++d0) { const v8s sf = *(const v8s*)(St + (size_t)(eb * 32 + r32) * 128 + d0 * 16 + hi * 8); ox = __builtin_amdgcn_mfma_f32_32x32x16_bf16(qr[d0], sf, ox, 0, 0, 0); }
        float fa, fb;
        if (it.mixer == 0) { fa = 1.f; fb = exp2f((float)(l + 1) * lg); }
        else { float qn = 0.f;
#pragma unroll
            for (int d0 = 0; d0 < 8; ++d0)
#pragma unroll
                for (int i = 0; i < 8; ++i) qn += bf1((bf16r)qr[d0][i]) * sn[d0 * 16 + hi * 8 + i];
            qn = swap_add(qn);
            const float wi = swi[l]; const float den = rs + wi * qn; const float dn = fmaxf(fabsf(den), semq[l]); fa = 1.0f / dn; fb = wi / dn; }
        LAS float* fww = fw + wave * 64;
        if (hi == 0) { fww[r32] = fa; fww[32 + r32] = fb; }
        asm volatile("s_waitcnt lgkmcnt(0)" ::: "memory");
#pragma unroll
        for (int r = 0; r < 16; ++r) { const int lr = ccrow(r, hi); OT[(lb * 32 + lr) * 132 + eb * 32 + r32] = fww[lr] * oi[r] + fww[32 + lr] * ox[r]; }
        __syncthreads();
        const int colbase = (it.mixer == 0 ? 0 : 1536) + it.h * 128;
        { const int row = wave * 8 + (lane >> 3), seg = lane & 7;
          const v4u gA = *(const v4u*)(gsrc + (size_t)row * 128 + seg * 16), gB = *(const v4u*)(gsrc + (size_t)row * 128 + seg * 16 + 8);
          float v[16];
#pragma unroll
          for (int q = 0; q < 4; ++q) { const v4f t = *(LAS v4f*)(OT + row * 132 + seg * 16 + 4 * q); v[4 * q] = t.x; v[4 * q + 1] = t.y; v[4 * q + 2] = t.z; v[4 * q + 3] = t.w; }
          float s = 0.f;
#pragma unroll
          for (int q = 0; q < 16; ++q) s += v[q];
          s += __shfl_xor(s, 1); s += __shfl_xor(s, 2); s += __shfl_xor(s, 4);
          const float mu = s * (1.f / 128.f); float sq = 0.f;
#pragma unroll
          for (int q = 0; q < 16; ++q) { v[q] -= mu; sq += v[q] * v[q]; }
          sq += __shfl_xor(sq, 1); sq += __shfl_xor(sq, 2); sq += __shfl_xor(sq, 4);
          const float rstd = 1.0f / sqrtf(sq * (1.f / 128.f) + NORM_EPS);
          float g[16] = {bflo(gA.x), bfhi(gA.x), bflo(gA.y), bfhi(gA.y), bflo(gA.z), bfhi(gA.z), bflo(gA.w), bfhi(gA.w), bflo(gB.x), bfhi(gB.x), bflo(gB.y), bfhi(gB.y), bflo(gB.z), bfhi(gB.z), bflo(gB.w), bfhi(gB.w)};
          const float* mp = msc + colbase + seg * 16;
#pragma unroll
          for (int q = 0; q < 16; ++q) { const float e = expf(-g[q]); const float gate = (it.mixer == 0) ? g[q] / (1.f + e) : 1.f / (1.f + e); v[q] = v[q] * rstd * gate * mp[q]; }
          v4u oA, oB; oA.x = pk2(v[0], v[1]); oA.y = pk2(v[2], v[3]); oA.z = pk2(v[4], v[5]); oA.w = pk2(v[6], v[7]); oB.x = pk2(v[8], v[9]); oB.y = pk2(v[10], v[11]); oB.z = pk2(v[12], v[13]); oB.w = pk2(v[14], v[15]);
          bf16r* yp = Y + (size_t)(it.row0 + row) * DM + colbase + seg * 16;
          *(v4u*)yp = oA; *(v4u*)(yp + 8) = oB; }
        __syncthreads();
    }
}

__device__ __forceinline__ fox::BlockRef<fox::bf16, fox::bf16> fox_ref(CArgs& a, int layer, int bh, int qb, int jlo) {
    const int b = bh >> 3, h = bh & 7; const fox::bf16* P = (const fox::bf16*)(a.ws + WS_P);
    fox::BlockRef<fox::bf16, fox::bf16> r;
    r.Q = P + ((size_t)(16 + h) * MROWS + (size_t)b * SEQ + (size_t)qb * 256) * 128;
    r.K = (unsigned)(WS_P + ((size_t)(24 + h) * MROWS + (size_t)b * SEQ) * 256); r.V = (unsigned)(WS_P + ((size_t)(32 + h) * MROWS + (size_t)b * SEQ) * 256);
    r.O = (fox::bf16*)(a.ws + WS_Y) + ((size_t)b * SEQ + (size_t)qb * 256) * DM + 512 + h * 128;
    r.C = (unsigned)(WS_CNEG + (size_t)bh * SEQ * 4); r.MS = (const float*)a.in[13] + (size_t)layer * DM + 512 + h * 128; const int j4 = jlo >> 2;
    r.P0 = (qb - j4) * 256; r.JLO = j4 * 4;
    r.K += (unsigned)j4 * 256u * 256u; r.V += (unsigned)j4 * 256u * 256u; r.C += (unsigned)j4 * 1024u;
    return r;
}
__device__ __forceinline__ void fox_table_phase(CArgs& a, int layer) {
    const int tid = lz_tid(), lane = tid & 63, u = lz_bid() * 8 + (tid >> 6);
    if (u >= 1024) return;
    const float* QK2 = (const float*)(a.ws + WS_QK2) + layer * 32; const float* CN = (const float*)(a.ws + WS_CNEG);
    const int bh = u & 15, qb = 63 - (u >> 4), b = bh >> 3, h = bh & 7;
    const float qkmax = sqrtf(QK2[b * 16 + h] * QK2[b * 16 + 8 + h]);
    const float* cn = CN + (size_t)bh * SEQ; const float thresh = cn[qb * 256] - (2.0f * qkmax + 1245.0f);
    int cnt = 0;
#pragma unroll
    for (int t = 0; t < 4; ++t) { const int tile = lane + 64 * t; const bool skip = (tile < qb * 4) && (cn[tile * 64 + 63] < thresh); cnt += __popcll(__ballot(skip)); }
    if (lane == 0) ((int*)(a.ws + WS_JT))[layer * 1024 + u] = cnt;
}
__device__ __forceinline__ void fox_phase(CArgs& a, int layer, char* lds, int rep = 0) {
    using BR = fox::BlockRef<fox::bf16, fox::bf16>;
    constexpr int W = 1 << 30, total = 1024;
    const int tid = lz_tid(), lane = tid & 63;
    volatile unsigned* sbuf = (volatile unsigned*)(lds + 69632);
    unsigned* qctr = (unsigned*)(a.ws + WS_QCTR) + layer * 64 + rep * 128;
    const int* JT = (const int*)(a.ws + WS_JT) + layer * 1024;
#define FOX_GRAB(U) do { if (tid == 0) sbuf[0] = __hip_atomic_fetch_add(qctr, 1u, __ATOMIC_RELAXED, __HIP_MEMORY_SCOPE_AGENT); __syncthreads(); U = __builtin_amdgcn_readfirstlane((int)sbuf[0]); __syncthreads(); } while (0)
#define FOX_MAKE(R, U) do { const int bh_ = (U) & 15, qb_ = 63 - ((U) >> 4); R = fox_ref(a, layer, bh_, qb_, __builtin_amdgcn_readfirstlane(JT[(U)])); } while (0)
    int u; FOX_GRAB(u); if (u >= total) return;
    BR cur; FOX_MAKE(cur, u);
    fox::Seam<fox::bf16> S;
    const __amdgpu_buffer_rsrc_t rs = __builtin_amdgcn_make_buffer_rsrc((void*)a.ws, 0, -1, 0x00020000);
    fox::causal_swa_prime<fox::bf16, fox::bf16>(cur, W, lds, S, rs);
    for (;;) {
        int un; FOX_GRAB(un); const bool last = un >= total;
        BR nxt = cur; if (!last) FOX_MAKE(nxt, un);
        fox::causal_swa_block<fox::bf16, fox::bf16>(cur, nxt, SEQ, W, lds, S, rs);
        if (last) break;
        cur = nxt;
    }
#undef FOX_GRAB
#undef FOX_MAKE
}

#ifdef NANPROBE
constexpr size_t WS_FLAGS = 32 * 1024;
__device__ __forceinline__ void probe_f32(const float* p, size_t n, unsigned* flag) { bool bad = false;
    for (size_t i = (size_t)lz_bid() * 512 + lz_tid(); i < n; i += (size_t)gridDim.x * 512) { const unsigned u = __float_as_uint(p[i]); if ((u & 0x7f800000u) == 0x7f800000u) bad = true; }
    if (bad) *flag = 1u; }
__device__ __forceinline__ void probe_bf16(const unsigned short* p, size_t n, unsigned* flag) { bool bad = false;
    for (size_t i = (size_t)lz_bid() * 512 + lz_tid(); i < n; i += (size_t)gridDim.x * 512) { const unsigned u = p[i]; if ((u & 0x7f80u) == 0x7f80u) bad = true; }
    if (bad) *flag = 1u; }
#define PROBE_F32(p, n, k) probe_f32((const float*)(p), (n), (unsigned*)(ws + WS_FLAGS) + (k))
#define PROBE_BF16(p, n, k) probe_bf16((const unsigned short*)(p), (n), (unsigned*)(ws + WS_FLAGS) + (k))
#else
#define PROBE_F32(p, n, k) do {} while (0)
#define PROBE_BF16(p, n, k) do {} while (0)
#endif
#ifndef PHMASK
#define PHMASK 0xfff
#endif
#define EN(k) ((PHMASK >> (k)) & 1)
#define IN(k) (lo <= (k) && (k) < hi)
#ifdef TWICE_SYNC
#define SEAM() do { if (IN(ph) && IN(ph + 1)) { grid.sync(); grid.sync(); grid.sync(); } ++ph; } while (0)
#else
#define SEAM() do { if (IN(ph) && IN(ph + 1)) { if (ph == 0) grid.sync(); else xcd_barrier(xbar); } ++ph; } while (0)
#endif
#define a (*fresh_args())
#define ws (a.ws)
#define MOD ((const float*)(ws + WS_MOD))
template <int layer>
__device__ __forceinline__ void layer_phases(int& ph, const int lo, const int hi, cg::grid_group& grid, const XcdBarrier& xbar, LAS unsigned char* lds, unsigned char* lds_raw) {

        const float* mod = MOD + (size_t)layer * NB * NMOD;
        const float* xin = layer == 0 ? (const float*)a.in[0] : a.out;
        if (EN(1) && IN(ph)) norm_phase(xin, (const float*)a.in[5] + (size_t)layer * DM, mod, mod + DM, (bf16r*)(ws + WS_H));
#ifdef TWICE_NORM
        if (IN(ph)) norm_phase(xin, (const float*)a.in[5] + (size_t)layer * DM, mod, mod + DM, (bf16r*)(ws + WS_H));
#endif
        SEAM();
        if (EN(2) && IN(ph)) { pg8::Gemm g{(const pg8::bf16_t*)(ws + WS_H), (const pg8::bf16_t*)(ws + WS_WIN + layer * WIN_BYTES), MROWS, NINP, DM}; pg8::StaticOrder S; S.init(MROWS, NINP, gridDim.x, lz_bid());
            pg8::EpiIn E{(pg8::bf16_t*)(ws + WS_P), (float*)(ws + WS_GATES)};
            pg8::gemm_phase<pg8::EpiIn, pg8::StaticOrder, true, true>(lds, g, S, E);
            gate_gemm((const bf16r*)(ws + WS_H), (const bf16r*)(ws + WS_WG + layer * WG_BYTES), (float*)(ws + WS_GATES));
#ifdef TWICE_IN
            __syncthreads(); pg8::gemm_phase<pg8::EpiIn, pg8::StaticOrder, true, true>(lds, g, S, E);
#endif
        }
        SEAM();
        if (EN(3) && IN(ph)) prep_phase(a, layer, lds);
#ifdef TWICE_INPREP
        if (IN(ph)) { xcd_barrier(xbar);
            { pg8::Gemm g{(const pg8::bf16_t*)(ws + WS_H), (const pg8::bf16_t*)(ws + WS_WIN + layer * WIN_BYTES), MROWS, NINP, DM}; pg8::StaticOrder S; S.init(MROWS, NINP, gridDim.x, lz_bid());
              pg8::EpiIn E{(pg8::bf16_t*)(ws + WS_P), (float*)(ws + WS_GATES)};
              pg8::gemm_phase<pg8::EpiIn, pg8::StaticOrder, true, true>(lds, g, S, E); }
            xcd_barrier(xbar); prep_phase(a, layer, lds); }
#endif
        SEAM();
        PROBE_F32(ws + WS_GATES, (size_t)MROWS * 16, 1 + 10 * layer); PROBE_F32(ws + WS_CNEG, (size_t)NB * 8 * SEQ, 2 + 10 * layer); PROBE_F32(ws + WS_MA, (size_t)3 * NB * 4 * SEQ, 3 + 10 * layer); PROBE_BF16(ws + WS_P, (size_t)56 * MROWS * 128, 4 + 10 * layer); PROBE_BF16(ws + WS_MQC, (size_t)8 * MROWS * 128, 5 + 10 * layer);
        if (IN(ph)) { fox_table_phase(a, layer); if (EN(4)) m1_phase(a, lds);
#if 0
#ifdef TWICE_FOX
            __syncthreads(); fox_phase(a, layer, (char*)lds_raw);
#endif
#endif
#ifdef TWICE_M1
            __syncthreads(); m1_phase(a, lds);
#endif
        }
        SEAM();
#ifdef NANPROBE
        PROBE_BF16(ws + WS_H, (size_t)MROWS * DM, 20 + layer); PROBE_F32(ws + WS_UN, (size_t)NB * 4 * 256 * 128, 22 + layer); PROBE_F32(ws + WS_MPREV, (size_t)NB * 4 * 256, 24 + layer); grid.sync();
#endif
        if (IN(ph)) { if (EN(6)) m2_phase(a, lds); __syncthreads(); if (EN(5)) fox_phase(a, layer, (char*)lds_raw);
#ifdef TWICE_FOX
            __syncthreads(); fox_phase(a, layer, (char*)lds_raw, 1);
#endif
        }
        SEAM();
        if (EN(7) && IN(ph)) m3_phase(a, layer, lds);
#ifdef TWICE_M3
        if (IN(ph)) { __syncthreads(); m3_phase(a, layer, lds); }
#endif
        SEAM();
        PROBE_BF16(ws + WS_H, (size_t)MROWS * DM, 6 + 10 * layer); PROBE_BF16(ws + WS_Y, (size_t)MROWS * DM, 7 + 10 * layer);
        if (EN(8) && IN(ph)) { pg8::Gemm g{(const pg8::bf16_t*)(ws + WS_Y), (const pg8::bf16_t*)(ws + WS_WOUT + layer * WOUT_BYTES), MROWS, DM, DM}; pg8::StaticOrder S; S.init(MROWS, DM, gridDim.x, lz_bid());
            pg8::EpiRes E{xin, a.out, mod + 2 * DM};
            pg8::gemm_phase<pg8::EpiRes, pg8::StaticOrder, true, true>(lds, g, S, E); }
        SEAM();
        PROBE_F32(a.out, (size_t)MROWS * DM, 8 + 10 * layer);
        if (EN(1) && IN(ph)) norm_phase(a.out, (const float*)a.in[6] + (size_t)layer * DM, mod + 3 * DM, mod + 4 * DM, (bf16r*)(ws + WS_H));
#ifdef TWICE_NORM
        if (IN(ph)) norm_phase(a.out, (const float*)a.in[6] + (size_t)layer * DM, mod + 3 * DM, mod + 4 * DM, (bf16r*)(ws + WS_H));
#endif
        SEAM();
        if (EN(9) && IN(ph)) { pg8::Gemm g{(const pg8::bf16_t*)(ws + WS_H), (const pg8::bf16_t*)(ws + WS_WFF1 + layer * WFF_BYTES), MROWS, DFF, DM}; pg8::StaticOrder S; S.init(MROWS, DFF, gridDim.x, lz_bid());
            pg8::EpiRelu2 E{(pg8::bf16_t*)(ws + WS_HID), DFF};
            pg8::gemm_phase<pg8::EpiRelu2, pg8::StaticOrder, true, true>(lds, g, S, E);
#ifdef TWICE_FF1
            __syncthreads(); pg8::gemm_phase<pg8::EpiRelu2, pg8::StaticOrder, true, true>(lds, g, S, E);
#endif
        }
        SEAM();
        if (EN(10) && IN(ph)) { pg8::Gemm g{(const pg8::bf16_t*)(ws + WS_HID), (const pg8::bf16_t*)(ws + WS_WFF2 + layer * WFF_BYTES), MROWS, DM, DFF}; pg8::StaticOrder S; S.init(MROWS, DM, gridDim.x, lz_bid());
            pg8::EpiRes E{a.out, a.out, mod + 5 * DM};
            pg8::gemm_phase<pg8::EpiRes, pg8::StaticOrder, true, true>(lds, g, S, E); }
        SEAM();
        PROBE_F32(a.out, (size_t)MROWS * DM, 9 + 10 * layer);
    }
__global__ void __launch_bounds__(512, 2) trunk_fwd(Args a_unused) {
    extern __shared__ __attribute__((aligned(16))) unsigned char lds_raw[];
    LAS unsigned char* lds = (LAS unsigned char*)lds_raw;
    cg::grid_group grid = cg::this_grid();
    int lo, hi; { CArgs& a0 = *fresh_args(); lo = a0.ph_lo; hi = a0.ph_hi; } int ph = 0;
    volatile LAS unsigned* xst = (volatile LAS unsigned*)(lds + 139264);
    if (lz_tid() < 2) xst[lz_tid()] = 0u;
    __syncthreads();
    if (lz_bid() == 0) { unsigned* z = (unsigned*)ws; for (int i = lz_tid(); i < 4096; i += 512) z[i] = 0u; }
#ifdef NANPROBE
    if (lz_bid() == 0 && lz_tid() < 32) ((unsigned*)(ws + WS_FLAGS))[lz_tid()] = 0u;
#endif
    if (EN(0) && IN(ph)) p0_phase(a, lds);
#ifdef TWICE_P0
    if (IN(ph)) { __syncthreads(); p0_phase(a, lds); }
#endif
    if (IN(ph) && IN(ph + 1)) grid.sync();
    ++ph;
    const XcdBarrier xbar = xcd_barrier_post((unsigned*)ws, xst);
    layer_phases<0>(ph, lo, hi, grid, xbar, lds, lds_raw);
    layer_phases<1>(ph, lo, hi, grid, xbar, lds, lds_raw);
    if (EN(11) && IN(ph)) final_norm_phase(a.out, (const float*)a.in[17]);
#ifdef NANPROBE
    { grid.sync(); float code = 0.f; const unsigned* fl = (const unsigned*)(ws + WS_FLAGS);
      const int order[16] = {1, 2, 3, 4, 5, 24, 20, 22, 6, 7, 8, 9, 11, 12, 13, 14};
      for (int q = 15; q >= 0; --q) if (fl[order[q]]) code = (float)order[q] * 1.0e6f;
      float* o = a.out; for (size_t i = (size_t)lz_bid() * 512 + lz_tid(); i < (size_t)MROWS * DM; i += (size_t)gridDim.x * 512) o[i] = (i == 0) ? code : 0.f; }
#endif
#ifdef DBG_OFF_MIB
    { grid.sync();
      const unsigned short* src = (const unsigned short*)(ws + (size_t)DBG_OFF_MIB * MiB); const size_t n = (size_t)DBG_MIB * MiB / 2; float* o = a.out;
      for (size_t i = (size_t)lz_bid() * 512 + lz_tid(); i < (size_t)MROWS * DM; i += (size_t)gridDim.x * 512) { const size_t k = (4 * i) % n;
          o[i] = (float)src[k] + 3.f * (float)src[k + 1] + 5.f * (float)src[k + 2] + 7.f * (float)src[k + 3]; } }
#endif
#undef IN
#undef SEAM
#undef a
#undef ws
#undef MOD
}

#ifndef MK_PER_PHASE
#define MK_PER_PHASE 0
#endif
extern "C" void kernel_launch(void* const* d_in, const int* in_sizes, int n_in, void* d_out, int out_size, void* d_ws, size_t ws_size, hipStream_t stream) {
    static int grid = 0;
    if (grid == 0) {
        if (n_in != 18 || in_sizes[0] != MROWS * DM || out_size != MROWS * DM || ws_size < WS_END) { fprintf(stderr, "kernel_launch: unexpected shapes (n_in %d, in0 %d, out %d, ws %zu)\n", n_in, n_in > 0 ? in_sizes[0] : -1, out_size, ws_size); grid = -1; return; }
        int dev = 0, cus = 0, per_cu = 0;
        if (hipGetDevice(&dev) != hipSuccess || hipDeviceGetAttribute(&cus, hipDeviceAttributeMultiprocessorCount, dev) != hipSuccess) { grid = -1; return; }
        if (hipFuncSetAttribute((const void*)trunk_fwd, hipFuncAttributeMaxDynamicSharedMemorySize, LDS_BYTES) != hipSuccess) { fprintf(stderr, "kernel_launch: hipFuncSetAttribute failed\n"); grid = -1; return; }
        if (hipOccupancyMaxActiveBlocksPerMultiprocessor(&per_cu, (const void*)trunk_fwd, 512, LDS_BYTES) != hipSuccess || per_cu < 1) { fprintf(stderr, "kernel_launch: occupancy query says %d\n", per_cu); per_cu = 1; }
        (void)hipGetLastError();
        grid = cus;
    }
    if (grid < 0) return;
    Args a{};
    for (int i = 0; i < 18; ++i) a.in[i] = d_in[i];
    a.out = (float*)d_out; a.ws = (unsigned char*)d_ws;
    constexpr int NPH = 1 + 2 * 10 + 1;
#if MK_PER_PHASE
    for (int p = 0; p < NPH; ++p) { a.ph_lo = p; a.ph_hi = p + 1; hipLaunchKernelGGL(trunk_fwd, dim3(grid), dim3(512), LDS_BYTES, stream, a); }
#else
#ifdef DBG_HI
    a.ph_lo = 0; a.ph_hi = DBG_HI;
#else
    a.ph_lo = 0; a.ph_hi = NPH;
#endif
    void* args[] = {&a};
    hipError_t e = hipLaunchCooperativeKernel((const void*)trunk_fwd, dim3(grid), dim3(512), args, LDS_BYTES, stream);
    if (e != hipSuccess) fprintf(stderr, "kernel_launch: cooperative launch failed: %s (grid %d)\n", hipGetErrorString(e), grid);
#endif
}
```

```cpp
#include <hip/hip_runtime.h>
#include <hip/hip_bf16.h>
#include <hip/hip_cooperative_groups.h>
#include <cstdio>
#include <cstdint>
namespace cg = cooperative_groups;

constexpr int NB = 2, SEQ = 16384, DM = 2048, MROWS = NB * SEQ, DIN = 7184, NINP = 7168, DFF = 8192, HD = 128, NMOD = 6 * DM;
constexpr int NSLOT = 56;
constexpr float NORM_EPS = 1e-6f;
constexpr float KSCALE = 0.08838834764831845f;

__device__ __forceinline__ int lz_tid() { const int w = __builtin_amdgcn_readfirstlane((int)threadIdx.x >> 6); int l; asm volatile("v_mbcnt_lo_u32_b32 %0, -1, 0\n\tv_mbcnt_hi_u32_b32 %0, -1, %0" : "=v"(l));
    int t = w * 64 + l; asm volatile("" : "+v"(t)); return t; }
__device__ __forceinline__ int lz_bid() { int b = blockIdx.x; asm volatile("" : "+s"(b)); return b; }

namespace pg8 {
#define PG8_LAS __attribute__((address_space(3)))
typedef unsigned short bf16_t;
typedef short bf16x8 __attribute__((ext_vector_type(8)));
typedef float f32x4 __attribute__((ext_vector_type(4)));
typedef unsigned u32x4 __attribute__((ext_vector_type(4)));
constexpr int BM = 256, BK = 64, HALF = 128, HTB = HALF * BK * 2  , STAGE_BYTES = 8 * HTB, NXCD = 8, WGM = 4;

__host__ __device__ __forceinline__ int lds_byte(int r, int c) { const int st = (r >> 4) * 2 + (c >> 5), rr = r & 15, cc = c & 31, ob = rr * 64 + cc * 2; return st * 1024 + (ob ^ (((ob >> 9) & 1) << 5)); }
__host__ __device__ __forceinline__ void stage_rc(int b, int& R, int& C) { const int st = b / 1024, sb = b % 1024, swz = sb ^ (((sb >> 9) & 1) << 5); R = (st >> 1) * 16 + swz / 64; C = (st & 1) * 32 + (swz % 64) / 2; }
__host__ __device__ __forceinline__ int perm32(int rho) { const int n = rho >> 4, i = rho & 15; return 8 * (i >> 2) + 4 * n + (i & 3); }

struct Unit { int pm, pn; };
struct Gemm { const bf16_t* A; const bf16_t* Bt; int M, N, K; };

struct StaticOrder {
    int nM, nN, nwg, G, c;
    __host__ __device__ void init(int M, int N, int G_, int c_) { nM = M / BM; nN = N / BM; nwg = nM * nN; G = G_; c = c_; }
    __host__ __device__ bool next(int i, Unit& u) const {
        const long L = (long)i * G + c; if (L >= nwg) return false;
        int wgid = (int)L; { const int q = nwg / NXCD, r = nwg % NXCD, xcd = wgid % NXCD, off = wgid / NXCD; wgid = (xcd < r ? xcd * (q + 1) : r * (q + 1) + (xcd - r) * q) + off; }
        const int nig = WGM * nN, gid = wgid / nig, fm = gid * WGM, gsz = (nM - fm) < WGM ? (nM - fm) : WGM;
        u.pm = fm + ((wgid % nig) % gsz); u.pn = (wgid % nig) / gsz; return true;
    }
    __device__ __forceinline__ void a_ready(const Unit&) const {}
    __device__ __forceinline__ void done(const Unit&) const {}
};

__device__ __forceinline__ unsigned cvt_pk_bf16(float lo, float hi) { unsigned r; asm volatile("v_cvt_pk_bf16_f32 %0, %1, %2" : "=v"(r) : "v"(lo), "v"(hi)); return r; }

typedef float epf2_t __attribute__((ext_vector_type(2))); typedef __bf16 epb2_t __attribute__((ext_vector_type(2)));
__device__ __forceinline__ unsigned cvt_pk_c(float lo, float hi) { epf2_t v = {lo, hi}; epb2_t b = __builtin_convertvector(v, epb2_t); return __builtin_bit_cast(unsigned, b); }
struct EpiIn {
    static constexpr bool PERM = true, AFTER_DRAIN = false;
    bf16_t* P; float* gates;
    __device__ __forceinline__ void operator()(const f32x4 (&acc)[2][2][4][2], const Unit& u, int wr, int wc, int fr, int fq) const {
        const int row0 = u.pm * BM + wr * 64 + fr;
#pragma unroll
        for (int bj = 0; bj < 2; ++bj) {
            const int g = 2 * u.pn + bj;
            if (g < 56) {
                bf16_t* base = P + ((size_t)g * MROWS + row0) * 128 + wc * 32 + 8 * fq;
#pragma unroll
                for (int ai = 0; ai < 2; ++ai)
#pragma unroll
                    for (int m = 0; m < 4; ++m) { const f32x4 v0 = acc[ai][bj][m][0], v1 = acc[ai][bj][m][1];
                        u32x4 w; w.x = cvt_pk_c(v0[0], v0[1]); w.y = cvt_pk_c(v0[2], v0[3]); w.z = cvt_pk_c(v1[0], v1[1]); w.w = cvt_pk_c(v1[2], v1[3]);
                        *(u32x4*)(base + (size_t)(ai * HALF + m * 16) * 128) = w; }
            } else if (g == 56) {
                if (wc == 0 && fq < 2) { float* gp = gates + (size_t)row0 * 16 + 8 * fq;
#pragma unroll
                    for (int ai = 0; ai < 2; ++ai)
#pragma unroll
                        for (int m = 0; m < 4; ++m) { *(f32x4*)(gp + (size_t)(ai * HALF + m * 16) * 16) = acc[ai][bj][m][0]; *(f32x4*)(gp + (size_t)(ai * HALF + m * 16) * 16 + 4) = acc[ai][bj][m][1]; } }
            }
        }
    }
};
struct EpiRes {
    static constexpr bool PERM = true, AFTER_DRAIN = false;
    const float* base; float* out; const float* gvec;
    __device__ __forceinline__ void operator()(const f32x4 (&acc)[2][2][4][2], const Unit& u, int wr, int wc, int fr, int fq) const {
        const int row0 = u.pm * BM + wr * 64 + fr; const int b = (u.pm * BM) / SEQ; const float* gv = gvec + (size_t)b * NMOD;
#pragma unroll
        for (int bj = 0; bj < 2; ++bj) { const int c = u.pn * BM + bj * HALF + wc * 32 + 8 * fq;
            const f32x4 g0 = *(const f32x4*)(gv + c), g1 = *(const f32x4*)(gv + c + 4);
#pragma unroll
            for (int ai = 0; ai < 2; ++ai)
#pragma unroll
                for (int m = 0; m < 4; ++m) { const size_t off = (size_t)(row0 + ai * HALF + m * 16) * DM + c;
                    const f32x4 x0 = *(const f32x4*)(base + off), x1 = *(const f32x4*)(base + off + 4);
                    *(f32x4*)(out + off) = x0 + g0 * acc[ai][bj][m][0]; *(f32x4*)(out + off + 4) = x1 + g1 * acc[ai][bj][m][1]; } }
    }
};
struct EpiRelu2 {
    static constexpr bool PERM = true, AFTER_DRAIN = false;
    bf16_t* O; int ldc;
    __device__ __forceinline__ void operator()(const f32x4 (&acc)[2][2][4][2], const Unit& u, int wr, int wc, int fr, int fq) const {
        const int row0 = u.pm * BM + wr * 64 + fr;
#pragma unroll
        for (int bj = 0; bj < 2; ++bj) { bf16_t* base = O + (size_t)row0 * ldc + u.pn * BM + bj * HALF + wc * 32 + 8 * fq;
#pragma unroll
            for (int ai = 0; ai < 2; ++ai)
#pragma unroll
                for (int m = 0; m < 4; ++m) { f32x4 v0 = acc[ai][bj][m][0], v1 = acc[ai][bj][m][1];
#pragma unroll
                    for (int i = 0; i < 4; ++i) { const float a = v0[i] > 0.f ? v0[i] : 0.f, b = v1[i] > 0.f ? v1[i] : 0.f; v0[i] = a * a; v1[i] = b * b; }
                    u32x4 w; w.x = cvt_pk_c(v0[0], v0[1]); w.y = cvt_pk_c(v0[2], v0[3]); w.z = cvt_pk_c(v1[0], v1[1]); w.w = cvt_pk_c(v1[2], v1[3]);
                    *(u32x4*)(base + (size_t)(ai * HALF + m * 16) * ldc) = w; } }
    }
};

template <class Epi, class Sched, bool ALIGN_EPI = false, bool SP2 = false>
__device__ __forceinline__ void gemm_phase(PG8_LAS unsigned char* lds, const Gemm g, const Sched& S, const Epi& E) {
    const int tid = lz_tid(), wid = __builtin_amdgcn_readfirstlane(tid >> 6), lane = tid & 63, wr = wid >> 2, wc = wid & 3, fr = lane & 15, fq = lane >> 4;
    const int K = g.K, nt = K / BK;
    unsigned voffA[2], voffB[2];
#pragma unroll
    for (int i = 0; i < 2; ++i) { int R, C; stage_rc(tid * 16 + i * 8192, R, C); const int Rb = Epi::PERM ? ((R & ~31) + perm32(R & 31)) : R;
        voffA[i] = (unsigned)(R * K + C) * 2u; voffB[i] = (unsigned)(Rb * K + C) * 2u; }
    const size_t kstep = (size_t)(BK * 2);
    const size_t hstep = (size_t)HALF * K * 2;
    const size_t tstep = 2 * hstep;
    const unsigned ldsw = (unsigned)wid * 1024u;
    const int aoff = lds_byte(wr * 64 + fr, fq * 8), boff = lds_byte(wc * 32 + fr, fq * 8);
#define PG8_SA(b, h) (((b) * 2 + (h)) * HTB)
#define PG8_SB(b, h) ((4 + (b) * 2 + (h)) * HTB)
#define PG8_STAGE(bufoff, gbase, voff) do { _Pragma("unroll") for (int _i = 0; _i < 2; ++_i) \
        __builtin_amdgcn_global_load_lds((const unsigned*)((const char*)(gbase) + (voff)[_i]), (PG8_LAS unsigned*)(lds + (bufoff) + ldsw + _i * 8192), 16, 0, 0); } while (0)
#define PG8_LDA(dst, b, h) do { _Pragma("unroll") for (int m = 0; m < 4; ++m) _Pragma("unroll") for (int k = 0; k < 2; ++k) dst[m][k] = *(const PG8_LAS bf16x8*)(lds + PG8_SA(b, h) + aoff + m * 2048 + k * 1024); } while (0)
#define PG8_LDB(dst, b, h) do { _Pragma("unroll") for (int n = 0; n < 2; ++n) _Pragma("unroll") for (int k = 0; k < 2; ++k) dst[n][k] = *(const PG8_LAS bf16x8*)(lds + PG8_SB(b, h) + boff + n * 2048 + k * 1024); } while (0)
#define PG8_MMA(ai, bj, At, Bt) do { __builtin_amdgcn_s_setprio(1); _Pragma("unroll") for (int m = 0; m < 4; ++m) _Pragma("unroll") for (int n = 0; n < 2; ++n) _Pragma("unroll") for (int k = 0; k < 2; ++k) \
        acc[ai][bj][m][n] = __builtin_amdgcn_mfma_f32_16x16x32_bf16(Bt[n][k], At[m][k], acc[ai][bj][m][n], 0, 0, 0); __builtin_amdgcn_s_setprio(0); } while (0)
#define PG8_WAIT_V(n) asm volatile("s_waitcnt vmcnt(" #n ")" ::: "memory")
#define PG8_WAIT_L(n) asm volatile("s_waitcnt lgkmcnt(" #n ")" ::: "memory")
#define PG8_BAR __builtin_amdgcn_s_barrier()
#define PG8_SCHED __builtin_amdgcn_sched_barrier(0)
    Unit cur, nxt; int ui = 0;
    if (!S.next(0, cur)) return;
    f32x4 acc[2][2][4][2];
#pragma unroll
    for (int a = 0; a < 2; ++a)
#pragma unroll
        for (int b = 0; b < 2; ++b)
#pragma unroll
            for (int m = 0; m < 4; ++m)
#pragma unroll
                for (int n = 0; n < 2; ++n) acc[a][b][m][n] = (f32x4){0.f, 0.f, 0.f, 0.f};
    bf16x8 At[4][2], B0[2][2], B1[2][2];
    const char* cA = (const char*)g.A + (size_t)cur.pm * tstep; const char* cB = (const char*)g.Bt + (size_t)cur.pn * tstep;
    S.a_ready(cur);
    if constexpr (SP2) {
        PG8_STAGE(PG8_SB(0, 0), cB, voffB); PG8_STAGE(PG8_SB(0, 1), cB + hstep, voffB); PG8_STAGE(PG8_SA(0, 0), cA, voffA); PG8_STAGE(PG8_SA(0, 1), cA + hstep, voffA);
        if (wr == 1) PG8_BAR;
        PG8_WAIT_V(2); PG8_BAR;
        PG8_STAGE(PG8_SB(1, 0), cB + kstep, voffB); PG8_STAGE(PG8_SA(1, 0), cA + kstep, voffA); PG8_STAGE(PG8_SB(1, 1), cB + hstep + kstep, voffB);
        PG8_WAIT_V(6); PG8_BAR;
    } else {
        PG8_STAGE(PG8_SB(0, 0), cB, voffB); PG8_STAGE(PG8_SA(0, 0), cA, voffA); PG8_STAGE(PG8_SB(0, 1), cB + hstep, voffB); PG8_STAGE(PG8_SA(0, 1), cA + hstep, voffA);
        if (wr == 1) PG8_BAR;
        PG8_WAIT_V(4); PG8_BAR;
        PG8_STAGE(PG8_SB(1, 0), cB + kstep, voffB); PG8_STAGE(PG8_SA(1, 0), cA + kstep, voffA); PG8_STAGE(PG8_SB(1, 1), cB + hstep + kstep, voffB);
        PG8_WAIT_V(6); PG8_BAR;
    }
    for (;;) {
        const bool has_next = S.next(ui + 1, nxt);
        const char* nA = has_next ? (const char*)g.A + (size_t)nxt.pm * tstep : cA; const char* nB = has_next ? (const char*)g.Bt + (size_t)nxt.pn * tstep : cB;
        for (int t = 0; t < nt; t += 2) {
            const bool last = (t == nt - 2);
            const char* a1 = cA + (size_t)(t + 1) * kstep;
            const char* a2 = last ? nA : cA + (size_t)(t + 2) * kstep; const char* b2 = last ? nB : cB + (size_t)(t + 2) * kstep;
            const char* a3 = a2 + kstep; const char* b3 = b2 + kstep;
            if (last && has_next) S.a_ready(nxt);
            if constexpr (SP2) {
            PG8_LDB(B0, 0, 0); PG8_LDB(B1, 0, 1); PG8_SCHED; PG8_LDA(At, 0, 0); PG8_STAGE(PG8_SA(1, 1), a1 + hstep, voffA);
            PG8_WAIT_V(8); PG8_WAIT_L(0); PG8_BAR; PG8_MMA(0, 0, At, B0); PG8_MMA(0, 1, At, B1); PG8_BAR; PG8_SCHED;
            PG8_LDA(At, 0, 1); PG8_STAGE(PG8_SB(0, 0), b2, voffB); PG8_STAGE(PG8_SB(0, 1), b2 + hstep, voffB); PG8_STAGE(PG8_SA(0, 0), a2, voffA);
            PG8_WAIT_V(8); PG8_WAIT_L(0); PG8_BAR; PG8_MMA(1, 0, At, B0); PG8_MMA(1, 1, At, B1); PG8_BAR; PG8_SCHED;
            PG8_LDB(B0, 1, 0); PG8_LDB(B1, 1, 1); PG8_SCHED; PG8_LDA(At, 1, 0); PG8_STAGE(PG8_SA(0, 1), a2 + hstep, voffA);
            PG8_WAIT_V(8); PG8_WAIT_L(0); PG8_BAR; PG8_MMA(0, 0, At, B0); PG8_MMA(0, 1, At, B1); PG8_BAR; PG8_SCHED;
            PG8_LDA(At, 1, 1); PG8_STAGE(PG8_SB(1, 0), b3, voffB); PG8_STAGE(PG8_SB(1, 1), b3 + hstep, voffB); PG8_STAGE(PG8_SA(1, 0), a3, voffA);
            PG8_WAIT_V(8); PG8_WAIT_L(0); PG8_BAR; PG8_MMA(1, 0, At, B0); PG8_MMA(1, 1, At, B1); PG8_BAR; PG8_SCHED;
            } else {
            PG8_LDB(B0, 0, 0); PG8_SCHED; PG8_LDA(At, 0, 0); PG8_STAGE(PG8_SA(1, 1), a1 + hstep, voffA);
            PG8_WAIT_L(8); PG8_BAR; PG8_WAIT_L(0); PG8_MMA(0, 0, At, B0); PG8_BAR; PG8_SCHED;
            PG8_LDB(B1, 0, 1); PG8_STAGE(PG8_SB(0, 0), b2, voffB);
            PG8_BAR; PG8_WAIT_L(0); PG8_MMA(0, 1, At, B1); PG8_BAR;
            PG8_LDA(At, 0, 1); PG8_STAGE(PG8_SA(0, 0), a2, voffA);
            PG8_BAR; PG8_WAIT_L(0); PG8_MMA(1, 0, At, B0); PG8_BAR; PG8_SCHED;
            PG8_STAGE(PG8_SB(0, 1), b2 + hstep, voffB);
            PG8_WAIT_V(6); PG8_BAR; PG8_MMA(1, 1, At, B1); PG8_BAR;
            PG8_LDB(B0, 1, 0); PG8_SCHED; PG8_LDA(At, 1, 0); PG8_STAGE(PG8_SA(0, 1), a2 + hstep, voffA);
            PG8_WAIT_L(8); PG8_BAR; PG8_WAIT_L(0); PG8_MMA(0, 0, At, B0); PG8_BAR; PG8_SCHED;
            PG8_LDB(B1, 1, 1); PG8_STAGE(PG8_SB(1, 0), b3, voffB);
            PG8_BAR; PG8_WAIT_L(0); PG8_MMA(0, 1, At, B1); PG8_BAR;
            PG8_LDA(At, 1, 1); PG8_STAGE(PG8_SA(1, 0), a3, voffA);
            PG8_BAR; PG8_WAIT_L(0); PG8_MMA(1, 0, At, B0); PG8_BAR; PG8_SCHED;
            PG8_STAGE(PG8_SB(1, 1), b3 + hstep, voffB);
            PG8_WAIT_V(6); PG8_BAR; PG8_MMA(1, 1, At, B1); PG8_BAR;
            }
        }
        if constexpr (ALIGN_EPI) { if (wr == 0) PG8_BAR; }
        if constexpr (!Epi::AFTER_DRAIN) { E(acc, cur, wr, wc, fr, fq); S.done(cur); }
        if (!has_next) break;
#pragma unroll
        for (int a = 0; a < 2; ++a)
#pragma unroll
            for (int b = 0; b < 2; ++b)
#pragma unroll
                for (int m = 0; m < 4; ++m)
#pragma unroll
                    for (int n = 0; n < 2; ++n) acc[a][b][m][n] = (f32x4){0.f, 0.f, 0.f, 0.f};
        cur = nxt; cA = nA; cB = nB; ++ui;
        if constexpr (ALIGN_EPI) { if (wr == 1) PG8_BAR; }
    }
    PG8_WAIT_V(0);
    if constexpr (!ALIGN_EPI) { if (wr == 0) PG8_BAR; }
    PG8_BAR;
    if constexpr (Epi::AFTER_DRAIN) { E.fused(acc, cur, wr, wc, fr, fq, lds, wid, lane); S.done(cur); }
#undef PG8_SA
#undef PG8_SB
#undef PG8_STAGE
#undef PG8_LDA
#undef PG8_LDB
#undef PG8_MMA
#undef PG8_WAIT_V
#undef PG8_WAIT_L
#undef PG8_BAR
#undef PG8_SCHED
}
}
namespace fox {
constexpr int D = 128; constexpr float THR = 32.f; constexpr bool WSKIP = false; constexpr int OSTR = 2048;
constexpr float SCALE = 0.08838834764831845f;
constexpr int NW = 8, QBLK = 32, KVBLK = 64, QB = NW * QBLK;
constexpr int SHM_V = KVBLK * D * 2, SHM_K = KVBLK * D * 2;
constexpr int LDS_CB = 2 * SHM_V + 2 * SHM_K + NW * 64 * 4; constexpr int LDS_BYTES = LDS_CB + 2 * 64 * 4;

using bf16 = __hip_bfloat16;
typedef short bf16x8 __attribute__((ext_vector_type(8)));
typedef short s16x4 __attribute__((ext_vector_type(4)));
typedef float f32x16 __attribute__((ext_vector_type(16)));
typedef float f32x4 __attribute__((ext_vector_type(4)));
typedef unsigned u32x4 __attribute__((ext_vector_type(4)));
template <class A, class Bt> struct same_t { static constexpr bool v = false; };
template <class A> struct same_t<A, A> { static constexpr bool v = true; };

#define KSWZ(row, colB) ((row) * 256 + ((colB) ^ (((row) & 7) << 4)))
#define SBAR() __builtin_amdgcn_sched_barrier(0)
__device__ __forceinline__ int v_st(int k, int c) { const int kk = (k & ~0xC) | ((k & 4) << 1) | ((k & 8) >> 1); return ((kk >> 3) * 4 + (c >> 5)) * 512 + ((kk & 7) * 32 + (c & 31)) * 2; }
__device__ __forceinline__ int v_rd_base(int lane) { return ((lane & 3) << 3) | (((lane >> 2) & 3) << 6) | (((lane >> 4) & 1) << 5) | (((lane >> 5) & 1) << 8); }
constexpr int v_rd_off(int d0, int ks, int half) { return d0 * 512 + ks * 4096 + half * 2048; }
__device__ __forceinline__ int crow(int r, int hi) { return (r & 3) + 8 * (r >> 2) + 4 * hi; }
__device__ __forceinline__ unsigned cvtpk(float lo, float hi) {
    unsigned r; asm volatile("v_cvt_pk_bf16_f32 %0, %1, %2" : "=v"(r) : "v"(lo), "v"(hi)); return r;
}
__device__ __forceinline__ bf16x8 pack8(f32x4 a, f32x4 b) {
    u32x4 w = {cvtpk(a[0], a[1]), cvtpk(a[2], a[3]), cvtpk(b[0], b[1]), cvtpk(b[2], b[3])};
    return *reinterpret_cast<bf16x8*>(&w);
}
template <class T> __device__ __forceinline__ bf16x8 load8(const T* p) {
    if constexpr (same_t<T, float>::v) { return pack8(*(const f32x4*)p, *(const f32x4*)(p + 4)); }
    else { return *reinterpret_cast<const bf16x8*>(p); }
}
__device__ __forceinline__ void mask_tile(f32x16& p0, f32x16& p1, int dq, unsigned W) {
    const float NEG = -__builtin_inff();
#pragma unroll
    for (int r = 0; r < 16; ++r) {
        const int c = (r & 3) + 8 * (r >> 2);
        if ((unsigned)(dq - c) >= W) p0[r] = NEG;
        if ((unsigned)(dq - c - 32) >= W) p1[r] = NEG;
    }
}
__device__ __forceinline__ void partialSM(f32x16& p0, f32x16& p1, float& m_reg, float& mn, float& alpha) {
    float pmax = p0[0]; for (int r = 1; r < 16; ++r) pmax = fmaxf(pmax, p0[r]); for (int r = 0; r < 16; ++r) pmax = fmaxf(pmax, p1[r]);
    { auto rr = __builtin_amdgcn_permlane32_swap(__float_as_uint(pmax), __float_as_uint(pmax), false, false);
      pmax = fmaxf(__uint_as_float(rr[0]), __uint_as_float(rr[1])); }
    constexpr float C2 = 1.4426950408889634f * SCALE;
    if (__builtin_expect(__all((pmax - m_reg) * SCALE <= THR), 1)) { mn = m_reg; alpha = 1.f; }
    else { mn = fmaxf(m_reg, pmax); alpha = __builtin_amdgcn_exp2f((m_reg - mn) * C2); m_reg = mn; }
    const float mnL = -mn * C2;
    for (int r = 0; r < 16; ++r) p0[r] = fmaf(p0[r], C2, mnL); for (int r = 0; r < 16; ++r) p1[r] = fmaf(p1[r], C2, mnL);
    for (int r = 0; r < 16; ++r) p0[r] = __builtin_amdgcn_exp2f(p0[r]);
}
__device__ __forceinline__ void finishSM(f32x16& p0, f32x16& p1, float alpha, float& l_reg, bf16x8& pa0, bf16x8& pa1, bf16x8& pa2, bf16x8& pa3) {
    for (int r = 0; r < 16; ++r) p1[r] = __builtin_amdgcn_exp2f(p1[r]);
    float ps = 0; for (int r = 0; r < 16; ++r) ps += p0[r]; for (int r = 0; r < 16; ++r) ps += p1[r];
    { auto rr = __builtin_amdgcn_permlane32_swap(__float_as_uint(ps), __float_as_uint(ps), false, false);
      ps = __uint_as_float(rr[0]) + __uint_as_float(rr[1]); }
    l_reg = l_reg * alpha + ps;
#define PK4(P, B_, OUT) do { unsigned a0 = cvtpk(P[B_+0], P[B_+1]), a1 = cvtpk(P[B_+2], P[B_+3]);                          \
        unsigned b0 = cvtpk(P[B_+4], P[B_+5]), b1 = cvtpk(P[B_+6], P[B_+7]);                                             \
        auto r0 = __builtin_amdgcn_permlane32_swap(a0, b0, false, false); auto r1 = __builtin_amdgcn_permlane32_swap(a1, b1, false, false); \
        u32x4 w = {r0[0], r1[0], r0[1], r1[1]}; OUT = *reinterpret_cast<bf16x8*>(&w); } while (0)
    PK4(p0, 0, pa0); PK4(p0, 8, pa1); PK4(p1, 0, pa2); PK4(p1, 8, pa3);
#undef PK4
}
template <int KB, bool SK>
__device__ __forceinline__ void qkt(f32x16& p0, f32x16& p1, const char* K_lds, const float* cb, int r32, int hi, const bf16x8* qr, bool act) {
    if (SK && !act) { const float NEG = -__builtin_inff();
#pragma unroll
        for (int r = 0; r < 16; ++r) { p0[r] = NEG; p1[r] = NEG; } return; }
    { const float* cbp = cb + KB * 64 + 4 * hi;
#pragma unroll
      for (int g = 0; g < 4; ++g) { const f32x4 t0 = *(const f32x4*)(cbp + 8 * g), t1 = *(const f32x4*)(cbp + 32 + 8 * g);
        p0[4*g] = t0[0]; p0[4*g+1] = t0[1]; p0[4*g+2] = t0[2]; p0[4*g+3] = t0[3]; p1[4*g] = t1[0]; p1[4*g+1] = t1[1]; p1[4*g+2] = t1[2]; p1[4*g+3] = t1[3]; } }
    const char* kb[4];
#pragma unroll
    for (int dd = 0; dd < 4; ++dd) kb[dd] = K_lds + KB * SHM_K + KSWZ(r32, (dd * 16 + hi * 8) * 2);
#pragma unroll
    for (int d0 = 0; d0 < 8; ++d0) { const char* a = kb[d0 & 3] + (d0 >> 2) * 128;
        bf16x8 b0 = *reinterpret_cast<const bf16x8*>(a);
        bf16x8 b1 = *reinterpret_cast<const bf16x8*>(a + 32 * 256);
        p0 = __builtin_amdgcn_mfma_f32_32x32x16_bf16(b0, qr[d0], p0, 0, 0, 0);
        p1 = __builtin_amdgcn_mfma_f32_32x32x16_bf16(b1, qr[d0], p1, 0, 0, 0); }
}
template <int VB, bool SK>
__device__ __forceinline__ void pv_tile(f32x16* o, int vb0, bf16x8 pa0, bf16x8 pa1, bf16x8 pa2, bf16x8 pa3, bool act) {
    if (SK && !act) return;
#define TRRD(dst, off) asm volatile("ds_read_b64_tr_b16 %0, %1 offset:%2" : "=&v"(dst) : "v"(vb0), "i"(off) : "memory")
#define PV_D0(d0) do { s16x4 l0, l1, l2, l3, h0, h1, h2, h3; constexpr int b_ = VB * SHM_V + v_rd_off(d0, 0, 0);     \
        TRRD(l0, b_); TRRD(h0, b_ + 2048); TRRD(l1, b_ + 4096); TRRD(h1, b_ + 6144); TRRD(l2, b_ + 8192); TRRD(h2, b_ + 10240); TRRD(l3, b_ + 12288); TRRD(h3, b_ + 14336); \
        asm volatile("s_waitcnt lgkmcnt(0)" ::: "memory"); SBAR();                 \
        o[d0] = __builtin_amdgcn_mfma_f32_32x32x16_bf16(pa0, (bf16x8){l0[0], l0[1], l0[2], l0[3], h0[0], h0[1], h0[2], h0[3]}, o[d0], 0, 0, 0);   \
        o[d0] = __builtin_amdgcn_mfma_f32_32x32x16_bf16(pa1, (bf16x8){l1[0], l1[1], l1[2], l1[3], h1[0], h1[1], h1[2], h1[3]}, o[d0], 0, 0, 0);   \
        o[d0] = __builtin_amdgcn_mfma_f32_32x32x16_bf16(pa2, (bf16x8){l2[0], l2[1], l2[2], l2[3], h2[0], h2[1], h2[2], h2[3]}, o[d0], 0, 0, 0);   \
        o[d0] = __builtin_amdgcn_mfma_f32_32x32x16_bf16(pa3, (bf16x8){l3[0], l3[1], l3[2], l3[3], h3[0], h3[1], h3[2], h3[3]}, o[d0], 0, 0, 0); } while (0)
    PV_D0(0); PV_D0(1); PV_D0(2); PV_D0(3);
#undef PV_D0
#undef TRRD
}

template <class TIn, class TOut> struct BlockRef { const TIn* Q; TOut* O; const float* MS; unsigned K, V, C; int P0; int JLO; };
__device__ __forceinline__ bf16x8 bl128(__amdgpu_buffer_rsrc_t rs, unsigned vo, unsigned so) { return __builtin_bit_cast(bf16x8, __builtin_amdgcn_raw_buffer_load_b128(rs, (int)vo, (int)so, 0)); }
__device__ __forceinline__ float bl32(__amdgpu_buffer_rsrc_t rs, unsigned vo, unsigned so) { return __builtin_bit_cast(float, __builtin_amdgcn_raw_buffer_load_b32(rs, (int)vo, (int)so, 0)); }
template <class TIn> struct Seam {
    bf16x8 qr[8];
    bf16x8 st_v0, st_v1, st_k0, st_k1; f32x4 sf0, sf1, sf2, sf3; float st_c;
    f32x4 tq[16];
};
__device__ __forceinline__ int swa_jlo(int P0, int W) { const int lowk = P0 - W + 1; return lowk > 0 ? lowk / KVBLK : 0; }
#define ROW(p, k0, rr) ((p) + (unsigned)(((k0) + (rr)) * D + sc))
#define VMW() asm volatile("s_waitcnt vmcnt(0)" ::: "memory")
#define VMWN(n) asm volatile("s_waitcnt vmcnt(%0)" :: "i"(n) : "memory")
#define SLOAD_H(Kp, Vp, Cp, k0) do { if (tid < 64) S.st_c = bl32(rs, (unsigned)tid * 4u, (Cp) + (unsigned)(k0) * 4u); \
        S.st_v0 = bl128(rs, vo_st, (Vp) + (unsigned)(k0) * 256u); S.st_v1 = bl128(rs, vo_st, (Vp) + (unsigned)(k0) * 256u + 8192u); \
        S.st_k0 = bl128(rs, vo_st, (Kp) + (unsigned)(k0) * 256u); S.st_k1 = bl128(rs, vo_st, (Kp) + (unsigned)(k0) * 256u + 8192u); } while (0)
#define SWRITE_HK(bf) do { if (tid < 64) cb_l[(bf) * 64 + tid] = S.st_c;  *(bf16x8*)(K_lds + (bf) * SHM_K + kws) = S.st_k0; *(bf16x8*)(K_lds + (bf) * SHM_K + kws + 32 * 256) = S.st_k1; } while (0)
#define SWRITE_HV(bf) do { *(bf16x8*)(V_lds + (bf) * SHM_V + vst0) = S.st_v0; *(bf16x8*)(V_lds + (bf) * SHM_V + vst1) = S.st_v1; } while (0)
#define SWRITE_H(bf) do { SWRITE_HV(bf); SWRITE_HK(bf); } while (0)
#define SLOAD_F(p, k0) do { S.sf0 = *(const f32x4*)ROW(p, k0, sr); S.sf1 = *(const f32x4*)(ROW(p, k0, sr) + 4);                \
                            S.sf2 = *(const f32x4*)ROW(p, k0, 32 + sr); S.sf3 = *(const f32x4*)(ROW(p, k0, 32 + sr) + 4); } while (0)
#define SWRITE_KF(bf) do { *(bf16x8*)(K_lds + (bf) * SHM_K + kws) = pack8(S.sf0, S.sf1); *(bf16x8*)(K_lds + (bf) * SHM_K + kws + 32 * 256) = pack8(S.sf2, S.sf3); } while (0)
#define SWRITE_VF(bf) do { *(bf16x8*)(V_lds + (bf) * SHM_V + vst0) = pack8(S.sf0, S.sf1); *(bf16x8*)(V_lds + (bf) * SHM_V + vst1) = pack8(S.sf2, S.sf3); } while (0)
template <class TIn, class TOut>
__device__ __forceinline__ void causal_swa_prime(const BlockRef<TIn, TOut>& cur, int W, char* lds, Seam<TIn>& S, __amdgpu_buffer_rsrc_t rs) {
    constexpr bool F32 = same_t<TIn, float>::v;
    const int tid = lz_tid(), wid = __builtin_amdgcn_readfirstlane(tid >> 6), lane = tid & 63, r32 = lane & 31, hi = lane >> 5;
    const int sr = tid >> 4, sc = (tid & 15) * 8, kws = KSWZ(sr, sc * 2); char* K_lds = lds + 2 * SHM_V; float* cb_l = (float*)(lds + LDS_CB); const unsigned vo_st = (unsigned)(sr * D + sc) * 2u;
    const int kb0 = swa_jlo(cur.P0, W) * KVBLK;
    for (int d0 = 0; d0 < 8; ++d0) S.qr[d0] = load8<TIn>(cur.Q + (unsigned)((wid * QBLK + r32) * D + d0 * 16 + hi * 8));
    if constexpr (F32) { SLOAD_F((const float*)cur.K, kb0); VMW(); SWRITE_KF(0); SBAR(); SLOAD_F((const float*)cur.V, kb0); }
    else { SLOAD_H(cur.K, cur.V, cur.C, kb0); VMW(); SWRITE_HK(0); }
    __syncthreads();
}
template <class TIn, class TOut>
__device__ __forceinline__ void causal_swa_block(const BlockRef<TIn, TOut>& cur, const BlockRef<TIn, TOut>& nxt, int skv, int W, char* lds, Seam<TIn>& S, __amdgpu_buffer_rsrc_t rs) {
    constexpr bool F32 = same_t<TIn, float>::v;
    const int tid = lz_tid(), wid = __builtin_amdgcn_readfirstlane(tid >> 6), lane = tid & 63, r32 = lane & 31, hi = lane >> 5;
    const int j_lo = swa_jlo(cur.P0, W);
    int j_hi = (cur.P0 + QB - 1) / KVBLK + 1; if (j_hi > skv / KVBLK) j_hi = skv / KVBLK;
    const int NT = j_hi - j_lo;
    const int kbn = swa_jlo(nxt.P0, W) * KVBLK;
    const int qlo = cur.P0 + wid * QBLK, qm = qlo + r32 - 4 * hi;
    char* V_lds = lds; char* K_lds = lds + 2 * SHM_V; float* cb_l = (float*)(lds + LDS_CB);
    float* ws = (float*)(lds + 2 * SHM_V + 2 * SHM_K) + wid * 64; float* li_l = ws, * al_l = ws + 32;
    float m_reg = -1e30f, l_reg = 0; f32x16 o[4] = {};
    const unsigned vo_st = (unsigned)((tid >> 4) * D + (tid & 15) * 8) * 2u; const int sr = tid >> 4, sc = (tid & 15) * 8, vst0 = v_st(sr, sc), vst1 = v_st(32 + sr, sc), kws = KSWZ(sr, sc * 2);
    const int vb0 = (int)(uintptr_t)V_lds + v_rd_base(lane);
    const unsigned Kh = cur.K, Vh = cur.V, Ch = cur.C;
#define RESC(a) do { if (__any((a) < 1.f)) { if (hi == 0) al_l[r32] = (a); asm volatile("s_waitcnt lgkmcnt(0)" ::: "memory");              \
                     for (int d_ = 0; d_ < 4; ++d_) for (int r = 0; r < 16; ++r) o[d_][r] *= al_l[crow(r, hi)]; } } while (0)
#define KBASE(t) ((j_lo + (t)) * KVBLK)
#define ACT(t) (KBASE(t) <= qlo + QBLK - 1 && KBASE(t) + KVBLK - 1 >= qlo - W + 1)
#define MASKT(P0_, P1_, t) do { const int kb_ = KBASE(t); if ((!SK || ACT(t)) && (kb_ + KVBLK - 1 > qlo || kb_ <= qlo + QBLK - 1 - W)) mask_tile(P0_, P1_, qm - kb_, (unsigned)W); } while (0)
    constexpr int NQL = F32 ? 16 : 8;
    constexpr bool SK = WSKIP && !F32;
#define SEAM_K0() do { VMWN(NQL); if constexpr (F32) { SWRITE_KF(0); SBAR(); SLOAD_F((const float*)nxt.V, kbn); } else { SWRITE_HK(0); } SBAR(); } while (0)
    f32x16 pA0, pA1, pB0, pB1; float mnA, mnB, alA, alB; bf16x8 pa0, pa1, pa2, pa3;
    if constexpr (F32) { VMW(); SWRITE_VF(0); SBAR(); } else { SWRITE_HV(0); SBAR(); }
    if (NT > 1) { if constexpr (F32) SLOAD_F((const float*)Kh, KBASE(1)); else SLOAD_H(Kh, Vh, Ch, KBASE(1)); }
    SBAR(); qkt<0, SK>(pA0, pA1, K_lds, cb_l, r32, hi, S.qr, ACT(0));
    if constexpr (F32) { if (NT > 1) { VMW(); SWRITE_KF(1); SBAR(); SLOAD_F((const float*)Vh, KBASE(1)); } }
    MASKT(pA0, pA1, 0); partialSM(pA0, pA1, m_reg, mnA, alA);
    if (NT > 1) { VMW(); if constexpr (F32) { SWRITE_VF(1); SBAR(); if (NT > 2) SLOAD_F((const float*)Kh, KBASE(2)); } else SWRITE_H(1); }
    __syncthreads();
#define HALF_STEP(PX0, PX1, mnX, alX, PY0, PY1, alY, t, KB, VB, SB) do {                                                      \
        SBAR(); qkt<KB, SK>(PX0, PX1, K_lds, cb_l, r32, hi, S.qr, ACT(t));                                             \
        finishSM(PY0, PY1, alY, l_reg, pa0, pa1, pa2, pa3); SBAR();                                                           \
        if ((t) + 1 < NT) { if constexpr (F32) { VMW(); SWRITE_KF(SB); SBAR(); SLOAD_F((const float*)Vh, KBASE((t) + 1)); }  \
                            else { SLOAD_H(Kh, Vh, Ch, KBASE((t) + 1)); } SBAR(); }                                               \
        pv_tile<VB, SK>(o, vb0, pa0, pa1, pa2, pa3, ACT((t) - 1)); MASKT(PX0, PX1, (t)); partialSM(PX0, PX1, m_reg, mnX, alX);                                        \
        __syncthreads();                                                                                                      \
        if ((t) + 1 < NT) { VMW(); if constexpr (F32) { SWRITE_VF(SB); SBAR(); if ((t) + 2 < NT) SLOAD_F((const float*)Kh, KBASE((t) + 2)); } \
                            else { SWRITE_H(SB); } }                                                                          \
        RESC(alX); __syncthreads(); } while (0)
    for (int t = 1; t + 1 < NT; t += 2) {
        HALF_STEP(pB0, pB1, mnB, alB, pA0, pA1, alA, t, 1, 0, 0);
        HALF_STEP(pA0, pA1, mnA, alA, pB0, pB1, alB, t + 1, 0, 1, 1);
    }
    const bool even = (NT & 1) == 0;
    if (even) { SBAR(); qkt<1, SK>(pB0, pB1, K_lds, cb_l, r32, hi, S.qr, ACT(NT - 1)); SBAR(); }
#define QROW(e) (nxt.Q + (size_t)(wid * QBLK + r32) * D + ((e) >> 1) * 16 + hi * 8 + ((e) & 1) * 4)
    if constexpr (F32) { SLOAD_F((const float*)nxt.K, kbn); SBAR();
#pragma unroll
        for (int e = 0; e < 8; ++e) S.tq[e] = *(const f32x4*)QROW(e); }
    else { SLOAD_H(nxt.K, nxt.V, nxt.C, kbn); SBAR();
#pragma unroll
        for (int d0 = 0; d0 < 8; ++d0) S.qr[d0] = load8<TIn>(nxt.Q + (unsigned)((wid * QBLK + r32) * D + d0 * 16 + hi * 8)); }
    SBAR();
    finishSM(pA0, pA1, alA, l_reg, pa0, pa1, pa2, pa3); SBAR();
    if constexpr (F32) {
#pragma unroll
        for (int e = 8; e < 16; ++e) S.tq[e] = *(const f32x4*)QROW(e); SBAR(); }
#undef QROW
    pv_tile<0, SK>(o, vb0, pa0, pa1, pa2, pa3, ACT(even ? NT - 2 : NT - 1));
    if (even) { MASKT(pB0, pB1, NT - 1); partialSM(pB0, pB1, m_reg, mnB, alB); __syncthreads(); RESC(alB);
        finishSM(pB0, pB1, alB, l_reg, pa0, pa1, pa2, pa3); SBAR(); pv_tile<1, SK>(o, vb0, pa0, pa1, pa2, pa3, ACT(NT - 1)); }
    SBAR(); SEAM_K0();
    if (hi == 0) li_l[r32] = l_reg; asm volatile("s_waitcnt lgkmcnt(0)" ::: "memory");
    float rli[16];
#pragma unroll
    for (int r = 0; r < 16; ++r) rli[r] = __builtin_amdgcn_rcpf(li_l[crow(r, hi)]);
    TOut* Ow = cur.O + (size_t)(wid * QBLK) * OSTR;
    { float msv[4];
#pragma unroll
      for (int d0 = 0; d0 < 4; ++d0) msv[d0] = cur.MS[d0 * 32 + r32];
#pragma unroll
      for (int r = 0; r < 16; ++r) { const int orow = crow(r, hi);
        float v0 = o[0][r] * rli[r], v1 = o[1][r] * rli[r], v2 = o[2][r] * rli[r], v3 = o[3][r] * rli[r];
        float sm = (v0 + v1) + (v2 + v3);
#pragma unroll
        for (int off = 1; off < 32; off <<= 1) sm += __shfl_xor(sm, off);
        const float mu = sm * (1.0f / 128.0f);
        v0 -= mu; v1 -= mu; v2 -= mu; v3 -= mu;
        float sq = (v0 * v0 + v1 * v1) + (v2 * v2 + v3 * v3);
#pragma unroll
        for (int off = 1; off < 32; off <<= 1) sq += __shfl_xor(sq, off);
        const float rstd = 1.0f / sqrtf(sq * (1.0f / 128.0f) + 1e-6f);
        float vv[4] = {v0 * rstd * msv[0], v1 * rstd * msv[1], v2 * rstd * msv[2], v3 * rstd * msv[3]};
#pragma unroll
        for (int d0 = 0; d0 < 4; ++d0) { const float v = vv[d0]; const float vn = __shfl_xor(v, 1);
            if ((r32 & 1) == 0) *(unsigned*)(Ow + (unsigned)(orow * OSTR + d0 * 32 + r32)) = cvtpk(v, vn); } } }
    if constexpr (F32) {
#pragma unroll
        for (int d0 = 0; d0 < 8; ++d0) S.qr[d0] = pack8(S.tq[2 * d0], S.tq[2 * d0 + 1]); }
    __syncthreads();
#undef RESC
#undef KBASE
#undef ACT
#undef MASKT
#undef SEAM_K0
#undef HALF_STEP
}
#undef ROW
#undef VMW
#undef VMWN
#undef SLOAD_H
#undef SWRITE_HK
#undef SWRITE_HV
#undef SWRITE_H
#undef SLOAD_F
#undef SWRITE_KF
#undef SWRITE_VF
#undef SBAR
}

#define LAS __attribute__((address_space(3)))
typedef unsigned short bf16r;
typedef unsigned v4u __attribute__((ext_vector_type(4)));
typedef unsigned v2u __attribute__((ext_vector_type(2)));
typedef float v4f __attribute__((ext_vector_type(4)));
typedef float v16f __attribute__((ext_vector_type(16)));
typedef short v8s __attribute__((ext_vector_type(8)));
typedef short v4s __attribute__((ext_vector_type(4)));

#define XB_TMO      128
#define XB_XCNT(j)  (256  + 64 * (j))
#define XB_XSUB(j)  (1280 + 64 * (j))
#define XB_XGEN(j)  (2304 + 64 * (j))
#define XB_TOP      3328
#define XB_TOPGEN   3392
#define XCD_BAR_WORDS 3456
#define XB_SPIN_CAP (1u << 18)

__device__ __forceinline__ unsigned xb_ld(unsigned* p)              { return __hip_atomic_load(p, __ATOMIC_RELAXED, __HIP_MEMORY_SCOPE_AGENT); }
__device__ __forceinline__ unsigned xb_add(unsigned* p, unsigned v) { return __hip_atomic_fetch_add(p, v, __ATOMIC_RELAXED, __HIP_MEMORY_SCOPE_AGENT); }
__device__ __forceinline__ unsigned xb_xcc_id() { return (unsigned)__builtin_amdgcn_s_getreg((3 << 11) | 20) & 0xFu; }
#define XB_SPIN(cond, bar) do { unsigned _sp = 0; while (cond) { __builtin_amdgcn_s_sleep(1); \
    if ((++_sp & 255u) == 0u) { if (xb_ld(&(bar)[XB_TMO])) break; if (_sp > XB_SPIN_CAP) { atomicAdd(&(bar)[XB_TMO], 1u); break; } } } } while (0)

struct XcdBarrier {
    unsigned* bar; unsigned x;
    volatile LAS unsigned* st;
};

__device__ __forceinline__ XcdBarrier xcd_barrier_post(unsigned* bar, volatile LAS unsigned* st) {
    XcdBarrier b; b.bar = bar; b.x = xb_xcc_id(); b.st = st;
    if (lz_tid() == 0) (void)xb_add(&bar[XB_XCNT(b.x)], 1u);
    return b;
}
__device__ __forceinline__ void xcd_barrier_complete(unsigned* bar, unsigned x, unsigned& nloc, unsigned& nx) {
    const unsigned G = gridDim.x * gridDim.y * gridDim.z;
    unsigned sum, cnt, mine, sp = 0u;
    for (;;) {
        sum = 0u; cnt = 0u; mine = 0u;
#pragma unroll
        for (unsigned j = 0; j < 16; ++j) { const unsigned c = xb_ld(&bar[XB_XCNT(j)]); sum += c; cnt += (c > 0u) ? 1u : 0u; mine = (j == x) ? c : mine; }
        if (sum == G) break;
        __builtin_amdgcn_s_sleep(1);
        if ((++sp & 255u) == 0u) { if (xb_ld(&bar[XB_TMO])) break; if (sp > XB_SPIN_CAP) { atomicAdd(&bar[XB_TMO], 1u); break; } }
    }
    nloc = mine > 0u ? mine : 1u; nx = cnt > 0u ? cnt : 1u;
}

__device__ __forceinline__ void xcd_barrier(const XcdBarrier& b) {
    asm volatile("s_waitcnt vmcnt(0)" ::: "memory");
    __syncthreads();
    if (lz_tid() == 0) {
        unsigned* bar = b.bar;
        __builtin_amdgcn_s_waitcnt(0);
        unsigned nloc = b.st[0], nx = b.st[1];
        if (nloc == 0u) { xcd_barrier_complete(bar, b.x, nloc, nx); b.st[0] = nloc; b.st[1] = nx; }
        const unsigned old = xb_add(&bar[XB_XSUB(b.x)], 1u);
        const unsigned gen = old / nloc;
        if (old + 1u == (gen + 1u) * nloc) {
            __builtin_amdgcn_fence(__ATOMIC_RELEASE, "agent");
            asm volatile("s_waitcnt vmcnt(0)" ::: "memory");
            const unsigned og = xb_add(&bar[XB_TOP], 1u);
            const unsigned tg = og / nx;
            if (og + 1u == (tg + 1u) * nx) xb_add(&bar[XB_TOPGEN], 1u);
            else XB_SPIN(xb_ld(&bar[XB_TOPGEN]) == tg, bar);
            __builtin_amdgcn_fence(__ATOMIC_ACQUIRE, "agent");
            xb_add(&bar[XB_XGEN(b.x)], 1u);
            asm volatile("s_waitcnt vmcnt(0)" ::: "memory");
        } else {
            XB_SPIN(xb_ld(&bar[XB_XGEN(b.x)]) == gen, bar);
            __builtin_amdgcn_fence(__ATOMIC_ACQUIRE, "agent");
            asm volatile("s_waitcnt vmcnt(0)" ::: "memory");
        }
    }
    __syncthreads();
}

constexpr size_t MiB = 1u << 20;
constexpr size_t WS_QK2 = 14336, WS_QCTR = 15360;
constexpr size_t WS_JT = 20480;
constexpr size_t WS_WG = 1 * MiB, WG_BYTES = 32 * DM * 2;
constexpr size_t WS_MOD = 64 * 1024;
constexpr size_t WS_WIN = 2 * MiB, WIN_BYTES = (size_t)NINP * DM * 2;
constexpr size_t WS_WOUT = 60 * MiB, WOUT_BYTES = (size_t)DM * DM * 2;
constexpr size_t WS_WFF1 = 76 * MiB, WFF_BYTES = (size_t)DFF * DM * 2;
constexpr size_t WS_WFF2 = 140 * MiB;
constexpr size_t WS_H = 204 * MiB;
constexpr size_t WS_P = 332 * MiB;
constexpr size_t WS_Y = 780 * MiB;
constexpr size_t WS_HID = WS_P;
constexpr size_t WS_GATES = 908 * MiB;
constexpr size_t WS_CNEG = 910 * MiB;
constexpr size_t WS_MA = 911 * MiB, WS_MCM = WS_MA + 512 * 1024, WS_MB = WS_MCM + 512 * 1024;
constexpr size_t WS_MPREV = 913 * MiB;
constexpr size_t WS_UN = 914 * MiB;
constexpr size_t WS_MQC = 916 * MiB;
constexpr size_t WS_END = 980 * MiB;
static_assert(WS_WIN + 2 * WIN_BYTES <= WS_WOUT && WS_HID + (size_t)MROWS * DFF * 2 <= WS_Y + (size_t)MROWS * DM * 2 && WS_MQC + (size_t)8 * MROWS * 128 * 2 <= WS_END, "ws map");

constexpr int LDS_BYTES = 147456;

__device__ __forceinline__ float wave_sum(float v) {
#pragma unroll
    for (int o = 1; o < 64; o <<= 1) v += __shfl_xor(v, o);
    return v;
}
typedef float pkf2_t __attribute__((ext_vector_type(2))); typedef __bf16 pkb2_t __attribute__((ext_vector_type(2)));
__device__ __forceinline__ unsigned pk2(float lo, float hi) { pkf2_t v = {lo, hi}; pkb2_t b = __builtin_convertvector(v, pkb2_t); return __builtin_bit_cast(unsigned, b); }
__device__ __forceinline__ float bflo(unsigned w) { return __uint_as_float(w << 16); }
__device__ __forceinline__ float bfhi(unsigned w) { return __uint_as_float(w & 0xffff0000u); }
__device__ __forceinline__ float bf1(bf16r h) { return __uint_as_float((unsigned)h << 16); }
__device__ __forceinline__ float log_sigmoid(float x) { return fminf(x, 0.f) - log1pf(expf(-fabsf(x))); }
__device__ __forceinline__ float swap_add(float v) { auto rr = __builtin_amdgcn_permlane32_swap(__float_as_uint(v), __float_as_uint(v), false, false); return __uint_as_float(rr[0]) + __uint_as_float(rr[1]); }

struct Args { const void* in[18]; float* out; unsigned char* ws; int ph_lo, ph_hi; };
typedef const __attribute__((address_space(4))) Args CArgs;
__device__ __forceinline__ CArgs* fresh_args() { CArgs* p = (CArgs*)__builtin_amdgcn_kernarg_segment_ptr(); asm volatile("" : "+s"(p)); return p; }

__device__ __forceinline__ int win_src(int n) { return n < 5120 ? n : n + 8; }
__device__ __forceinline__ int wg_src(int n) { return n < 8 ? 5120 + n : (n < 16 ? 7176 + (n - 8) : -1); }
template <int MAP>
__device__ __forceinline__ void transpose_item(const float* W, int K, int N, bf16r* WT, LAS float* scr, int item, int nblk, int lane) {
    const int kb = item / nblk, nb = item % nblk, k0 = 64 * kb, n0 = 32 * nb;
    int sc = n0 + (lane & 31); if (MAP == 1) sc = win_src(sc); else if (MAP == 2) sc = wg_src(sc);
#ifdef OLD_P0
#pragma unroll 8
    for (int i = 0; i < 32; ++i) { const int kk = 2 * i + (lane >> 5); scr[kk * 33 + (lane & 31)] = sc >= 0 ? W[(size_t)(k0 + kk) * N + sc] : 0.f; }
#else
    float tv[32];
#pragma unroll
    for (int i = 0; i < 32; ++i) { const int kk = 2 * i + (lane >> 5); tv[i] = sc >= 0 ? W[(size_t)(k0 + kk) * N + sc] : 0.f; }
#pragma unroll
    for (int i = 0; i < 32; ++i) { const int kk = 2 * i + (lane >> 5); scr[kk * 33 + (lane & 31)] = tv[i]; }
#endif
    asm volatile("s_waitcnt lgkmcnt(0)" ::: "memory");
    const int c = lane & 7;
#pragma unroll
    for (int j = 0; j < 4; ++j) { const int n = (lane >> 3) + 8 * j; const LAS float* s = scr + (8 * c) * 33 + n;
        v4u o; o.x = pk2(s[0 * 33], s[1 * 33]); o.y = pk2(s[2 * 33], s[3 * 33]); o.z = pk2(s[4 * 33], s[5 * 33]); o.w = pk2(s[6 * 33], s[7 * 33]);
        *(v4u*)(WT + (size_t)(n0 + n) * K + k0 + 8 * c) = o; }
    asm volatile("s_waitcnt lgkmcnt(0)" ::: "memory");
}
__device__ __forceinline__ void p0_phase(CArgs& a, LAS unsigned char* lds) {
    const int tid = lz_tid(), lane = tid & 63, wave = tid >> 6, G = gridDim.x;
    unsigned char* ws = a.ws;
    { LAS float* cond = (LAS float*)lds; LAS float* red = (LAS float*)(lds + 16384);
      const float* c = (const float*)a.in[1]; const float* ada_w = (const float*)a.in[3]; const float* ada_b = (const float*)a.in[4]; float* MOD = (float*)(ws + WS_MOD);
      for (int i = tid; i < NB * DM; i += 512) { const float cv = c[i]; cond[i] = cv / (1.f + expf(-cv)); }
      __syncthreads();
      for (int item = lz_bid(); item < 2 * (NMOD / 64); item += G) {
          const int layer = item / (NMOD / 64), cgp = item % (NMOD / 64), col = cgp * 64 + lane, kq = wave;
          const float* W = ada_w + (size_t)layer * DM * NMOD + col;
          float a0 = 0.f, a1 = 0.f;
#ifdef OLD_P0
#pragma unroll 8
#else
#pragma unroll 32
#endif
          for (int k = kq * 256; k < kq * 256 + 256; ++k) { const float w = W[(size_t)k * NMOD]; a0 += cond[k] * w; a1 += cond[DM + k] * w; }
          red[(kq * 2 + 0) * 64 + lane] = a0; red[(kq * 2 + 1) * 64 + lane] = a1;
          __syncthreads();
          if (tid < 128) { const int b = tid >> 6; float s = 0.f;
#pragma unroll
              for (int q = 0; q < 8; ++q) s += red[(q * 2 + b) * 64 + lane];
              MOD[(size_t)(layer * NB + b) * NMOD + cgp * 64 + lane] = s + ada_b[(size_t)layer * NMOD + cgp * 64 + lane]; }
          __syncthreads();
      } }
    { LAS float* scr = (LAS float*)(lds + wave * 16384);
      const int gw = lz_bid() * 8 + wave, NGW = G * 8;
      constexpr int I_IN = (DM / 64) * (NINP / 32), I_OUT = (DM / 64) * (DM / 32), I_F1 = (DM / 64) * (DFF / 32), I_F2 = (DFF / 64) * (DM / 32), I_G = DM / 64, I_L = I_IN + I_OUT + I_F1 + I_F2 + I_G;
      for (int it = gw; it < 2 * I_L; it += NGW) {
          const int layer = it / I_L; int r = it % I_L;
          if (r < I_IN) { transpose_item<1>((const float*)a.in[7] + (size_t)layer * DM * DIN, DM, DIN, (bf16r*)(ws + WS_WIN + layer * WIN_BYTES), scr, r, NINP / 32, lane); continue; } r -= I_IN;
          if (r < I_G) { transpose_item<2>((const float*)a.in[7] + (size_t)layer * DM * DIN, DM, DIN, (bf16r*)(ws + WS_WG + layer * WG_BYTES), scr, r, 1, lane); continue; } r -= I_G;
          if (r < I_OUT) { transpose_item<0>((const float*)a.in[14] + (size_t)layer * DM * DM, DM, DM, (bf16r*)(ws + WS_WOUT + layer * WOUT_BYTES), scr, r, DM / 32, lane); continue; } r -= I_OUT;
          if (r < I_F1) { transpose_item<0>((const float*)a.in[15] + (size_t)layer * DM * DFF, DM, DFF, (bf16r*)(ws + WS_WFF1 + layer * WFF_BYTES), scr, r, DFF / 32, lane); continue; } r -= I_F1;
          transpose_item<0>((const float*)a.in[16] + (size_t)layer * DFF * DM, DFF, DM, (bf16r*)(ws + WS_WFF2 + layer * WFF_BYTES), scr, r, DM / 32, lane);
      } }
}

__device__ __forceinline__ void gate_gemm(const bf16r* H, const bf16r* WG, float* gates) {
    const int tid = lz_tid(), lane = tid & 63, wave = __builtin_amdgcn_readfirstlane(tid >> 6), r32 = lane & 31, hi = lane >> 5;
    if (wave >= 4) return;
    for (int rb = lz_bid(); rb < MROWS / 128; rb += gridDim.x) {
        const int r0 = rb * 128 + wave * 32;
        const bf16r* ap = H + (size_t)(r0 + r32) * DM + 8 * hi; const bf16r* bp = WG + (size_t)r32 * DM + 8 * hi;
        v16f acc = {};
#pragma unroll 16
        for (int ks = 0; ks < DM / 16; ++ks) { const v8s af = *(const v8s*)(ap + ks * 16), bf = *(const v8s*)(bp + ks * 16); acc = __builtin_amdgcn_mfma_f32_32x32x16_bf16(af, bf, acc, 0, 0, 0); }
        if (r32 < 16) {
#pragma unroll
            for (int r = 0; r < 16; ++r) gates[(size_t)(r0 + (r & 3) + 8 * (r >> 2) + 4 * hi) * 16 + r32] = acc[r]; }
    }
}

__device__ __forceinline__ void norm_phase(const float* x, const float* w, const float* sh, const float* sc, bf16r* H) {
    const int lane = lz_tid() & 63, gw = lz_bid() * 8 + (lz_tid() >> 6), NGW = gridDim.x * 8;
    v4f nx[8];
    if (gw < MROWS) { const v4f* xr0 = (const v4f*)(x + (size_t)gw * DM) + lane;
#pragma unroll
        for (int j = 0; j < 8; ++j) nx[j] = xr0[64 * j]; }
    for (int m = gw; m < MROWS; m += NGW) {
        const int b = m / SEQ;
        v4f v[8]; float s = 0.f;
#pragma unroll
        for (int j = 0; j < 8; ++j) v[j] = nx[j];
        if (m + NGW < MROWS) { const v4f* xr1 = (const v4f*)(x + (size_t)(m + NGW) * DM) + lane;
#pragma unroll
            for (int j = 0; j < 8; ++j) nx[j] = xr1[64 * j]; }
#pragma unroll
        for (int j = 0; j < 8; ++j) s += (v[j].x * v[j].x + v[j].y * v[j].y) + (v[j].z * v[j].z + v[j].w * v[j].w);
        const float rstd = 1.0f / sqrtf(wave_sum(s) * (1.f / DM) + NORM_EPS);
        v2u* o = (v2u*)(H + (size_t)m * DM) + lane;
#pragma unroll
        for (int j = 0; j < 8; ++j) { const int c = 4 * lane + 256 * j;
            const v4f wv = *(const v4f*)(w + c), sv = *(const v4f*)(sc + (size_t)b * NMOD + c), hv = *(const v4f*)(sh + (size_t)b * NMOD + c);
            const v4f y = v[j] * rstd * wv * (sv + 1.0f) + hv;
            v2u p; p.x = pk2(y.x, y.y); p.y = pk2(y.z, y.w); o[64 * j] = p; }
    }
}
__device__ __forceinline__ void final_norm_phase(float* x, const float* w) {
    const int lane = lz_tid() & 63, gw = lz_bid() * 8 + (lz_tid() >> 6), NGW = gridDim.x * 8;
    v4f nx[8];
    if (gw < MROWS) { const v4f* xr0 = (const v4f*)(x + (size_t)gw * DM) + lane;
#pragma unroll
        for (int j = 0; j < 8; ++j) nx[j] = xr0[64 * j]; }
    for (int m = gw; m < MROWS; m += NGW) {
        v4f* xr = (v4f*)(x + (size_t)m * DM) + lane;
        v4f v[8]; float s = 0.f;
#pragma unroll
        for (int j = 0; j < 8; ++j) v[j] = nx[j];
        if (m + NGW < MROWS) { const v4f* xr1 = (const v4f*)(x + (size_t)(m + NGW) * DM) + lane;
#pragma unroll
            for (int j = 0; j < 8; ++j) nx[j] = xr1[64 * j]; }
#pragma unroll
        for (int j = 0; j < 8; ++j) s += (v[j].x * v[j].x + v[j].y * v[j].y) + (v[j].z * v[j].z + v[j].w * v[j].w);
        const float rstd = 1.0f / sqrtf(wave_sum(s) * (1.f / DM) + NORM_EPS);
#pragma unroll
        for (int j = 0; j < 8; ++j) { const v4f wv = *(const v4f*)(w + 4 * lane + 256 * j); xr[64 * j] = v[j] * rstd * wv; }
    }
}

__device__ __forceinline__ void fox_cumsum_item(CArgs& a, int layer, int item, LAS unsigned char* lds) {
    const int tid = lz_tid(), b = item >> 3, h = item & 7;
    const float* gates = (const float*)(a.ws + WS_GATES); float* cneg = (float*)(a.ws + WS_CNEG) + (size_t)item * SEQ;
    const float bias = ((const float*)a.in[10])[layer * 8 + h];
    LAS double* tot = (LAS double*)lds;
    double sum = 0.0;
    const float* gp = gates + ((size_t)b * SEQ + (size_t)tid * 32) * 16 + h;
#pragma unroll 4
    for (int i = 0; i < 32; ++i) sum += (double)log_sigmoid(gp[i * 16] + bias);
    tot[tid] = sum;
    __syncthreads();
    if (tid == 0) { double run = 0.0; for (int i = 0; i < 512; ++i) { const double t = tot[i]; tot[i] = run; run += t; } }
    __syncthreads();
    double run = tot[tid];
#pragma unroll 2
    for (int i = 0; i < 32; i += 4) { v4f o;
        run += (double)log_sigmoid(gp[(i + 0) * 16] + bias); o.x = (float)(-run * 11.313708498984761);
        run += (double)log_sigmoid(gp[(i + 1) * 16] + bias); o.y = (float)(-run * 11.313708498984761);
        run += (double)log_sigmoid(gp[(i + 2) * 16] + bias); o.z = (float)(-run * 11.313708498984761);
        run += (double)log_sigmoid(gp[(i + 3) * 16] + bias); o.w = (float)(-run * 11.313708498984761);
        *(v4f*)(cneg + tid * 32 + i) = o; }
    __syncthreads();
}
__device__ __forceinline__ void mlstm_scan_item(CArgs& a, int layer, int item, LAS unsigned char* lds) {
    const int tid = lz_tid(), lane = tid & 63, wave = tid >> 6, b = item >> 2, h = item & 3;
    const float* gates = (const float*)(a.ws + WS_GATES);
    float* MA = (float*)(a.ws + WS_MA) + (size_t)item * SEQ; float* MCM = (float*)(a.ws + WS_MCM) + (size_t)item * SEQ; float* MBv = (float*)(a.ws + WS_MB) + (size_t)item * SEQ;
    float* MPREV = (float*)(a.ws + WS_MPREV) + item * 256;
    const float ib = ((const float*)a.in[11])[layer * 4 + h], fb = ((const float*)a.in[12])[layer * 4 + h];
    LAS float* Bc = (LAS float*)lds; LAS float* Ac = Bc + 256;
#pragma unroll 4
    for (int c = wave; c < 256; c += 8) {
        const size_t m = (size_t)b * SEQ + c * 64 + lane;
        const float ig = gates[m * 16 + 8 + h] + ib, fg = gates[m * 16 + 12 + h] + fb;
        float bb = log_sigmoid(fg);
#pragma unroll
        for (int o = 1; o < 64; o <<= 1) { const float t = __shfl_up(bb, o); if (lane >= o) bb += t; }
        const float av = ig - bb; float cm = av;
#pragma unroll
        for (int o = 1; o < 64; o <<= 1) { const float t = __shfl_up(cm, o); if (lane >= o) cm = fmaxf(cm, t); }
        MA[c * 64 + lane] = av; MCM[c * 64 + lane] = cm; MBv[c * 64 + lane] = bb;
        if (lane == 63) { Bc[c] = bb; Ac[c] = cm; }
    }
    __syncthreads();
    if (tid == 0) { float mm = 0.f; for (int c = 0; c < 256; ++c) { MPREV[c] = mm; mm = Bc[c] + fmaxf(mm, Ac[c]); } }
    __syncthreads();
}
__device__ __forceinline__ void prep_phase(CArgs& a, int layer, LAS unsigned char* lds) {
    const int tid = lz_tid(), bid = lz_bid(), G = gridDim.x;
    if (bid < 16) { fox_cumsum_item(a, layer, bid, lds); return; }
    if (bid < 24) { mlstm_scan_item(a, layer, bid - 16, lds); return; }
    const int wk = bid - 24, NWK = G - 24;
    bf16r* P = (bf16r*)(a.ws + WS_P);
    { const int jg = tid & 7; double invf[8];
#pragma unroll
      for (int i = 0; i < 8; ++i) { double r = 1.0, bs = 0.8659643233600653; int e = 8 * jg + i;
#pragma unroll
          for (int q = 0; q < 6; ++q) { if (e & 1) r *= bs; bs *= bs; e >>= 1; }
          invf[i] = r * 0.15915494309189535; }
      const int* positions = (const int*)a.in[2];
      for (int it0 = wk; it0 < 8 * MROWS / 64; it0 += 4 * NWK) {
          v4u A[4], Bv[4]; bf16r* pp[4]; int mm[4], sl[4];
#pragma unroll
          for (int q = 0; q < 4; ++q) { const int it = it0 + q * NWK; const bool ok = it < 8 * MROWS / 64; const int grow = (ok ? it : wk) * 64 + (tid >> 3); sl[q] = ok ? grow / MROWS : -1; mm[q] = grow % MROWS;
              pp[q] = P + ((size_t)(grow / MROWS) * MROWS + mm[q]) * 128 + 8 * jg; A[q] = *(const v4u*)pp[q]; Bv[q] = *(const v4u*)(pp[q] + 64); }
#pragma unroll
          for (int q = 0; q < 4; ++q) { if (sl[q] < 0) continue;
              const double pos = (double)positions[mm[q]]; const float sc = sl[q] >= 4 ? KSCALE : 1.0f;
              float t1[8] = {bflo(A[q].x), bfhi(A[q].x), bflo(A[q].y), bfhi(A[q].y), bflo(A[q].z), bfhi(A[q].z), bflo(A[q].w), bfhi(A[q].w)};
              float t2[8] = {bflo(Bv[q].x), bfhi(Bv[q].x), bflo(Bv[q].y), bfhi(Bv[q].y), bflo(Bv[q].z), bfhi(Bv[q].z), bflo(Bv[q].w), bfhi(Bv[q].w)};
              float o1[8], o2[8];
#pragma unroll
              for (int i = 0; i < 8; ++i) { const double rev = pos * invf[i]; const float fr = (float)(rev - floor(rev));
                  const float sn = __builtin_amdgcn_sinf(fr) * sc, cs = __builtin_amdgcn_cosf(fr) * sc;
                  o1[i] = t1[i] * cs - t2[i] * sn; o2[i] = t2[i] * cs + t1[i] * sn; }
              v4u oa, ob; oa.x = pk2(o1[0], o1[1]); oa.y = pk2(o1[2], o1[3]); oa.z = pk2(o1[4], o1[5]); oa.w = pk2(o1[6], o1[7]);
              ob.x = pk2(o2[0], o2[1]); ob.y = pk2(o2[2], o2[3]); ob.z = pk2(o2[4], o2[5]); ob.w = pk2(o2[6], o2[7]);
              *(v4u*)pp[q] = oa; *(v4u*)(pp[q] + 64) = ob; }
      } }
    { const int slot = wk % 8, sub = wk / 8, nsub = (NWK - slot + 7) / 8, cgp = tid & 15;
      const float* cw = (const float*)a.in[8] + (size_t)layer * 4 * 1024 + slot * 128 + 8 * cgp; const float* cbv = (const float*)a.in[9] + (size_t)layer * 1024 + slot * 128 + 8 * cgp;
      float w[4][8], bsv[8];
#pragma unroll
      for (int j = 0; j < 4; ++j)
#pragma unroll
          for (int i = 0; i < 8; ++i) w[j][i] = cw[j * 1024 + i];
#pragma unroll
      for (int i = 0; i < 8; ++i) bsv[i] = cbv[i];
      const bf16r* __restrict__ src = P + (size_t)(40 + slot) * MROWS * 128 + 8 * cgp; bf16r* __restrict__ dst = (bf16r*)(a.ws + WS_MQC) + (size_t)slot * MROWS * 128 + 8 * cgp;
      const float sc = slot >= 4 ? KSCALE : 1.0f;
#pragma unroll 2
      for (int rb = sub; rb < MROWS / 32; rb += nsub) {
          const int row = rb * 32 + (tid >> 4), s = row % SEQ;
          float acc[8];
#pragma unroll
          for (int i = 0; i < 8; ++i) acc[i] = bsv[i];
#pragma unroll
          for (int j = 0; j < 4; ++j) { if (s - 3 + j >= 0) { const v4u X = *(const v4u*)(src + (size_t)(row - 3 + j) * 128);
              acc[0] += w[j][0] * bflo(X.x); acc[1] += w[j][1] * bfhi(X.x); acc[2] += w[j][2] * bflo(X.y); acc[3] += w[j][3] * bfhi(X.y);
              acc[4] += w[j][4] * bflo(X.z); acc[5] += w[j][5] * bfhi(X.z); acc[6] += w[j][6] * bflo(X.w); acc[7] += w[j][7] * bfhi(X.w); } }
#pragma unroll
          for (int i = 0; i < 8; ++i) acc[i] = acc[i] / (1.f + expf(-acc[i])) * sc;
          v4u o; o.x = pk2(acc[0], acc[1]); o.y = pk2(acc[2], acc[3]); o.z = pk2(acc[4], acc[5]); o.w = pk2(acc[6], acc[7]);
          *(v4u*)(dst + (size_t)row * 128) = o;
      } }
    { const int slot = wk % 16, sub = wk / 16, nsub = (NWK - slot + 15) / 16, c16 = tid & 15;
      const bf16r* src = P + (size_t)(16 + slot) * MROWS * 128 + 8 * c16;
      float mx0 = 0.f, mx1 = 0.f;
#pragma unroll 8
      for (int rb = sub; rb < MROWS / 32; rb += nsub) {
          const int row = rb * 32 + (tid >> 4); const v4u X = *(const v4u*)(src + (size_t)row * 128);
          const float x0 = bflo(X.x), x1 = bfhi(X.x), x2 = bflo(X.y), x3 = bfhi(X.y), x4 = bflo(X.z), x5 = bfhi(X.z), x6 = bflo(X.w), x7 = bfhi(X.w);
          float s = (x0 * x0 + x1 * x1) + (x2 * x2 + x3 * x3) + (x4 * x4 + x5 * x5) + (x6 * x6 + x7 * x7);
          s += __shfl_xor(s, 1); s += __shfl_xor(s, 2); s += __shfl_xor(s, 4); s += __shfl_xor(s, 8);
          if (row < SEQ) mx0 = fmaxf(mx0, s); else mx1 = fmaxf(mx1, s);
      }
#pragma unroll
      for (int o = 1; o < 64; o <<= 1) { mx0 = fmaxf(mx0, __shfl_xor(mx0, o)); mx1 = fmaxf(mx1, __shfl_xor(mx1, o)); }
      if ((tid & 63) == 0) { unsigned* QK2 = (unsigned*)(a.ws + WS_QK2) + layer * 32;
          __hip_atomic_fetch_max(QK2 + slot, __float_as_uint(mx0 * 1.02f), __ATOMIC_RELAXED, __HIP_MEMORY_SCOPE_AGENT);
          __hip_atomic_fetch_max(QK2 + 16 + slot, __float_as_uint(mx1 * 1.02f), __ATOMIC_RELAXED, __HIP_MEMORY_SCOPE_AGENT); }
    }
}

__device__ __forceinline__ int cv_st(int k, int c) { const int kk = (k & ~0xC) | ((k & 4) << 1) | ((k & 8) >> 1); return ((kk >> 3) * 4 + (c >> 5)) * 512 + ((kk & 7) * 32 + (c & 31)) * 2; }
__device__ __forceinline__ int cv_rd_base(int lane) { return ((lane & 3) << 3) | (((lane >> 2) & 3) << 6) | (((lane >> 4) & 1) << 5) | (((lane >> 5) & 1) << 8); }
__device__ __forceinline__ int ccrow(int r, int hi) { return (r & 3) + 8 * (r >> 2) + 4 * hi; }
#define CFRAG(dst, vb, ks) do { v4s l_, h_; asm volatile("ds_read_b64_tr_b16 %0, %1 offset:%2" : "=&v"(l_) : "v"(vb), "i"((ks) * 4096) : "memory"); \
        asm volatile("ds_read_b64_tr_b16 %0, %1 offset:%2" : "=&v"(h_) : "v"(vb), "i"((ks) * 4096 + 2048) : "memory"); asm volatile("s_waitcnt lgkmcnt(0)" ::: "memory"); \
        dst = (v8s){l_[0], l_[1], l_[2], l_[3], h_[0], h_[1], h_[2], h_[3]}; } while (0)

struct ChunkItem { int mixer, bh, b, h, c, row0; };
__device__ __forceinline__ ChunkItem chunk_decode(int idx) { ChunkItem it; it.mixer = idx / 2048; const int rem = idx % 2048; it.bh = rem / 256; it.b = it.bh >> 2; it.h = it.bh & 3; it.c = rem % 256; it.row0 = it.b * SEQ + it.c * 64; return it; }
__device__ __forceinline__ float ret_lg(int h) { return log2f(1.0f - exp2f(-5.0f - (float)h)); }

__device__ __forceinline__ void m1_phase(CArgs& a, LAS unsigned char* lds) {
    const int tid = lz_tid(), lane = tid & 63, wave = __builtin_amdgcn_readfirstlane(tid >> 6), r32 = lane & 31, hi = lane >> 5;
    const bf16r* P = (const bf16r*)(a.ws + WS_P); const bf16r* MQC = (const bf16r*)(a.ws + WS_MQC); bf16r* US = (bf16r*)(a.ws + WS_H);
    LAS unsigned char* KT = lds; LAS unsigned char* VT = lds + 16384; LAS float* wt = (LAS float*)(lds + 32768); LAS float* red = (LAS float*)(lds + 33024);
    const int sr = tid >> 4, sc = (tid & 15) * 8;
    for (int idx = lz_bid(); idx < 4096; idx += gridDim.x) {
        const ChunkItem it = chunk_decode(idx);
        const bf16r* ksrc = (it.mixer == 0 ? P + (size_t)(4 + it.h) * MROWS * 128 : MQC + (size_t)(4 + it.h) * MROWS * 128) + (size_t)it.row0 * 128;
        const bf16r* vsrc = P + (size_t)((it.mixer == 0 ? 8 : 48) + it.h) * MROWS * 128 + (size_t)it.row0 * 128;
        if (tid < 64) { float w;
            if (it.mixer == 0) w = exp2f((float)(63 - tid) * ret_lg(it.h));
            else { const float* MA = (const float*)(a.ws + WS_MA) + (size_t)it.bh * SEQ + it.c * 64; const float* MCM = (const float*)(a.ws + WS_MCM) + (size_t)it.bh * SEQ + it.c * 64;
                   const float mp = ((const float*)(a.ws + WS_MPREV))[it.bh * 256 + it.c]; w = expf(MA[tid] - fmaxf(mp, MCM[63])); }
            wt[tid] = w; }
        const v4u k0 = *(const v4u*)(ksrc + (size_t)sr * 128 + sc), k1 = *(const v4u*)(ksrc + (size_t)(32 + sr) * 128 + sc);
        const v4u v0 = *(const v4u*)(vsrc + (size_t)sr * 128 + sc), v1 = *(const v4u*)(vsrc + (size_t)(32 + sr) * 128 + sc);
        __syncthreads();
        const float w0 = wt[sr], w1 = wt[32 + sr];
        float a0[8] = {bflo(k0.x) * w0, bfhi(k0.x) * w0, bflo(k0.y) * w0, bfhi(k0.y) * w0, bflo(k0.z) * w0, bfhi(k0.z) * w0, bflo(k0.w) * w0, bfhi(k0.w) * w0};
        float a1[8] = {bflo(k1.x) * w1, bfhi(k1.x) * w1, bflo(k1.y) * w1, bfhi(k1.y) * w1, bflo(k1.z) * w1, bfhi(k1.z) * w1, bflo(k1.w) * w1, bfhi(k1.w) * w1};
        { v4u o; o.x = pk2(a0[0], a0[1]); o.y = pk2(a0[2], a0[3]); o.z = pk2(a0[4], a0[5]); o.w = pk2(a0[6], a0[7]); *(LAS v4u*)(KT + cv_st(sr, sc)) = o;
          o.x = pk2(a1[0], a1[1]); o.y = pk2(a1[2], a1[3]); o.z = pk2(a1[4], a1[5]); o.w = pk2(a1[6], a1[7]); *(LAS v4u*)(KT + cv_st(32 + sr, sc)) = o;
          *(LAS v4u*)(VT + cv_st(sr, sc)) = v0; *(LAS v4u*)(VT + cv_st(32 + sr, sc)) = v1; }
        if (it.mixer == 1) {
#pragma unroll
            for (int i = 0; i < 8; ++i) { float s = a0[i] + a1[i]; s += __shfl_xor(s, 16); s += __shfl_xor(s, 32); if (lane < 16) red[wave * 128 + sc + i] = s; }
        }
        __syncthreads();
        if (it.mixer == 1 && tid < 128) { float s = 0.f;
#pragma unroll
            for (int q = 0; q < 8; ++q) s += red[q * 128 + tid];
            ((float*)(a.ws + WS_UN))[((size_t)it.bh * 256 + it.c) * 128 + tid] = s; }
        const int db = wave >> 1;
        const int kvb = (int)(uintptr_t)KT + cv_rd_base(lane) + db * 512;
        v8s kf[4]; CFRAG(kf[0], kvb, 0); CFRAG(kf[1], kvb, 1); CFRAG(kf[2], kvb, 2); CFRAG(kf[3], kvb, 3);
#pragma unroll
        for (int e2 = 0; e2 < 2; ++e2) { const int eb = (wave & 1) * 2 + e2; const int vvb = (int)(uintptr_t)VT + cv_rd_base(lane) + eb * 512;
            v8s vf[4]; CFRAG(vf[0], vvb, 0); CFRAG(vf[1], vvb, 1); CFRAG(vf[2], vvb, 2); CFRAG(vf[3], vvb, 3);
            v16f acc = {};
#pragma unroll
            for (int ks = 0; ks < 4; ++ks) acc = __builtin_amdgcn_mfma_f32_32x32x16_bf16(kf[ks], vf[ks], acc, 0, 0, 0);
            bf16r* dst = US + (size_t)idx * 16384 + (size_t)(eb * 32 + r32) * 128 + db * 32 + 4 * hi;
#pragma unroll
            for (int g = 0; g < 4; ++g) { v2u o; o.x = pk2(acc[4 * g], acc[4 * g + 1]); o.y = pk2(acc[4 * g + 2], acc[4 * g + 3]); *(v2u*)(dst + 8 * g) = o; } }
        __syncthreads();
    }
}

#ifndef M2U
#define M2U 64
#endif
__device__ __forceinline__ void m2_phase(CArgs& a, LAS unsigned char* lds) {
    const int tid = lz_tid();
    unsigned* US = (unsigned*)(a.ws + WS_H); LAS float* coef = (LAS float*)lds;
    const float* MCM = (const float*)(a.ws + WS_MCM); const float* MPREV = (const float*)(a.ws + WS_MPREV);
    for (int blk = lz_bid(); blk < 16 * 8192 / 512; blk += gridDim.x) {
        const int chain = blk / 16, mixer = chain >> 3, bh = chain & 7;
        __syncthreads();
        if (tid < 256) { float cf;
            if (mixer == 0) cf = exp2f(64.0f * ret_lg(bh & 3));
            else { const float mp = MPREV[bh * 256 + tid]; cf = expf(mp - fmaxf(mp, MCM[(size_t)bh * SEQ + tid * 64 + 63])); }
            coef[tid] = cf; }
        __syncthreads();
        unsigned* p = US + (size_t)chain * 256 * 8192 + (blk % 16) * 512 + tid;
        float s0 = 0.f, s1 = 0.f;
        for (int c = 0; c < 256; c += M2U) { unsigned u[M2U];
#pragma unroll
            for (int i = 0; i < M2U; ++i) u[i] = p[(size_t)(c + i) * 8192];
#pragma unroll
            for (int i = 0; i < M2U; ++i) { const float cf = coef[c + i]; p[(size_t)(c + i) * 8192] = pk2(s0, s1); s0 = s0 * cf + bflo(u[i]); s1 = s1 * cf + bfhi(u[i]); } }
    }
    float* UN = (float*)(a.ws + WS_UN);
    for (int bh = lz_bid(); bh < 8; bh += gridDim.x) {
        __syncthreads();
        if (tid < 256) { const float mp = MPREV[bh * 256 + tid]; coef[tid] = expf(mp - fmaxf(mp, MCM[(size_t)bh * SEQ + tid * 64 + 63])); }
        __syncthreads();
        if (tid < 128) { float* p = UN + (size_t)bh * 256 * 128 + tid; float s = 0.f;
            for (int c = 0; c < 256; c += 16) { float u[16];
#pragma unroll
                for (int i2 = 0; i2 < 16; ++i2) u[i2] = p[(c + i2) * 128];
#pragma unroll
                for (int i2 = 0; i2 < 16; ++i2) { p[(c + i2) * 128] = s; s = s * coef[c + i2] + u[i2]; } } }
    }
}

__device__ __forceinline__ void m3_phase(CArgs& a, int layer, LAS unsigned char* lds) {
    const int tid = lz_tid(), lane = tid & 63, wave = __builtin_amdgcn_readfirstlane(tid >> 6), r32 = lane & 31, hi = lane >> 5;
    const bf16r* P = (const bf16r*)(a.ws + WS_P); const bf16r* MQC = (const bf16r*)(a.ws + WS_MQC); const bf16r* US = (const bf16r*)(a.ws + WS_H);
    bf16r* Y = (bf16r*)(a.ws + WS_Y); const float* msc = (const float*)a.in[13] + (size_t)layer * DM;
    LAS unsigned char* VT = lds; LAS float* OT = (LAS float*)(lds + 16384);
    LAS float* sa = (LAS float*)(lds + 16384 + 64 * 132 * 4); LAS float* sg = sa + 64; LAS float* swi = sg + 64; LAS float* semq = swi + 64; LAS float* sn = semq + 64; LAS float* fw = sn + 128;
    const int sr = tid >> 4, sc = (tid & 15) * 8;
    const int lb = wave & 1, eb = wave >> 1, l = lb * 32 + r32;
    for (int idx = lz_bid(); idx < 4096; idx += gridDim.x) {
        const ChunkItem it = chunk_decode(idx);
        const bf16r* qsrc = (it.mixer == 0 ? P + (size_t)it.h * MROWS * 128 : MQC + (size_t)it.h * MROWS * 128) + (size_t)it.row0 * 128;
        const bf16r* ksrc = (it.mixer == 0 ? P + (size_t)(4 + it.h) * MROWS * 128 : MQC + (size_t)(4 + it.h) * MROWS * 128) + (size_t)it.row0 * 128;
        const bf16r* vsrc = P + (size_t)((it.mixer == 0 ? 8 : 48) + it.h) * MROWS * 128 + (size_t)it.row0 * 128;
        const bf16r* gsrc = P + (size_t)((it.mixer == 0 ? 12 : 52) + it.h) * MROWS * 128 + (size_t)it.row0 * 128;
        const bf16r* St = US + (size_t)idx * 16384;
        const float lg = ret_lg(it.h);
        if (it.mixer == 1) {
            if (tid < 64) { const size_t o = (size_t)it.bh * SEQ + it.c * 64 + tid; const float mp = ((const float*)(a.ws + WS_MPREV))[it.bh * 256 + it.c];
                const float av = ((const float*)(a.ws + WS_MA))[o], cm = ((const float*)(a.ws + WS_MCM))[o], bb = ((const float*)(a.ws + WS_MB))[o];
                const float g = fmaxf(mp, cm); sa[tid] = av; sg[tid] = g; swi[tid] = expf(mp - g); semq[tid] = expf(-(bb + g)); }
            else if (tid < 192) sn[tid - 64] = ((const float*)(a.ws + WS_UN))[((size_t)it.bh * 256 + it.c) * 128 + tid - 64];
        }
        { const v4u v0 = *(const v4u*)(vsrc + (size_t)sr * 128 + sc), v1 = *(const v4u*)(vsrc + (size_t)(32 + sr) * 128 + sc);
          *(LAS v4u*)(VT + cv_st(sr, sc)) = v0; *(LAS v4u*)(VT + cv_st(32 + sr, sc)) = v1; }
        v8s qr[8];
#pragma unroll
        for (int d0 = 0; d0 < 8; ++d0) qr[d0] = *(const v8s*)(qsrc + (size_t)l * 128 + d0 * 16 + hi * 8);
        __syncthreads();
        v16f p0 = {}, p1 = {};
#pragma unroll
        for (int d0 = 0; d0 < 8; ++d0) { const v8s kf = *(const v8s*)(ksrc + (size_t)r32 * 128 + d0 * 16 + hi * 8); p0 = __builtin_amdgcn_mfma_f32_32x32x16_bf16(kf, qr[d0], p0, 0, 0, 0); }
        if (lb == 1) {
#pragma unroll
            for (int d0 = 0; d0 < 8; ++d0) { const v8s kf = *(const v8s*)(ksrc + (size_t)(32 + r32) * 128 + d0 * 16 + hi * 8); p1 = __builtin_amdgcn_mfma_f32_32x32x16_bf16(kf, qr[d0], p1, 0, 0, 0); }
        }
        float rs = 0.f;
        int ll = l; asm volatile("" : "+v"(ll));
        if (it.mixer == 0) {
#pragma unroll
            for (int r = 0; r < 16; ++r) { const int m0 = ccrow(r, hi), m1 = m0 + 32;
                p0[r] = (m0 <= ll) ? p0[r] * exp2f((float)(ll - m0) * lg) : 0.f; p1[r] = (m1 <= ll) ? p1[r] * exp2f((float)(ll - m1) * lg) : 0.f; }
        } else { const float gl = sg[l];
#pragma unroll
            for (int r = 0; r < 16; ++r) { const int m0 = ccrow(r, hi), m1 = m0 + 32;
                p0[r] = (m0 <= ll) ? p0[r] * expf(sa[m0] - gl) : 0.f; p1[r] = (m1 <= ll) ? p1[r] * expf(sa[m1] - gl) : 0.f; rs += p0[r] + p1[r]; }
            rs = swap_add(rs);
        }
        v8s pa0, pa1, pa2, pa3;
#define CPK4(Pv, B_, OUT) do { unsigned a0_ = pk2(Pv[B_+0], Pv[B_+1]), a1_ = pk2(Pv[B_+2], Pv[B_+3]), b0_ = pk2(Pv[B_+4], Pv[B_+5]), b1_ = pk2(Pv[B_+6], Pv[B_+7]); \
        auto r0_ = __builtin_amdgcn_permlane32_swap(a0_, b0_, false, false); auto r1_ = __builtin_amdgcn_permlane32_swap(a1_, b1_, false, false); \
        v4u w_ = {r0_[0], r1_[0], r0_[1], r1_[1]}; OUT = *reinterpret_cast<v8s*>(&w_); } while (0)
        CPK4(p0, 0, pa0); CPK4(p0, 8, pa1); CPK4(p1, 0, pa2); CPK4(p1, 8, pa3);
#undef CPK4
        const int vvb = (int)(uintptr_t)VT + cv_rd_base(lane) + eb * 512;
        v16f oi = {}, ox = {};
        { v8s vf; CFRAG(vf, vvb, 0); oi = __builtin_amdgcn_mfma_f32_32x32x16_bf16(pa0, vf, oi, 0, 0, 0); CFRAG(vf, vvb, 1); oi = __builtin_amdgcn_mfma_f32_32x32x16_bf16(pa1, vf, oi, 0, 0, 0);
          CFRAG(vf, vvb, 2); oi = __builtin_amdgcn_mfma_f32_32x32x16_bf16(pa2, vf, oi, 0, 0, 0); CFRAG(vf, vvb, 3); oi = __builtin_amdgcn_mfma_f32_32x32x16_bf16(pa3, vf, oi, 0, 0, 0); }
#pragma unroll
        for (int d0 = 0; d0 < 8; ++d0) { const v8s sf = *(const v8s*)(St + (size_t)(eb * 32 + r32) * 128 + d0 * 16 + hi * 8); ox = __builtin_amdgcn_mfma_f32_32x32x16_bf16(qr[d0], sf, ox, 0, 0, 0); }
        float fa, fb;
        if (it.mixer == 0) { fa = 1.f; fb = exp2f((float)(l + 1) * lg); }
        else { float qn = 0.f;
#pragma unroll
            for (int d0 = 0; d0 < 8; ++d0)
#pragma unroll
                for (int i = 0; i < 8; ++i) qn += bf1((bf16r)qr[d0][i]) * sn[d0 * 16 + hi * 8 + i];
            qn = swap_add(qn);
            const float wi = swi[l]; const float den = rs + wi * qn; const float dn = fmaxf(fabsf(den), semq[l]); fa = 1.0f / dn; fb = wi / dn; }
        LAS float* fww = fw + wave * 64;
        if (hi == 0) { fww[r32] = fa; fww[32 + r32] = fb; }
        asm volatile("s_waitcnt lgkmcnt(0)" ::: "memory");
#pragma unroll
        for (int r = 0; r < 16; ++r) { const int lr = ccrow(r, hi); OT[(lb * 32 + lr) * 132 + eb * 32 + r32] = fww[lr] * oi[r] + fww[32 + lr] * ox[r]; }
        __syncthreads();
        const int colbase = (it.mixer == 0 ? 0 : 1536) + it.h * 128;
        { const int row = wave * 8 + (lane >> 3), seg = lane & 7;
          const v4u gA = *(const v4u*)(gsrc + (size_t)row * 128 + seg * 16), gB = *(const v4u*)(gsrc + (size_t)row * 128 + seg * 16 + 8);
          float v[16];
#pragma unroll
          for (int q = 0; q < 4; ++q) { const v4f t = *(LAS v4f*)(OT + row * 132 + seg * 16 + 4 * q); v[4 * q] = t.x; v[4 * q + 1] = t.y; v[4 * q + 2] = t.z; v[4 * q + 3] = t.w; }
          float s = 0.f;
#pragma unroll
          for (int q = 0; q < 16; ++q) s += v[q];
          s += __shfl_xor(s, 1); s += __shfl_xor(s, 2); s += __shfl_xor(s, 4);
          const float mu = s * (1.f / 128.f); float sq = 0.f;
#pragma unroll
          for (int q = 0; q < 16; ++q) { v[q] -= mu; sq += v[q] * v[q]; }
          sq += __shfl_xor(sq, 1); sq += __shfl_xor(sq, 2); sq += __shfl_xor(sq, 4);
          const float rstd = 1.0f / sqrtf(sq * (1.f / 128.f) + NORM_EPS);
          float g[16] = {bflo(gA.x), bfhi(gA.x), bflo(gA.y), bfhi(gA.y), bflo(gA.z), bfhi(gA.z), bflo(gA.w), bfhi(gA.w), bflo(gB.x), bfhi(gB.x), bflo(gB.y), bfhi(gB.y), bflo(gB.z), bfhi(gB.z), bflo(gB.w), bfhi(gB.w)};
          const float* mp = msc + colbase + seg * 16;
#pragma unroll
          for (int q = 0; q < 16; ++q) { const float e = expf(-g[q]); const float gate = (it.mixer == 0) ? g[q] / (1.f + e) : 1.f / (1.f + e); v[q] = v[q] * rstd * gate * mp[q]; }
          v4u oA, oB; oA.x = pk2(v[0], v[1]); oA.y = pk2(v[2], v[3]); oA.z = pk2(v[4], v[5]); oA.w = pk2(v[6], v[7]); oB.x = pk2(v[8], v[9]); oB.y = pk2(v[10], v[11]); oB.z = pk2(v[12], v[13]); oB.w = pk2(v[14], v[15]);
          bf16r* yp = Y + (size_t)(it.row0 + row) * DM + colbase + seg * 16;
          *(v4u*)yp = oA; *(v4u*)(yp + 8) = oB; }
        __syncthreads();
    }
}

__device__ __forceinline__ fox::BlockRef<fox::bf16, fox::bf16> fox_ref(CArgs& a, int layer, int bh, int qb, int jlo) {
    const int b = bh >> 3, h = bh & 7; const fox::bf16* P = (const fox::bf16*)(a.ws + WS_P);
    fox::BlockRef<fox::bf16, fox::bf16> r;
    r.Q = P + ((size_t)(16 + h) * MROWS + (size_t)b * SEQ + (size_t)qb * 256) * 128;
    r.K = (unsigned)(WS_P + ((size_t)(24 + h) * MROWS + (size_t)b * SEQ) * 256); r.V = (unsigned)(WS_P + ((size_t)(32 + h) * MROWS + (size_t)b * SEQ) * 256);
    r.O = (fox::bf16*)(a.ws + WS_Y) + ((size_t)b * SEQ + (size_t)qb * 256) * DM + 512 + h * 128;
    r.C = (unsigned)(WS_CNEG + (size_t)bh * SEQ * 4); r.MS = (const float*)a.in[13] + (size_t)layer * DM + 512 + h * 128; const int j4 = jlo >> 2;
    r.P0 = (qb - j4) * 256; r.JLO = j4 * 4;
    r.K += (unsigned)j4 * 256u * 256u; r.V += (unsigned)j4 * 256u * 256u; r.C += (unsigned)j4 * 1024u;
    return r;
}
__device__ __forceinline__ void fox_table_phase(CArgs& a, int layer) {
    const int tid = lz_tid(), lane = tid & 63, u = lz_bid() * 8 + (tid >> 6);
    if (u >= 1024) return;
    const float* QK2 = (const float*)(a.ws + WS_QK2) + layer * 32; const float* CN = (const float*)(a.ws + WS_CNEG);
    const int bh = u & 15, qb = 63 - (u >> 4), b = bh >> 3, h = bh & 7;
    const float qkmax = sqrtf(QK2[b * 16 + h] * QK2[b * 16 + 8 + h]);
    const float* cn = CN + (size_t)bh * SEQ; const float thresh = cn[qb * 256] - (2.0f * qkmax + 1245.0f);
    int cnt = 0;
#pragma unroll
    for (int t = 0; t < 4; ++t) { const int tile = lane + 64 * t; const bool skip = (tile < qb * 4) && (cn[tile * 64 + 63] < thresh); cnt += __popcll(__ballot(skip)); }
    if (lane == 0) ((int*)(a.ws + WS_JT))[layer * 1024 + u] = cnt;
}
__device__ __forceinline__ void fox_phase(CArgs& a, int layer, char* lds, int rep = 0) {
    using BR = fox::BlockRef<fox::bf16, fox::bf16>;
    constexpr int W = 1 << 30, total = 1024;
    const int tid = lz_tid(), lane = tid & 63;
    volatile unsigned* sbuf = (volatile unsigned*)(lds + 69632);
    unsigned* qctr = (unsigned*)(a.ws + WS_QCTR) + layer * 64 + rep * 128;
    const int* JT = (const int*)(a.ws + WS_JT) + layer * 1024;
#define FOX_GRAB(U) do { if (tid == 0) sbuf[0] = __hip_atomic_fetch_add(qctr, 1u, __ATOMIC_RELAXED, __HIP_MEMORY_SCOPE_AGENT); __syncthreads(); U = __builtin_amdgcn_readfirstlane((int)sbuf[0]); __syncthreads(); } while (0)
#define FOX_MAKE(R, U) do { const int bh_ = (U) & 15, qb_ = 63 - ((U) >> 4); R = fox_ref(a, layer, bh_, qb_, __builtin_amdgcn_readfirstlane(JT[(U)])); } while (0)
    int u; FOX_GRAB(u); if (u >= total) return;
    BR cur; FOX_MAKE(cur, u);
    fox::Seam<fox::bf16> S;
    const __amdgpu_buffer_rsrc_t rs = __builtin_amdgcn_make_buffer_rsrc((void*)a.ws, 0, -1, 0x00020000);
    fox::causal_swa_prime<fox::bf16, fox::bf16>(cur, W, lds, S, rs);
    for (;;) {
        int un; FOX_GRAB(un); const bool last = un >= total;
        BR nxt = cur; if (!last) FOX_MAKE(nxt, un);
        fox::causal_swa_block<fox::bf16, fox::bf16>(cur, nxt, SEQ, W, lds, S, rs);
        if (last) break;
        cur = nxt;
    }
#undef FOX_GRAB
#undef FOX_MAKE
}

#ifdef NANPROBE
constexpr size_t WS_FLAGS = 32 * 1024;
__device__ __forceinline__ void probe_f32(const float* p, size_t n, unsigned* flag) { bool bad = false;
    for (size_t i = (size_t)lz_bid() * 512 + lz_tid(); i < n; i += (size_t)gridDim.x * 512) { const unsigned u = __float_as_uint(p[i]); if ((u & 0x7f800000u) == 0x7f800000u) bad = true; }
    if (bad) *flag = 1u; }
__device__ __forceinline__ void probe_bf16(const unsigned short* p, size_t n, unsigned* flag) { bool bad = false;
    for (size_t i = (size_t)lz_bid() * 512 + lz_tid(); i < n; i += (size_t)gridDim.x * 512) { const unsigned u = p[i]; if ((u & 0x7f80u) == 0x7f80u) bad = true; }
    if (bad) *flag = 1u; }
#define PROBE_F32(p, n, k) probe_f32((const float*)(p), (n), (unsigned*)(ws + WS_FLAGS) + (k))
#define PROBE_BF16(p, n, k) probe_bf16((const unsigned short*)(p), (n), (unsigned*)(ws + WS_FLAGS) + (k))
#else
#define PROBE_F32(p, n, k) do {} while (0)
#define PROBE_BF16(p, n, k) do {} while (0)
#endif
#ifndef PHMASK
#define PHMASK 0xfff
#endif
#define EN(k) ((PHMASK >> (k)) & 1)
#define IN(k) (lo <= (k) && (k) < hi)
#ifdef TWICE_SYNC
#define SEAM() do { if (IN(ph) && IN(ph + 1)) { grid.sync(); grid.sync(); grid.sync(); } ++ph; } while (0)
#else
#define SEAM() do { if (IN(ph) && IN(ph + 1)) { if (ph == 0) grid.sync(); else xcd_barrier(xbar); } ++ph; } while (0)
#endif
#define a (*fresh_args())
#define ws (a.ws)
#define MOD ((const float*)(ws + WS_MOD))
template <int layer>
__device__ __forceinline__ void layer_phases(int& ph, const int lo, const int hi, cg::grid_group& grid, const XcdBarrier& xbar, LAS unsigned char* lds, unsigned char* lds_raw) {

        const float* mod = MOD + (size_t)layer * NB * NMOD;
        const float* xin = layer == 0 ? (const float*)a.in[0] : a.out;
        if (EN(1) && IN(ph)) norm_phase(xin, (const float*)a.in[5] + (size_t)layer * DM, mod, mod + DM, (bf16r*)(ws + WS_H));
#ifdef TWICE_NORM
        if (IN(ph)) norm_phase(xin, (const float*)a.in[5] + (size_t)layer * DM, mod, mod + DM, (bf16r*)(ws + WS_H));
#endif
        SEAM();
        if (EN(2) && IN(ph)) { pg8::Gemm g{(const pg8::bf16_t*)(ws + WS_H), (const pg8::bf16_t*)(ws + WS_WIN + layer * WIN_BYTES), MROWS, NINP, DM}; pg8::StaticOrder S; S.init(MROWS, NINP, gridDim.x, lz_bid());
            pg8::EpiIn E{(pg8::bf16_t*)(ws + WS_P), (float*)(ws + WS_GATES)};
            pg8::gemm_phase<pg8::EpiIn, pg8::StaticOrder, true, true>(lds, g, S, E);
            gate_gemm((const bf16r*)(ws + WS_H), (const bf16r*)(ws + WS_WG + layer * WG_BYTES), (float*)(ws + WS_GATES));
#ifdef TWICE_IN
            __syncthreads(); pg8::gemm_phase<pg8::EpiIn, pg8::StaticOrder, true, true>(lds, g, S, E);
#endif
        }
        SEAM();
        if (EN(3) && IN(ph)) prep_phase(a, layer, lds);
#ifdef TWICE_INPREP
        if (IN(ph)) { xcd_barrier(xbar);
            { pg8::Gemm g{(const pg8::bf16_t*)(ws + WS_H), (const pg8::bf16_t*)(ws + WS_WIN + layer * WIN_BYTES), MROWS, NINP, DM}; pg8::StaticOrder S; S.init(MROWS, NINP, gridDim.x, lz_bid());
              pg8::EpiIn E{(pg8::bf16_t*)(ws + WS_P), (float*)(ws + WS_GATES)};
              pg8::gemm_phase<pg8::EpiIn, pg8::StaticOrder, true, true>(lds, g, S, E); }
            xcd_barrier(xbar); prep_phase(a, layer, lds); }
#endif
        SEAM();
        PROBE_F32(ws + WS_GATES, (size_t)MROWS * 16, 1 + 10 * layer); PROBE_F32(ws + WS_CNEG, (size_t)NB * 8 * SEQ, 2 + 10 * layer); PROBE_F32(ws + WS_MA, (size_t)3 * NB * 4 * SEQ, 3 + 10 * layer); PROBE_BF16(ws + WS_P, (size_t)56 * MROWS * 128, 4 + 10 * layer); PROBE_BF16(ws + WS_MQC, (size_t)8 * MROWS * 128, 5 + 10 * layer);
        if (IN(ph)) { fox_table_phase(a, layer); if (EN(4)) m1_phase(a, lds);
#if 0
#ifdef TWICE_FOX
            __syncthreads(); fox_phase(a, layer, (char*)lds_raw);
#endif
#endif
#ifdef TWICE_M1
            __syncthreads(); m1_phase(a, lds);
#endif
        }
        SEAM();
#ifdef NANPROBE
        PROBE_BF16(ws + WS_H, (size_t)MROWS * DM, 20 + layer); PROBE_F32(ws + WS_UN, (size_t)NB * 4 * 256 * 128, 22 + layer); PROBE_F32(ws + WS_MPREV, (size_t)NB * 4 * 256, 24 + layer); grid.sync();
#endif
        if (IN(ph)) { if (EN(6)) m2_phase(a, lds); __syncthreads(); if (EN(5)) fox_phase(a, layer, (char*)lds_raw);
#ifdef TWICE_FOX
            __syncthreads(); fox_phase(a, layer, (char*)lds_raw, 1);
#endif
        }
        SEAM();
        if (EN(7) && IN(ph)) m3_phase(a, layer, lds);
#ifdef TWICE_M3
        if (IN(ph)) { __syncthreads(); m3_phase(a, layer, lds); }
#endif
        SEAM();
        PROBE_BF16(ws + WS_H, (size_t)MROWS * DM, 6 + 10 * layer); PROBE_BF16(ws + WS_Y, (size_t)MROWS * DM, 7 + 10 * layer);
        if (EN(8) && IN(ph)) { pg8::Gemm g{(const pg8::bf16_t*)(ws + WS_Y), (const pg8::bf16_t*)(ws + WS_WOUT + layer * WOUT_BYTES), MROWS, DM, DM}; pg8::StaticOrder S; S.init(MROWS, DM, gridDim.x, lz_bid());
            pg8::EpiRes E{xin, a.out, mod + 2 * DM};
            pg8::gemm_phase<pg8::EpiRes, pg8::StaticOrder, true, true>(lds, g, S, E); }
        SEAM();
        PROBE_F32(a.out, (size_t)MROWS * DM, 8 + 10 * layer);
        if (EN(1) && IN(ph)) norm_phase(a.out, (const float*)a.in[6] + (size_t)layer * DM, mod + 3 * DM, mod + 4 * DM, (bf16r*)(ws + WS_H));
#ifdef TWICE_NORM
        if (IN(ph)) norm_phase(a.out, (const float*)a.in[6] + (size_t)layer * DM, mod + 3 * DM, mod + 4 * DM, (bf16r*)(ws + WS_H));
#endif
        SEAM();
        if (EN(9) && IN(ph)) { pg8::Gemm g{(const pg8::bf16_t*)(ws + WS_H), (const pg8::bf16_t*)(ws + WS_WFF1 + layer * WFF_BYTES), MROWS, DFF, DM}; pg8::StaticOrder S; S.init(MROWS, DFF, gridDim.x, lz_bid());
            pg8::EpiRelu2 E{(pg8::bf16_t*)(ws + WS_HID), DFF};
            pg8::gemm_phase<pg8::EpiRelu2, pg8::StaticOrder, true, true>(lds, g, S, E);
#ifdef TWICE_FF1
            __syncthreads(); pg8::gemm_phase<pg8::EpiRelu2, pg8::StaticOrder, true, true>(lds, g, S, E);
#endif
        }
        SEAM();
        if (EN(10) && IN(ph)) { pg8::Gemm g{(const pg8::bf16_t*)(ws + WS_HID), (const pg8::bf16_t*)(ws + WS_WFF2 + layer * WFF_BYTES), MROWS, DM, DFF}; pg8::StaticOrder S; S.init(MROWS, DM, gridDim.x, lz_bid());
            pg8::EpiRes E{a.out, a.out, mod + 5 * DM};
            pg8::gemm_phase<pg8::EpiRes, pg8::StaticOrder, true, true>(lds, g, S, E); }
        SEAM();
        PROBE_F32(a.out, (size_t)MROWS * DM, 9 + 10 * layer);
    }
__global__ void __launch_bounds__(512, 2) trunk_fwd(Args a_unused) {
    extern __shared__ __attribute__((aligned(16))) unsigned char lds_raw[];
    LAS unsigned char* lds = (LAS unsigned char*)lds_raw;
    cg::grid_group grid = cg::this_grid();
    int lo, hi; { CArgs& a0 = *fresh_args(); lo = a0.ph_lo; hi = a0.ph_hi; } int ph = 0;
    volatile LAS unsigned* xst = (volatile LAS unsigned*)(lds + 139264);
    if (lz_tid() < 2) xst[lz_tid()] = 0u;
    __syncthreads();
    if (lz_bid() == 0) { unsigned* z = (unsigned*)ws; for (int i = lz_tid(); i < 4096; i += 512) z[i] = 0u; }
#ifdef NANPROBE
    if (lz_bid() == 0 && lz_tid() < 32) ((unsigned*)(ws + WS_FLAGS))[lz_tid()] = 0u;
#endif
    if (EN(0) && IN(ph)) p0_phase(a, lds);
#ifdef TWICE_P0
    if (IN(ph)) { __syncthreads(); p0_phase(a, lds); }
#endif
    if (IN(ph) && IN(ph + 1)) grid.sync();
    ++ph;
    const XcdBarrier xbar = xcd_barrier_post((unsigned*)ws, xst);
    layer_phases<0>(ph, lo, hi, grid, xbar, lds, lds_raw);
    layer_phases<1>(ph, lo, hi, grid, xbar, lds, lds_raw);
    if (EN(11) && IN(ph)) final_norm_phase(a.out, (const float*)a.in[17]);
#ifdef NANPROBE
    { grid.sync(); float code = 0.f; const unsigned* fl = (const unsigned*)(ws + WS_FLAGS);
      const int order[16] = {1, 2, 3, 4, 5, 24, 20, 22, 6, 7, 8, 9, 11, 12, 13, 14};
      for (int q = 15; q >= 0; --q) if (fl[order[q]]) code = (float)order[q] * 1.0e6f;
      float* o = a.out; for (size_t i = (size_t)lz_bid() * 512 + lz_tid(); i < (size_t)MROWS * DM; i += (size_t)gridDim.x * 512) o[i] = (i == 0) ? code : 0.f; }
#endif
#ifdef DBG_OFF_MIB
    { grid.sync();
      const unsigned short* src = (const unsigned short*)(ws + (size_t)DBG_OFF_MIB * MiB); const size_t n = (size_t)DBG_MIB * MiB / 2; float* o = a.out;
      for (size_t i = (size_t)lz_bid() * 512 + lz_tid(); i < (size_t)MROWS * DM; i += (size_t)gridDim.x * 512) { const size_t k = (4 * i) % n;
          o[i] = (float)src[k] + 3.f * (float)src[k + 1] + 5.f * (float)src[k + 2] + 7.f * (float)src[k + 3]; } }
#endif
#undef IN
#undef SEAM
#undef a
#undef ws
#undef MOD
}

#ifndef MK_PER_PHASE
#define MK_PER_PHASE 0
#endif
extern "C" void kernel_launch(void* const* d_in, const int* in_sizes, int n_in, void* d_out, int out_size, void* d_ws, size_t ws_size, hipStream_t stream) {
    static int grid = 0;
    if (grid == 0) {
        if (n_in != 18 || in_sizes[0] != MROWS * DM || out_size != MROWS * DM || ws_size < WS_END) { fprintf(stderr, "kernel_launch: unexpected shapes (n_in %d, in0 %d, out %d, ws %zu)\n", n_in, n_in > 0 ? in_sizes[0] : -1, out_size, ws_size); grid = -1; return; }
        int dev = 0, cus = 0, per_cu = 0;
        if (hipGetDevice(&dev) != hipSuccess || hipDeviceGetAttribute(&cus, hipDeviceAttributeMultiprocessorCount, dev) != hipSuccess) { grid = -1; return; }
        if (hipFuncSetAttribute((const void*)trunk_fwd, hipFuncAttributeMaxDynamicSharedMemorySize, LDS_BYTES) != hipSuccess) { fprintf(stderr, "kernel_launch: hipFuncSetAttribute failed\n"); grid = -1; return; }
        if (hipOccupancyMaxActiveBlocksPerMultiprocessor(&per_cu, (const void*)trunk_fwd, 512, LDS_BYTES) != hipSuccess || per_cu < 1) { fprintf(stderr, "kernel_launch: occupancy query says %d\n", per_cu); per_cu = 1; }
        (void)hipGetLastError();
        grid = cus;
    }
    if (grid < 0) return;
    Args a{};
    for (int i = 0; i < 18; ++i) a.in[i] = d_in[i];
    a.out = (float*)d_out; a.ws = (unsigned char*)d_ws;
    constexpr int NPH = 1 + 2 * 10 + 1;
#if MK_PER_PHASE
    for (int p = 0; p < NPH; ++p) { a.ph_lo = p; a.ph_hi = p + 1; hipLaunchKernelGGL(trunk_fwd, dim3(grid), dim3(512), LDS_BYTES, stream, a); }
#else
#ifdef DBG_HI
    a.ph_lo = 0; a.ph_hi = DBG_HI;
#else
    a.ph_lo = 0; a.ph_hi = NPH;
#endif
    void* args[] = {&a};
    hipError_t e = hipLaunchCooperativeKernel((const void*)trunk_fwd, dim3(grid), dim3(512), args, LDS_BYTES, stream);
    if (e != hipSuccess) fprintf(stderr, "kernel_launch: cooperative launch failed: %s (grid %d)\n", hipGetErrorString(e), grid);
#endif
}
```

```cpp
#include <hip/hip_runtime.h>
#include <hip/hip_bf16.h>
#include <hip/hip_cooperative_groups.h>
#include <cstdio>
#include <cstdint>
namespace cg = cooperative_groups;

constexpr int NB = 2, SEQ = 16384, DM = 2048, MROWS = NB * SEQ, DIN = 7184, NINP = 7168, DFF = 8192, HD = 128, NMOD = 6 * DM;
constexpr int NSLOT = 56;
constexpr float NORM_EPS = 1e-6f;
constexpr float KSCALE = 0.08838834764831845f;

__device__ __forceinline__ int lz_tid() { const int w = __builtin_amdgcn_readfirstlane((int)threadIdx.x >> 6); int l; asm volatile("v_mbcnt_lo_u32_b32 %0, -1, 0\n\tv_mbcnt_hi_u32_b32 %0, -1, %0" : "=v"(l));
    int t = w * 64 + l; asm volatile("" : "+v"(t)); return t; }
__device__ __forceinline__ int lz_bid() { int b = blockIdx.x; asm volatile("" : "+s"(b)); return b; }

namespace pg8 {
#define PG8_LAS __attribute__((address_space(3)))
typedef unsigned short bf16_t;
typedef short bf16x8 __attribute__((ext_vector_type(8)));
typedef float f32x4 __attribute__((ext_vector_type(4)));
typedef unsigned u32x4 __attribute__((ext_vector_type(4)));
constexpr int BM = 256, BK = 64, HALF = 128, HTB = HALF * BK * 2  , STAGE_BYTES = 8 * HTB, NXCD = 8, WGM = 4;

__host__ __device__ __forceinline__ int lds_byte(int r, int c) { const int st = (r >> 4) * 2 + (c >> 5), rr = r & 15, cc = c & 31, ob = rr * 64 + cc * 2; return st * 1024 + (ob ^ (((ob >> 9) & 1) << 5)); }
__host__ __device__ __forceinline__ void stage_rc(int b, int& R, int& C) { const int st = b / 1024, sb = b % 1024, swz = sb ^ (((sb >> 9) & 1) << 5); R = (st >> 1) * 16 + swz / 64; C = (st & 1) * 32 + (swz % 64) / 2; }
__host__ __device__ __forceinline__ int perm32(int rho) { const int n = rho >> 4, i = rho & 15; return 8 * (i >> 2) + 4 * n + (i & 3); }

struct Unit { int pm, pn; };
struct Gemm { const bf16_t* A; const bf16_t* Bt; int M, N, K; };

struct StaticOrder {
    int nM, nN, nwg, G, c;
    __host__ __device__ void init(int M, int N, int G_, int c_) { nM = M / BM; nN = N / BM; nwg = nM * nN; G = G_; c = c_; }
    __host__ __device__ bool next(int i, Unit& u) const {
        const long L = (long)i * G + c; if (L >= nwg) return false;
        int wgid = (int)L; { const int q = nwg / NXCD, r = nwg % NXCD, xcd = wgid % NXCD, off = wgid / NXCD; wgid = (xcd < r ? xcd * (q + 1) : r * (q + 1) + (xcd - r) * q) + off; }
        const int nig = WGM * nN, gid = wgid / nig, fm = gid * WGM, gsz = (nM - fm) < WGM ? (nM - fm) : WGM;
        u.pm = fm + ((wgid % nig) % gsz); u.pn = (wgid % nig) / gsz; return true;
    }
    __device__ __forceinline__ void a_ready(const Unit&) const {}
    __device__ __forceinline__ void done(const Unit&) const {}
};

__device__ __forceinline__ unsigned cvt_pk_bf16(float lo, float hi) { unsigned r; asm volatile("v_cvt_pk_bf16_f32 %0, %1, %2" : "=v"(r) : "v"(lo), "v"(hi)); return r; }

typedef float epf2_t __attribute__((ext_vector_type(2))); typedef __bf16 epb2_t __attribute__((ext_vector_type(2)));
__device__ __forceinline__ unsigned cvt_pk_c(float lo, float hi) { epf2_t v = {lo, hi}; epb2_t b = __builtin_convertvector(v, epb2_t); return __builtin_bit_cast(unsigned, b); }
struct EpiIn {
    static constexpr bool PERM = true, AFTER_DRAIN = false;
    bf16_t* P; float* gates;
    __device__ __forceinline__ void operator()(const f32x4 (&acc)[2][2][4][2], const Unit& u, int wr, int wc, int fr, int fq) const {
        const int row0 = u.pm * BM + wr * 64 + fr;
#pragma unroll
        for (int bj = 0; bj < 2; ++bj) {
            const int g = 2 * u.pn + bj;
            if (g < 56) {
                bf16_t* base = P + ((size_t)g * MROWS + row0) * 128 + wc * 32 + 8 * fq;
#pragma unroll
                for (int ai = 0; ai < 2; ++ai)
#pragma unroll
                    for (int m = 0; m < 4; ++m) { const f32x4 v0 = acc[ai][bj][m][0], v1 = acc[ai][bj][m][1];
                        u32x4 w; w.x = cvt_pk_c(v0[0], v0[1]); w.y = cvt_pk_c(v0[2], v0[3]); w.z = cvt_pk_c(v1[0], v1[1]); w.w = cvt_pk_c(v1[2], v1[3]);
                        *(u32x4*)(base + (size_t)(ai * HALF + m * 16) * 128) = w; }
            } else if (g == 56) {
                if (wc == 0 && fq < 2) { float* gp = gates + (size_t)row0 * 16 + 8 * fq;
#pragma unroll
                    for (int ai = 0; ai < 2; ++ai)
#pragma unroll
                        for (int m = 0; m < 4; ++m) { *(f32x4*)(gp + (size_t)(ai * HALF + m * 16) * 16) = acc[ai][bj][m][0]; *(f32x4*)(gp + (size_t)(ai * HALF + m * 16) * 16 + 4) = acc[ai][bj][m][1]; } }
            }
        }
    }
};
struct EpiRes {
    static constexpr bool PERM = true, AFTER_DRAIN = false;
    const float* base; float* out; const float* gvec;
    __device__ __forceinline__ void operator()(const f32x4 (&acc)[2][2][4][2], const Unit& u, int wr, int wc, int fr, int fq) const {
        const int row0 = u.pm * BM + wr * 64 + fr; const int b = (u.pm * BM) / SEQ; const float* gv = gvec + (size_t)b * NMOD;
#pragma unroll
        for (int bj = 0; bj < 2; ++bj) { const int c = u.pn * BM + bj * HALF + wc * 32 + 8 * fq;
            const f32x4 g0 = *(const f32x4*)(gv + c), g1 = *(const f32x4*)(gv + c + 4);
#pragma unroll
            for (int ai = 0; ai < 2; ++ai)
#pragma unroll
                for (int m = 0; m < 4; ++m) { const size_t off = (size_t)(row0 + ai * HALF + m * 16) * DM + c;
                    const f32x4 x0 = *(const f32x4*)(base + off), x1 = *(const f32x4*)(base + off + 4);
                    *(f32x4*)(out + off) = x0 + g0 * acc[ai][bj][m][0]; *(f32x4*)(out + off + 4) = x1 + g1 * acc[ai][bj][m][1]; } }
    }
};
struct EpiRelu2 {
    static constexpr bool PERM = true, AFTER_DRAIN = false;
    bf16_t* O; int ldc;
    __device__ __forceinline__ void operator()(const f32x4 (&acc)[2][2][4][2], const Unit& u, int wr, int wc, int fr, int fq) const {
        const int row0 = u.pm * BM + wr * 64 + fr;
#pragma unroll
        for (int bj = 0; bj < 2; ++bj) { bf16_t* base = O + (size_t)row0 * ldc + u.pn * BM + bj * HALF + wc * 32 + 8 * fq;
#pragma unroll
            for (int ai = 0; ai < 2; ++ai)
#pragma unroll
                for (int m = 0; m < 4; ++m) { f32x4 v0 = acc[ai][bj][m][0], v1 = acc[ai][bj][m][1];
#pragma unroll
                    for (int i = 0; i < 4; ++i) { const float a = v0[i] > 0.f ? v0[i] : 0.f, b = v1[i] > 0.f ? v1[i] : 0.f; v0[i] = a * a; v1[i] = b * b; }
                    u32x4 w; w.x = cvt_pk_c(v0[0], v0[1]); w.y = cvt_pk_c(v0[2], v0[3]); w.z = cvt_pk_c(v1[0], v1[1]); w.w = cvt_pk_c(v1[2], v1[3]);
                    *(u32x4*)(base + (size_t)(ai * HALF + m * 16) * ldc) = w; } }
    }
};

template <class Epi, class Sched, bool ALIGN_EPI = false, bool SP2 = false>
__device__ __forceinline__ void gemm_phase(PG8_LAS unsigned char* lds, const Gemm g, const Sched& S, const Epi& E) {
    const int tid = lz_tid(), wid = __builtin_amdgcn_readfirstlane(tid >> 6), lane = tid & 63, wr = wid >> 2, wc = wid & 3, fr = lane & 15, fq = lane >> 4;
    const int K = g.K, nt = K / BK;
    unsigned voffA[2], voffB[2];
#pragma unroll
    for (int i = 0; i < 2; ++i) { int R, C; stage_rc(tid * 16 + i * 8192, R, C); const int Rb = Epi::PERM ? ((R & ~31) + perm32(R & 31)) : R;
        voffA[i] = (unsigned)(R * K + C) * 2u; voffB[i] = (unsigned)(Rb * K + C) * 2u; }
    const size_t kstep = (size_t)(BK * 2);
    const size_t hstep = (size_t)HALF * K * 2;
    const size_t tstep = 2 * hstep;
    const unsigned ldsw = (unsigned)wid * 1024u;
    const int aoff = lds_byte(wr * 64 + fr, fq * 8), boff = lds_byte(wc * 32 + fr, fq * 8);
#define PG8_SA(b, h) (((b) * 2 + (h)) * HTB)
#define PG8_SB(b, h) ((4 + (b) * 2 + (h)) * HTB)
#define PG8_STAGE(bufoff, gbase, voff) do { _Pragma("unroll") for (int _i = 0; _i < 2; ++_i) \
        __builtin_amdgcn_global_load_lds((const unsigned*)((const char*)(gbase) + (voff)[_i]), (PG8_LAS unsigned*)(lds + (bufoff) + ldsw + _i * 8192), 16, 0, 0); } while (0)
#define PG8_LDA(dst, b, h) do { _Pragma("unroll") for (int m = 0; m < 4; ++m) _Pragma("unroll") for (int k = 0; k < 2; ++k) dst[m][k] = *(const PG8_LAS bf16x8*)(lds + PG8_SA(b, h) + aoff + m * 2048 + k * 1024); } while (0)
#define PG8_LDB(dst, b, h) do { _Pragma("unroll") for (int n = 0; n < 2; ++n) _Pragma("unroll") for (int k = 0; k < 2; ++k) dst[n][k] = *(const PG8_LAS bf16x8*)(lds + PG8_SB(b, h) + boff + n * 2048 + k * 1024); } while (0)
#define PG8_MMA(ai, bj, At, Bt) do { __builtin_amdgcn_s_setprio(1); _Pragma("unroll") for (int m = 0; m < 4; ++m) _Pragma("unroll") for (int n = 0; n < 2; ++n) _Pragma("unroll") for (int k = 0; k < 2; ++k) \
        acc[ai][bj][m][n] = __builtin_amdgcn_mfma_f32_16x16x32_bf16(Bt[n][k], At[m][k], acc[ai][bj][m][n], 0, 0, 0); __builtin_amdgcn_s_setprio(0); } while (0)
#define PG8_WAIT_V(n) asm volatile("s_waitcnt vmcnt(" #n ")" ::: "memory")
#define PG8_WAIT_L(n) asm volatile("s_waitcnt lgkmcnt(" #n ")" ::: "memory")
#define PG8_BAR __builtin_amdgcn_s_barrier()
#define PG8_SCHED __builtin_amdgcn_sched_barrier(0)
    Unit cur, nxt; int ui = 0;
    if (!S.next(0, cur)) return;
    f32x4 acc[2][2][4][2];
#pragma unroll
    for (int a = 0; a < 2; ++a)
#pragma unroll
        for (int b = 0; b < 2; ++b)
#pragma unroll
            for (int m = 0; m < 4; ++m)
#pragma unroll
                for (int n = 0; n < 2; ++n) acc[a][b][m][n] = (f32x4){0.f, 0.f, 0.f, 0.f};
    bf16x8 At[4][2], B0[2][2], B1[2][2];
    const char* cA = (const char*)g.A + (size_t)cur.pm * tstep; const char* cB = (const char*)g.Bt + (size_t)cur.pn * tstep;
    S.a_ready(cur);
    if constexpr (SP2) {
        PG8_STAGE(PG8_SB(0, 0), cB, voffB); PG8_STAGE(PG8_SB(0, 1), cB + hstep, voffB); PG8_STAGE(PG8_SA(0, 0), cA, voffA); PG8_STAGE(PG8_SA(0, 1), cA + hstep, voffA);
        if (wr == 1) PG8_BAR;
        PG8_WAIT_V(2); PG8_BAR;
        PG8_STAGE(PG8_SB(1, 0), cB + kstep, voffB); PG8_STAGE(PG8_SA(1, 0), cA + kstep, voffA); PG8_STAGE(PG8_SB(1, 1), cB + hstep + kstep, voffB);
        PG8_WAIT_V(6); PG8_BAR;
    } else {
        PG8_STAGE(PG8_SB(0, 0), cB, voffB); PG8_STAGE(PG8_SA(0, 0), cA, voffA); PG8_STAGE(PG8_SB(0, 1), cB + hstep, voffB); PG8_STAGE(PG8_SA(0, 1), cA + hstep, voffA);
        if (wr == 1) PG8_BAR;
        PG8_WAIT_V(4); PG8_BAR;
        PG8_STAGE(PG8_SB(1, 0), cB + kstep, voffB); PG8_STAGE(PG8_SA(1, 0), cA + kstep, voffA); PG8_STAGE(PG8_SB(1, 1), cB + hstep + kstep, voffB);
        PG8_WAIT_V(6); PG8_BAR;
    }
    for (;;) {
        const bool has_next = S.next(ui + 1, nxt);
        const char* nA = has_next ? (const char*)g.A + (size_t)nxt.pm * tstep : cA; const char* nB = has_next ? (const char*)g.Bt + (size_t)nxt.pn * tstep : cB;
        for (int t = 0; t < nt; t += 2) {
            const bool last = (t == nt - 2);
            const char* a1 = cA + (size_t)(t + 1) * kstep;
            const char* a2 = last ? nA : cA + (size_t)(t + 2) * kstep; const char* b2 = last ? nB : cB + (size_t)(t + 2) * kstep;
            const char* a3 = a2 + kstep; const char* b3 = b2 + kstep;
            if (last && has_next) S.a_ready(nxt);
            if constexpr (SP2) {
            PG8_LDB(B0, 0, 0); PG8_LDB(B1, 0, 1); PG8_SCHED; PG8_LDA(At, 0, 0); PG8_STAGE(PG8_SA(1, 1), a1 + hstep, voffA);
            PG8_WAIT_V(8); PG8_WAIT_L(0); PG8_BAR; PG8_MMA(0, 0, At, B0); PG8_MMA(0, 1, At, B1); PG8_BAR; PG8_SCHED;
            PG8_LDA(At, 0, 1); PG8_STAGE(PG8_SB(0, 0), b2, voffB); PG8_STAGE(PG8_SB(0, 1), b2 + hstep, voffB); PG8_STAGE(PG8_SA(0, 0), a2, voffA);
            PG8_WAIT_V(8); PG8_WAIT_L(0); PG8_BAR; PG8_MMA(1, 0, At, B0); PG8_MMA(1, 1, At, B1); PG8_BAR; PG8_SCHED;
            PG8_LDB(B0, 1, 0); PG8_LDB(B1, 1, 1); PG8_SCHED; PG8_LDA(At, 1, 0); PG8_STAGE(PG8_SA(0, 1), a2 + hstep, voffA);
            PG8_WAIT_V(8); PG8_WAIT_L(0); PG8_BAR; PG8_MMA(0, 0, At, B0); PG8_MMA(0, 1, At, B1); PG8_BAR; PG8_SCHED;
            PG8_LDA(At, 1, 1); PG8_STAGE(PG8_SB(1, 0), b3, voffB); PG8_STAGE(PG8_SB(1, 1), b3 + hstep, voffB); PG8_STAGE(PG8_SA(1, 0), a3, voffA);
            PG8_WAIT_V(8); PG8_WAIT_L(0); PG8_BAR; PG8_MMA(1, 0, At, B0); PG8_MMA(1, 1, At, B1); PG8_BAR; PG8_SCHED;
            } else {
            PG8_LDB(B0, 0, 0); PG8_SCHED; PG8_LDA(At, 0, 0); PG8_STAGE(PG8_SA(1, 1), a1 + hstep, voffA);
            PG8_WAIT_L(8); PG8_BAR; PG8_WAIT_L(0); PG8_MMA(0, 0, At, B0); PG8_BAR; PG8_SCHED;
            PG8_LDB(B1, 0, 1); PG8_STAGE(PG8_SB(0, 0), b2, voffB);
            PG8_BAR; PG8_WAIT_L(0); PG8_MMA(0, 1, At, B1); PG8_BAR;
            PG8_LDA(At, 0, 1); PG8_STAGE(PG8_SA(0, 0), a2, voffA);
            PG8_BAR; PG8_WAIT_L(0); PG8_MMA(1, 0, At, B0); PG8_BAR; PG8_SCHED;
            PG8_STAGE(PG8_SB(0, 1), b2 + hstep, voffB);
            PG8_WAIT_V(6); PG8_BAR; PG8_MMA(1, 1, At, B1); PG8_BAR;
            PG8_LDB(B0, 1, 0); PG8_SCHED; PG8_LDA(At, 1, 0); PG8_STAGE(PG8_SA(0, 1), a2 + hstep, voffA);
            PG8_WAIT_L(8); PG8_BAR; PG8_WAIT_L(0); PG8_MMA(0, 0, At, B0); PG8_BAR; PG8_SCHED;
            PG8_LDB(B1, 1, 1); PG8_STAGE(PG8_SB(1, 0), b3, voffB);
            PG8_BAR; PG8_WAIT_L(0); PG8_MMA(0, 1, At, B1); PG8_BAR;
            PG8_LDA(At, 1, 1); PG8_STAGE(PG8_SA(1, 0), a3, voffA);
            PG8_BAR; PG8_WAIT_L(0); PG8_MMA(1, 0, At, B0); PG8_BAR; PG8_SCHED;
            PG8_STAGE(PG8_SB(1, 1), b3 + hstep, voffB);
            PG8_WAIT_V(6); PG8_BAR; PG8_MMA(1, 1, At, B1); PG8_BAR;
            }
        }
        if constexpr (ALIGN_EPI) { if (wr == 0) PG8_BAR; }
        if constexpr (!Epi::AFTER_DRAIN) { E(acc, cur, wr, wc, fr, fq); S.done(cur); }
        if (!has_next) break;
#pragma unroll
        for (int a = 0; a < 2; ++a)
#pragma unroll
            for (int b = 0; b < 2; ++b)
#pragma unroll
                for (int m = 0; m < 4; ++m)
#pragma unroll
                    for (int n = 0; n < 2; ++n) acc[a][b][m][n] = (f32x4){0.f, 0.f, 0.f, 0.f};
        cur = nxt; cA = nA; cB = nB; ++ui;
        if constexpr (ALIGN_EPI) { if (wr == 1) PG8_BAR; }
    }
    PG8_WAIT_V(0);
    if constexpr (!ALIGN_EPI) { if (wr == 0) PG8_BAR; }
    PG8_BAR;
    if constexpr (Epi::AFTER_DRAIN) { E.fused(acc, cur, wr, wc, fr, fq, lds, wid, lane); S.done(cur); }
#undef PG8_SA
#undef PG8_SB
#undef PG8_STAGE
#undef PG8_LDA
#undef PG8_LDB
#undef PG8_MMA
#undef PG8_WAIT_V
#undef PG8_WAIT_L
#undef PG8_BAR
#undef PG8_SCHED
}
}
namespace fox {
constexpr int D = 128; constexpr float THR = 32.f; constexpr bool WSKIP = false; constexpr int OSTR = 2048;
constexpr float SCALE = 0.08838834764831845f;
constexpr int NW = 8, QBLK = 32, KVBLK = 64, QB = NW * QBLK;
constexpr int SHM_V = KVBLK * D * 2, SHM_K = KVBLK * D * 2;
constexpr int LDS_CB = 2 * SHM_V + 2 * SHM_K + NW * 64 * 4; constexpr int LDS_BYTES = LDS_CB + 2 * 64 * 4;

using bf16 = __hip_bfloat16;
typedef short bf16x8 __attribute__((ext_vector_type(8)));
typedef short s16x4 __attribute__((ext_vector_type(4)));
typedef float f32x16 __attribute__((ext_vector_type(16)));
typedef float f32x4 __attribute__((ext_vector_type(4)));
typedef unsigned u32x4 __attribute__((ext_vector_type(4)));
template <class A, class Bt> struct same_t { static constexpr bool v = false; };
template <class A> struct same_t<A, A> { static constexpr bool v = true; };

#define KSWZ(row, colB) ((row) * 256 + ((colB) ^ (((row) & 7) << 4)))
#define SBAR() __builtin_amdgcn_sched_barrier(0)
__device__ __forceinline__ int v_st(int k, int c) { const int kk = (k & ~0xC) | ((k & 4) << 1) | ((k & 8) >> 1); return ((kk >> 3) * 4 + (c >> 5)) * 512 + ((kk & 7) * 32 + (c & 31)) * 2; }
__device__ __forceinline__ int v_rd_base(int lane) { return ((lane & 3) << 3) | (((lane >> 2) & 3) << 6) | (((lane >> 4) & 1) << 5) | (((lane >> 5) & 1) << 8); }
constexpr int v_rd_off(int d0, int ks, int half) { return d0 * 512 + ks * 4096 + half * 2048; }
__device__ __forceinline__ int crow(int r, int hi) { return (r & 3) + 8 * (r >> 2) + 4 * hi; }
__device__ __forceinline__ unsigned cvtpk(float lo, float hi) {
    unsigned r; asm volatile("v_cvt_pk_bf16_f32 %0, %1, %2" : "=v"(r) : "v"(lo), "v"(hi)); return r;
}
__device__ __forceinline__ bf16x8 pack8(f32x4 a, f32x4 b) {
    u32x4 w = {cvtpk(a[0], a[1]), cvtpk(a[2], a[3]), cvtpk(b[0], b[1]), cvtpk(b[2], b[3])};
    return *reinterpret_cast<bf16x8*>(&w);
}
template <class T> __device__ __forceinline__ bf16x8 load8(const T* p) {
    if constexpr (same_t<T, float>::v) { return pack8(*(const f32x4*)p, *(const f32x4*)(p + 4)); }
    else { return *reinterpret_cast<const bf16x8*>(p); }
}
__device__ __forceinline__ void mask_tile(f32x16& p0, f32x16& p1, int dq, unsigned W) {
    const float NEG = -__builtin_inff();
#pragma unroll
    for (int r = 0; r < 16; ++r) {
        const int c = (r & 3) + 8 * (r >> 2);
        if ((unsigned)(dq - c) >= W) p0[r] = NEG;
        if ((unsigned)(dq - c - 32) >= W) p1[r] = NEG;
    }
}
__device__ __forceinline__ void partialSM(f32x16& p0, f32x16& p1, float& m_reg, float& mn, float& alpha) {
    float pmax = p0[0]; for (int r = 1; r < 16; ++r) pmax = fmaxf(pmax, p0[r]); for (int r = 0; r < 16; ++r) pmax = fmaxf(pmax, p1[r]);
    { auto rr = __builtin_amdgcn_permlane32_swap(__float_as_uint(pmax), __float_as_uint(pmax), false, false);
      pmax = fmaxf(__uint_as_float(rr[0]), __uint_as_float(rr[1])); }
    constexpr float C2 = 1.4426950408889634f * SCALE;
    if (__builtin_expect(__all((pmax - m_reg) * SCALE <= THR), 1)) { mn = m_reg; alpha = 1.f; }
    else { mn = fmaxf(m_reg, pmax); alpha = __builtin_amdgcn_exp2f((m_reg - mn) * C2); m_reg = mn; }
    const float mnL = -mn * C2;
    for (int r = 0; r < 16; ++r) p0[r] = fmaf(p0[r], C2, mnL); for (int r = 0; r < 16; ++r) p1[r] = fmaf(p1[r], C2, mnL);
    for (int r = 0; r < 16; ++r) p0[r] = __builtin_amdgcn_exp2f(p0[r]);
}
__device__ __forceinline__ void finishSM(f32x16& p0, f32x16& p1, float alpha, float& l_reg, bf16x8& pa0, bf16x8& pa1, bf16x8& pa2, bf16x8& pa3) {
    for (int r = 0; r < 16; ++r) p1[r] = __builtin_amdgcn_exp2f(p1[r]);
    float ps = 0; for (int r = 0; r < 16; ++r) ps += p0[r]; for (int r = 0; r < 16; ++r) ps += p1[r];
    { auto rr = __builtin_amdgcn_permlane32_swap(__float_as_uint(ps), __float_as_uint(ps), false, false);
      ps = __uint_as_float(rr[0]) + __uint_as_float(rr[1]); }
    l_reg = l_reg * alpha + ps;
#define PK4(P, B_, OUT) do { unsigned a0 = cvtpk(P[B_+0], P[B_+1]), a1 = cvtpk(P[B_+2], P[B_+3]);                          \
        unsigned b0 = cvtpk(P[B_+4], P[B_+5]), b1 = cvtpk(P[B_+6], P[B_+7]);                                             \
        auto r0 = __builtin_amdgcn_permlane32_swap(a0, b0, false, false); auto r1 = __builtin_amdgcn_permlane32_swap(a1, b1, false, false); \
        u32x4 w = {r0[0], r1[0], r0[1], r1[1]}; OUT = *reinterpret_cast<bf16x8*>(&w); } while (0)
    PK4(p0, 0, pa0); PK4(p0, 8, pa1); PK4(p1, 0, pa2); PK4(p1, 8, pa3);
#undef PK4
}
template <int KB, bool SK>
__device__ __forceinline__ void qkt(f32x16& p0, f32x16& p1, const char* K_lds, const float* cb, int r32, int hi, const bf16x8* qr, bool act) {
    if (SK && !act) { const float NEG = -__builtin_inff();
#pragma unroll
        for (int r = 0; r < 16; ++r) { p0[r] = NEG; p1[r] = NEG; } return; }
    { const float* cbp = cb + KB * 64 + 4 * hi;
#pragma unroll
      for (int g = 0; g < 4; ++g) { const f32x4 t0 = *(const f32x4*)(cbp + 8 * g), t1 = *(const f32x4*)(cbp + 32 + 8 * g);
        p0[4*g] = t0[0]; p0[4*g+1] = t0[1]; p0[4*g+2] = t0[2]; p0[4*g+3] = t0[3]; p1[4*g] = t1[0]; p1[4*g+1] = t1[1]; p1[4*g+2] = t1[2]; p1[4*g+3] = t1[3]; } }
    const char* kb[4];
#pragma unroll
    for (int dd = 0; dd < 4; ++dd) kb[dd] = K_lds + KB * SHM_K + KSWZ(r32, (dd * 16 + hi * 8) * 2);
#pragma unroll
    for (int d0 = 0; d0 < 8; ++d0) { const char* a = kb[d0 & 3] + (d0 >> 2) * 128;
        bf16x8 b0 = *reinterpret_cast<const bf16x8*>(a);
        bf16x8 b1 = *reinterpret_cast<const bf16x8*>(a + 32 * 256);
        p0 = __builtin_amdgcn_mfma_f32_32x32x16_bf16(b0, qr[d0], p0, 0, 0, 0);
        p1 = __builtin_amdgcn_mfma_f32_32x32x16_bf16(b1, qr[d0], p1, 0, 0, 0); }
}
template <int VB, bool SK>
__device__ __forceinline__ void pv_tile(f32x16* o, int vb0, bf16x8 pa0, bf16x8 pa1, bf16x8 pa2, bf16x8 pa3, bool act) {
    if (SK && !act) return;
#define TRRD(dst, off) asm volatile("ds_read_b64_tr_b16 %0, %1 offset:%2" : "=&v"(dst) : "v"(vb0), "i"(off) : "memory")
#define PV_D0(d0) do { s16x4 l0, l1, l2, l3, h0, h1, h2, h3; constexpr int b_ = VB * SHM_V + v_rd_off(d0, 0, 0);     \
        TRRD(l0, b_); TRRD(h0, b_ + 2048); TRRD(l1, b_ + 4096); TRRD(h1, b_ + 6144); TRRD(l2, b_ + 8192); TRRD(h2, b_ + 10240); TRRD(l3, b_ + 12288); TRRD(h3, b_ + 14336); \
        asm volatile("s_waitcnt lgkmcnt(0)" ::: "memory"); SBAR();                 \
        o[d0] = __builtin_amdgcn_mfma_f32_32x32x16_bf16(pa0, (bf16x8){l0[0], l0[1], l0[2], l0[3], h0[0], h0[1], h0[2], h0[3]}, o[d0], 0, 0, 0);   \
        o[d0] = __builtin_amdgcn_mfma_f32_32x32x16_bf16(pa1, (bf16x8){l1[0], l1[1], l1[2], l1[3], h1[0], h1[1], h1[2], h1[3]}, o[d0], 0, 0, 0);   \
        o[d0] = __builtin_amdgcn_mfma_f32_32x32x16_bf16(pa2, (bf16x8){l2[0], l2[1], l2[2], l2[3], h2[0], h2[1], h2[2], h2[3]}, o[d0], 0, 0, 0);   \
        o[d0] = __builtin_amdgcn_mfma_f32_32x32x16_bf16(pa3, (bf16x8){l3[0], l3[1], l3[2], l3[3], h3[0], h3[1], h3[2], h3[3]}, o[d0], 0, 0, 0); } while (0)
    PV_D0(0); PV_D0(1); PV_D0(2); PV_D0(3);
#undef PV_D0
#undef TRRD
}

template <class TIn, class TOut> struct BlockRef { const TIn* Q; TOut* O; const float* MS; unsigned K, V, C; int P0; int JLO; };
__device__ __forceinline__ bf16x8 bl128(__amdgpu_buffer_rsrc_t rs, unsigned vo, unsigned so) { return __builtin_bit_cast(bf16x8, __builtin_amdgcn_raw_buffer_load_b128(rs, (int)vo, (int)so, 0)); }
__device__ __forceinline__ float bl32(__amdgpu_buffer_rsrc_t rs, unsigned vo, unsigned so) { return __builtin_bit_cast(float, __builtin_amdgcn_raw_buffer_load_b32(rs, (int)vo, (int)so, 0)); }
template <class TIn> struct Seam {
    bf16x8 qr[8];
    bf16x8 st_v0, st_v1, st_k0, st_k1; f32x4 sf0, sf1, sf2, sf3; float st_c;
    f32x4 tq[16];
};
__device__ __forceinline__ int swa_jlo(int P0, int W) { const int lowk = P0 - W + 1; return lowk > 0 ? lowk / KVBLK : 0; }
#define ROW(p, k0, rr) ((p) + (unsigned)(((k0) + (rr)) * D + sc))
#define VMW() asm volatile("s_waitcnt vmcnt(0)" ::: "memory")
#define VMWN(n) asm volatile("s_waitcnt vmcnt(%0)" :: "i"(n) : "memory")
#define SLOAD_H(Kp, Vp, Cp, k0) do { if (tid < 64) S.st_c = bl32(rs, (unsigned)tid * 4u, (Cp) + (unsigned)(k0) * 4u); \
        S.st_v0 = bl128(rs, vo_st, (Vp) + (unsigned)(k0) * 256u); S.st_v1 = bl128(rs, vo_st, (Vp) + (unsigned)(k0) * 256u + 8192u); \
        S.st_k0 = bl128(rs, vo_st, (Kp) + (unsigned)(k0) * 256u); S.st_k1 = bl128(rs, vo_st, (Kp) + (unsigned)(k0) * 256u + 8192u); } while (0)
#define SWRITE_HK(bf) do { if (tid < 64) cb_l[(bf) * 64 + tid] = S.st_c;  *(bf16x8*)(K_lds + (bf) * SHM_K + kws) = S.st_k0; *(bf16x8*)(K_lds + (bf) * SHM_K + kws + 32 * 256) = S.st_k1; } while (0)
#define SWRITE_HV(bf) do { *(bf16x8*)(V_lds + (bf) * SHM_V + vst0) = S.st_v0; *(bf16x8*)(V_lds + (bf) * SHM_V + vst1) = S.st_v1; } while (0)
#define SWRITE_H(bf) do { SWRITE_HV(bf); SWRITE_HK(bf); } while (0)
#define SLOAD_F(p, k0) do { S.sf0 = *(const f32x4*)ROW(p, k0, sr); S.sf1 = *(const f32x4*)(ROW(p, k0, sr) + 4);                \
                            S.sf2 = *(const f32x4*)ROW(p, k0, 32 + sr); S.sf3 = *(const f32x4*)(ROW(p, k0, 32 + sr) + 4); } while (0)
#define SWRITE_KF(bf) do { *(bf16x8*)(K_lds + (bf) * SHM_K + kws) = pack8(S.sf0, S.sf1); *(bf16x8*)(K_lds + (bf) * SHM_K + kws + 32 * 256) = pack8(S.sf2, S.sf3); } while (0)
#define SWRITE_VF(bf) do { *(bf16x8*)(V_lds + (bf) * SHM_V + vst0) = pack8(S.sf0, S.sf1); *(bf16x8*)(V_lds + (bf) * SHM_V + vst1) = pack8(S.sf2, S.sf3); } while (0)
template <class TIn, class TOut>
__device__ __forceinline__ void causal_swa_prime(const BlockRef<TIn, TOut>& cur, int W, char* lds, Seam<TIn>& S, __amdgpu_buffer_rsrc_t rs) {
    constexpr bool F32 = same_t<TIn, float>::v;
    const int tid = lz_tid(), wid = __builtin_amdgcn_readfirstlane(tid >> 6), lane = tid & 63, r32 = lane & 31, hi = lane >> 5;
    const int sr = tid >> 4, sc = (tid & 15) * 8, kws = KSWZ(sr, sc * 2); char* K_lds = lds + 2 * SHM_V; float* cb_l = (float*)(lds + LDS_CB); const unsigned vo_st = (unsigned)(sr * D + sc) * 2u;
    const int kb0 = swa_jlo(cur.P0, W) * KVBLK;
    for (int d0 = 0; d0 < 8; ++d0) S.qr[d0] = load8<TIn>(cur.Q + (unsigned)((wid * QBLK + r32) * D + d0 * 16 + hi * 8));
    if constexpr (F32) { SLOAD_F((const float*)cur.K, kb0); VMW(); SWRITE_KF(0); SBAR(); SLOAD_F((const float*)cur.V, kb0); }
    else { SLOAD_H(cur.K, cur.V, cur.C, kb0); VMW(); SWRITE_HK(0); }
    __syncthreads();
}
template <class TIn, class TOut>
__device__ __forceinline__ void causal_swa_block(const BlockRef<TIn, TOut>& cur, const BlockRef<TIn, TOut>& nxt, int skv, int W, char* lds, Seam<TIn>& S, __amdgpu_buffer_rsrc_t rs) {
    constexpr bool F32 = same_t<TIn, float>::v;
    const int tid = lz_tid(), wid = __builtin_amdgcn_readfirstlane(tid >> 6), lane = tid & 63, r32 = lane & 31, hi = lane >> 5;
    const int j_lo = swa_jlo(cur.P0, W);
    int j_hi = (cur.P0 + QB - 1) / KVBLK + 1; if (j_hi > skv / KVBLK) j_hi = skv / KVBLK;
    const int NT = j_hi - j_lo;
    const int kbn = swa_jlo(nxt.P0, W) * KVBLK;
    const int qlo = cur.P0 + wid * QBLK, qm = qlo + r32 - 4 * hi;
    char* V_lds = lds; char* K_lds = lds + 2 * SHM_V; float* cb_l = (float*)(lds + LDS_CB);
    float* ws = (float*)(lds + 2 * SHM_V + 2 * SHM_K) + wid * 64; float* li_l = ws, * al_l = ws + 32;
    float m_reg = -1e30f, l_reg = 0; f32x16 o[4] = {};
    const unsigned vo_st = (unsigned)((tid >> 4) * D + (tid & 15) * 8) * 2u; const int sr = tid >> 4, sc = (tid & 15) * 8, vst0 = v_st(sr, sc), vst1 = v_st(32 + sr, sc), kws = KSWZ(sr, sc * 2);
    const int vb0 = (int)(uintptr_t)V_lds + v_rd_base(lane);
    const unsigned Kh = cur.K, Vh = cur.V, Ch = cur.C;
#define RESC(a) do { if (__any((a) < 1.f)) { if (hi == 0) al_l[r32] = (a); asm volatile("s_waitcnt lgkmcnt(0)" ::: "memory");              \
                     for (int d_ = 0; d_ < 4; ++d_) for (int r = 0; r < 16; ++r) o[d_][r] *= al_l[crow(r, hi)]; } } while (0)
#define KBASE(t) ((j_lo + (t)) * KVBLK)
#define ACT(t) (KBASE(t) <= qlo + QBLK - 1 && KBASE(t) + KVBLK - 1 >= qlo - W + 1)
#define MASKT(P0_, P1_, t) do { const int kb_ = KBASE(t); if ((!SK || ACT(t)) && (kb_ + KVBLK - 1 > qlo || kb_ <= qlo + QBLK - 1 - W)) mask_tile(P0_, P1_, qm - kb_, (unsigned)W); } while (0)
    constexpr int NQL = F32 ? 16 : 8;
    constexpr bool SK = WSKIP && !F32;
#define SEAM_K0() do { VMWN(NQL); if constexpr (F32) { SWRITE_KF(0); SBAR(); SLOAD_F((const float*)nxt.V, kbn); } else { SWRITE_HK(0); } SBAR(); } while (0)
    f32x16 pA0, pA1, pB0, pB1; float mnA, mnB, alA, alB; bf16x8 pa0, pa1, pa2, pa3;
    if constexpr (F32) { VMW(); SWRITE_VF(0); SBAR(); } else { SWRITE_HV(0); SBAR(); }
    if (NT > 1) { if constexpr (F32) SLOAD_F((const float*)Kh, KBASE(1)); else SLOAD_H(Kh, Vh, Ch, KBASE(1)); }
    SBAR(); qkt<0, SK>(pA0, pA1, K_lds, cb_l, r32, hi, S.qr, ACT(0));
    if constexpr (F32) { if (NT > 1) { VMW(); SWRITE_KF(1); SBAR(); SLOAD_F((const float*)Vh, KBASE(1)); } }
    MASKT(pA0, pA1, 0); partialSM(pA0, pA1, m_reg, mnA, alA);
    if (NT > 1) { VMW(); if constexpr (F32) { SWRITE_VF(1); SBAR(); if (NT > 2) SLOAD_F((const float*)Kh, KBASE(2)); } else SWRITE_H(1); }
    __syncthreads();
#define HALF_STEP(PX0, PX1, mnX, alX, PY0, PY1, alY, t, KB, VB, SB) do {                                                      \
        SBAR(); qkt<KB, SK>(PX0, PX1, K_lds, cb_l, r32, hi, S.qr, ACT(t));                                             \
        finishSM(PY0, PY1, alY, l_reg, pa0, pa1, pa2, pa3); SBAR();                                                           \
        if ((t) + 1 < NT) { if constexpr (F32) { VMW(); SWRITE_KF(SB); SBAR(); SLOAD_F((const float*)Vh, KBASE((t) + 1)); }  \
                            else { SLOAD_H(Kh, Vh, Ch, KBASE((t) + 1)); } SBAR(); }                                               \
        pv_tile<VB, SK>(o, vb0, pa0, pa1, pa2, pa3, ACT((t) - 1)); MASKT(PX0, PX1, (t)); partialSM(PX0, PX1, m_reg, mnX, alX);                                        \
        __syncthreads();                                                                                                      \
        if ((t) + 1 < NT) { VMW(); if constexpr (F32) { SWRITE_VF(SB); SBAR(); if ((t) + 2 < NT) SLOAD_F((const float*)Kh, KBASE((t) + 2)); } \
                            else { SWRITE_H(SB); } }                                                                          \
        RESC(alX); __syncthreads(); } while (0)
    for (int t = 1; t + 1 < NT; t += 2) {
        HALF_STEP(pB0, pB1, mnB, alB, pA0, pA1, alA, t, 1, 0, 0);
        HALF_STEP(pA0, pA1, mnA, alA, pB0, pB1, alB, t + 1, 0, 1, 1);
    }
    const bool even = (NT & 1) == 0;
    if (even) { SBAR(); qkt<1, SK>(pB0, pB1, K_lds, cb_l, r32, hi, S.qr, ACT(NT - 1)); SBAR(); }
#define QROW(e) (nxt.Q + (size_t)(wid * QBLK + r32) * D + ((e) >> 1) * 16 + hi * 8 + ((e) & 1) * 4)
    if constexpr (F32) { SLOAD_F((const float*)nxt.K, kbn); SBAR();
#pragma unroll
        for (int e = 0; e < 8; ++e) S.tq[e] = *(const f32x4*)QROW(e); }
    else { SLOAD_H(nxt.K, nxt.V, nxt.C, kbn); SBAR();
#pragma unroll
        for (int d0 = 0; d0 < 8; ++d0) S.qr[d0] = load8<TIn>(nxt.Q + (unsigned)((wid * QBLK + r32) * D + d0 * 16 + hi * 8)); }
    SBAR();
    finishSM(pA0, pA1, alA, l_reg, pa0, pa1, pa2, pa3); SBAR();
    if constexpr (F32) {
#pragma unroll
        for (int e = 8; e < 16; ++e) S.tq[e] = *(const f32x4*)QROW(e); SBAR(); }
#undef QROW
    pv_tile<0, SK>(o, vb0, pa0, pa1, pa2, pa3, ACT(even ? NT - 2 : NT - 1));
    if (even) { MASKT(pB0, pB1, NT - 1); partialSM(pB0, pB1, m_reg, mnB, alB); __syncthreads(); RESC(alB);
        finishSM(pB0, pB1, alB, l_reg, pa0, pa1, pa2, pa3); SBAR(); pv_tile<1, SK>(o, vb0, pa0, pa1, pa2, pa3, ACT(NT - 1)); }
    SBAR(); SEAM_K0();
    if (hi == 0) li_l[r32] = l_reg; asm volatile("s_waitcnt lgkmcnt(0)" ::: "memory");
    float rli[16];
#pragma unroll
    for (int r = 0; r < 16; ++r) rli[r] = __builtin_amdgcn_rcpf(li_l[crow(r, hi)]);
    TOut* Ow = cur.O + (size_t)(wid * QBLK) * OSTR;
    { float msv[4];
#pragma unroll
      for (int d0 = 0; d0 < 4; ++d0) msv[d0] = cur.MS[d0 * 32 + r32];
#pragma unroll
      for (int r = 0; r < 16; ++r) { const int orow = crow(r, hi);
        float v0 = o[0][r] * rli[r], v1 = o[1][r] * rli[r], v2 = o[2][r] * rli[r], v3 = o[3][r] * rli[r];
        float sm = (v0 + v1) + (v2 + v3);
#pragma unroll
        for (int off = 1; off < 32; off <<= 1) sm += __shfl_xor(sm, off);
        const float mu = sm * (1.0f / 128.0f);
        v0 -= mu; v1 -= mu; v2 -= mu; v3 -= mu;
        float sq = (v0 * v0 + v1 * v1) + (v2 * v2 + v3 * v3);
#pragma unroll
        for (int off = 1; off < 32; off <<= 1) sq += __shfl_xor(sq, off);
        const float rstd = 1.0f / sqrtf(sq * (1.0f / 128.0f) + 1e-6f);
        float vv[4] = {v0 * rstd * msv[0], v1 * rstd * msv[1], v2 * rstd * msv[2], v3 * rstd * msv[3]};
#pragma unroll
        for (int d0 = 0; d0 < 4; ++d0) { const float v = vv[d0]; const float vn = __shfl_xor(v, 1);
            if ((r32 & 1) == 0) *(unsigned*)(Ow + (unsigned)(orow * OSTR + d0 * 32 + r32)) = cvtpk(v, vn); } } }
    if constexpr (F32) {
#pragma unroll
        for (int d0 = 0; d0 < 8; ++d0) S.qr[d0] = pack8(S.tq[2 * d0], S.tq[2 * d0 + 1]); }
    __syncthreads();
#undef RESC
#undef KBASE
#undef ACT
#undef MASKT
#undef SEAM_K0
#undef HALF_STEP
}
#undef ROW
#undef VMW
#undef VMWN
#undef SLOAD_H
#undef SWRITE_HK
#undef SWRITE_HV
#undef SWRITE_H
#undef SLOAD_F
#undef SWRITE_KF
#undef SWRITE_VF
#undef SBAR
}

#define LAS __attribute__((address_space(3)))
typedef unsigned short bf16r;
typedef unsigned v4u __attribute__((ext_vector_type(4)));
typedef unsigned v2u __attribute__((ext_vector_type(2)));
typedef float v4f __attribute__((ext_vector_type(4)));
typedef float v16f __attribute__((ext_vector_type(16)));
typedef short v8s __attribute__((ext_vector_type(8)));
typedef short v4s __attribute__((ext_vector_type(4)));

#define XB_TMO      128
#define XB_XCNT(j)  (256  + 64 * (j))
#define XB_XSUB(j)  (1280 + 64 * (j))
#define XB_XGEN(j)  (2304 + 64 * (j))
#define XB_TOP      3328
#define XB_TOPGEN   3392
#define XCD_BAR_WORDS 3456
#define XB_SPIN_CAP (1u << 18)

__device__ __forceinline__ unsigned xb_ld(unsigned* p)              { return __hip_atomic_load(p, __ATOMIC_RELAXED, __HIP_MEMORY_SCOPE_AGENT); }
__device__ __forceinline__ unsigned xb_add(unsigned* p, unsigned v) { return __hip_atomic_fetch_add(p, v, __ATOMIC_RELAXED, __HIP_MEMORY_SCOPE_AGENT); }
__device__ __forceinline__ unsigned xb_xcc_id() { return (unsigned)__builtin_amdgcn_s_getreg((3 << 11) | 20) & 0xFu; }
#define XB_SPIN(cond, bar) do { unsigned _sp = 0; while (cond) { __builtin_amdgcn_s_sleep(1); \
    if ((++_sp & 255u) == 0u) { if (xb_ld(&(bar)[XB_TMO])) break; if (_sp > XB_SPIN_CAP) { atomicAdd(&(bar)[XB_TMO], 1u); break; } } } } while (0)

struct XcdBarrier {
    unsigned* bar; unsigned x;
    volatile LAS unsigned* st;
};

__device__ __forceinline__ XcdBarrier xcd_barrier_post(unsigned* bar, volatile LAS unsigned* st) {
    XcdBarrier b; b.bar = bar; b.x = xb_xcc_id(); b.st = st;
    if (lz_tid() == 0) (void)xb_add(&bar[XB_XCNT(b.x)], 1u);
    return b;
}
__device__ __forceinline__ void xcd_barrier_complete(unsigned* bar, unsigned x, unsigned& nloc, unsigned& nx) {
    const unsigned G = gridDim.x * gridDim.y * gridDim.z;
    unsigned sum, cnt, mine, sp = 0u;
    for (;;) {
        sum = 0u; cnt = 0u; mine = 0u;
#pragma unroll
        for (unsigned j = 0; j < 16; ++j) { const unsigned c = xb_ld(&bar[XB_XCNT(j)]); sum += c; cnt += (c > 0u) ? 1u : 0u; mine = (j == x) ? c : mine; }
        if (sum == G) break;
        __builtin_amdgcn_s_sleep(1);
        if ((++sp & 255u) == 0u) { if (xb_ld(&bar[XB_TMO])) break; if (sp > XB_SPIN_CAP) { atomicAdd(&bar[XB_TMO], 1u); break; } }
    }
    nloc = mine > 0u ? mine : 1u; nx = cnt > 0u ? cnt : 1u;
}

__device__ __forceinline__ void xcd_barrier(const XcdBarrier& b) {
    asm volatile("s_waitcnt vmcnt(0)" ::: "memory");
    __syncthreads();
    if (lz_tid() == 0) {
        unsigned* bar = b.bar;
        __builtin_amdgcn_s_waitcnt(0);
        unsigned nloc = b.st[0], nx = b.st[1];
        if (nloc == 0u) { xcd_barrier_complete(bar, b.x, nloc, nx); b.st[0] = nloc; b.st[1] = nx; }
        const unsigned old = xb_add(&bar[XB_XSUB(b.x)], 1u);
        const unsigned gen = old / nloc;
        if (old + 1u == (gen + 1u) * nloc) {
            __builtin_amdgcn_fence(__ATOMIC_RELEASE, "agent");
            asm volatile("s_waitcnt vmcnt(0)" ::: "memory");
            const unsigned og = xb_add(&bar[XB_TOP], 1u);
            const unsigned tg = og / nx;
            if (og + 1u == (tg + 1u) * nx) xb_add(&bar[XB_TOPGEN], 1u);
            else XB_SPIN(xb_ld(&bar[XB_TOPGEN]) == tg, bar);
            __builtin_amdgcn_fence(__ATOMIC_ACQUIRE, "agent");
            xb_add(&bar[XB_XGEN(b.x)], 1u);
            asm volatile("s_waitcnt vmcnt(0)" ::: "memory");
        } else {
            XB_SPIN(xb_ld(&bar[XB_XGEN(b.x)]) == gen, bar);
            __builtin_amdgcn_fence(__ATOMIC_ACQUIRE, "agent");
            asm volatile("s_waitcnt vmcnt(0)" ::: "memory");
        }
    }
    __syncthreads();
}

constexpr size_t MiB = 1u << 20;
constexpr size_t WS_QK2 = 14336, WS_QCTR = 15360;
constexpr size_t WS_JT = 20480;
constexpr size_t WS_WG = 1 * MiB, WG_BYTES = 32 * DM * 2;
constexpr size_t WS_MOD = 64 * 1024;
constexpr size_t WS_WIN = 2 * MiB, WIN_BYTES = (size_t)NINP * DM * 2;
constexpr size_t WS_WOUT = 60 * MiB, WOUT_BYTES = (size_t)DM * DM * 2;
constexpr size_t WS_WFF1 = 76 * MiB, WFF_BYTES = (size_t)DFF * DM * 2;
constexpr size_t WS_WFF2 = 140 * MiB;
constexpr size_t WS_H = 204 * MiB;
constexpr size_t WS_P = 332 * MiB;
constexpr size_t WS_Y = 780 * MiB;
constexpr size_t WS_HID = WS_P;
constexpr size_t WS_GATES = 908 * MiB;
constexpr size_t WS_CNEG = 910 * MiB;
constexpr size_t WS_MA = 911 * MiB, WS_MCM = WS_MA + 512 * 1024, WS_MB = WS_MCM + 512 * 1024;
constexpr size_t WS_MPREV = 913 * MiB;
constexpr size_t WS_UN = 914 * MiB;
constexpr size_t WS_MQC = 916 * MiB;
constexpr size_t WS_END = 980 * MiB;
static_assert(WS_WIN + 2 * WIN_BYTES <= WS_WOUT && WS_HID + (size_t)MROWS * DFF * 2 <= WS_Y + (size_t)MROWS * DM * 2 && WS_MQC + (size_t)8 * MROWS * 128 * 2 <= WS_END, "ws map");

constexpr int LDS_BYTES = 147456;

__device__ __forceinline__ float wave_sum(float v) {
#pragma unroll
    for (int o = 1; o < 64; o <<= 1) v += __shfl_xor(v, o);
    return v;
}
typedef float pkf2_t __attribute__((ext_vector_type(2))); typedef __bf16 pkb2_t __attribute__((ext_vector_type(2)));
__device__ __forceinline__ unsigned pk2(float lo, float hi) { pkf2_t v = {lo, hi}; pkb2_t b = __builtin_convertvector(v, pkb2_t); return __builtin_bit_cast(unsigned, b); }
__device__ __forceinline__ float bflo(unsigned w) { return __uint_as_float(w << 16); }
__device__ __forceinline__ float bfhi(unsigned w) { return __uint_as_float(w & 0xffff0000u); }
__device__ __forceinline__ float bf1(bf16r h) { return __uint_as_float((unsigned)h << 16); }
__device__ __forceinline__ float log_sigmoid(float x) { return fminf(x, 0.f) - log1pf(expf(-fabsf(x))); }
__device__ __forceinline__ float swap_add(float v) { auto rr = __builtin_amdgcn_permlane32_swap(__float_as_uint(v), __float_as_uint(v), false, false); return __uint_as_float(rr[0]) + __uint_as_float(rr[1]); }

struct Args { const void* in[18]; float* out; unsigned char* ws; int ph_lo, ph_hi; };
typedef const __attribute__((address_space(4))) Args CArgs;
__device__ __forceinline__ CArgs* fresh_args() { CArgs* p = (CArgs*)__builtin_amdgcn_kernarg_segment_ptr(); asm volatile("" : "+s"(p)); return p; }

__device__ __forceinline__ int win_src(int n) { return n < 5120 ? n : n + 8; }
__device__ __forceinline__ int wg_src(int n) { return n < 8 ? 5120 + n : (n < 16 ? 7176 + (n - 8) : -1); }
template <int MAP>
__device__ __forceinline__ void transpose_item(const float* W, int K, int N, bf16r* WT, LAS float* scr, int item, int nblk, int lane) {
    const int kb = item / nblk, nb = item % nblk, k0 = 64 * kb, n0 = 32 * nb;
    int sc = n0 + (lane & 31); if (MAP == 1) sc = win_src(sc); else if (MAP == 2) sc = wg_src(sc);
#ifdef OLD_P0
#pragma unroll 8
    for (int i = 0; i < 32; ++i) { const int kk = 2 * i + (lane >> 5); scr[kk * 33 + (lane & 31)] = sc >= 0 ? W[(size_t)(k0 + kk) * N + sc] : 0.f; }
#else
    float tv[32];
#pragma unroll
    for (int i = 0; i < 32; ++i) { const int kk = 2 * i + (lane >> 5); tv[i] = sc >= 0 ? W[(size_t)(k0 + kk) * N + sc] : 0.f; }
#pragma unroll
    for (int i = 0; i < 32; ++i) { const int kk = 2 * i + (lane >> 5); scr[kk * 33 + (lane & 31)] = tv[i]; }
#endif
    asm volatile("s_waitcnt lgkmcnt(0)" ::: "memory");
    const int c = lane & 7;
#pragma unroll
    for (int j = 0; j < 4; ++j) { const int n = (lane >> 3) + 8 * j; const LAS float* s = scr + (8 * c) * 33 + n;
        v4u o; o.x = pk2(s[0 * 33], s[1 * 33]); o.y = pk2(s[2 * 33], s[3 * 33]); o.z = pk2(s[4 * 33], s[5 * 33]); o.w = pk2(s[6 * 33], s[7 * 33]);
        *(v4u*)(WT + (size_t)(n0 + n) * K + k0 + 8 * c) = o; }
    asm volatile("s_waitcnt lgkmcnt(0)" ::: "memory");
}
__device__ __forceinline__ void p0_phase(CArgs& a, LAS unsigned char* lds) {
    const int tid = lz_tid(), lane = tid & 63, wave = tid >> 6, G = gridDim.x;
    unsigned char* ws = a.ws;
    { LAS float* cond = (LAS float*)lds; LAS float* red = (LAS float*)(lds + 16384);
      const float* c = (const float*)a.in[1]; const float* ada_w = (const float*)a.in[3]; const float* ada_b = (const float*)a.in[4]; float* MOD = (float*)(ws + WS_MOD);
      for (int i = tid; i < NB * DM; i += 512) { const float cv = c[i]; cond[i] = cv / (1.f + expf(-cv)); }
      __syncthreads();
      for (int item = lz_bid(); item < 2 * (NMOD / 64); item += G) {
          const int layer = item / (NMOD / 64), cgp = item % (NMOD / 64), col = cgp * 64 + lane, kq = wave;
          const float* W = ada_w + (size_t)layer * DM * NMOD + col;
          float a0 = 0.f, a1 = 0.f;
#ifdef OLD_P0
#pragma unroll 8
#else
#pragma unroll 32
#endif
          for (int k = kq * 256; k < kq * 256 + 256; ++k) { const float w = W[(size_t)k * NMOD]; a0 += cond[k] * w; a1 += cond[DM + k] * w; }
          red[(kq * 2 + 0) * 64 + lane] = a0; red[(kq * 2 + 1) * 64 + lane] = a1;
          __syncthreads();
          if (tid < 128) { const int b = tid >> 6; float s = 0.f;
#pragma unroll
              for (int q = 0; q < 8; ++q) s += red[(q * 2 + b) * 64 + lane];
              MOD[(size_t)(layer * NB + b) * NMOD + cgp * 64 + lane] = s + ada_b[(size_t)layer * NMOD + cgp * 64 + lane]; }
          __syncthreads();
      } }
    { LAS float* scr = (LAS float*)(lds + wave * 16384);
      const int gw = lz_bid() * 8 + wave, NGW = G * 8;
      constexpr int I_IN = (DM / 64) * (NINP / 32), I_OUT = (DM / 64) * (DM / 32), I_F1 = (DM / 64) * (DFF / 32), I_F2 = (DFF / 64) * (DM / 32), I_G = DM / 64, I_L = I_IN + I_OUT + I_F1 + I_F2 + I_G;
      for (int it = gw; it < 2 * I_L; it += NGW) {
          const int layer = it / I_L; int r = it % I_L;
          if (r < I_IN) { transpose_item<1>((const float*)a.in[7] + (size_t)layer * DM * DIN, DM, DIN, (bf16r*)(ws + WS_WIN + layer * WIN_BYTES), scr, r, NINP / 32, lane); continue; } r -= I_IN;
          if (r < I_G) { transpose_item<2>((const float*)a.in[7] + (size_t)layer * DM * DIN, DM, DIN, (bf16r*)(ws + WS_WG + layer * WG_BYTES), scr, r, 1, lane); continue; } r -= I_G;
          if (r < I_OUT) { transpose_item<0>((const float*)a.in[14] + (size_t)layer * DM * DM, DM, DM, (bf16r*)(ws + WS_WOUT + layer * WOUT_BYTES), scr, r, DM / 32, lane); continue; } r -= I_OUT;
          if (r < I_F1) { transpose_item<0>((const float*)a.in[15] + (size_t)layer * DM * DFF, DM, DFF, (bf16r*)(ws + WS_WFF1 + layer * WFF_BYTES), scr, r, DFF / 32, lane); continue; } r -= I_F1;
          transpose_item<0>((const float*)a.in[16] + (size_t)layer * DFF * DM, DFF, DM, (bf16r*)(ws + WS_WFF2 + layer * WFF_BYTES), scr, r, DM / 32, lane);
      } }
}

__device__ __forceinline__ void gate_gemm(const bf16r* H, const bf16r* WG, float* gates) {
    const int tid = lz_tid(), lane = tid & 63, wave = __builtin_amdgcn_readfirstlane(tid >> 6), r32 = lane & 31, hi = lane >> 5;
    if (wave >= 4) return;
    for (int rb = lz_bid(); rb < MROWS / 128; rb += gridDim.x) {
        const int r0 = rb * 128 + wave * 32;
        const bf16r* ap = H + (size_t)(r0 + r32) * DM + 8 * hi; const bf16r* bp = WG + (size_t)r32 * DM + 8 * hi;
        v16f acc = {};
#pragma unroll 16
        for (int ks = 0; ks < DM / 16; ++ks) { const v8s af = *(const v8s*)(ap + ks * 16), bf = *(const v8s*)(bp + ks * 16); acc = __builtin_amdgcn_mfma_f32_32x32x16_bf16(af, bf, acc, 0, 0, 0); }
        if (r32 < 16) {
#pragma unroll
            for (int r = 0; r < 16; ++r) gates[(size_t)(r0 + (r & 3) + 8 * (r >> 2) + 4 * hi) * 16 + r32] = acc[r]; }
    }
}

__device__ __forceinline__ void norm_phase(const float* x, const float* w, const float* sh, const float* sc, bf16r* H) {
    const int lane = lz_tid() & 63, gw = lz_bid() * 8 + (lz_tid() >> 6), NGW = gridDim.x * 8;
    v4f nx[8];
    if (gw < MROWS) { const v4f* xr0 = (const v4f*)(x + (size_t)gw * DM) + lane;
#pragma unroll
        for (int j = 0; j < 8; ++j) nx[j] = xr0[64 * j]; }
    for (int m = gw; m < MROWS; m += NGW) {
        const int b = m / SEQ;
        v4f v[8]; float s = 0.f;
#pragma unroll
        for (int j = 0; j < 8; ++j) v[j] = nx[j];
        if (m + NGW < MROWS) { const v4f* xr1 = (const v4f*)(x + (size_t)(m + NGW) * DM) + lane;
#pragma unroll
            for (int j = 0; j < 8; ++j) nx[j] = xr1[64 * j]; }
#pragma unroll
        for (int j = 0; j < 8; ++j) s += (v[j].x * v[j].x + v[j].y * v[j].y) + (v[j].z * v[j].z + v[j].w * v[j].w);
        const float rstd = 1.0f / sqrtf(wave_sum(s) * (1.f / DM) + NORM_EPS);
        v2u* o = (v2u*)(H + (size_t)m * DM) + lane;
#pragma unroll
        for (int j = 0; j < 8; ++j) { const int c = 4 * lane + 256 * j;
            const v4f wv = *(const v4f*)(w + c), sv = *(const v4f*)(sc + (size_t)b * NMOD + c), hv = *(const v4f*)(sh + (size_t)b * NMOD + c);
            const v4f y = v[j] * rstd * wv * (sv + 1.0f) + hv;
            v2u p; p.x = pk2(y.x, y.y); p.y = pk2(y.z, y.w); o[64 * j] = p; }
    }
}
__device__ __forceinline__ void final_norm_phase(float* x, const float* w) {
    const int lane = lz_tid() & 63, gw = lz_bid() * 8 + (lz_tid() >> 6), NGW = gridDim.x * 8;
    v4f nx[8];
    if (gw < MROWS) { const v4f* xr0 = (const v4f*)(x + (size_t)gw * DM) + lane;
#pragma unroll
        for (int j = 0; j < 8; ++j) nx[j] = xr0[64 * j]; }
    for (int m = gw; m < MROWS; m += NGW) {
        v4f* xr = (v4f*)(x + (size_t)m * DM) + lane;
        v4f v[8]; float s = 0.f;
#pragma unroll
        for (int j = 0; j < 8; ++j) v[j] = nx[j];
        if (m + NGW < MROWS) { const v4f* xr1 = (const v4f*)(x + (size_t)(m + NGW) * DM) + lane;
#pragma unroll
            for (int j = 0; j < 8; ++j) nx[j] = xr1[64 * j]; }
#pragma unroll
        for (int j = 0; j < 8; ++j) s += (v[j].x * v[j].x + v[j].y * v[j].y) + (v[j].z * v[j].z + v[j].w * v[j].w);
        const float rstd = 1.0f / sqrtf(wave_sum(s) * (1.f / DM) + NORM_EPS);
#pragma unroll
        for (int j = 0; j < 8; ++j) { const v4f wv = *(const v4f*)(w + 4 * lane + 256 * j); xr[64 * j] = v[j] * rstd * wv; }
    }
}

__device__ __forceinline__ void fox_cumsum_item(CArgs& a, int layer, int item, LAS unsigned char* lds) {
    const int tid = lz_tid(), b = item >> 3, h = item & 7;
    const float* gates = (const float*)(a.ws + WS_GATES); float* cneg = (float*)(a.ws + WS_CNEG) + (size_t)item * SEQ;
    const float bias = ((const float*)a.in[10])[layer * 8 + h];
    LAS double* tot = (LAS double*)lds;
    double sum = 0.0;
    const float* gp = gates + ((size_t)b * SEQ + (size_t)tid * 32) * 16 + h;
#pragma unroll 4
    for (int i = 0; i < 32; ++i) sum += (double)log_sigmoid(gp[i * 16] + bias);
    tot[tid] = sum;
    __syncthreads();
    if (tid == 0) { double run = 0.0; for (int i = 0; i < 512; ++i) { const double t = tot[i]; tot[i] = run; run += t; } }
    __syncthreads();
    double run = tot[tid];
#pragma unroll 2
    for (int i = 0; i < 32; i += 4) { v4f o;
        run += (double)log_sigmoid(gp[(i + 0) * 16] + bias); o.x = (float)(-run * 11.313708498984761);
        run += (double)log_sigmoid(gp[(i + 1) * 16] + bias); o.y = (float)(-run * 11.313708498984761);
        run += (double)log_sigmoid(gp[(i + 2) * 16] + bias); o.z = (float)(-run * 11.313708498984761);
        run += (double)log_sigmoid(gp[(i + 3) * 16] + bias); o.w = (float)(-run * 11.313708498984761);
        *(v4f*)(cneg + tid * 32 + i) = o; }
    __syncthreads();
}
__device__ __forceinline__ void mlstm_scan_item(CArgs& a, int layer, int item, LAS unsigned char* lds) {
    const int tid = lz_tid(), lane = tid & 63, wave = tid >> 6, b = item >> 2, h = item & 3;
    const float* gates = (const float*)(a.ws + WS_GATES);
    float* MA = (float*)(a.ws + WS_MA) + (size_t)item * SEQ; float* MCM = (float*)(a.ws + WS_MCM) + (size_t)item * SEQ; float* MBv = (float*)(a.ws + WS_MB) + (size_t)item * SEQ;
    float* MPREV = (float*)(a.ws + WS_MPREV) + item * 256;
    const float ib = ((const float*)a.in[11])[layer * 4 + h], fb = ((const float*)a.in[12])[layer * 4 + h];
    LAS float* Bc = (LAS float*)lds; LAS float* Ac = Bc + 256;
#pragma unroll 4
    for (int c = wave; c < 256; c += 8) {
        const size_t m = (size_t)b * SEQ + c * 64 + lane;
        const float ig = gates[m * 16 + 8 + h] + ib, fg = gates[m * 16 + 12 + h] + fb;
        float bb = log_sigmoid(fg);
#pragma unroll
        for (int o = 1; o < 64; o <<= 1) { const float t = __shfl_up(bb, o); if (lane >= o) bb += t; }
        const float av = ig - bb; float cm = av;
#pragma unroll
        for (int o = 1; o < 64; o <<= 1) { const float t = __shfl_up(cm, o); if (lane >= o) cm = fmaxf(cm, t); }
        MA[c * 64 + lane] = av; MCM[c * 64 + lane] = cm; MBv[c * 64 + lane] = bb;
        if (lane == 63) { Bc[c] = bb; Ac[c] = cm; }
    }
    __syncthreads();
    if (tid == 0) { float mm = 0.f; for (int c = 0; c < 256; ++c) { MPREV[c] = mm; mm = Bc[c] + fmaxf(mm, Ac[c]); } }
    __syncthreads();
}
__device__ __forceinline__ void prep_phase(CArgs& a, int layer, LAS unsigned char* lds) {
    const int tid = lz_tid(), bid = lz_bid(), G = gridDim.x;
    if (bid < 16) { fox_cumsum_item(a, layer, bid, lds); return; }
    if (bid < 24) { mlstm_scan_item(a, layer, bid - 16, lds); return; }
    const int wk = bid - 24, NWK = G - 24;
    bf16r* P = (bf16r*)(a.ws + WS_P);
    { const int jg = tid & 7; double invf[8];
#pragma unroll
      for (int i = 0; i < 8; ++i) { double r = 1.0, bs = 0.8659643233600653; int e = 8 * jg + i;
#pragma unroll
          for (int q = 0; q < 6; ++q) { if (e & 1) r *= bs; bs *= bs; e >>= 1; }
          invf[i] = r * 0.15915494309189535; }
      const int* positions = (const int*)a.in[2];
      for (int it0 = wk; it0 < 8 * MROWS / 64; it0 += 4 * NWK) {
          v4u A[4], Bv[4]; bf16r* pp[4]; int mm[4], sl[4];
#pragma unroll
          for (int q = 0; q < 4; ++q) { const int it = it0 + q * NWK; const bool ok = it < 8 * MROWS / 64; const int grow = (ok ? it : wk) * 64 + (tid >> 3); sl[q] = ok ? grow / MROWS : -1; mm[q] = grow % MROWS;
              pp[q] = P + ((size_t)(grow / MROWS) * MROWS + mm[q]) * 128 + 8 * jg; A[q] = *(const v4u*)pp[q]; Bv[q] = *(const v4u*)(pp[q] + 64); }
#pragma unroll
          for (int q = 0; q < 4; ++q) { if (sl[q] < 0) continue;
              const double pos = (double)positions[mm[q]]; const float sc = sl[q] >= 4 ? KSCALE : 1.0f;
              float t1[8] = {bflo(A[q].x), bfhi(A[q].x), bflo(A[q].y), bfhi(A[q].y), bflo(A[q].z), bfhi(A[q].z), bflo(A[q].w), bfhi(A[q].w)};
              float t2[8] = {bflo(Bv[q].x), bfhi(Bv[q].x), bflo(Bv[q].y), bfhi(Bv[q].y), bflo(Bv[q].z), bfhi(Bv[q].z), bflo(Bv[q].w), bfhi(Bv[q].w)};
              float o1[8], o2[8];
#pragma unroll
              for (int i = 0; i < 8; ++i) { const double rev = pos * invf[i]; const float fr = (float)(rev - floor(rev));
                  const float sn = __builtin_amdgcn_sinf(fr) * sc, cs = __builtin_amdgcn_cosf(fr) * sc;
                  o1[i] = t1[i] * cs - t2[i] * sn; o2[i] = t2[i] * cs + t1[i] * sn; }
              v4u oa, ob; oa.x = pk2(o1[0], o1[1]); oa.y = pk2(o1[2], o1[3]); oa.z = pk2(o1[4], o1[5]); oa.w = pk2(o1[6], o1[7]);
              ob.x = pk2(o2[0], o2[1]); ob.y = pk2(o2[2], o2[3]); ob.z = pk2(o2[4], o2[5]); ob.w = pk2(o2[6], o2[7]);
              *(v4u*)pp[q] = oa; *(v4u*)(pp[q] + 64) = ob; }
      } }
    { const int slot = wk % 8, sub = wk / 8, nsub = (NWK - slot + 7) / 8, cgp = tid & 15;
      const float* cw = (const float*)a.in[8] + (size_t)layer * 4 * 1024 + slot * 128 + 8 * cgp; const float* cbv = (const float*)a.in[9] + (size_t)layer * 1024 + slot * 128 + 8 * cgp;
      float w[4][8], bsv[8];
#pragma unroll
      for (int j = 0; j < 4; ++j)
#pragma unroll
          for (int i = 0; i < 8; ++i) w[j][i] = cw[j * 1024 + i];
#pragma unroll
      for (int i = 0; i < 8; ++i) bsv[i] = cbv[i];
      const bf16r* __restrict__ src = P + (size_t)(40 + slot) * MROWS * 128 + 8 * cgp; bf16r* __restrict__ dst = (bf16r*)(a.ws + WS_MQC) + (size_t)slot * MROWS * 128 + 8 * cgp;
      const float sc = slot >= 4 ? KSCALE : 1.0f;
#pragma unroll 2
      for (int rb = sub; rb < MROWS / 32; rb += nsub) {
          const int row = rb * 32 + (tid >> 4), s = row % SEQ;
          float acc[8];
#pragma unroll
          for (int i = 0; i < 8; ++i) acc[i] = bsv[i];
#pragma unroll
          for (int j = 0; j < 4; ++j) { if (s - 3 + j >= 0) { const v4u X = *(const v4u*)(src + (size_t)(row - 3 + j) * 128);
              acc[0] += w[j][0] * bflo(X.x); acc[1] += w[j][1] * bfhi(X.x); acc[2] += w[j][2] * bflo(X.y); acc[3] += w[j][3] * bfhi(X.y);
              acc[4] += w[j][4] * bflo(X.z); acc[5] += w[j][5] * bfhi(X.z); acc[6] += w[j][6] * bflo(X.w); acc[7] += w[j][7] * bfhi(X.w); } }
#pragma unroll
          for (int i = 0; i < 8; ++i) acc[i] = acc[i] / (1.f + expf(-acc[i])) * sc;
          v4u o; o.x = pk2(acc[0], acc[1]); o.y = pk2(acc[2], acc[3]); o.z = pk2(acc[4], acc[5]); o.w = pk2(acc[6], acc[7]);
          *(v4u*)(dst + (size_t)row * 128) = o;
      } }
    { const int slot = wk % 16, sub = wk / 16, nsub = (NWK - slot + 15) / 16, c16 = tid & 15;
      const bf16r* src = P + (size_t)(16 + slot) * MROWS * 128 + 8 * c16;
      float mx0 = 0.f, mx1 = 0.f;
#pragma unroll 8
      for (int rb = sub; rb < MROWS / 32; rb += nsub) {
          const int row = rb * 32 + (tid >> 4); const v4u X = *(const v4u*)(src + (size_t)row * 128);
          const float x0 = bflo(X.x), x1 = bfhi(X.x), x2 = bflo(X.y), x3 = bfhi(X.y), x4 = bflo(X.z), x5 = bfhi(X.z), x6 = bflo(X.w), x7 = bfhi(X.w);
          float s = (x0 * x0 + x1 * x1) + (x2 * x2 + x3 * x3) + (x4 * x4 + x5 * x5) + (x6 * x6 + x7 * x7);
          s += __shfl_xor(s, 1); s += __shfl_xor(s, 2); s += __shfl_xor(s, 4); s += __shfl_xor(s, 8);
          if (row < SEQ) mx0 = fmaxf(mx0, s); else mx1 = fmaxf(mx1, s);
      }
#pragma unroll
      for (int o = 1; o < 64; o <<= 1) { mx0 = fmaxf(mx0, __shfl_xor(mx0, o)); mx1 = fmaxf(mx1, __shfl_xor(mx1, o)); }
      if ((tid & 63) == 0) { unsigned* QK2 = (unsigned*)(a.ws + WS_QK2) + layer * 32;
          __hip_atomic_fetch_max(QK2 + slot, __float_as_uint(mx0 * 1.02f), __ATOMIC_RELAXED, __HIP_MEMORY_SCOPE_AGENT);
          __hip_atomic_fetch_max(QK2 + 16 + slot, __float_as_uint(mx1 * 1.02f), __ATOMIC_RELAXED, __HIP_MEMORY_SCOPE_AGENT); }
    }
}

__device__ __forceinline__ int cv_st(int k, int c) { const int kk = (k & ~0xC) | ((k & 4) << 1) | ((k & 8) >> 1); return ((kk >> 3) * 4 + (c >> 5)) * 512 + ((kk & 7) * 32 + (c & 31)) * 2; }
__device__ __forceinline__ int cv_rd_base(int lane) { return ((lane & 3) << 3) | (((lane >> 2) & 3) << 6) | (((lane >> 4) & 1) << 5) | (((lane >> 5) & 1) << 8); }
__device__ __forceinline__ int ccrow(int r, int hi) { return (r & 3) + 8 * (r >> 2) + 4 * hi; }
#define CFRAG(dst, vb, ks) do { v4s l_, h_; asm volatile("ds_read_b64_tr_b16 %0, %1 offset:%2" : "=&v"(l_) : "v"(vb), "i"((ks) * 4096) : "memory"); \
        asm volatile("ds_read_b64_tr_b16 %0, %1 offset:%2" : "=&v"(h_) : "v"(vb), "i"((ks) * 4096 + 2048) : "memory"); asm volatile("s_waitcnt lgkmcnt(0)" ::: "memory"); \
        dst = (v8s){l_[0], l_[1], l_[2], l_[3], h_[0], h_[1], h_[2], h_[3]}; } while (0)

struct ChunkItem { int mixer, bh, b, h, c, row0; };
__device__ __forceinline__ ChunkItem chunk_decode(int idx) { ChunkItem it; it.mixer = idx / 2048; const int rem = idx % 2048; it.bh = rem / 256; it.b = it.bh >> 2; it.h = it.bh & 3; it.c = rem % 256; it.row0 = it.b * SEQ + it.c * 64; return it; }
__device__ __forceinline__ float ret_lg(int h) { return log2f(1.0f - exp2f(-5.0f - (float)h)); }

__device__ __forceinline__ void m1_phase(CArgs& a, LAS unsigned char* lds) {
    const int tid = lz_tid(), lane = tid & 63, wave = __builtin_amdgcn_readfirstlane(tid >> 6), r32 = lane & 31, hi = lane >> 5;
    const bf16r* P = (const bf16r*)(a.ws + WS_P); const bf16r* MQC = (const bf16r*)(a.ws + WS_MQC); bf16r* US = (bf16r*)(a.ws + WS_H);
    LAS unsigned char* KT = lds; LAS unsigned char* VT = lds + 16384; LAS float* wt = (LAS float*)(lds + 32768); LAS float* red = (LAS float*)(lds + 33024);
    const int sr = tid >> 4, sc = (tid & 15) * 8;
    for (int idx = lz_bid(); idx < 4096; idx += gridDim.x) {
        const ChunkItem it = chunk_decode(idx);
        const bf16r* ksrc = (it.mixer == 0 ? P + (size_t)(4 + it.h) * MROWS * 128 : MQC + (size_t)(4 + it.h) * MROWS * 128) + (size_t)it.row0 * 128;
        const bf16r* vsrc = P + (size_t)((it.mixer == 0 ? 8 : 48) + it.h) * MROWS * 128 + (size_t)it.row0 * 128;
        if (tid < 64) { float w;
            if (it.mixer == 0) w = exp2f((float)(63 - tid) * ret_lg(it.h));
            else { const float* MA = (const float*)(a.ws + WS_MA) + (size_t)it.bh * SEQ + it.c * 64; const float* MCM = (const float*)(a.ws + WS_MCM) + (size_t)it.bh * SEQ + it.c * 64;
                   const float mp = ((const float*)(a.ws + WS_MPREV))[it.bh * 256 + it.c]; w = expf(MA[tid] - fmaxf(mp, MCM[63])); }
            wt[tid] = w; }
        const v4u k0 = *(const v4u*)(ksrc + (size_t)sr * 128 + sc), k1 = *(const v4u*)(ksrc + (size_t)(32 + sr) * 128 + sc);
        const v4u v0 = *(const v4u*)(vsrc + (size_t)sr * 128 + sc), v1 = *(const v4u*)(vsrc + (size_t)(32 + sr) * 128 + sc);
        __syncthreads();
        const float w0 = wt[sr], w1 = wt[32 + sr];
        float a0[8] = {bflo(k0.x) * w0, bfhi(k0.x) * w0, bflo(k0.y) * w0, bfhi(k0.y) * w0, bflo(k0.z) * w0, bfhi(k0.z) * w0, bflo(k0.w) * w0, bfhi(k0.w) * w0};
        float a1[8] = {bflo(k1.x) * w1, bfhi(k1.x) * w1, bflo(k1.y) * w1, bfhi(k1.y) * w1, bflo(k1.z) * w1, bfhi(k1.z) * w1, bflo(k1.w) * w1, bfhi(k1.w) * w1};
        { v4u o; o.x = pk2(a0[0], a0[1]); o.y = pk2(a0[2], a0[3]); o.z = pk2(a0[4], a0[5]); o.w = pk2(a0[6], a0[7]); *(LAS v4u*)(KT + cv_st(sr, sc)) = o;
          o.x = pk2(a1[0], a1[1]); o.y = pk2(a1[2], a1[3]); o.z = pk2(a1[4], a1[5]); o.w = pk2(a1[6], a1[7]); *(LAS v4u*)(KT + cv_st(32 + sr, sc)) = o;
          *(LAS v4u*)(VT + cv_st(sr, sc)) = v0; *(LAS v4u*)(VT + cv_st(32 + sr, sc)) = v1; }
        if (it.mixer == 1) {
#pragma unroll
            for (int i = 0; i < 8; ++i) { float s = a0[i] + a1[i]; s += __shfl_xor(s, 16); s += __shfl_xor(s, 32); if (lane < 16) red[wave * 128 + sc + i] = s; }
        }
        __syncthreads();
        if (it.mixer == 1 && tid < 128) { float s = 0.f;
#pragma unroll
            for (int q = 0; q < 8; ++q) s += red[q * 128 + tid];
            ((float*)(a.ws + WS_UN))[((size_t)it.bh * 256 + it.c) * 128 + tid] = s; }
        const int db = wave >> 1;
        const int kvb = (int)(uintptr_t)KT + cv_rd_base(lane) + db * 512;
        v8s kf[4]; CFRAG(kf[0], kvb, 0); CFRAG(kf[1], kvb, 1); CFRAG(kf[2], kvb, 2); CFRAG(kf[3], kvb, 3);
#pragma unroll
        for (int e2 = 0; e2 < 2; ++e2) { const int eb = (wave & 1) * 2 + e2; const int vvb = (int)(uintptr_t)VT + cv_rd_base(lane) + eb * 512;
            v8s vf[4]; CFRAG(vf[0], vvb, 0); CFRAG(vf[1], vvb, 1); CFRAG(vf[2], vvb, 2); CFRAG(vf[3], vvb, 3);
            v16f acc = {};
#pragma unroll
            for (int ks = 0; ks < 4; ++ks) acc = __builtin_amdgcn_mfma_f32_32x32x16_bf16(kf[ks], vf[ks], acc, 0, 0, 0);
            bf16r* dst = US + (size_t)idx * 16384 + (size_t)(eb * 32 + r32) * 128 + db * 32 + 4 * hi;
#pragma unroll
            for (int g = 0; g < 4; ++g) { v2u o; o.x = pk2(acc[4 * g], acc[4 * g + 1]); o.y = pk2(acc[4 * g + 2], acc[4 * g + 3]); *(v2u*)(dst + 8 * g) = o; } }
        __syncthreads();
    }
}

#ifndef M2U
#define M2U 64
#endif
__device__ __forceinline__ void m2_phase(CArgs& a, LAS unsigned char* lds) {
    const int tid = lz_tid();
    unsigned* US = (unsigned*)(a.ws + WS_H); LAS float* coef = (LAS float*)lds;
    const float* MCM = (const float*)(a.ws + WS_MCM); const float* MPREV = (const float*)(a.ws + WS_MPREV);
    for (int blk = lz_bid(); blk < 16 * 8192 / 512; blk += gridDim.x) {
        const int chain = blk / 16, mixer = chain >> 3, bh = chain & 7;
        __syncthreads();
        if (tid < 256) { float cf;
            if (mixer == 0) cf = exp2f(64.0f * ret_lg(bh & 3));
            else { const float mp = MPREV[bh * 256 + tid]; cf = expf(mp - fmaxf(mp, MCM[(size_t)bh * SEQ + tid * 64 + 63])); }
            coef[tid] = cf; }
        __syncthreads();
        unsigned* p = US + (size_t)chain * 256 * 8192 + (blk % 16) * 512 + tid;
        float s0 = 0.f, s1 = 0.f;
        for (int c = 0; c < 256; c += M2U) { unsigned u[M2U];
#pragma unroll
            for (int i = 0; i < M2U; ++i) u[i] = p[(size_t)(c + i) * 8192];
#pragma unroll
            for (int i = 0; i < M2U; ++i) { const float cf = coef[c + i]; p[(size_t)(c + i) * 8192] = pk2(s0, s1); s0 = s0 * cf + bflo(u[i]); s1 = s1 * cf + bfhi(u[i]); } }
    }
    float* UN = (float*)(a.ws + WS_UN);
    for (int bh = lz_bid(); bh < 8; bh += gridDim.x) {
        __syncthreads();
        if (tid < 256) { const float mp = MPREV[bh * 256 + tid]; coef[tid] = expf(mp - fmaxf(mp, MCM[(size_t)bh * SEQ + tid * 64 + 63])); }
        __syncthreads();
        if (tid < 128) { float* p = UN + (size_t)bh * 256 * 128 + tid; float s = 0.f;
            for (int c = 0; c < 256; c += 16) { float u[16];
#pragma unroll
                for (int i2 = 0; i2 < 16; ++i2) u[i2] = p[(c + i2) * 128];
#pragma unroll
                for (int i2 = 0; i2 < 16; ++i2) { p[(c + i2) * 128] = s; s = s * coef[c + i2] + u[i2]; } } }
    }
}

__device__ __forceinline__ void m3_phase(CArgs& a, int layer, LAS unsigned char* lds) {
    const int tid = lz_tid(), lane = tid & 63, wave = __builtin_amdgcn_readfirstlane(tid >> 6), r32 = lane & 31, hi = lane >> 5;
    const bf16r* P = (const bf16r*)(a.ws + WS_P); const bf16r* MQC = (const bf16r*)(a.ws + WS_MQC); const bf16r* US = (const bf16r*)(a.ws + WS_H);
    bf16r* Y = (bf16r*)(a.ws + WS_Y); const float* msc = (const float*)a.in[13] + (size_t)layer * DM;
    LAS unsigned char* VT = lds; LAS float* OT = (LAS float*)(lds + 16384);
    LAS float* sa = (LAS float*)(lds + 16384 + 64 * 132 * 4); LAS float* sg = sa + 64; LAS float* swi = sg + 64; LAS float* semq = swi + 64; LAS float* sn = semq + 64; LAS float* fw = sn + 128;
    const int sr = tid >> 4, sc = (tid & 15) * 8;
    const int lb = wave & 1, eb = wave >> 1, l = lb * 32 + r32;
    for (int idx = lz_bid(); idx < 4096; idx += gridDim.x) {
        const ChunkItem it = chunk_decode(idx);
        const bf16r* qsrc = (it.mixer == 0 ? P + (size_t)it.h * MROWS * 128 : MQC + (size_t)it.h * MROWS * 128) + (size_t)it.row0 * 128;
        const bf16r* ksrc = (it.mixer == 0 ? P + (size_t)(4 + it.h) * MROWS * 128 : MQC + (size_t)(4 + it.h) * MROWS * 128) + (size_t)it.row0 * 128;
        const bf16r* vsrc = P + (size_t)((it.mixer == 0 ? 8 : 48) + it.h) * MROWS * 128 + (size_t)it.row0 * 128;
        const bf16r* gsrc = P + (size_t)((it.mixer == 0 ? 12 : 52) + it.h) * MROWS * 128 + (size_t)it.row0 * 128;
        const bf16r* St = US + (size_t)idx * 16384;
        const float lg = ret_lg(it.h);
        if (it.mixer == 1) {
            if (tid < 64) { const size_t o = (size_t)it.bh * SEQ + it.c * 64 + tid; const float mp = ((const float*)(a.ws + WS_MPREV))[it.bh * 256 + it.c];
                const float av = ((const float*)(a.ws + WS_MA))[o], cm = ((const float*)(a.ws + WS_MCM))[o], bb = ((const float*)(a.ws + WS_MB))[o];
                const float g = fmaxf(mp, cm); sa[tid] = av; sg[tid] = g; swi[tid] = expf(mp - g); semq[tid] = expf(-(bb + g)); }
            else if (tid < 192) sn[tid - 64] = ((const float*)(a.ws + WS_UN))[((size_t)it.bh * 256 + it.c) * 128 + tid - 64];
        }
        { const v4u v0 = *(const v4u*)(vsrc + (size_t)sr * 128 + sc), v1 = *(const v4u*)(vsrc + (size_t)(32 + sr) * 128 + sc);
          *(LAS v4u*)(VT + cv_st(sr, sc)) = v0; *(LAS v4u*)(VT + cv_st(32 + sr, sc)) = v1; }
        v8s qr[8];
#pragma unroll
        for (int d0 = 0; d0 < 8; ++d0) qr[d0] = *(const v8s*)(qsrc + (size_t)l * 128 + d0 * 16 + hi * 8);
        __syncthreads();
        v16f p0 = {}, p1 = {};
#pragma unroll
        for (int d0 = 0; d0 < 8; ++d0) { const v8s kf = *(const v8s*)(ksrc + (size_t)r32 * 128 + d0 * 16 + hi * 8); p0 = __builtin_amdgcn_mfma_f32_32x32x16_bf16(kf, qr[d0], p0, 0, 0, 0); }
        if (lb == 1) {
#pragma unroll
            for (int d0 = 0; d0 < 8; ++d0) { const v8s kf = *(const v8s*)(ksrc + (size_t)(32 + r32) * 128 + d0 * 16 + hi * 8); p1 = __builtin_amdgcn_mfma_f32_32x32x16_bf16(kf, qr[d0], p1, 0, 0, 0); }
        }
        float rs = 0.f;
        int ll = l; asm volatile("" : "+v"(ll));
        if (it.mixer == 0) {
#pragma unroll
            for (int r = 0; r < 16; ++r) { const int m0 = ccrow(r, hi), m1 = m0 + 32;
                p0[r] = (m0 <= ll) ? p0[r] * __builtin_amdgcn_exp2f(fminf((float)(ll - m0) * lg, 0.f)) : 0.f; p1[r] = (m1 <= ll) ? p1[r] * __builtin_amdgcn_exp2f(fminf((float)(ll - m1) * lg, 0.f)) : 0.f; }
        } else { const float gl = sg[l];
#pragma unroll
            for (int r = 0; r < 16; ++r) { const int m0 = ccrow(r, hi), m1 = m0 + 32;
                p0[r] = (m0 <= ll) ? p0[r] * __builtin_amdgcn_exp2f(fminf(sa[m0] - gl, 0.f) * 1.4426950408889634f) : 0.f; p1[r] = (m1 <= ll) ? p1[r] * __builtin_amdgcn_exp2f(fminf(sa[m1] - gl, 0.f) * 1.4426950408889634f) : 0.f; rs += p0[r] + p1[r]; }
            rs = swap_add(rs);
        }
        v8s pa0, pa1, pa2, pa3;
#define CPK4(Pv, B_, OUT) do { unsigned a0_ = pk2(Pv[B_+0], Pv[B_+1]), a1_ = pk2(Pv[B_+2], Pv[B_+3]), b0_ = pk2(Pv[B_+4], Pv[B_+5]), b1_ = pk2(Pv[B_+6], Pv[B_+7]); \
        auto r0_ = __builtin_amdgcn_permlane32_swap(a0_, b0_, false, false); auto r1_ = __builtin_amdgcn_permlane32_swap(a1_, b1_, false, false); \
        v4u w_ = {r0_[0], r1_[0], r0_[1], r1_[1]}; OUT = *reinterpret_cast<v8s*>(&w_); } while (0)
        CPK4(p0, 0, pa0); CPK4(p0, 8, pa1); CPK4(p1, 0, pa2); CPK4(p1, 8, pa3);
#undef CPK4
        const int vvb = (int)(uintptr_t)VT + cv_rd_base(lane) + eb * 512;
        v16f oi = {}, ox = {};
        { v8s vf; CFRAG(vf, vvb, 0); oi = __builtin_amdgcn_mfma_f32_32x32x16_bf16(pa0, vf, oi, 0, 0, 0); CFRAG(vf, vvb, 1); oi = __builtin_amdgcn_mfma_f32_32x32x16_bf16(pa1, vf, oi, 0, 0, 0);
          CFRAG(vf, vvb, 2); oi = __builtin_amdgcn_mfma_f32_32x32x16_bf16(pa2, vf, oi, 0, 0, 0); CFRAG(vf, vvb, 3); oi = __builtin_amdgcn_mfma_f32_32x32x16_bf16(pa3, vf, oi, 0, 0, 0); }
#pragma unroll
        for (int d0 = 0; d0 < 8; ++d0) { const v8s sf = *(const v8s*)(St + (size_t)(eb * 32 + r32) * 128 + d0 * 16 + hi * 8); ox = __builtin_amdgcn_mfma_f32_32x32x16_bf16(qr[d0], sf, ox, 0, 0, 0); }
        float fa, fb;
        if (it.mixer == 0) { fa = 1.f; fb = exp2f((float)(l + 1) * lg); }
        else { float qn = 0.f;
#pragma unroll
            for (int d0 = 0; d0 < 8; ++d0)
#pragma unroll
                for (int i = 0; i < 8; ++i) qn += bf1((bf16r)qr[d0][i]) * sn[d0 * 16 + hi * 8 + i];
            qn = swap_add(qn);
            const float wi = swi[l]; const float den = rs + wi * qn; const float dn = fmaxf(fabsf(den), semq[l]); fa = 1.0f / dn; fb = wi / dn; }
        LAS float* fww = fw + wave * 64;
        if (hi == 0) { fww[r32] = fa; fww[32 + r32] = fb; }
        asm volatile("s_waitcnt lgkmcnt(0)" ::: "memory");
#pragma unroll
        for (int r = 0; r < 16; ++r) { const int lr = ccrow(r, hi); OT[(lb * 32 + lr) * 132 + eb * 32 + r32] = fww[lr] * oi[r] + fww[32 + lr] * ox[r]; }
        __syncthreads();
        const int colbase = (it.mixer == 0 ? 0 : 1536) + it.h * 128;
        { const int row = wave * 8 + (lane >> 3), seg = lane & 7;
          const v4u gA = *(const v4u*)(gsrc + (size_t)row * 128 + seg * 16), gB = *(const v4u*)(gsrc + (size_t)row * 128 + seg * 16 + 8);
          float v[16];
#pragma unroll
          for (int q = 0; q < 4; ++q) { const v4f t = *(LAS v4f*)(OT + row * 132 + seg * 16 + 4 * q); v[4 * q] = t.x; v[4 * q + 1] = t.y; v[4 * q + 2] = t.z; v[4 * q + 3] = t.w; }
          float s = 0.f;
#pragma unroll
          for (int q = 0; q < 16; ++q) s += v[q];
          s += __shfl_xor(s, 1); s += __shfl_xor(s, 2); s += __shfl_xor(s, 4);
          const float mu = s * (1.f / 128.f); float sq = 0.f;
#pragma unroll
          for (int q = 0; q < 16; ++q) { v[q] -= mu; sq += v[q] * v[q]; }
          sq += __shfl_xor(sq, 1); sq += __shfl_xor(sq, 2); sq += __shfl_xor(sq, 4);
          const float rstd = 1.0f / sqrtf(sq * (1.f / 128.f) + NORM_EPS);
          float g[16] = {bflo(gA.x), bfhi(gA.x), bflo(gA.y), bfhi(gA.y), bflo(gA.z), bfhi(gA.z), bflo(gA.w), bfhi(gA.w), bflo(gB.x), bfhi(gB.x), bflo(gB.y), bfhi(gB.y), bflo(gB.z), bfhi(gB.z), bflo(gB.w), bfhi(gB.w)};
          const float* mp = msc + colbase + seg * 16;
#pragma unroll
          for (int q = 0; q < 16; ++q) { const float e = expf(-g[q]); const float gate = (it.mixer == 0) ? g[q] / (1.f + e) : 1.f / (1.f + e); v[q] = v[q] * rstd * gate * mp[q]; }
          v4u oA, oB; oA.x = pk2(v[0], v[1]); oA.y = pk2(v[2], v[3]); oA.z = pk2(v[4], v[5]); oA.w = pk2(v[6], v[7]); oB.x = pk2(v[8], v[9]); oB.y = pk2(v[10], v[11]); oB.z = pk2(v[12], v[13]); oB.w = pk2(v[14], v[15]);
          bf16r* yp = Y + (size_t)(it.row0 + row) * DM + colbase + seg * 16;
          *(v4u*)yp = oA; *(v4u*)(yp + 8) = oB; }
        __syncthreads();
    }
}

__device__ __forceinline__ fox::BlockRef<fox::bf16, fox::bf16> fox_ref(CArgs& a, int layer, int bh, int qb, int jlo) {
    const int b = bh >> 3, h = bh & 7; const fox::bf16* P = (const fox::bf16*)(a.ws + WS_P);
    fox::BlockRef<fox::bf16, fox::bf16> r;
    r.Q = P + ((size_t)(16 + h) * MROWS + (size_t)b * SEQ + (size_t)qb * 256) * 128;
    r.K = (unsigned)(WS_P + ((size_t)(24 + h) * MROWS + (size_t)b * SEQ) * 256); r.V = (unsigned)(WS_P + ((size_t)(32 + h) * MROWS + (size_t)b * SEQ) * 256);
    r.O = (fox::bf16*)(a.ws + WS_Y) + ((size_t)b * SEQ + (size_t)qb * 256) * DM + 512 + h * 128;
    r.C = (unsigned)(WS_CNEG + (size_t)bh * SEQ * 4); r.MS = (const float*)a.in[13] + (size_t)layer * DM + 512 + h * 128; const int j4 = jlo >> 2;
    r.P0 = (qb - j4) * 256; r.JLO = j4 * 4;
    r.K += (unsigned)j4 * 256u * 256u; r.V += (unsigned)j4 * 256u * 256u; r.C += (unsigned)j4 * 1024u;
    return r;
}
__device__ __forceinline__ void fox_table_phase(CArgs& a, int layer) {
    const int tid = lz_tid(), lane = tid & 63, u = lz_bid() * 8 + (tid >> 6);
    if (u >= 1024) return;
    const float* QK2 = (const float*)(a.ws + WS_QK2) + layer * 32; const float* CN = (const float*)(a.ws + WS_CNEG);
    const int bh = u & 15, qb = 63 - (u >> 4), b = bh >> 3, h = bh & 7;
    const float qkmax = sqrtf(QK2[b * 16 + h] * QK2[b * 16 + 8 + h]);
    const float* cn = CN + (size_t)bh * SEQ; const float thresh = cn[qb * 256] - (2.0f * qkmax + 1245.0f);
    int cnt = 0;
#pragma unroll
    for (int t = 0; t < 4; ++t) { const int tile = lane + 64 * t; const bool skip = (tile < qb * 4) && (cn[tile * 64 + 63] < thresh); cnt += __popcll(__ballot(skip)); }
    if (lane == 0) ((int*)(a.ws + WS_JT))[layer * 1024 + u] = cnt;
}
__device__ __forceinline__ void fox_phase(CArgs& a, int layer, char* lds, int rep = 0) {
    using BR = fox::BlockRef<fox::bf16, fox::bf16>;
    constexpr int W = 1 << 30, total = 1024;
    const int tid = lz_tid(), lane = tid & 63;
    volatile unsigned* sbuf = (volatile unsigned*)(lds + 69632);
    unsigned* qctr = (unsigned*)(a.ws + WS_QCTR) + layer * 64 + rep * 128;
    const int* JT = (const int*)(a.ws + WS_JT) + layer * 1024;
#define FOX_GRAB(U) do { if (tid == 0) sbuf[0] = __hip_atomic_fetch_add(qctr, 1u, __ATOMIC_RELAXED, __HIP_MEMORY_SCOPE_AGENT); __syncthreads(); U = __builtin_amdgcn_readfirstlane((int)sbuf[0]); __syncthreads(); } while (0)
#define FOX_MAKE(R, U) do { const int bh_ = (U) & 15, qb_ = 63 - ((U) >> 4); R = fox_ref(a, layer, bh_, qb_, __builtin_amdgcn_readfirstlane(JT[(U)])); } while (0)
    int u; FOX_GRAB(u); if (u >= total) return;
    BR cur; FOX_MAKE(cur, u);
    fox::Seam<fox::bf16> S;
    const __amdgpu_buffer_rsrc_t rs = __builtin_amdgcn_make_buffer_rsrc((void*)a.ws, 0, -1, 0x00020000);
    fox::causal_swa_prime<fox::bf16, fox::bf16>(cur, W, lds, S, rs);
    for (;;) {
        int un; FOX_GRAB(un); const bool last = un >= total;
        BR nxt = cur; if (!last) FOX_MAKE(nxt, un);
        fox::causal_swa_block<fox::bf16, fox::bf16>(cur, nxt, SEQ, W, lds, S, rs);
        if (last) break;
        cur = nxt;
    }
#undef FOX_GRAB
#undef FOX_MAKE
}

#ifdef NANPROBE
constexpr size_t WS_FLAGS = 32 * 1024;
__device__ __forceinline__ void probe_f32(const float* p, size_t n, unsigned* flag) { bool bad = false;
    for (size_t i = (size_t)lz_bid() * 512 + lz_tid(); i < n; i += (size_t)gridDim.x * 512) { const unsigned u = __float_as_uint(p[i]); if ((u & 0x7f800000u) == 0x7f800000u) bad = true; }
    if (bad) *flag = 1u; }
__device__ __forceinline__ void probe_bf16(const unsigned short* p, size_t n, unsigned* flag) { bool bad = false;
    for (size_t i = (size_t)lz_bid() * 512 + lz_tid(); i < n; i += (size_t)gridDim.x * 512) { const unsigned u = p[i]; if ((u & 0x7f80u) == 0x7f80u) bad = true; }
    if (bad) *flag = 1u; }
#define PROBE_F32(p, n, k) probe_f32((const float*)(p), (n), (unsigned*)(ws + WS_FLAGS) + (k))
#define PROBE_BF16(p, n, k) probe_bf16((const unsigned short*)(p), (n), (unsigned*)(ws + WS_FLAGS) + (k))
#else
#define PROBE_F32(p, n, k) do {} while (0)
#define PROBE_BF16(p, n, k) do {} while (0)
#endif
#ifndef PHMASK
#define PHMASK 0xfff
#endif
#define EN(k) ((PHMASK >> (k)) & 1)
#define IN(k) (lo <= (k) && (k) < hi)
#ifdef TWICE_SYNC
#define SEAM() do { if (IN(ph) && IN(ph + 1)) { grid.sync(); grid.sync(); grid.sync(); } ++ph; } while (0)
#else
#define SEAM() do { if (IN(ph) && IN(ph + 1)) { if (ph == 0) grid.sync(); else xcd_barrier(xbar); } ++ph; } while (0)
#endif
#define a (*fresh_args())
#define ws (a.ws)
#define MOD ((const float*)(ws + WS_MOD))
template <int layer>
__device__ __forceinline__ void layer_phases(int& ph, const int lo, const int hi, cg::grid_group& grid, const XcdBarrier& xbar, LAS unsigned char* lds, unsigned char* lds_raw) {

        const float* mod = MOD + (size_t)layer * NB * NMOD;
        const float* xin = layer == 0 ? (const float*)a.in[0] : a.out;
        if (EN(1) && IN(ph)) norm_phase(xin, (const float*)a.in[5] + (size_t)layer * DM, mod, mod + DM, (bf16r*)(ws + WS_H));
#ifdef TWICE_NORM
        if (IN(ph)) norm_phase(xin, (const float*)a.in[5] + (size_t)layer * DM, mod, mod + DM, (bf16r*)(ws + WS_H));
#endif
        SEAM();
        if (EN(2) && IN(ph)) { pg8::Gemm g{(const pg8::bf16_t*)(ws + WS_H), (const pg8::bf16_t*)(ws + WS_WIN + layer * WIN_BYTES), MROWS, NINP, DM}; pg8::StaticOrder S; S.init(MROWS, NINP, gridDim.x, lz_bid());
            pg8::EpiIn E{(pg8::bf16_t*)(ws + WS_P), (float*)(ws + WS_GATES)};
            pg8::gemm_phase<pg8::EpiIn, pg8::StaticOrder, true, true>(lds, g, S, E);
            gate_gemm((const bf16r*)(ws + WS_H), (const bf16r*)(ws + WS_WG + layer * WG_BYTES), (float*)(ws + WS_GATES));
#ifdef TWICE_IN
            __syncthreads(); pg8::gemm_phase<pg8::EpiIn, pg8::StaticOrder, true, true>(lds, g, S, E);
#endif
        }
        SEAM();
        if (EN(3) && IN(ph)) prep_phase(a, layer, lds);
#ifdef TWICE_INPREP
        if (IN(ph)) { xcd_barrier(xbar);
            { pg8::Gemm g{(const pg8::bf16_t*)(ws + WS_H), (const pg8::bf16_t*)(ws + WS_WIN + layer * WIN_BYTES), MROWS, NINP, DM}; pg8::StaticOrder S; S.init(MROWS, NINP, gridDim.x, lz_bid());
              pg8::EpiIn E{(pg8::bf16_t*)(ws + WS_P), (float*)(ws + WS_GATES)};
              pg8::gemm_phase<pg8::EpiIn, pg8::StaticOrder, true, true>(lds, g, S, E); }
            xcd_barrier(xbar); prep_phase(a, layer, lds); }
#endif
        SEAM();
        PROBE_F32(ws + WS_GATES, (size_t)MROWS * 16, 1 + 10 * layer); PROBE_F32(ws + WS_CNEG, (size_t)NB * 8 * SEQ, 2 + 10 * layer); PROBE_F32(ws + WS_MA, (size_t)3 * NB * 4 * SEQ, 3 + 10 * layer); PROBE_BF16(ws + WS_P, (size_t)56 * MROWS * 128, 4 + 10 * layer); PROBE_BF16(ws + WS_MQC, (size_t)8 * MROWS * 128, 5 + 10 * layer);
        if (IN(ph)) { fox_table_phase(a, layer); if (EN(4)) m1_phase(a, lds);
#if 0
#ifdef TWICE_FOX
            __syncthreads(); fox_phase(a, layer, (char*)lds_raw);
#endif
#endif
#ifdef TWICE_M1
            __syncthreads(); m1_phase(a, lds);
#endif
        }
        SEAM();
#ifdef NANPROBE
        PROBE_BF16(ws + WS_H, (size_t)MROWS * DM, 20 + layer); PROBE_F32(ws + WS_UN, (size_t)NB * 4 * 256 * 128, 22 + layer); PROBE_F32(ws + WS_MPREV, (size_t)NB * 4 * 256, 24 + layer); grid.sync();
#endif
        if (IN(ph)) { if (EN(6)) m2_phase(a, lds); __syncthreads(); if (EN(5)) fox_phase(a, layer, (char*)lds_raw);
#ifdef TWICE_FOX
            __syncthreads(); fox_phase(a, layer, (char*)lds_raw, 1);
#endif
        }
        SEAM();
        if (EN(7) && IN(ph)) m3_phase(a, layer, lds);
#ifdef TWICE_M3
        if (IN(ph)) { __syncthreads(); m3_phase(a, layer, lds); }
#endif
        SEAM();
        PROBE_BF16(ws + WS_H, (size_t)MROWS * DM, 6 + 10 * layer); PROBE_BF16(ws + WS_Y, (size_t)MROWS * DM, 7 + 10 * layer);
        if (EN(8) && IN(ph)) { pg8::Gemm g{(const pg8::bf16_t*)(ws + WS_Y), (const pg8::bf16_t*)(ws + WS_WOUT + layer * WOUT_BYTES), MROWS, DM, DM}; pg8::StaticOrder S; S.init(MROWS, DM, gridDim.x, lz_bid());
            pg8::EpiRes E{xin, a.out, mod + 2 * DM};
            pg8::gemm_phase<pg8::EpiRes, pg8::StaticOrder, true, true>(lds, g, S, E); }
        SEAM();
        PROBE_F32(a.out, (size_t)MROWS * DM, 8 + 10 * layer);
        if (EN(1) && IN(ph)) norm_phase(a.out, (const float*)a.in[6] + (size_t)layer * DM, mod + 3 * DM, mod + 4 * DM, (bf16r*)(ws + WS_H));
#ifdef TWICE_NORM
        if (IN(ph)) norm_phase(a.out, (const float*)a.in[6] + (size_t)layer * DM, mod + 3 * DM, mod + 4 * DM, (bf16r*)(ws + WS_H));
#endif
        SEAM();
        if (EN(9) && IN(ph)) { pg8::Gemm g{(const pg8::bf16_t*)(ws + WS_H), (const pg8::bf16_t*)(ws + WS_WFF1 + layer * WFF_BYTES), MROWS, DFF, DM}; pg8::StaticOrder S; S.init(MROWS, DFF, gridDim.x, lz_bid());
            pg8::EpiRelu2 E{(pg8::bf16_t*)(ws + WS_HID), DFF};
            pg8::gemm_phase<pg8::EpiRelu2, pg8::StaticOrder, true, true>(lds, g, S, E);
#ifdef TWICE_FF1
            __syncthreads(); pg8::gemm_phase<pg8::EpiRelu2, pg8::StaticOrder, true, true>(lds, g, S, E);
#endif
        }
        SEAM();
        if (EN(10) && IN(ph)) { pg8::Gemm g{(const pg8::bf16_t*)(ws + WS_HID), (const pg8::bf16_t*)(ws + WS_WFF2 + layer * WFF_BYTES), MROWS, DM, DFF}; pg8::StaticOrder S; S.init(MROWS, DM, gridDim.x, lz_bid());
            pg8::EpiRes E{a.out, a.out, mod + 5 * DM};
            pg8::gemm_phase<pg8::EpiRes, pg8::StaticOrder, true, true>(lds, g, S, E); }
        SEAM();
        PROBE_F32(a.out, (size_t)MROWS * DM, 9 + 10 * layer);
    }
__global__ void __launch_bounds__(512, 2) trunk_fwd(Args a_unused) {
    extern __shared__ __attribute__((aligned(16))) unsigned char lds_raw[];
    LAS unsigned char* lds = (LAS unsigned char*)lds_raw;
    cg::grid_group grid = cg::this_grid();
    int lo, hi; { CArgs& a0 = *fresh_args(); lo = a0.ph_lo; hi = a0.ph_hi; } int ph = 0;
    volatile LAS unsigned* xst = (volatile LAS unsigned*)(lds + 139264);
    if (lz_tid() < 2) xst[lz_tid()] = 0u;
    __syncthreads();
    if (lz_bid() == 0) { unsigned* z = (unsigned*)ws; for (int i = lz_tid(); i < 4096; i += 512) z[i] = 0u; }
#ifdef NANPROBE
    if (lz_bid() == 0 && lz_tid() < 32) ((unsigned*)(ws + WS_FLAGS))[lz_tid()] = 0u;
#endif
    if (EN(0) && IN(ph)) p0_phase(a, lds);
#ifdef TWICE_P0
    if (IN(ph)) { __syncthreads(); p0_phase(a, lds); }
#endif
    if (IN(ph) && IN(ph + 1)) grid.sync();
    ++ph;
    const XcdBarrier xbar = xcd_barrier_post((unsigned*)ws, xst);
    layer_phases<0>(ph, lo, hi, grid, xbar, lds, lds_raw);
    layer_phases<1>(ph, lo, hi, grid, xbar, lds, lds_raw);
    if (EN(11) && IN(ph)) final_norm_phase(a.out, (const float*)a.in[17]);
#ifdef NANPROBE
    { grid.sync(); float code = 0.f; const unsigned* fl = (const unsigned*)(ws + WS_FLAGS);
      const int order[16] = {1, 2, 3, 4, 5, 24, 20, 22, 6, 7, 8, 9, 11, 12, 13, 14};
      for (int q = 15; q >= 0; --q) if (fl[order[q]]) code = (float)order[q] * 1.0e6f;
      float* o = a.out; for (size_t i = (size_t)lz_bid() * 512 + lz_tid(); i < (size_t)MROWS * DM; i += (size_t)gridDim.x * 512) o[i] = (i == 0) ? code : 0.f; }
#endif
#ifdef DBG_OFF_MIB
    { grid.sync();
      const unsigned short* src = (const unsigned short*)(ws + (size_t)DBG_OFF_MIB * MiB); const size_t n = (size_t)DBG_MIB * MiB / 2; float* o = a.out;
      for (size_t i = (size_t)lz_bid() * 512 + lz_tid(); i < (size_t)MROWS * DM; i += (size_t)gridDim.x * 512) { const size_t k = (4 * i) % n;
          o[i] = (float)src[k] + 3.f * (float)src[k + 1] + 5.f * (float)src[k + 2] + 7.f * (float)src[k + 3]; } }
#endif
#undef IN
#undef SEAM
#undef a
#undef ws
#undef MOD
}

#ifndef MK_PER_PHASE
#define MK_PER_PHASE 0
#endif
extern "C" void kernel_launch(void* const* d_in, const int* in_sizes, int n_in, void* d_out, int out_size, void* d_ws, size_t ws_size, hipStream_t stream) {
    static int grid = 0;
    if (grid == 0) {
        if (n_in != 18 || in_sizes[0] != MROWS * DM || out_size != MROWS * DM || ws_size < WS_END) { fprintf(stderr, "kernel_launch: unexpected shapes (n_in %d, in0 %d, out %d, ws %zu)\n", n_in, n_in > 0 ? in_sizes[0] : -1, out_size, ws_size); grid = -1; return; }
        int dev = 0, cus = 0, per_cu = 0;
        if (hipGetDevice(&dev) != hipSuccess || hipDeviceGetAttribute(&cus, hipDeviceAttributeMultiprocessorCount, dev) != hipSuccess) { grid = -1; return; }
        if (hipFuncSetAttribute((const void*)trunk_fwd, hipFuncAttributeMaxDynamicSharedMemorySize, LDS_BYTES) != hipSuccess) { fprintf(stderr, "kernel_launch: hipFuncSetAttribute failed\n"); grid = -1; return; }
        if (hipOccupancyMaxActiveBlocksPerMultiprocessor(&per_cu, (const void*)trunk_fwd, 512, LDS_BYTES) != hipSuccess || per_cu < 1) { fprintf(stderr, "kernel_launch: occupancy query says %d\n", per_cu); per_cu = 1; }
        (void)hipGetLastError();
        grid = cus;
    }
    if (grid < 0) return;
    Args a{};
    for (int i = 0; i < 18; ++i) a.in[i] = d_in[i];
    a.out = (float*)d_out; a.ws = (unsigned char*)d_ws;
    constexpr int NPH = 1 + 2 * 10 + 1;
#if MK_PER_PHASE
    for (int p = 0; p < NPH; ++p) { a.ph_lo = p; a.ph_hi = p + 1; hipLaunchKernelGGL(trunk_fwd, dim3(grid), dim3(512), LDS_BYTES, stream, a); }
#else
#ifdef DBG_HI
    a.ph_lo = 0; a.ph_hi = DBG_HI;
#else
    a.ph_lo = 0; a.ph_hi = NPH;
#endif
    void* args[] = {&a};
    hipError_t e = hipLaunchCooperativeKernel((const void*)trunk_fwd, dim3(grid), dim3(512), args, LDS_BYTES, stream);
    if (e != hipSuccess) fprintf(stderr, "kernel_launch: cooperative launch failed: %s (grid %d)\n", hipGetErrorString(e), grid);
#endif
}
```

```cpp
#include <hip/hip_runtime.h>
#include <hip/hip_bf16.h>
#include <hip/hip_cooperative_groups.h>
#include <cstdio>
#include <cstdint>
namespace cg = cooperative_groups;

constexpr int NB = 2, SEQ = 16384, DM = 2048, MROWS = NB * SEQ, DIN = 7184, NINP = 7168, DFF = 8192, HD = 128, NMOD = 6 * DM;
constexpr int NSLOT = 56;
constexpr float NORM_EPS = 1e-6f;
constexpr float KSCALE = 0.08838834764831845f;

__device__ __forceinline__ int lz_tid() { const int w = __builtin_amdgcn_readfirstlane((int)threadIdx.x >> 6); int l; asm volatile("v_mbcnt_lo_u32_b32 %0, -1, 0\n\tv_mbcnt_hi_u32_b32 %0, -1, %0" : "=v"(l));
    int t = w * 64 + l; asm volatile("" : "+v"(t)); return t; }
__device__ __forceinline__ int lz_bid() { int b = blockIdx.x; asm volatile("" : "+s"(b)); return b; }

namespace pg8 {
#define PG8_LAS __attribute__((address_space(3)))
typedef unsigned short bf16_t;
typedef short bf16x8 __attribute__((ext_vector_type(8)));
typedef float f32x4 __attribute__((ext_vector_type(4)));
typedef unsigned u32x4 __attribute__((ext_vector_type(4)));
constexpr int BM = 256, BK = 64, HALF = 128, HTB = HALF * BK * 2  , STAGE_BYTES = 8 * HTB, NXCD = 8, WGM = 4;

__host__ __device__ __forceinline__ int lds_byte(int r, int c) { const int st = (r >> 4) * 2 + (c >> 5), rr = r & 15, cc = c & 31, ob = rr * 64 + cc * 2; return st * 1024 + (ob ^ (((ob >> 9) & 1) << 5)); }
__host__ __device__ __forceinline__ void stage_rc(int b, int& R, int& C) { const int st = b / 1024, sb = b % 1024, swz = sb ^ (((sb >> 9) & 1) << 5); R = (st >> 1) * 16 + swz / 64; C = (st & 1) * 32 + (swz % 64) / 2; }
__host__ __device__ __forceinline__ int perm32(int rho) { const int n = rho >> 4, i = rho & 15; return 8 * (i >> 2) + 4 * n + (i & 3); }

struct Unit { int pm, pn; };
struct Gemm { const bf16_t* A; const bf16_t* Bt; int M, N, K; };

struct StaticOrder {
    int nM, nN, nwg, G, c;
    __host__ __device__ void init(int M, int N, int G_, int c_) { nM = M / BM; nN = N / BM; nwg = nM * nN; G = G_; c = c_; }
    __host__ __device__ bool next(int i, Unit& u) const {
        const long L = (long)i * G + c; if (L >= nwg) return false;
        int wgid = (int)L; { const int q = nwg / NXCD, r = nwg % NXCD, xcd = wgid % NXCD, off = wgid / NXCD; wgid = (xcd < r ? xcd * (q + 1) : r * (q + 1) + (xcd - r) * q) + off; }
        const int nig = WGM * nN, gid = wgid / nig, fm = gid * WGM, gsz = (nM - fm) < WGM ? (nM - fm) : WGM;
        u.pm = fm + ((wgid % nig) % gsz); u.pn = (wgid % nig) / gsz; return true;
    }
    __device__ __forceinline__ void a_ready(const Unit&) const {}
    __device__ __forceinline__ void done(const Unit&) const {}
};

__device__ __forceinline__ unsigned cvt_pk_bf16(float lo, float hi) { unsigned r; asm volatile("v_cvt_pk_bf16_f32 %0, %1, %2" : "=v"(r) : "v"(lo), "v"(hi)); return r; }

typedef float epf2_t __attribute__((ext_vector_type(2))); typedef __bf16 epb2_t __attribute__((ext_vector_type(2)));
__device__ __forceinline__ unsigned cvt_pk_c(float lo, float hi) { epf2_t v = {lo, hi}; epb2_t b = __builtin_convertvector(v, epb2_t); return __builtin_bit_cast(unsigned, b); }
struct EpiIn {
    static constexpr bool PERM = true, AFTER_DRAIN = false;
    bf16_t* P; float* gates;
    __device__ __forceinline__ void operator()(const f32x4 (&acc)[2][2][4][2], const Unit& u, int wr, int wc, int fr, int fq) const {
        const int row0 = u.pm * BM + wr * 64 + fr;
#pragma unroll
        for (int bj = 0; bj < 2; ++bj) {
            const int g = 2 * u.pn + bj;
            if (g < 56) {
                bf16_t* base = P + ((size_t)g * MROWS + row0) * 128 + wc * 32 + 8 * fq;
#pragma unroll
                for (int ai = 0; ai < 2; ++ai)
#pragma unroll
                    for (int m = 0; m < 4; ++m) { const f32x4 v0 = acc[ai][bj][m][0], v1 = acc[ai][bj][m][1];
                        u32x4 w; w.x = cvt_pk_c(v0[0], v0[1]); w.y = cvt_pk_c(v0[2], v0[3]); w.z = cvt_pk_c(v1[0], v1[1]); w.w = cvt_pk_c(v1[2], v1[3]);
                        *(u32x4*)(base + (size_t)(ai * HALF + m * 16) * 128) = w; }
            } else if (g == 56) {
                if (wc == 0 && fq < 2) { float* gp = gates + (size_t)row0 * 16 + 8 * fq;
#pragma unroll
                    for (int ai = 0; ai < 2; ++ai)
#pragma unroll
                        for (int m = 0; m < 4; ++m) { *(f32x4*)(gp + (size_t)(ai * HALF + m * 16) * 16) = acc[ai][bj][m][0]; *(f32x4*)(gp + (size_t)(ai * HALF + m * 16) * 16 + 4) = acc[ai][bj][m][1]; } }
            }
        }
    }
};
struct EpiRes {
    static constexpr bool PERM = true, AFTER_DRAIN = false;
    const float* base; float* out; const float* gvec;
    __device__ __forceinline__ void operator()(const f32x4 (&acc)[2][2][4][2], const Unit& u, int wr, int wc, int fr, int fq) const {
        const int row0 = u.pm * BM + wr * 64 + fr; const int b = (u.pm * BM) / SEQ; const float* gv = gvec + (size_t)b * NMOD;
#pragma unroll
        for (int bj = 0; bj < 2; ++bj) { const int c = u.pn * BM + bj * HALF + wc * 32 + 8 * fq;
            const f32x4 g0 = *(const f32x4*)(gv + c), g1 = *(const f32x4*)(gv + c + 4);
#pragma unroll
            for (int ai = 0; ai < 2; ++ai)
#pragma unroll
                for (int m = 0; m < 4; ++m) { const size_t off = (size_t)(row0 + ai * HALF + m * 16) * DM + c;
                    const f32x4 x0 = *(const f32x4*)(base + off), x1 = *(const f32x4*)(base + off + 4);
                    *(f32x4*)(out + off) = x0 + g0 * acc[ai][bj][m][0]; *(f32x4*)(out + off + 4) = x1 + g1 * acc[ai][bj][m][1]; } }
    }
};
struct EpiRelu2 {
    static constexpr bool PERM = true, AFTER_DRAIN = false;
    bf16_t* O; int ldc;
    __device__ __forceinline__ void operator()(const f32x4 (&acc)[2][2][4][2], const Unit& u, int wr, int wc, int fr, int fq) const {
        const int row0 = u.pm * BM + wr * 64 + fr;
#pragma unroll
        for (int bj = 0; bj < 2; ++bj) { bf16_t* base = O + (size_t)row0 * ldc + u.pn * BM + bj * HALF + wc * 32 + 8 * fq;
#pragma unroll
            for (int ai = 0; ai < 2; ++ai)
#pragma unroll
                for (int m = 0; m < 4; ++m) { f32x4 v0 = acc[ai][bj][m][0], v1 = acc[ai][bj][m][1];
#pragma unroll
                    for (int i = 0; i < 4; ++i) { const float a = v0[i] > 0.f ? v0[i] : 0.f, b = v1[i] > 0.f ? v1[i] : 0.f; v0[i] = a * a; v1[i] = b * b; }
                    u32x4 w; w.x = cvt_pk_c(v0[0], v0[1]); w.y = cvt_pk_c(v0[2], v0[3]); w.z = cvt_pk_c(v1[0], v1[1]); w.w = cvt_pk_c(v1[2], v1[3]);
                    *(u32x4*)(base + (size_t)(ai * HALF + m * 16) * ldc) = w; } }
    }
};

template <class Epi, class Sched, bool ALIGN_EPI = false, bool SP2 = false>
__device__ __forceinline__ void gemm_phase(PG8_LAS unsigned char* lds, const Gemm g, const Sched& S, const Epi& E) {
    const int tid = lz_tid(), wid = __builtin_amdgcn_readfirstlane(tid >> 6), lane = tid & 63, wr = wid >> 2, wc = wid & 3, fr = lane & 15, fq = lane >> 4;
    const int K = g.K, nt = K / BK;
    unsigned voffA[2], voffB[2];
#pragma unroll
    for (int i = 0; i < 2; ++i) { int R, C; stage_rc(tid * 16 + i * 8192, R, C); const int Rb = Epi::PERM ? ((R & ~31) + perm32(R & 31)) : R;
        voffA[i] = (unsigned)(R * K + C) * 2u; voffB[i] = (unsigned)(Rb * K + C) * 2u; }
    const size_t kstep = (size_t)(BK * 2);
    const size_t hstep = (size_t)HALF * K * 2;
    const size_t tstep = 2 * hstep;
    const unsigned ldsw = (unsigned)wid * 1024u;
    const int aoff = lds_byte(wr * 64 + fr, fq * 8), boff = lds_byte(wc * 32 + fr, fq * 8);
#define PG8_SA(b, h) (((b) * 2 + (h)) * HTB)
#define PG8_SB(b, h) ((4 + (b) * 2 + (h)) * HTB)
#define PG8_STAGE(bufoff, gbase, voff) do { _Pragma("unroll") for (int _i = 0; _i < 2; ++_i) \
        __builtin_amdgcn_global_load_lds((const unsigned*)((const char*)(gbase) + (voff)[_i]), (PG8_LAS unsigned*)(lds + (bufoff) + ldsw + _i * 8192), 16, 0, 0); } while (0)
#define PG8_LDA(dst, b, h) do { _Pragma("unroll") for (int m = 0; m < 4; ++m) _Pragma("unroll") for (int k = 0; k < 2; ++k) dst[m][k] = *(const PG8_LAS bf16x8*)(lds + PG8_SA(b, h) + aoff + m * 2048 + k * 1024); } while (0)
#define PG8_LDB(dst, b, h) do { _Pragma("unroll") for (int n = 0; n < 2; ++n) _Pragma("unroll") for (int k = 0; k < 2; ++k) dst[n][k] = *(const PG8_LAS bf16x8*)(lds + PG8_SB(b, h) + boff + n * 2048 + k * 1024); } while (0)
#define PG8_MMA(ai, bj, At, Bt) do { __builtin_amdgcn_s_setprio(1); _Pragma("unroll") for (int m = 0; m < 4; ++m) _Pragma("unroll") for (int n = 0; n < 2; ++n) _Pragma("unroll") for (int k = 0; k < 2; ++k) \
        acc[ai][bj][m][n] = __builtin_amdgcn_mfma_f32_16x16x32_bf16(Bt[n][k], At[m][k], acc[ai][bj][m][n], 0, 0, 0); __builtin_amdgcn_s_setprio(0); } while (0)
#define PG8_WAIT_V(n) asm volatile("s_waitcnt vmcnt(" #n ")" ::: "memory")
#define PG8_WAIT_L(n) asm volatile("s_waitcnt lgkmcnt(" #n ")" ::: "memory")
#define PG8_BAR __builtin_amdgcn_s_barrier()
#define PG8_SCHED __builtin_amdgcn_sched_barrier(0)
    Unit cur, nxt; int ui = 0;
    if (!S.next(0, cur)) return;
    f32x4 acc[2][2][4][2];
#pragma unroll
    for (int a = 0; a < 2; ++a)
#pragma unroll
        for (int b = 0; b < 2; ++b)
#pragma unroll
            for (int m = 0; m < 4; ++m)
#pragma unroll
                for (int n = 0; n < 2; ++n) acc[a][b][m][n] = (f32x4){0.f, 0.f, 0.f, 0.f};
    bf16x8 At[4][2], B0[2][2], B1[2][2];
    const char* cA = (const char*)g.A + (size_t)cur.pm * tstep; const char* cB = (const char*)g.Bt + (size_t)cur.pn * tstep;
    S.a_ready(cur);
    if constexpr (SP2) {
        PG8_STAGE(PG8_SB(0, 0), cB, voffB); PG8_STAGE(PG8_SB(0, 1), cB + hstep, voffB); PG8_STAGE(PG8_SA(0, 0), cA, voffA); PG8_STAGE(PG8_SA(0, 1), cA + hstep, voffA);
        if (wr == 1) PG8_BAR;
        PG8_WAIT_V(2); PG8_BAR;
        PG8_STAGE(PG8_SB(1, 0), cB + kstep, voffB); PG8_STAGE(PG8_SA(1, 0), cA + kstep, voffA); PG8_STAGE(PG8_SB(1, 1), cB + hstep + kstep, voffB);
        PG8_WAIT_V(6); PG8_BAR;
    } else {
        PG8_STAGE(PG8_SB(0, 0), cB, voffB); PG8_STAGE(PG8_SA(0, 0), cA, voffA); PG8_STAGE(PG8_SB(0, 1), cB + hstep, voffB); PG8_STAGE(PG8_SA(0, 1), cA + hstep, voffA);
        if (wr == 1) PG8_BAR;
        PG8_WAIT_V(4); PG8_BAR;
        PG8_STAGE(PG8_SB(1, 0), cB + kstep, voffB); PG8_STAGE(PG8_SA(1, 0), cA + kstep, voffA); PG8_STAGE(PG8_SB(1, 1), cB + hstep + kstep, voffB);
        PG8_WAIT_V(6); PG8_BAR;
    }
    for (;;) {
        const bool has_next = S.next(ui + 1, nxt);
        const char* nA = has_next ? (const char*)g.A + (size_t)nxt.pm * tstep : cA; const char* nB = has_next ? (const char*)g.Bt + (size_t)nxt.pn * tstep : cB;
        for (int t = 0; t < nt; t += 2) {
            const bool last = (t == nt - 2);
            const char* a1 = cA + (size_t)(t + 1) * kstep;
            const char* a2 = last ? nA : cA + (size_t)(t + 2) * kstep; const char* b2 = last ? nB : cB + (size_t)(t + 2) * kstep;
            const char* a3 = a2 + kstep; const char* b3 = b2 + kstep;
            if (last && has_next) S.a_ready(nxt);
            if constexpr (SP2) {
            PG8_LDB(B0, 0, 0); PG8_LDB(B1, 0, 1); PG8_SCHED; PG8_LDA(At, 0, 0); PG8_STAGE(PG8_SA(1, 1), a1 + hstep, voffA);
            PG8_WAIT_V(8); PG8_WAIT_L(0); PG8_BAR; PG8_MMA(0, 0, At, B0); PG8_MMA(0, 1, At, B1); PG8_BAR; PG8_SCHED;
            PG8_LDA(At, 0, 1); PG8_STAGE(PG8_SB(0, 0), b2, voffB); PG8_STAGE(PG8_SB(0, 1), b2 + hstep, voffB); PG8_STAGE(PG8_SA(0, 0), a2, voffA);
            PG8_WAIT_V(8); PG8_WAIT_L(0); PG8_BAR; PG8_MMA(1, 0, At, B0); PG8_MMA(1, 1, At, B1); PG8_BAR; PG8_SCHED;
            PG8_LDB(B0, 1, 0); PG8_LDB(B1, 1, 1); PG8_SCHED; PG8_LDA(At, 1, 0); PG8_STAGE(PG8_SA(0, 1), a2 + hstep, voffA);
            PG8_WAIT_V(8); PG8_WAIT_L(0); PG8_BAR; PG8_MMA(0, 0, At, B0); PG8_MMA(0, 1, At, B1); PG8_BAR; PG8_SCHED;
            PG8_LDA(At, 1, 1); PG8_STAGE(PG8_SB(1, 0), b3, voffB); PG8_STAGE(PG8_SB(1, 1), b3 + hstep, voffB); PG8_STAGE(PG8_SA(1, 0), a3, voffA);
            PG8_WAIT_V(8); PG8_WAIT_L(0); PG8_BAR; PG8_MMA(1, 0, At, B0); PG8_MMA(1, 1, At, B1); PG8_BAR; PG8_SCHED;
            } else {
            PG8_LDB(B0, 0, 0); PG8_SCHED; PG8_LDA(At, 0, 0); PG8_STAGE(PG8_SA(1, 1), a1 + hstep, voffA);
            PG8_WAIT_L(8); PG8_BAR; PG8_WAIT_L(0); PG8_MMA(0, 0, At, B0); PG8_BAR; PG8_SCHED;
            PG8_LDB(B1, 0, 1); PG8_STAGE(PG8_SB(0, 0), b2, voffB);
            PG8_BAR; PG8_WAIT_L(0); PG8_MMA(0, 1, At, B1); PG8_BAR;
            PG8_LDA(At, 0, 1); PG8_STAGE(PG8_SA(0, 0), a2, voffA);
            PG8_BAR; PG8_WAIT_L(0); PG8_MMA(1, 0, At, B0); PG8_BAR; PG8_SCHED;
            PG8_STAGE(PG8_SB(0, 1), b2 + hstep, voffB);
            PG8_WAIT_V(6); PG8_BAR; PG8_MMA(1, 1, At, B1); PG8_BAR;
            PG8_LDB(B0, 1, 0); PG8_SCHED; PG8_LDA(At, 1, 0); PG8_STAGE(PG8_SA(0, 1), a2 + hstep, voffA);
            PG8_WAIT_L(8); PG8_BAR; PG8_WAIT_L(0); PG8_MMA(0, 0, At, B0); PG8_BAR; PG8_SCHED;
            PG8_LDB(B1, 1, 1); PG8_STAGE(PG8_SB(1, 0), b3, voffB);
            PG8_BAR; PG8_WAIT_L(0); PG8_MMA(0, 1, At, B1); PG8_BAR;
            PG8_LDA(At, 1, 1); PG8_STAGE(PG8_SA(1, 0), a3, voffA);
            PG8_BAR; PG8_WAIT_L(0); PG8_MMA(1, 0, At, B0); PG8_BAR; PG8_SCHED;
            PG8_STAGE(PG8_SB(1, 1), b3 + hstep, voffB);
            PG8_WAIT_V(6); PG8_BAR; PG8_MMA(1, 1, At, B1); PG8_BAR;
            }
        }
        if constexpr (ALIGN_EPI) { if (wr == 0) PG8_BAR; }
        if constexpr (!Epi::AFTER_DRAIN) { E(acc, cur, wr, wc, fr, fq); S.done(cur); }
        if (!has_next) break;
#pragma unroll
        for (int a = 0; a < 2; ++a)
#pragma unroll
            for (int b = 0; b < 2; ++b)
#pragma unroll
                for (int m = 0; m < 4; ++m)
#pragma unroll
                    for (int n = 0; n < 2; ++n) acc[a][b][m][n] = (f32x4){0.f, 0.f, 0.f, 0.f};
        cur = nxt; cA = nA; cB = nB; ++ui;
        if constexpr (ALIGN_EPI) { if (wr == 1) PG8_BAR; }
    }
    PG8_WAIT_V(0);
    if constexpr (!ALIGN_EPI) { if (wr == 0) PG8_BAR; }
    PG8_BAR;
    if constexpr (Epi::AFTER_DRAIN) { E.fused(acc, cur, wr, wc, fr, fq, lds, wid, lane); S.done(cur); }
#undef PG8_SA
#undef PG8_SB
#undef PG8_STAGE
#undef PG8_LDA
#undef PG8_LDB
#undef PG8_MMA
#undef PG8_WAIT_V
#undef PG8_WAIT_L
#undef PG8_BAR
#undef PG8_SCHED
}
}
namespace fox {
constexpr int D = 128; constexpr float THR = 32.f; constexpr bool WSKIP = false; constexpr int OSTR = 2048;
constexpr float SCALE = 0.08838834764831845f;
constexpr int NW = 8, QBLK = 32, KVBLK = 64, QB = NW * QBLK;
constexpr int SHM_V = KVBLK * D * 2, SHM_K = KVBLK * D * 2;
constexpr int LDS_CB = 2 * SHM_V + 2 * SHM_K + NW * 64 * 4; constexpr int LDS_BYTES = LDS_CB + 2 * 64 * 4;

using bf16 = __hip_bfloat16;
typedef short bf16x8 __attribute__((ext_vector_type(8)));
typedef short s16x4 __attribute__((ext_vector_type(4)));
typedef float f32x16 __attribute__((ext_vector_type(16)));
typedef float f32x4 __attribute__((ext_vector_type(4)));
typedef unsigned u32x4 __attribute__((ext_vector_type(4)));
template <class A, class Bt> struct same_t { static constexpr bool v = false; };
template <class A> struct same_t<A, A> { static constexpr bool v = true; };

#define KSWZ(row, colB) ((row) * 256 + ((colB) ^ (((row) & 7) << 4)))
#define SBAR() __builtin_amdgcn_sched_barrier(0)
__device__ __forceinline__ int v_st(int k, int c) { const int kk = (k & ~0xC) | ((k & 4) << 1) | ((k & 8) >> 1); return ((kk >> 3) * 4 + (c >> 5)) * 512 + ((kk & 7) * 32 + (c & 31)) * 2; }
__device__ __forceinline__ int v_rd_base(int lane) { return ((lane & 3) << 3) | (((lane >> 2) & 3) << 6) | (((lane >> 4) & 1) << 5) | (((lane >> 5) & 1) << 8); }
constexpr int v_rd_off(int d0, int ks, int half) { return d0 * 512 + ks * 4096 + half * 2048; }
__device__ __forceinline__ int crow(int r, int hi) { return (r & 3) + 8 * (r >> 2) + 4 * hi; }
__device__ __forceinline__ unsigned cvtpk(float lo, float hi) {
    unsigned r; asm volatile("v_cvt_pk_bf16_f32 %0, %1, %2" : "=v"(r) : "v"(lo), "v"(hi)); return r;
}
__device__ __forceinline__ bf16x8 pack8(f32x4 a, f32x4 b) {
    u32x4 w = {cvtpk(a[0], a[1]), cvtpk(a[2], a[3]), cvtpk(b[0], b[1]), cvtpk(b[2], b[3])};
    return *reinterpret_cast<bf16x8*>(&w);
}
template <class T> __device__ __forceinline__ bf16x8 load8(const T* p) {
    if constexpr (same_t<T, float>::v) { return pack8(*(const f32x4*)p, *(const f32x4*)(p + 4)); }
    else { return *reinterpret_cast<const bf16x8*>(p); }
}
__device__ __forceinline__ void mask_tile(f32x16& p0, f32x16& p1, int dq, unsigned W) {
    const float NEG = -__builtin_inff();
#pragma unroll
    for (int r = 0; r < 16; ++r) {
        const int c = (r & 3) + 8 * (r >> 2);
        if ((unsigned)(dq - c) >= W) p0[r] = NEG;
        if ((unsigned)(dq - c - 32) >= W) p1[r] = NEG;
    }
}
__device__ __forceinline__ void partialSM(f32x16& p0, f32x16& p1, float& m_reg, float& mn, float& alpha) {
    float pmax = p0[0]; for (int r = 1; r < 16; ++r) pmax = fmaxf(pmax, p0[r]); for (int r = 0; r < 16; ++r) pmax = fmaxf(pmax, p1[r]);
    { auto rr = __builtin_amdgcn_permlane32_swap(__float_as_uint(pmax), __float_as_uint(pmax), false, false);
      pmax = fmaxf(__uint_as_float(rr[0]), __uint_as_float(rr[1])); }
    constexpr float C2 = 1.4426950408889634f * SCALE;
    if (__builtin_expect(__all((pmax - m_reg) * SCALE <= THR), 1)) { mn = m_reg; alpha = 1.f; }
    else { mn = fmaxf(m_reg, pmax); alpha = __builtin_amdgcn_exp2f((m_reg - mn) * C2); m_reg = mn; }
    const float mnL = -mn * C2;
    for (int r = 0; r < 16; ++r) p0[r] = fmaf(p0[r], C2, mnL); for (int r = 0; r < 16; ++r) p1[r] = fmaf(p1[r], C2, mnL);
    for (int r = 0; r < 16; ++r) p0[r] = __builtin_amdgcn_exp2f(p0[r]);
}
__device__ __forceinline__ void finishSM(f32x16& p0, f32x16& p1, float alpha, float& l_reg, bf16x8& pa0, bf16x8& pa1, bf16x8& pa2, bf16x8& pa3) {
    for (int r = 0; r < 16; ++r) p1[r] = __builtin_amdgcn_exp2f(p1[r]);
    float ps = 0; for (int r = 0; r < 16; ++r) ps += p0[r]; for (int r = 0; r < 16; ++r) ps += p1[r];
    { auto rr = __builtin_amdgcn_permlane32_swap(__float_as_uint(ps), __float_as_uint(ps), false, false);
      ps = __uint_as_float(rr[0]) + __uint_as_float(rr[1]); }
    l_reg = l_reg * alpha + ps;
#define PK4(P, B_, OUT) do { unsigned a0 = cvtpk(P[B_+0], P[B_+1]), a1 = cvtpk(P[B_+2], P[B_+3]);                          \
        unsigned b0 = cvtpk(P[B_+4], P[B_+5]), b1 = cvtpk(P[B_+6], P[B_+7]);                                             \
        auto r0 = __builtin_amdgcn_permlane32_swap(a0, b0, false, false); auto r1 = __builtin_amdgcn_permlane32_swap(a1, b1, false, false); \
        u32x4 w = {r0[0], r1[0], r0[1], r1[1]}; OUT = *reinterpret_cast<bf16x8*>(&w); } while (0)
    PK4(p0, 0, pa0); PK4(p0, 8, pa1); PK4(p1, 0, pa2); PK4(p1, 8, pa3);
#undef PK4
}
template <int KB, bool SK>
__device__ __forceinline__ void qkt(f32x16& p0, f32x16& p1, const char* K_lds, const float* cb, int r32, int hi, const bf16x8* qr, bool act) {
    if (SK && !act) { const float NEG = -__builtin_inff();
#pragma unroll
        for (int r = 0; r < 16; ++r) { p0[r] = NEG; p1[r] = NEG; } return; }
    { const float* cbp = cb + KB * 64 + 4 * hi;
#pragma unroll
      for (int g = 0; g < 4; ++g) { const f32x4 t0 = *(const f32x4*)(cbp + 8 * g), t1 = *(const f32x4*)(cbp + 32 + 8 * g);
        p0[4*g] = t0[0]; p0[4*g+1] = t0[1]; p0[4*g+2] = t0[2]; p0[4*g+3] = t0[3]; p1[4*g] = t1[0]; p1[4*g+1] = t1[1]; p1[4*g+2] = t1[2]; p1[4*g+3] = t1[3]; } }
    const char* kb[4];
#pragma unroll
    for (int dd = 0; dd < 4; ++dd) kb[dd] = K_lds + KB * SHM_K + KSWZ(r32, (dd * 16 + hi * 8) * 2);
#pragma unroll
    for (int d0 = 0; d0 < 8; ++d0) { const char* a = kb[d0 & 3] + (d0 >> 2) * 128;
        bf16x8 b0 = *reinterpret_cast<const bf16x8*>(a);
        bf16x8 b1 = *reinterpret_cast<const bf16x8*>(a + 32 * 256);
        p0 = __builtin_amdgcn_mfma_f32_32x32x16_bf16(b0, qr[d0], p0, 0, 0, 0);
        p1 = __builtin_amdgcn_mfma_f32_32x32x16_bf16(b1, qr[d0], p1, 0, 0, 0); }
}
template <int VB, bool SK>
__device__ __forceinline__ void pv_tile(f32x16* o, int vb0, bf16x8 pa0, bf16x8 pa1, bf16x8 pa2, bf16x8 pa3, bool act) {
    if (SK && !act) return;
#define TRRD(dst, off) asm volatile("ds_read_b64_tr_b16 %0, %1 offset:%2" : "=&v"(dst) : "v"(vb0), "i"(off) : "memory")
#define PV_D0(d0) do { s16x4 l0, l1, l2, l3, h0, h1, h2, h3; constexpr int b_ = VB * SHM_V + v_rd_off(d0, 0, 0);     \
        TRRD(l0, b_); TRRD(h0, b_ + 2048); TRRD(l1, b_ + 4096); TRRD(h1, b_ + 6144); TRRD(l2, b_ + 8192); TRRD(h2, b_ + 10240); TRRD(l3, b_ + 12288); TRRD(h3, b_ + 14336); \
        asm volatile("s_waitcnt lgkmcnt(0)" ::: "memory"); SBAR();                 \
        o[d0] = __builtin_amdgcn_mfma_f32_32x32x16_bf16(pa0, (bf16x8){l0[0], l0[1], l0[2], l0[3], h0[0], h0[1], h0[2], h0[3]}, o[d0], 0, 0, 0);   \
        o[d0] = __builtin_amdgcn_mfma_f32_32x32x16_bf16(pa1, (bf16x8){l1[0], l1[1], l1[2], l1[3], h1[0], h1[1], h1[2], h1[3]}, o[d0], 0, 0, 0);   \
        o[d0] = __builtin_amdgcn_mfma_f32_32x32x16_bf16(pa2, (bf16x8){l2[0], l2[1], l2[2], l2[3], h2[0], h2[1], h2[2], h2[3]}, o[d0], 0, 0, 0);   \
        o[d0] = __builtin_amdgcn_mfma_f32_32x32x16_bf16(pa3, (bf16x8){l3[0], l3[1], l3[2], l3[3], h3[0], h3[1], h3[2], h3[3]}, o[d0], 0, 0, 0); } while (0)
    PV_D0(0); PV_D0(1); PV_D0(2); PV_D0(3);
#undef PV_D0
#undef TRRD
}

template <class TIn, class TOut> struct BlockRef { const TIn* Q; TOut* O; const float* MS; unsigned K, V, C; int P0; int JLO; };
__device__ __forceinline__ bf16x8 bl128(__amdgpu_buffer_rsrc_t rs, unsigned vo, unsigned so) { return __builtin_bit_cast(bf16x8, __builtin_amdgcn_raw_buffer_load_b128(rs, (int)vo, (int)so, 0)); }
__device__ __forceinline__ float bl32(__amdgpu_buffer_rsrc_t rs, unsigned vo, unsigned so) { return __builtin_bit_cast(float, __builtin_amdgcn_raw_buffer_load_b32(rs, (int)vo, (int)so, 0)); }
template <class TIn> struct Seam {
    bf16x8 qr[8];
    bf16x8 st_v0, st_v1, st_k0, st_k1; f32x4 sf0, sf1, sf2, sf3; float st_c;
    f32x4 tq[16];
};
__device__ __forceinline__ int swa_jlo(int P0, int W) { const int lowk = P0 - W + 1; return lowk > 0 ? lowk / KVBLK : 0; }
#define ROW(p, k0, rr) ((p) + (unsigned)(((k0) + (rr)) * D + sc))
#define VMW() asm volatile("s_waitcnt vmcnt(0)" ::: "memory")
#define VMWN(n) asm volatile("s_waitcnt vmcnt(%0)" :: "i"(n) : "memory")
#define SLOAD_H(Kp, Vp, Cp, k0) do { if (tid < 64) S.st_c = bl32(rs, (unsigned)tid * 4u, (Cp) + (unsigned)(k0) * 4u); \
        S.st_v0 = bl128(rs, vo_st, (Vp) + (unsigned)(k0) * 256u); S.st_v1 = bl128(rs, vo_st, (Vp) + (unsigned)(k0) * 256u + 8192u); \
        S.st_k0 = bl128(rs, vo_st, (Kp) + (unsigned)(k0) * 256u); S.st_k1 = bl128(rs, vo_st, (Kp) + (unsigned)(k0) * 256u + 8192u); } while (0)
#define SWRITE_HK(bf) do { if (tid < 64) cb_l[(bf) * 64 + tid] = S.st_c;  *(bf16x8*)(K_lds + (bf) * SHM_K + kws) = S.st_k0; *(bf16x8*)(K_lds + (bf) * SHM_K + kws + 32 * 256) = S.st_k1; } while (0)
#define SWRITE_HV(bf) do { *(bf16x8*)(V_lds + (bf) * SHM_V + vst0) = S.st_v0; *(bf16x8*)(V_lds + (bf) * SHM_V + vst1) = S.st_v1; } while (0)
#define SWRITE_H(bf) do { SWRITE_HV(bf); SWRITE_HK(bf); } while (0)
#define SLOAD_F(p, k0) do { S.sf0 = *(const f32x4*)ROW(p, k0, sr); S.sf1 = *(const f32x4*)(ROW(p, k0, sr) + 4);                \
                            S.sf2 = *(const f32x4*)ROW(p, k0, 32 + sr); S.sf3 = *(const f32x4*)(ROW(p, k0, 32 + sr) + 4); } while (0)
#define SWRITE_KF(bf) do { *(bf16x8*)(K_lds + (bf) * SHM_K + kws) = pack8(S.sf0, S.sf1); *(bf16x8*)(K_lds + (bf) * SHM_K + kws + 32 * 256) = pack8(S.sf2, S.sf3); } while (0)
#define SWRITE_VF(bf) do { *(bf16x8*)(V_lds + (bf) * SHM_V + vst0) = pack8(S.sf0, S.sf1); *(bf16x8*)(V_lds + (bf) * SHM_V + vst1) = pack8(S.sf2, S.sf3); } while (0)
template <class TIn, class TOut>
__device__ __forceinline__ void causal_swa_prime(const BlockRef<TIn, TOut>& cur, int W, char* lds, Seam<TIn>& S, __amdgpu_buffer_rsrc_t rs) {
    constexpr bool F32 = same_t<TIn, float>::v;
    const int tid = lz_tid(), wid = __builtin_amdgcn_readfirstlane(tid >> 6), lane = tid & 63, r32 = lane & 31, hi = lane >> 5;
    const int sr = tid >> 4, sc = (tid & 15) * 8, kws = KSWZ(sr, sc * 2); char* K_lds = lds + 2 * SHM_V; float* cb_l = (float*)(lds + LDS_CB); const unsigned vo_st = (unsigned)(sr * D + sc) * 2u;
    const int kb0 = swa_jlo(cur.P0, W) * KVBLK;
    for (int d0 = 0; d0 < 8; ++d0) S.qr[d0] = load8<TIn>(cur.Q + (unsigned)((wid * QBLK + r32) * D + d0 * 16 + hi * 8));
    if constexpr (F32) { SLOAD_F((const float*)cur.K, kb0); VMW(); SWRITE_KF(0); SBAR(); SLOAD_F((const float*)cur.V, kb0); }
    else { SLOAD_H(cur.K, cur.V, cur.C, kb0); VMW(); SWRITE_HK(0); }
    __syncthreads();
}
template <class TIn, class TOut>
__device__ __forceinline__ void causal_swa_block(const BlockRef<TIn, TOut>& cur, const BlockRef<TIn, TOut>& nxt, int skv, int W, char* lds, Seam<TIn>& S, __amdgpu_buffer_rsrc_t rs) {
    constexpr bool F32 = same_t<TIn, float>::v;
    const int tid = lz_tid(), wid = __builtin_amdgcn_readfirstlane(tid >> 6), lane = tid & 63, r32 = lane & 31, hi = lane >> 5;
    const int j_lo = swa_jlo(cur.P0, W);
    int j_hi = (cur.P0 + QB - 1) / KVBLK + 1; if (j_hi > skv / KVBLK) j_hi = skv / KVBLK;
    const int NT = j_hi - j_lo;
    const int kbn = swa_jlo(nxt.P0, W) * KVBLK;
    const int qlo = cur.P0 + wid * QBLK, qm = qlo + r32 - 4 * hi;
    char* V_lds = lds; char* K_lds = lds + 2 * SHM_V; float* cb_l = (float*)(lds + LDS_CB);
    float* ws = (float*)(lds + 2 * SHM_V + 2 * SHM_K) + wid * 64; float* li_l = ws, * al_l = ws + 32;
    float m_reg = -1e30f, l_reg = 0; f32x16 o[4] = {};
    const unsigned vo_st = (unsigned)((tid >> 4) * D + (tid & 15) * 8) * 2u; const int sr = tid >> 4, sc = (tid & 15) * 8, vst0 = v_st(sr, sc), vst1 = v_st(32 + sr, sc), kws = KSWZ(sr, sc * 2);
    const int vb0 = (int)(uintptr_t)V_lds + v_rd_base(lane);
    const unsigned Kh = cur.K, Vh = cur.V, Ch = cur.C;
#define RESC(a) do { if (__any((a) < 1.f)) { if (hi == 0) al_l[r32] = (a); asm volatile("s_waitcnt lgkmcnt(0)" ::: "memory");              \
                     for (int d_ = 0; d_ < 4; ++d_) for (int r = 0; r < 16; ++r) o[d_][r] *= al_l[crow(r, hi)]; } } while (0)
#define KBASE(t) ((j_lo + (t)) * KVBLK)
#define ACT(t) (KBASE(t) <= qlo + QBLK - 1 && KBASE(t) + KVBLK - 1 >= qlo - W + 1)
#define MASKT(P0_, P1_, t) do { const int kb_ = KBASE(t); if ((!SK || ACT(t)) && (kb_ + KVBLK - 1 > qlo || kb_ <= qlo + QBLK - 1 - W)) mask_tile(P0_, P1_, qm - kb_, (unsigned)W); } while (0)
    constexpr int NQL = F32 ? 16 : 8;
    constexpr bool SK = WSKIP && !F32;
#define SEAM_K0() do { VMWN(NQL); if constexpr (F32) { SWRITE_KF(0); SBAR(); SLOAD_F((const float*)nxt.V, kbn); } else { SWRITE_HK(0); } SBAR(); } while (0)
    f32x16 pA0, pA1, pB0, pB1; float mnA, mnB, alA, alB; bf16x8 pa0, pa1, pa2, pa3;
    if constexpr (F32) { VMW(); SWRITE_VF(0); SBAR(); } else { SWRITE_HV(0); SBAR(); }
    if (NT > 1) { if constexpr (F32) SLOAD_F((const float*)Kh, KBASE(1)); else SLOAD_H(Kh, Vh, Ch, KBASE(1)); }
    SBAR(); qkt<0, SK>(pA0, pA1, K_lds, cb_l, r32, hi, S.qr, ACT(0));
    if constexpr (F32) { if (NT > 1) { VMW(); SWRITE_KF(1); SBAR(); SLOAD_F((const float*)Vh, KBASE(1)); } }
    MASKT(pA0, pA1, 0); partialSM(pA0, pA1, m_reg, mnA, alA);
    if (NT > 1) { VMW(); if constexpr (F32) { SWRITE_VF(1); SBAR(); if (NT > 2) SLOAD_F((const float*)Kh, KBASE(2)); } else SWRITE_H(1); }
    __syncthreads();
#define HALF_STEP(PX0, PX1, mnX, alX, PY0, PY1, alY, t, KB, VB, SB) do {                                                      \
        SBAR(); qkt<KB, SK>(PX0, PX1, K_lds, cb_l, r32, hi, S.qr, ACT(t));                                             \
        finishSM(PY0, PY1, alY, l_reg, pa0, pa1, pa2, pa3); SBAR();                                                           \
        if ((t) + 1 < NT) { if constexpr (F32) { VMW(); SWRITE_KF(SB); SBAR(); SLOAD_F((const float*)Vh, KBASE((t) + 1)); }  \
                            else { SLOAD_H(Kh, Vh, Ch, KBASE((t) + 1)); } SBAR(); }                                               \
        pv_tile<VB, SK>(o, vb0, pa0, pa1, pa2, pa3, ACT((t) - 1)); MASKT(PX0, PX1, (t)); partialSM(PX0, PX1, m_reg, mnX, alX);                                        \
        __syncthreads();                                                                                                      \
        if ((t) + 1 < NT) { VMW(); if constexpr (F32) { SWRITE_VF(SB); SBAR(); if ((t) + 2 < NT) SLOAD_F((const float*)Kh, KBASE((t) + 2)); } \
                            else { SWRITE_H(SB); } }                                                                          \
        RESC(alX); __syncthreads(); } while (0)
    for (int t = 1; t + 1 < NT; t += 2) {
        HALF_STEP(pB0, pB1, mnB, alB, pA0, pA1, alA, t, 1, 0, 0);
        HALF_STEP(pA0, pA1, mnA, alA, pB0, pB1, alB, t + 1, 0, 1, 1);
    }
    const bool even = (NT & 1) == 0;
    if (even) { SBAR(); qkt<1, SK>(pB0, pB1, K_lds, cb_l, r32, hi, S.qr, ACT(NT - 1)); SBAR(); }
#define QROW(e) (nxt.Q + (size_t)(wid * QBLK + r32) * D + ((e) >> 1) * 16 + hi * 8 + ((e) & 1) * 4)
    if constexpr (F32) { SLOAD_F((const float*)nxt.K, kbn); SBAR();
#pragma unroll
        for (int e = 0; e < 8; ++e) S.tq[e] = *(const f32x4*)QROW(e); }
    else { SLOAD_H(nxt.K, nxt.V, nxt.C, kbn); SBAR();
#pragma unroll
        for (int d0 = 0; d0 < 8; ++d0) S.qr[d0] = load8<TIn>(nxt.Q + (unsigned)((wid * QBLK + r32) * D + d0 * 16 + hi * 8)); }
    SBAR();
    finishSM(pA0, pA1, alA, l_reg, pa0, pa1, pa2, pa3); SBAR();
    if constexpr (F32) {
#pragma unroll
        for (int e = 8; e < 16; ++e) S.tq[e] = *(const f32x4*)QROW(e); SBAR(); }
#undef QROW
    pv_tile<0, SK>(o, vb0, pa0, pa1, pa2, pa3, ACT(even ? NT - 2 : NT - 1));
    if (even) { MASKT(pB0, pB1, NT - 1); partialSM(pB0, pB1, m_reg, mnB, alB); __syncthreads(); RESC(alB);
        finishSM(pB0, pB1, alB, l_reg, pa0, pa1, pa2, pa3); SBAR(); pv_tile<1, SK>(o, vb0, pa0, pa1, pa2, pa3, ACT(NT - 1)); }
    SBAR(); SEAM_K0();
    if (hi == 0) li_l[r32] = l_reg; asm volatile("s_waitcnt lgkmcnt(0)" ::: "memory");
    float rli[16];
#pragma unroll
    for (int r = 0; r < 16; ++r) rli[r] = __builtin_amdgcn_rcpf(li_l[crow(r, hi)]);
    TOut* Ow = cur.O + (size_t)(wid * QBLK) * OSTR;
    { float msv[4];
#pragma unroll
      for (int d0 = 0; d0 < 4; ++d0) msv[d0] = cur.MS[d0 * 32 + r32];
#pragma unroll
      for (int r = 0; r < 16; ++r) { const int orow = crow(r, hi);
        float v0 = o[0][r] * rli[r], v1 = o[1][r] * rli[r], v2 = o[2][r] * rli[r], v3 = o[3][r] * rli[r];
        float sm = (v0 + v1) + (v2 + v3);
#pragma unroll
        for (int off = 1; off < 32; off <<= 1) sm += __shfl_xor(sm, off);
        const float mu = sm * (1.0f / 128.0f);
        v0 -= mu; v1 -= mu; v2 -= mu; v3 -= mu;
        float sq = (v0 * v0 + v1 * v1) + (v2 * v2 + v3 * v3);
#pragma unroll
        for (int off = 1; off < 32; off <<= 1) sq += __shfl_xor(sq, off);
        const float rstd = 1.0f / sqrtf(sq * (1.0f / 128.0f) + 1e-6f);
        float vv[4] = {v0 * rstd * msv[0], v1 * rstd * msv[1], v2 * rstd * msv[2], v3 * rstd * msv[3]};
#pragma unroll
        for (int d0 = 0; d0 < 4; ++d0) { const float v = vv[d0]; const float vn = __shfl_xor(v, 1);
            if ((r32 & 1) == 0) *(unsigned*)(Ow + (unsigned)(orow * OSTR + d0 * 32 + r32)) = cvtpk(v, vn); } } }
    if constexpr (F32) {
#pragma unroll
        for (int d0 = 0; d0 < 8; ++d0) S.qr[d0] = pack8(S.tq[2 * d0], S.tq[2 * d0 + 1]); }
    __syncthreads();
#undef RESC
#undef KBASE
#undef ACT
#undef MASKT
#undef SEAM_K0
#undef HALF_STEP
}
#undef ROW
#undef VMW
#undef VMWN
#undef SLOAD_H
#undef SWRITE_HK
#undef SWRITE_HV
#undef SWRITE_H
#undef SLOAD_F
#undef SWRITE_KF
#undef SWRITE_VF
#undef SBAR
}

#define LAS __attribute__((address_space(3)))
typedef unsigned short bf16r;
typedef unsigned v4u __attribute__((ext_vector_type(4)));
typedef unsigned v2u __attribute__((ext_vector_type(2)));
typedef float v4f __attribute__((ext_vector_type(4)));
typedef float v16f __attribute__((ext_vector_type(16)));
typedef short v8s __attribute__((ext_vector_type(8)));
typedef short v4s __attribute__((ext_vector_type(4)));

#define XB_TMO      128
#define XB_XCNT(j)  (256  + 64 * (j))
#define XB_XSUB(j)  (1280 + 64 * (j))
#define XB_XGEN(j)  (2304 + 64 * (j))
#define XB_TOP      3328
#define XB_TOPGEN   3392
#define XCD_BAR_WORDS 3456
#define XB_SPIN_CAP (1u << 18)

__device__ __forceinline__ unsigned xb_ld(unsigned* p)              { return __hip_atomic_load(p, __ATOMIC_RELAXED, __HIP_MEMORY_SCOPE_AGENT); }
__device__ __forceinline__ unsigned xb_add(unsigned* p, unsigned v) { return __hip_atomic_fetch_add(p, v, __ATOMIC_RELAXED, __HIP_MEMORY_SCOPE_AGENT); }
__device__ __forceinline__ unsigned xb_xcc_id() { return (unsigned)__builtin_amdgcn_s_getreg((3 << 11) | 20) & 0xFu; }
#define XB_SPIN(cond, bar) do { unsigned _sp = 0; while (cond) { __builtin_amdgcn_s_sleep(1); \
    if ((++_sp & 255u) == 0u) { if (xb_ld(&(bar)[XB_TMO])) break; if (_sp > XB_SPIN_CAP) { atomicAdd(&(bar)[XB_TMO], 1u); break; } } } } while (0)

struct XcdBarrier {
    unsigned* bar; unsigned x;
    volatile LAS unsigned* st;
};

__device__ __forceinline__ XcdBarrier xcd_barrier_post(unsigned* bar, volatile LAS unsigned* st) {
    XcdBarrier b; b.bar = bar; b.x = xb_xcc_id(); b.st = st;
    if (lz_tid() == 0) (void)xb_add(&bar[XB_XCNT(b.x)], 1u);
    return b;
}
__device__ __forceinline__ void xcd_barrier_complete(unsigned* bar, unsigned x, unsigned& nloc, unsigned& nx) {
    const unsigned G = gridDim.x * gridDim.y * gridDim.z;
    unsigned sum, cnt, mine, sp = 0u;
    for (;;) {
        sum = 0u; cnt = 0u; mine = 0u;
#pragma unroll
        for (unsigned j = 0; j < 16; ++j) { const unsigned c = xb_ld(&bar[XB_XCNT(j)]); sum += c; cnt += (c > 0u) ? 1u : 0u; mine = (j == x) ? c : mine; }
        if (sum == G) break;
        __builtin_amdgcn_s_sleep(1);
        if ((++sp & 255u) == 0u) { if (xb_ld(&bar[XB_TMO])) break; if (sp > XB_SPIN_CAP) { atomicAdd(&bar[XB_TMO], 1u); break; } }
    }
    nloc = mine > 0u ? mine : 1u; nx = cnt > 0u ? cnt : 1u;
}

__device__ __forceinline__ void xcd_barrier(const XcdBarrier& b) {
    asm volatile("s_waitcnt vmcnt(0)" ::: "memory");
    __syncthreads();
    if (lz_tid() == 0) {
        unsigned* bar = b.bar;
        __builtin_amdgcn_s_waitcnt(0);
        unsigned nloc = b.st[0], nx = b.st[1];
        if (nloc == 0u) { xcd_barrier_complete(bar, b.x, nloc, nx); b.st[0] = nloc; b.st[1] = nx; }
        const unsigned old = xb_add(&bar[XB_XSUB(b.x)], 1u);
        const unsigned gen = old / nloc;
        if (old + 1u == (gen + 1u) * nloc) {
            __builtin_amdgcn_fence(__ATOMIC_RELEASE, "agent");
            asm volatile("s_waitcnt vmcnt(0)" ::: "memory");
            const unsigned og = xb_add(&bar[XB_TOP], 1u);
            const unsigned tg = og / nx;
            if (og + 1u == (tg + 1u) * nx) xb_add(&bar[XB_TOPGEN], 1u);
            else XB_SPIN(xb_ld(&bar[XB_TOPGEN]) == tg, bar);
            __builtin_amdgcn_fence(__ATOMIC_ACQUIRE, "agent");
            xb_add(&bar[XB_XGEN(b.x)], 1u);
            asm volatile("s_waitcnt vmcnt(0)" ::: "memory");
        } else {
            XB_SPIN(xb_ld(&bar[XB_XGEN(b.x)]) == gen, bar);
            __builtin_amdgcn_fence(__ATOMIC_ACQUIRE, "agent");
            asm volatile("s_waitcnt vmcnt(0)" ::: "memory");
        }
    }
    __syncthreads();
}

constexpr size_t MiB = 1u << 20;
constexpr size_t WS_QK2 = 14336, WS_QCTR = 15360;
constexpr size_t WS_JT = 20480;
constexpr size_t WS_WG = 1 * MiB, WG_BYTES = 32 * DM * 2;
constexpr size_t WS_MOD = 64 * 1024;
constexpr size_t WS_WIN = 2 * MiB, WIN_BYTES = (size_t)NINP * DM * 2;
constexpr size_t WS_WOUT = 60 * MiB, WOUT_BYTES = (size_t)DM * DM * 2;
constexpr size_t WS_WFF1 = 76 * MiB, WFF_BYTES = (size_t)DFF * DM * 2;
constexpr size_t WS_WFF2 = 140 * MiB;
constexpr size_t WS_H = 204 * MiB;
constexpr size_t WS_P = 332 * MiB;
constexpr size_t WS_Y = 780 * MiB;
constexpr size_t WS_HID = WS_P;
constexpr size_t WS_GATES = 908 * MiB;
constexpr size_t WS_CNEG = 910 * MiB;
constexpr size_t WS_MA = 911 * MiB, WS_MCM = WS_MA + 512 * 1024, WS_MB = WS_MCM + 512 * 1024;
constexpr size_t WS_MPREV = 913 * MiB;
constexpr size_t WS_UN = 914 * MiB;
constexpr size_t WS_MQC = 916 * MiB;
constexpr size_t WS_END = 980 * MiB;
static_assert(WS_WIN + 2 * WIN_BYTES <= WS_WOUT && WS_HID + (size_t)MROWS * DFF * 2 <= WS_Y + (size_t)MROWS * DM * 2 && WS_MQC + (size_t)8 * MROWS * 128 * 2 <= WS_END, "ws map");

constexpr int LDS_BYTES = 147456;

__device__ __forceinline__ float wave_sum(float v) {
#pragma unroll
    for (int o = 1; o < 64; o <<= 1) v += __shfl_xor(v, o);
    return v;
}
typedef float pkf2_t __attribute__((ext_vector_type(2))); typedef __bf16 pkb2_t __attribute__((ext_vector_type(2)));
__device__ __forceinline__ unsigned pk2(float lo, float hi) { pkf2_t v = {lo, hi}; pkb2_t b = __builtin_convertvector(v, pkb2_t); return __builtin_bit_cast(unsigned, b); }
__device__ __forceinline__ float bflo(unsigned w) { return __uint_as_float(w << 16); }
__device__ __forceinline__ float bfhi(unsigned w) { return __uint_as_float(w & 0xffff0000u); }
__device__ __forceinline__ float bf1(bf16r h) { return __uint_as_float((unsigned)h << 16); }
__device__ __forceinline__ float log_sigmoid(float x) { return fminf(x, 0.f) - log1pf(expf(-fabsf(x))); }
__device__ __forceinline__ float swap_add(float v) { auto rr = __builtin_amdgcn_permlane32_swap(__float_as_uint(v), __float_as_uint(v), false, false); return __uint_as_float(rr[0]) + __uint_as_float(rr[1]); }

struct Args { const void* in[18]; float* out; unsigned char* ws; int ph_lo, ph_hi; };
typedef const __attribute__((address_space(4))) Args CArgs;
__device__ __forceinline__ CArgs* fresh_args() { CArgs* p = (CArgs*)__builtin_amdgcn_kernarg_segment_ptr(); asm volatile("" : "+s"(p)); return p; }

__device__ __forceinline__ int win_src(int n) { return n < 5120 ? n : n + 8; }
__device__ __forceinline__ int wg_src(int n) { return n < 8 ? 5120 + n : (n < 16 ? 7176 + (n - 8) : -1); }
template <int MAP>
__device__ __forceinline__ void transpose_item(const float* W, int K, int N, bf16r* WT, LAS float* scr, int item, int nblk, int lane) {
    const int kb = item / nblk, nb = item % nblk, k0 = 64 * kb, n0 = 32 * nb;
    int sc = n0 + (lane & 31); if (MAP == 1) sc = win_src(sc); else if (MAP == 2) sc = wg_src(sc);
#ifdef OLD_P0
#pragma unroll 8
    for (int i = 0; i < 32; ++i) { const int kk = 2 * i + (lane >> 5); scr[kk * 33 + (lane & 31)] = sc >= 0 ? W[(size_t)(k0 + kk) * N + sc] : 0.f; }
#else
    float tv[32];
#pragma unroll
    for (int i = 0; i < 32; ++i) { const int kk = 2 * i + (lane >> 5); tv[i] = sc >= 0 ? W[(size_t)(k0 + kk) * N + sc] : 0.f; }
#pragma unroll
    for (int i = 0; i < 32; ++i) { const int kk = 2 * i + (lane >> 5); scr[kk * 33 + (lane & 31)] = tv[i]; }
#endif
    asm volatile("s_waitcnt lgkmcnt(0)" ::: "memory");
    const int c = lane & 7;
#pragma unroll
    for (int j = 0; j < 4; ++j) { const int n = (lane >> 3) + 8 * j; const LAS float* s = scr + (8 * c) * 33 + n;
        v4u o; o.x = pk2(s[0 * 33], s[1 * 33]); o.y = pk2(s[2 * 33], s[3 * 33]); o.z = pk2(s[4 * 33], s[5 * 33]); o.w = pk2(s[6 * 33], s[7 * 33]);
        *(v4u*)(WT + (size_t)(n0 + n) * K + k0 + 8 * c) = o; }
    asm volatile("s_waitcnt lgkmcnt(0)" ::: "memory");
}
__device__ __forceinline__ void p0_phase(CArgs& a, LAS unsigned char* lds) {
    const int tid = lz_tid(), lane = tid & 63, wave = tid >> 6, G = gridDim.x;
    unsigned char* ws = a.ws;
    { LAS float* cond = (LAS float*)lds; LAS float* red = (LAS float*)(lds + 16384);
      const float* c = (const float*)a.in[1]; const float* ada_w = (const float*)a.in[3]; const float* ada_b = (const float*)a.in[4]; float* MOD = (float*)(ws + WS_MOD);
      for (int i = tid; i < NB * DM; i += 512) { const float cv = c[i]; cond[i] = cv / (1.f + expf(-cv)); }
      __syncthreads();
      for (int item = lz_bid(); item < 2 * (NMOD / 64); item += G) {
          const int layer = item / (NMOD / 64), cgp = item % (NMOD / 64), col = cgp * 64 + lane, kq = wave;
          const float* W = ada_w + (size_t)layer * DM * NMOD + col;
          float a0 = 0.f, a1 = 0.f;
#ifdef OLD_P0
#pragma unroll 8
#else
#pragma unroll 32
#endif
          for (int k = kq * 256; k < kq * 256 + 256; ++k) { const float w = W[(size_t)k * NMOD]; a0 += cond[k] * w; a1 += cond[DM + k] * w; }
          red[(kq * 2 + 0) * 64 + lane] = a0; red[(kq * 2 + 1) * 64 + lane] = a1;
          __syncthreads();
          if (tid < 128) { const int b = tid >> 6; float s = 0.f;
#pragma unroll
              for (int q = 0; q < 8; ++q) s += red[(q * 2 + b) * 64 + lane];
              MOD[(size_t)(layer * NB + b) * NMOD + cgp * 64 + lane] = s + ada_b[(size_t)layer * NMOD + cgp * 64 + lane]; }
          __syncthreads();
      } }
    { LAS float* scr = (LAS float*)(lds + wave * 16384);
      const int gw = lz_bid() * 8 + wave, NGW = G * 8;
      constexpr int I_IN = (DM / 64) * (NINP / 32), I_OUT = (DM / 64) * (DM / 32), I_F1 = (DM / 64) * (DFF / 32), I_F2 = (DFF / 64) * (DM / 32), I_G = DM / 64, I_L = I_IN + I_OUT + I_F1 + I_F2 + I_G;
      for (int it = gw; it < 2 * I_L; it += NGW) {
          const int layer = it / I_L; int r = it % I_L;
          if (r < I_IN) { transpose_item<1>((const float*)a.in[7] + (size_t)layer * DM * DIN, DM, DIN, (bf16r*)(ws + WS_WIN + layer * WIN_BYTES), scr, r, NINP / 32, lane); continue; } r -= I_IN;
          if (r < I_G) { transpose_item<2>((const float*)a.in[7] + (size_t)layer * DM * DIN, DM, DIN, (bf16r*)(ws + WS_WG + layer * WG_BYTES), scr, r, 1, lane); continue; } r -= I_G;
          if (r < I_OUT) { transpose_item<0>((const float*)a.in[14] + (size_t)layer * DM * DM, DM, DM, (bf16r*)(ws + WS_WOUT + layer * WOUT_BYTES), scr, r, DM / 32, lane); continue; } r -= I_OUT;
          if (r < I_F1) { transpose_item<0>((const float*)a.in[15] + (size_t)layer * DM * DFF, DM, DFF, (bf16r*)(ws + WS_WFF1 + layer * WFF_BYTES), scr, r, DFF / 32, lane); continue; } r -= I_F1;
          transpose_item<0>((const float*)a.in[16] + (size_t)layer * DFF * DM, DFF, DM, (bf16r*)(ws + WS_WFF2 + layer * WFF_BYTES), scr, r, DM / 32, lane);
      } }
}

__device__ __forceinline__ void gate_gemm(const bf16r* H, const bf16r* WG, float* gates) {
    const int tid = lz_tid(), lane = tid & 63, wave = __builtin_amdgcn_readfirstlane(tid >> 6), r32 = lane & 31, hi = lane >> 5;
    if (wave >= 4) return;
    for (int rb = lz_bid(); rb < MROWS / 128; rb += gridDim.x) {
        const int r0 = rb * 128 + wave * 32;
        const bf16r* ap = H + (size_t)(r0 + r32) * DM + 8 * hi; const bf16r* bp = WG + (size_t)r32 * DM + 8 * hi;
        v16f acc = {};
#pragma unroll 16
        for (int ks = 0; ks < DM / 16; ++ks) { const v8s af = *(const v8s*)(ap + ks * 16), bf = *(const v8s*)(bp + ks * 16); acc = __builtin_amdgcn_mfma_f32_32x32x16_bf16(af, bf, acc, 0, 0, 0); }
        if (r32 < 16) {
#pragma unroll
            for (int r = 0; r < 16; ++r) gates[(size_t)(r0 + (r & 3) + 8 * (r >> 2) + 4 * hi) * 16 + r32] = acc[r]; }
    }
}

__device__ __forceinline__ void norm_phase(const float* x, const float* w, const float* sh, const float* sc, bf16r* H) {
    const int lane = lz_tid() & 63, gw = lz_bid() * 8 + (lz_tid() >> 6), NGW = gridDim.x * 8;
    v4f nx[8];
    if (gw < MROWS) { const v4f* xr0 = (const v4f*)(x + (size_t)gw * DM) + lane;
#pragma unroll
        for (int j = 0; j < 8; ++j) nx[j] = xr0[64 * j]; }
    for (int m = gw; m < MROWS; m += NGW) {
        const int b = m / SEQ;
        v4f v[8]; float s = 0.f;
#pragma unroll
        for (int j = 0; j < 8; ++j) v[j] = nx[j];
        if (m + NGW < MROWS) { const v4f* xr1 = (const v4f*)(x + (size_t)(m + NGW) * DM) + lane;
#pragma unroll
            for (int j = 0; j < 8; ++j) nx[j] = xr1[64 * j]; }
#pragma unroll
        for (int j = 0; j < 8; ++j) s += (v[j].x * v[j].x + v[j].y * v[j].y) + (v[j].z * v[j].z + v[j].w * v[j].w);
        const float rstd = 1.0f / sqrtf(wave_sum(s) * (1.f / DM) + NORM_EPS);
        v2u* o = (v2u*)(H + (size_t)m * DM) + lane;
#pragma unroll
        for (int j = 0; j < 8; ++j) { const int c = 4 * lane + 256 * j;
            const v4f wv = *(const v4f*)(w + c), sv = *(const v4f*)(sc + (size_t)b * NMOD + c), hv = *(const v4f*)(sh + (size_t)b * NMOD + c);
            const v4f y = v[j] * rstd * wv * (sv + 1.0f) + hv;
            v2u p; p.x = pk2(y.x, y.y); p.y = pk2(y.z, y.w); o[64 * j] = p; }
    }
}
__device__ __forceinline__ void final_norm_phase(float* x, const float* w) {
    const int lane = lz_tid() & 63, gw = lz_bid() * 8 + (lz_tid() >> 6), NGW = gridDim.x * 8;
    v4f nx[8];
    if (gw < MROWS) { const v4f* xr0 = (const v4f*)(x + (size_t)gw * DM) + lane;
#pragma unroll
        for (int j = 0; j < 8; ++j) nx[j] = xr0[64 * j]; }
    for (int m = gw; m < MROWS; m += NGW) {
        v4f* xr = (v4f*)(x + (size_t)m * DM) + lane;
        v4f v[8]; float s = 0.f;
#pragma unroll
        for (int j = 0; j < 8; ++j) v[j] = nx[j];
        if (m + NGW < MROWS) { const v4f* xr1 = (const v4f*)(x + (size_t)(m + NGW) * DM) + lane;
#pragma unroll
            for (int j = 0; j < 8; ++j) nx[j] = xr1[64 * j]; }
#pragma unroll
        for (int j = 0; j < 8; ++j) s += (v[j].x * v[j].x + v[j].y * v[j].y) + (v[j].z * v[j].z + v[j].w * v[j].w);
        const float rstd = 1.0f / sqrtf(wave_sum(s) * (1.f / DM) + NORM_EPS);
#pragma unroll
        for (int j = 0; j < 8; ++j) { const v4f wv = *(const v4f*)(w + 4 * lane + 256 * j); xr[64 * j] = v[j] * rstd * wv; }
    }
}

__device__ __forceinline__ void fox_cumsum_item(CArgs& a, int layer, int item, LAS unsigned char* lds) {
    const int tid = lz_tid(), b = item >> 3, h = item & 7;
    const float* gates = (const float*)(a.ws + WS_GATES); float* cneg = (float*)(a.ws + WS_CNEG) + (size_t)item * SEQ;
    const float bias = ((const float*)a.in[10])[layer * 8 + h];
    LAS double* tot = (LAS double*)lds;
    double sum = 0.0;
    const float* gp = gates + ((size_t)b * SEQ + (size_t)tid * 32) * 16 + h;
#pragma unroll 4
    for (int i = 0; i < 32; ++i) sum += (double)log_sigmoid(gp[i * 16] + bias);
    tot[tid] = sum;
    __syncthreads();
    if (tid == 0) { double run = 0.0; for (int i = 0; i < 512; ++i) { const double t = tot[i]; tot[i] = run; run += t; } }
    __syncthreads();
    double run = tot[tid];
#pragma unroll 2
    for (int i = 0; i < 32; i += 4) { v4f o;
        run += (double)log_sigmoid(gp[(i + 0) * 16] + bias); o.x = (float)(-run * 11.313708498984761);
        run += (double)log_sigmoid(gp[(i + 1) * 16] + bias); o.y = (float)(-run * 11.313708498984761);
        run += (double)log_sigmoid(gp[(i + 2) * 16] + bias); o.z = (float)(-run * 11.313708498984761);
        run += (double)log_sigmoid(gp[(i + 3) * 16] + bias); o.w = (float)(-run * 11.313708498984761);
        *(v4f*)(cneg + tid * 32 + i) = o; }
    __syncthreads();
}
__device__ __forceinline__ void mlstm_scan_item(CArgs& a, int layer, int item, LAS unsigned char* lds) {
    const int tid = lz_tid(), lane = tid & 63, wave = tid >> 6, b = item >> 2, h = item & 3;
    const float* gates = (const float*)(a.ws + WS_GATES);
    float* MA = (float*)(a.ws + WS_MA) + (size_t)item * SEQ; float* MCM = (float*)(a.ws + WS_MCM) + (size_t)item * SEQ; float* MBv = (float*)(a.ws + WS_MB) + (size_t)item * SEQ;
    float* MPREV = (float*)(a.ws + WS_MPREV) + item * 256;
    const float ib = ((const float*)a.in[11])[layer * 4 + h], fb = ((const float*)a.in[12])[layer * 4 + h];
    LAS float* Bc = (LAS float*)lds; LAS float* Ac = Bc + 256;
#pragma unroll 4
    for (int c = wave; c < 256; c += 8) {
        const size_t m = (size_t)b * SEQ + c * 64 + lane;
        const float ig = gates[m * 16 + 8 + h] + ib, fg = gates[m * 16 + 12 + h] + fb;
        float bb = log_sigmoid(fg);
#pragma unroll
        for (int o = 1; o < 64; o <<= 1) { const float t = __shfl_up(bb, o); if (lane >= o) bb += t; }
        const float av = ig - bb; float cm = av;
#pragma unroll
        for (int o = 1; o < 64; o <<= 1) { const float t = __shfl_up(cm, o); if (lane >= o) cm = fmaxf(cm, t); }
        MA[c * 64 + lane] = av; MCM[c * 64 + lane] = cm; MBv[c * 64 + lane] = bb;
        if (lane == 63) { Bc[c] = bb; Ac[c] = cm; }
    }
    __syncthreads();
    if (tid == 0) { float mm = 0.f; for (int c = 0; c < 256; ++c) { MPREV[c] = mm; mm = Bc[c] + fmaxf(mm, Ac[c]); } }
    __syncthreads();
}
__device__ __forceinline__ void prep_phase(CArgs& a, int layer, LAS unsigned char* lds) {
    const int tid = lz_tid(), bid = lz_bid(), G = gridDim.x;
    if (bid < 16) { fox_cumsum_item(a, layer, bid, lds); return; }
    if (bid < 24) { mlstm_scan_item(a, layer, bid - 16, lds); return; }
    const int wk = bid - 24, NWK = G - 24;
    bf16r* P = (bf16r*)(a.ws + WS_P);
    { const int jg = tid & 7; double invf[8];
#pragma unroll
      for (int i = 0; i < 8; ++i) { double r = 1.0, bs = 0.8659643233600653; int e = 8 * jg + i;
#pragma unroll
          for (int q = 0; q < 6; ++q) { if (e & 1) r *= bs; bs *= bs; e >>= 1; }
          invf[i] = r * 0.15915494309189535; }
      const int* positions = (const int*)a.in[2];
      for (int it0 = wk; it0 < 8 * MROWS / 64; it0 += 4 * NWK) {
          v4u A[4], Bv[4]; bf16r* pp[4]; int mm[4], sl[4];
#pragma unroll
          for (int q = 0; q < 4; ++q) { const int it = it0 + q * NWK; const bool ok = it < 8 * MROWS / 64; const int grow = (ok ? it : wk) * 64 + (tid >> 3); sl[q] = ok ? grow / MROWS : -1; mm[q] = grow % MROWS;
              pp[q] = P + ((size_t)(grow / MROWS) * MROWS + mm[q]) * 128 + 8 * jg; A[q] = *(const v4u*)pp[q]; Bv[q] = *(const v4u*)(pp[q] + 64); }
#pragma unroll
          for (int q = 0; q < 4; ++q) { if (sl[q] < 0) continue;
              const double pos = (double)positions[mm[q]]; const float sc = sl[q] >= 4 ? KSCALE : 1.0f;
              float t1[8] = {bflo(A[q].x), bfhi(A[q].x), bflo(A[q].y), bfhi(A[q].y), bflo(A[q].z), bfhi(A[q].z), bflo(A[q].w), bfhi(A[q].w)};
              float t2[8] = {bflo(Bv[q].x), bfhi(Bv[q].x), bflo(Bv[q].y), bfhi(Bv[q].y), bflo(Bv[q].z), bfhi(Bv[q].z), bflo(Bv[q].w), bfhi(Bv[q].w)};
              float o1[8], o2[8];
#pragma unroll
              for (int i = 0; i < 8; ++i) { const double rev = pos * invf[i]; const float fr = (float)(rev - floor(rev));
                  const float sn = __builtin_amdgcn_sinf(fr) * sc, cs = __builtin_amdgcn_cosf(fr) * sc;
                  o1[i] = t1[i] * cs - t2[i] * sn; o2[i] = t2[i] * cs + t1[i] * sn; }
              v4u oa, ob; oa.x = pk2(o1[0], o1[1]); oa.y = pk2(o1[2], o1[3]); oa.z = pk2(o1[4], o1[5]); oa.w = pk2(o1[6], o1[7]);
              ob.x = pk2(o2[0], o2[1]); ob.y = pk2(o2[2], o2[3]); ob.z = pk2(o2[4], o2[5]); ob.w = pk2(o2[6], o2[7]);
              *(v4u*)pp[q] = oa; *(v4u*)(pp[q] + 64) = ob; }
      } }
    { const int slot = wk % 8, sub = wk / 8, nsub = (NWK - slot + 7) / 8, cgp = tid & 15;
      const float* cw = (const float*)a.in[8] + (size_t)layer * 4 * 1024 + slot * 128 + 8 * cgp; const float* cbv = (const float*)a.in[9] + (size_t)layer * 1024 + slot * 128 + 8 * cgp;
      float w[4][8], bsv[8];
#pragma unroll
      for (int j = 0; j < 4; ++j)
#pragma unroll
          for (int i = 0; i < 8; ++i) w[j][i] = cw[j * 1024 + i];
#pragma unroll
      for (int i = 0; i < 8; ++i) bsv[i] = cbv[i];
      const bf16r* __restrict__ src = P + (size_t)(40 + slot) * MROWS * 128 + 8 * cgp; bf16r* __restrict__ dst = (bf16r*)(a.ws + WS_MQC) + (size_t)slot * MROWS * 128 + 8 * cgp;
      const float sc = slot >= 4 ? KSCALE : 1.0f;
#pragma unroll 2
      for (int rb = sub; rb < MROWS / 32; rb += nsub) {
          const int row = rb * 32 + (tid >> 4), s = row % SEQ;
          float acc[8];
#pragma unroll
          for (int i = 0; i < 8; ++i) acc[i] = bsv[i];
#pragma unroll
          for (int j = 0; j < 4; ++j) { if (s - 3 + j >= 0) { const v4u X = *(const v4u*)(src + (size_t)(row - 3 + j) * 128);
              acc[0] += w[j][0] * bflo(X.x); acc[1] += w[j][1] * bfhi(X.x); acc[2] += w[j][2] * bflo(X.y); acc[3] += w[j][3] * bfhi(X.y);
              acc[4] += w[j][4] * bflo(X.z); acc[5] += w[j][5] * bfhi(X.z); acc[6] += w[j][6] * bflo(X.w); acc[7] += w[j][7] * bfhi(X.w); } }
#pragma unroll
          for (int i = 0; i < 8; ++i) acc[i] = acc[i] / (1.f + expf(-acc[i])) * sc;
          v4u o; o.x = pk2(acc[0], acc[1]); o.y = pk2(acc[2], acc[3]); o.z = pk2(acc[4], acc[5]); o.w = pk2(acc[6], acc[7]);
          *(v4u*)(dst + (size_t)row * 128) = o;
      } }
    { const int slot = wk % 16, sub = wk / 16, nsub = (NWK - slot + 15) / 16, c16 = tid & 15;
      const bf16r* src = P + (size_t)(16 + slot) * MROWS * 128 + 8 * c16;
      float mx0 = 0.f, mx1 = 0.f;
#pragma unroll 8
      for (int rb = sub; rb < MROWS / 32; rb += nsub) {
          const int row = rb * 32 + (tid >> 4); const v4u X = *(const v4u*)(src + (size_t)row * 128);
          const float x0 = bflo(X.x), x1 = bfhi(X.x), x2 = bflo(X.y), x3 = bfhi(X.y), x4 = bflo(X.z), x5 = bfhi(X.z), x6 = bflo(X.w), x7 = bfhi(X.w);
          float s = (x0 * x0 + x1 * x1) + (x2 * x2 + x3 * x3) + (x4 * x4 + x5 * x5) + (x6 * x6 + x7 * x7);
          s += __shfl_xor(s, 1); s += __shfl_xor(s, 2); s += __shfl_xor(s, 4); s += __shfl_xor(s, 8);
          if (row < SEQ) mx0 = fmaxf(mx0, s); else mx1 = fmaxf(mx1, s);
      }
#pragma unroll
      for (int o = 1; o < 64; o <<= 1) { mx0 = fmaxf(mx0, __shfl_xor(mx0, o)); mx1 = fmaxf(mx1, __shfl_xor(mx1, o)); }
      if ((tid & 63) == 0) { unsigned* QK2 = (unsigned*)(a.ws + WS_QK2) + layer * 32;
          __hip_atomic_fetch_max(QK2 + slot, __float_as_uint(mx0 * 1.02f), __ATOMIC_RELAXED, __HIP_MEMORY_SCOPE_AGENT);
          __hip_atomic_fetch_max(QK2 + 16 + slot, __float_as_uint(mx1 * 1.02f), __ATOMIC_RELAXED, __HIP_MEMORY_SCOPE_AGENT); }
    }
}

__device__ __forceinline__ int cv_st(int k, int c) { const int kk = (k & ~0xC) | ((k & 4) << 1) | ((k & 8) >> 1); return ((kk >> 3) * 4 + (c >> 5)) * 512 + ((kk & 7) * 32 + (c & 31)) * 2; }
__device__ __forceinline__ int cv_rd_base(int lane) { return ((lane & 3) << 3) | (((lane >> 2) & 3) << 6) | (((lane >> 4) & 1) << 5) | (((lane >> 5) & 1) << 8); }
__device__ __forceinline__ int ccrow(int r, int hi) { return (r & 3) + 8 * (r >> 2) + 4 * hi; }
#define CFRAG(dst, vb, ks) do { v4s l_, h_; asm volatile("ds_read_b64_tr_b16 %0, %1 offset:%2" : "=&v"(l_) : "v"(vb), "i"((ks) * 4096) : "memory"); \
        asm volatile("ds_read_b64_tr_b16 %0, %1 offset:%2" : "=&v"(h_) : "v"(vb), "i"((ks) * 4096 + 2048) : "memory"); asm volatile("s_waitcnt lgkmcnt(0)" ::: "memory"); \
        dst = (v8s){l_[0], l_[1], l_[2], l_[3], h_[0], h_[1], h_[2], h_[3]}; } while (0)

struct ChunkItem { int mixer, bh, b, h, c, row0; };
__device__ __forceinline__ ChunkItem chunk_decode(int idx) { ChunkItem it; it.mixer = idx / 2048; const int rem = idx % 2048; it.bh = rem / 256; it.b = it.bh >> 2; it.h = it.bh & 3; it.c = rem % 256; it.row0 = it.b * SEQ + it.c * 64; return it; }
__device__ __forceinline__ float ret_lg(int h) { return log2f(1.0f - exp2f(-5.0f - (float)h)); }

__device__ __forceinline__ void m1_phase(CArgs& a, LAS unsigned char* lds) {
    const int tid = lz_tid(), lane = tid & 63, wave = __builtin_amdgcn_readfirstlane(tid >> 6), r32 = lane & 31, hi = lane >> 5;
    const bf16r* P = (const bf16r*)(a.ws + WS_P); const bf16r* MQC = (const bf16r*)(a.ws + WS_MQC); bf16r* US = (bf16r*)(a.ws + WS_H);
    LAS unsigned char* KT = lds; LAS unsigned char* VT = lds + 16384; LAS float* wt = (LAS float*)(lds + 32768); LAS float* red = (LAS float*)(lds + 33024);
    const int sr = tid >> 4, sc = (tid & 15) * 8;
    for (int idx = lz_bid(); idx < 4096; idx += gridDim.x) {
        const ChunkItem it = chunk_decode(idx);
        const bf16r* ksrc = (it.mixer == 0 ? P + (size_t)(4 + it.h) * MROWS * 128 : MQC + (size_t)(4 + it.h) * MROWS * 128) + (size_t)it.row0 * 128;
        const bf16r* vsrc = P + (size_t)((it.mixer == 0 ? 8 : 48) + it.h) * MROWS * 128 + (size_t)it.row0 * 128;
        if (tid < 64) { float w;
            if (it.mixer == 0) w = exp2f((float)(63 - tid) * ret_lg(it.h));
            else { const float* MA = (const float*)(a.ws + WS_MA) + (size_t)it.bh * SEQ + it.c * 64; const float* MCM = (const float*)(a.ws + WS_MCM) + (size_t)it.bh * SEQ + it.c * 64;
                   const float mp = ((const float*)(a.ws + WS_MPREV))[it.bh * 256 + it.c]; w = expf(MA[tid] - fmaxf(mp, MCM[63])); }
            wt[tid] = w; }
        const v4u k0 = *(const v4u*)(ksrc + (size_t)sr * 128 + sc), k1 = *(const v4u*)(ksrc + (size_t)(32 + sr) * 128 + sc);
        const v4u v0 = *(const v4u*)(vsrc + (size_t)sr * 128 + sc), v1 = *(const v4u*)(vsrc + (size_t)(32 + sr) * 128 + sc);
        __syncthreads();
        const float w0 = wt[sr], w1 = wt[32 + sr];
        float a0[8] = {bflo(k0.x) * w0, bfhi(k0.x) * w0, bflo(k0.y) * w0, bfhi(k0.y) * w0, bflo(k0.z) * w0, bfhi(k0.z) * w0, bflo(k0.w) * w0, bfhi(k0.w) * w0};
        float a1[8] = {bflo(k1.x) * w1, bfhi(k1.x) * w1, bflo(k1.y) * w1, bfhi(k1.y) * w1, bflo(k1.z) * w1, bfhi(k1.z) * w1, bflo(k1.w) * w1, bfhi(k1.w) * w1};
        { v4u o; o.x = pk2(a0[0], a0[1]); o.y = pk2(a0[2], a0[3]); o.z = pk2(a0[4], a0[5]); o.w = pk2(a0[6], a0[7]); *(LAS v4u*)(KT + cv_st(sr, sc)) = o;
          o.x = pk2(a1[0], a1[1]); o.y = pk2(a1[2], a1[3]); o.z = pk2(a1[4], a1[5]); o.w = pk2(a1[6], a1[7]); *(LAS v4u*)(KT + cv_st(32 + sr, sc)) = o;
          *(LAS v4u*)(VT + cv_st(sr, sc)) = v0; *(LAS v4u*)(VT + cv_st(32 + sr, sc)) = v1; }
        if (it.mixer == 1) {
#pragma unroll
            for (int i = 0; i < 8; ++i) { float s = a0[i] + a1[i]; s += __shfl_xor(s, 16); s += __shfl_xor(s, 32); if (lane < 16) red[wave * 128 + sc + i] = s; }
        }
        __syncthreads();
        if (it.mixer == 1 && tid < 128) { float s = 0.f;
#pragma unroll
            for (int q = 0; q < 8; ++q) s += red[q * 128 + tid];
            ((float*)(a.ws + WS_UN))[((size_t)it.bh * 256 + it.c) * 128 + tid] = s; }
        const int db = wave >> 1;
        const int kvb = (int)(uintptr_t)KT + cv_rd_base(lane) + db * 512;
        v8s kf[4]; CFRAG(kf[0], kvb, 0); CFRAG(kf[1], kvb, 1); CFRAG(kf[2], kvb, 2); CFRAG(kf[3], kvb, 3);
#pragma unroll
        for (int e2 = 0; e2 < 2; ++e2) { const int eb = (wave & 1) * 2 + e2; const int vvb = (int)(uintptr_t)VT + cv_rd_base(lane) + eb * 512;
            v8s vf[4]; CFRAG(vf[0], vvb, 0); CFRAG(vf[1], vvb, 1); CFRAG(vf[2], vvb, 2); CFRAG(vf[3], vvb, 3);
            v16f acc = {};
#pragma unroll
            for (int ks = 0; ks < 4; ++ks) acc = __builtin_amdgcn_mfma_f32_32x32x16_bf16(kf[ks], vf[ks], acc, 0, 0, 0);
            bf16r* dst = US + (size_t)idx * 16384 + (size_t)(eb * 32 + r32) * 128 + db * 32 + 4 * hi;
#pragma unroll
            for (int g = 0; g < 4; ++g) { v2u o; o.x = pk2(acc[4 * g], acc[4 * g + 1]); o.y = pk2(acc[4 * g + 2], acc[4 * g + 3]); *(v2u*)(dst + 8 * g) = o; } }
        __syncthreads();
    }
}

#ifndef M2U
#define M2U 64
#endif
__device__ __forceinline__ void m2_phase(CArgs& a, LAS unsigned char* lds) {
    const int tid = lz_tid();
    unsigned* US = (unsigned*)(a.ws + WS_H); LAS float* coef = (LAS float*)lds;
    const float* MCM = (const float*)(a.ws + WS_MCM); const float* MPREV = (const float*)(a.ws + WS_MPREV);
    for (int blk = lz_bid(); blk < 16 * 8192 / 512; blk += gridDim.x) {
        const int chain = blk / 16, mixer = chain >> 3, bh = chain & 7;
        __syncthreads();
        if (tid < 256) { float cf;
            if (mixer == 0) cf = exp2f(64.0f * ret_lg(bh & 3));
            else { const float mp = MPREV[bh * 256 + tid]; cf = expf(mp - fmaxf(mp, MCM[(size_t)bh * SEQ + tid * 64 + 63])); }
            coef[tid] = cf; }
        __syncthreads();
        unsigned* p = US + (size_t)chain * 256 * 8192 + (blk % 16) * 512 + tid;
        float s0 = 0.f, s1 = 0.f;
        for (int c = 0; c < 256; c += M2U) { unsigned u[M2U];
#pragma unroll
            for (int i = 0; i < M2U; ++i) u[i] = p[(size_t)(c + i) * 8192];
#pragma unroll
            for (int i = 0; i < M2U; ++i) { const float cf = coef[c + i]; p[(size_t)(c + i) * 8192] = pk2(s0, s1); s0 = s0 * cf + bflo(u[i]); s1 = s1 * cf + bfhi(u[i]); } }
    }
    float* UN = (float*)(a.ws + WS_UN);
    for (int bh = lz_bid(); bh < 8; bh += gridDim.x) {
        __syncthreads();
        if (tid < 256) { const float mp = MPREV[bh * 256 + tid]; coef[tid] = expf(mp - fmaxf(mp, MCM[(size_t)bh * SEQ + tid * 64 + 63])); }
        __syncthreads();
        if (tid < 128) { float* p = UN + (size_t)bh * 256 * 128 + tid; float s = 0.f;
            for (int c = 0; c < 256; c += 16) { float u[16];
#pragma unroll
                for (int i2 = 0; i2 < 16; ++i2) u[i2] = p[(c + i2) * 128];
#pragma unroll
                for (int i2 = 0; i2 < 16; ++i2) { p[(c + i2) * 128] = s; s = s * coef[c + i2] + u[i2]; } } }
    }
}

__device__ __forceinline__ void m3_phase(CArgs& a, int layer, LAS unsigned char* lds) {
    const int tid = lz_tid(), lane = tid & 63, wave = __builtin_amdgcn_readfirstlane(tid >> 6), r32 = lane & 31, hi = lane >> 5;
    const bf16r* P = (const bf16r*)(a.ws + WS_P); const bf16r* MQC = (const bf16r*)(a.ws + WS_MQC); const bf16r* US = (const bf16r*)(a.ws + WS_H);
    bf16r* Y = (bf16r*)(a.ws + WS_Y); const float* msc = (const float*)a.in[13] + (size_t)layer * DM;
    LAS unsigned char* VT = lds; LAS float* OT = (LAS float*)(lds + 16384);
    LAS float* sa = (LAS float*)(lds + 16384 + 64 * 132 * 4); LAS float* sg = sa + 64; LAS float* swi = sg + 64; LAS float* semq = swi + 64; LAS float* sn = semq + 64; LAS float* fw = sn + 128;
    const int sr = tid >> 4, sc = (tid & 15) * 8;
    const int lb = wave & 1, eb = wave >> 1, l = lb * 32 + r32;
    for (int idx = lz_bid(); idx < 4096; idx += gridDim.x) {
        const ChunkItem it = chunk_decode(idx);
        const bf16r* qsrc = (it.mixer == 0 ? P + (size_t)it.h * MROWS * 128 : MQC + (size_t)it.h * MROWS * 128) + (size_t)it.row0 * 128;
        const bf16r* ksrc = (it.mixer == 0 ? P + (size_t)(4 + it.h) * MROWS * 128 : MQC + (size_t)(4 + it.h) * MROWS * 128) + (size_t)it.row0 * 128;
        const bf16r* vsrc = P + (size_t)((it.mixer == 0 ? 8 : 48) + it.h) * MROWS * 128 + (size_t)it.row0 * 128;
        const bf16r* gsrc = P + (size_t)((it.mixer == 0 ? 12 : 52) + it.h) * MROWS * 128 + (size_t)it.row0 * 128;
        const bf16r* St = US + (size_t)idx * 16384;
        const float lg = ret_lg(it.h);
        if (it.mixer == 1) {
            if (tid < 64) { const size_t o = (size_t)it.bh * SEQ + it.c * 64 + tid; const float mp = ((const float*)(a.ws + WS_MPREV))[it.bh * 256 + it.c];
                const float av = ((const float*)(a.ws + WS_MA))[o], cm = ((const float*)(a.ws + WS_MCM))[o], bb = ((const float*)(a.ws + WS_MB))[o];
                const float g = fmaxf(mp, cm); sa[tid] = av; sg[tid] = g; swi[tid] = expf(mp - g); semq[tid] = expf(-(bb + g)); }
            else if (tid < 192) sn[tid - 64] = ((const float*)(a.ws + WS_UN))[((size_t)it.bh * 256 + it.c) * 128 + tid - 64];
        }
        { const v4u v0 = *(const v4u*)(vsrc + (size_t)sr * 128 + sc), v1 = *(const v4u*)(vsrc + (size_t)(32 + sr) * 128 + sc);
          *(LAS v4u*)(VT + cv_st(sr, sc)) = v0; *(LAS v4u*)(VT + cv_st(32 + sr, sc)) = v1; }
        v8s qr[8];
#pragma unroll
        for (int d0 = 0; d0 < 8; ++d0) qr[d0] = *(const v8s*)(qsrc + (size_t)l * 128 + d0 * 16 + hi * 8);
        __syncthreads();
        v16f p0 = {}, p1 = {};
#pragma unroll
        for (int d0 = 0; d0 < 8; ++d0) { const v8s kf = *(const v8s*)(ksrc + (size_t)r32 * 128 + d0 * 16 + hi * 8); p0 = __builtin_amdgcn_mfma_f32_32x32x16_bf16(kf, qr[d0], p0, 0, 0, 0); }
        if (lb == 1) {
#pragma unroll
            for (int d0 = 0; d0 < 8; ++d0) { const v8s kf = *(const v8s*)(ksrc + (size_t)(32 + r32) * 128 + d0 * 16 + hi * 8); p1 = __builtin_amdgcn_mfma_f32_32x32x16_bf16(kf, qr[d0], p1, 0, 0, 0); }
        }
        float rs = 0.f;
        int ll = l; asm volatile("" : "+v"(ll));
        if (it.mixer == 0) {
#pragma unroll
            for (int r = 0; r < 16; ++r) { const int m0 = ccrow(r, hi), m1 = m0 + 32;
                p0[r] = (m0 <= ll) ? p0[r] * __builtin_amdgcn_exp2f(fminf((float)(ll - m0) * lg, 0.f)) : 0.f; p1[r] = (m1 <= ll) ? p1[r] * __builtin_amdgcn_exp2f(fminf((float)(ll - m1) * lg, 0.f)) : 0.f; }
        } else { const float gl = sg[l];
#pragma unroll
            for (int r = 0; r < 16; ++r) { const int m0 = ccrow(r, hi), m1 = m0 + 32;
                p0[r] = (m0 <= ll) ? p0[r] * __builtin_amdgcn_exp2f(fminf(sa[m0] - gl, 0.f) * 1.4426950408889634f) : 0.f; p1[r] = (m1 <= ll) ? p1[r] * __builtin_amdgcn_exp2f(fminf(sa[m1] - gl, 0.f) * 1.4426950408889634f) : 0.f; rs += p0[r] + p1[r]; }
            rs = swap_add(rs);
        }
        v8s pa0, pa1, pa2, pa3;
#define CPK4(Pv, B_, OUT) do { unsigned a0_ = pk2(Pv[B_+0], Pv[B_+1]), a1_ = pk2(Pv[B_+2], Pv[B_+3]), b0_ = pk2(Pv[B_+4], Pv[B_+5]), b1_ = pk2(Pv[B_+6], Pv[B_+7]); \
        auto r0_ = __builtin_amdgcn_permlane32_swap(a0_, b0_, false, false); auto r1_ = __builtin_amdgcn_permlane32_swap(a1_, b1_, false, false); \
        v4u w_ = {r0_[0], r1_[0], r0_[1], r1_[1]}; OUT = *reinterpret_cast<v8s*>(&w_); } while (0)
        CPK4(p0, 0, pa0); CPK4(p0, 8, pa1); CPK4(p1, 0, pa2); CPK4(p1, 8, pa3);
#undef CPK4
        const int vvb = (int)(uintptr_t)VT + cv_rd_base(lane) + eb * 512;
        v16f oi = {}, ox = {};
        { v8s vf; CFRAG(vf, vvb, 0); oi = __builtin_amdgcn_mfma_f32_32x32x16_bf16(pa0, vf, oi, 0, 0, 0); CFRAG(vf, vvb, 1); oi = __builtin_amdgcn_mfma_f32_32x32x16_bf16(pa1, vf, oi, 0, 0, 0);
          CFRAG(vf, vvb, 2); oi = __builtin_amdgcn_mfma_f32_32x32x16_bf16(pa2, vf, oi, 0, 0, 0); CFRAG(vf, vvb, 3); oi = __builtin_amdgcn_mfma_f32_32x32x16_bf16(pa3, vf, oi, 0, 0, 0); }
#pragma unroll
        for (int d0 = 0; d0 < 8; ++d0) { const v8s sf = *(const v8s*)(St + (size_t)(eb * 32 + r32) * 128 + d0 * 16 + hi * 8); ox = __builtin_amdgcn_mfma_f32_32x32x16_bf16(qr[d0], sf, ox, 0, 0, 0); }
        float fa, fb;
        if (it.mixer == 0) { fa = 1.f; fb = exp2f((float)(l + 1) * lg); }
        else { float qn = 0.f;
#pragma unroll
            for (int d0 = 0; d0 < 8; ++d0)
#pragma unroll
                for (int i = 0; i < 8; ++i) qn += bf1((bf16r)qr[d0][i]) * sn[d0 * 16 + hi * 8 + i];
            qn = swap_add(qn);
            const float wi = swi[l]; const float den = rs + wi * qn; const float dn = fmaxf(fabsf(den), semq[l]); fa = 1.0f / dn; fb = wi / dn; }
        LAS float* fww = fw + wave * 64;
        if (hi == 0) { fww[r32] = fa; fww[32 + r32] = fb; }
        asm volatile("s_waitcnt lgkmcnt(0)" ::: "memory");
#pragma unroll
        for (int r = 0; r < 16; ++r) { const int lr = ccrow(r, hi); OT[(lb * 32 + lr) * 132 + eb * 32 + r32] = fww[lr] * oi[r] + fww[32 + lr] * ox[r]; }
        __syncthreads();
        const int colbase = (it.mixer == 0 ? 0 : 1536) + it.h * 128;
        { const int row = wave * 8 + (lane >> 3), seg = lane & 7;
          const v4u gA = *(const v4u*)(gsrc + (size_t)row * 128 + seg * 16), gB = *(const v4u*)(gsrc + (size_t)row * 128 + seg * 16 + 8);
          float v[16];
#pragma unroll
          for (int q = 0; q < 4; ++q) { const v4f t = *(LAS v4f*)(OT + row * 132 + seg * 16 + 4 * q); v[4 * q] = t.x; v[4 * q + 1] = t.y; v[4 * q + 2] = t.z; v[4 * q + 3] = t.w; }
          float s = 0.f;
#pragma unroll
          for (int q = 0; q < 16; ++q) s += v[q];
          s += __shfl_xor(s, 1); s += __shfl_xor(s, 2); s += __shfl_xor(s, 4);
          const float mu = s * (1.f / 128.f); float sq = 0.f;
#pragma unroll
          for (int q = 0; q < 16; ++q) { v[q] -= mu; sq += v[q] * v[q]; }
          sq += __shfl_xor(sq, 1); sq += __shfl_xor(sq, 2); sq += __shfl_xor(sq, 4);
          const float rstd = 1.0f / sqrtf(sq * (1.f / 128.f) + NORM_EPS);
          float g[16] = {bflo(gA.x), bfhi(gA.x), bflo(gA.y), bfhi(gA.y), bflo(gA.z), bfhi(gA.z), bflo(gA.w), bfhi(gA.w), bflo(gB.x), bfhi(gB.x), bflo(gB.y), bfhi(gB.y), bflo(gB.z), bfhi(gB.z), bflo(gB.w), bfhi(gB.w)};
          const float* mp = msc + colbase + seg * 16;
#pragma unroll
          for (int q = 0; q < 16; ++q) { const float e = expf(-g[q]); const float gate = (it.mixer == 0) ? g[q] / (1.f + e) : 1.f / (1.f + e); v[q] = v[q] * rstd * gate * mp[q]; }
          v4u oA, oB; oA.x = pk2(v[0], v[1]); oA.y = pk2(v[2], v[3]); oA.z = pk2(v[4], v[5]); oA.w = pk2(v[6], v[7]); oB.x = pk2(v[8], v[9]); oB.y = pk2(v[10], v[11]); oB.z = pk2(v[12], v[13]); oB.w = pk2(v[14], v[15]);
          bf16r* yp = Y + (size_t)(it.row0 + row) * DM + colbase + seg * 16;
          *(v4u*)yp = oA; *(v4u*)(yp + 8) = oB; }
        __syncthreads();
    }
}

__device__ __forceinline__ fox::BlockRef<fox::bf16, fox::bf16> fox_ref(CArgs& a, int layer, int bh, int qb, int jlo) {
    const int b = bh >> 3, h = bh & 7; const fox::bf16* P = (const fox::bf16*)(a.ws + WS_P);
    fox::BlockRef<fox::bf16, fox::bf16> r;
    r.Q = P + ((size_t)(16 + h) * MROWS + (size_t)b * SEQ + (size_t)qb * 256) * 128;
    r.K = (unsigned)(WS_P + ((size_t)(24 + h) * MROWS + (size_t)b * SEQ) * 256); r.V = (unsigned)(WS_P + ((size_t)(32 + h) * MROWS + (size_t)b * SEQ) * 256);
    r.O = (fox::bf16*)(a.ws + WS_Y) + ((size_t)b * SEQ + (size_t)qb * 256) * DM + 512 + h * 128;
    r.C = (unsigned)(WS_CNEG + (size_t)bh * SEQ * 4); r.MS = (const float*)a.in[13] + (size_t)layer * DM + 512 + h * 128; const int j4 = jlo >> 2;
    r.P0 = (qb - j4) * 256; r.JLO = j4 * 4;
    r.K += (unsigned)j4 * 256u * 256u; r.V += (unsigned)j4 * 256u * 256u; r.C += (unsigned)j4 * 1024u;
    return r;
}
__device__ __forceinline__ void fox_table_phase(CArgs& a, int layer) {
    const int tid = lz_tid(), lane = tid & 63, u = lz_bid() * 8 + (tid >> 6);
    if (u >= 1024) return;
    const float* QK2 = (const float*)(a.ws + WS_QK2) + layer * 32; const float* CN = (const float*)(a.ws + WS_CNEG);
    const int bh = u & 15, qb = 63 - (u >> 4), b = bh >> 3, h = bh & 7;
    const float qkmax = sqrtf(QK2[b * 16 + h] * QK2[b * 16 + 8 + h]);
    const float* cn = CN + (size_t)bh * SEQ; const float thresh = cn[qb * 256] - (2.0f * qkmax + 1200.0f);
    int cnt = 0;
#pragma unroll
    for (int t = 0; t < 4; ++t) { const int tile = lane + 64 * t; const bool skip = (tile < qb * 4) && (cn[tile * 64 + 63] < thresh); cnt += __popcll(__ballot(skip)); }
    if (lane == 0) ((int*)(a.ws + WS_JT))[layer * 1024 + u] = cnt;
}
__device__ __forceinline__ void fox_phase(CArgs& a, int layer, char* lds, int rep = 0) {
    using BR = fox::BlockRef<fox::bf16, fox::bf16>;
    constexpr int W = 1 << 30, total = 1024;
    const int tid = lz_tid(), lane = tid & 63;
    volatile unsigned* sbuf = (volatile unsigned*)(lds + 69632);
    unsigned* qctr = (unsigned*)(a.ws + WS_QCTR) + layer * 64 + rep * 128;
    const int* JT = (const int*)(a.ws + WS_JT) + layer * 1024;
#define FOX_GRAB(U) do { if (tid == 0) sbuf[0] = __hip_atomic_fetch_add(qctr, 1u, __ATOMIC_RELAXED, __HIP_MEMORY_SCOPE_AGENT); __syncthreads(); U = __builtin_amdgcn_readfirstlane((int)sbuf[0]); __syncthreads(); } while (0)
#define FOX_MAKE(R, U) do { const int bh_ = (U) & 15, qb_ = 63 - ((U) >> 4); R = fox_ref(a, layer, bh_, qb_, __builtin_amdgcn_readfirstlane(JT[(U)])); } while (0)
    int u; FOX_GRAB(u); if (u >= total) return;
    BR cur; FOX_MAKE(cur, u);
    fox::Seam<fox::bf16> S;
    const __amdgpu_buffer_rsrc_t rs = __builtin_amdgcn_make_buffer_rsrc((void*)a.ws, 0, -1, 0x00020000);
    fox::causal_swa_prime<fox::bf16, fox::bf16>(cur, W, lds, S, rs);
    for (;;) {
        int un; FOX_GRAB(un); const bool last = un >= total;
        BR nxt = cur; if (!last) FOX_MAKE(nxt, un);
        fox::causal_swa_block<fox::bf16, fox::bf16>(cur, nxt, SEQ, W, lds, S, rs);
        if (last) break;
        cur = nxt;
    }
#undef FOX_GRAB
#undef FOX_MAKE
}

#ifdef NANPROBE
constexpr size_t WS_FLAGS = 32 * 1024;
__device__ __forceinline__ void probe_f32(const float* p, size_t n, unsigned* flag) { bool bad = false;
    for (size_t i = (size_t)lz_bid() * 512 + lz_tid(); i < n; i += (size_t)gridDim.x * 512) { const unsigned u = __float_as_uint(p[i]); if ((u & 0x7f800000u) == 0x7f800000u) bad = true; }
    if (bad) *flag = 1u; }
__device__ __forceinline__ void probe_bf16(const unsigned short* p, size_t n, unsigned* flag) { bool bad = false;
    for (size_t i = (size_t)lz_bid() * 512 + lz_tid(); i < n; i += (size_t)gridDim.x * 512) { const unsigned u = p[i]; if ((u & 0x7f80u) == 0x7f80u) bad = true; }
    if (bad) *flag = 1u; }
#define PROBE_F32(p, n, k) probe_f32((const float*)(p), (n), (unsigned*)(ws + WS_FLAGS) + (k))
#define PROBE_BF16(p, n, k) probe_bf16((const unsigned short*)(p), (n), (unsigned*)(ws + WS_FLAGS) + (k))
#else
#define PROBE_F32(p, n, k) do {} while (0)
#define PROBE_BF16(p, n, k) do {} while (0)
#endif
#ifndef PHMASK
#define PHMASK 0xfff
#endif
#define EN(k) ((PHMASK >> (k)) & 1)
#define IN(k) (lo <= (k) && (k) < hi)
#ifdef TWICE_SYNC
#define SEAM() do { if (IN(ph) && IN(ph + 1)) { grid.sync(); grid.sync(); grid.sync(); } ++ph; } while (0)
#else
#define SEAM() do { if (IN(ph) && IN(ph + 1)) { if (ph == 0) grid.sync(); else xcd_barrier(xbar); } ++ph; } while (0)
#endif
#define a (*fresh_args())
#define ws (a.ws)
#define MOD ((const float*)(ws + WS_MOD))
template <int layer>
__device__ __forceinline__ void layer_phases(int& ph, const int lo, const int hi, cg::grid_group& grid, const XcdBarrier& xbar, LAS unsigned char* lds, unsigned char* lds_raw) {

        const float* mod = MOD + (size_t)layer * NB * NMOD;
        const float* xin = layer == 0 ? (const float*)a.in[0] : a.out;
        if (EN(1) && IN(ph)) norm_phase(xin, (const float*)a.in[5] + (size_t)layer * DM, mod, mod + DM, (bf16r*)(ws + WS_H));
#ifdef TWICE_NORM
        if (IN(ph)) norm_phase(xin, (const float*)a.in[5] + (size_t)layer * DM, mod, mod + DM, (bf16r*)(ws + WS_H));
#endif
        SEAM();
        if (EN(2) && IN(ph)) { pg8::Gemm g{(const pg8::bf16_t*)(ws + WS_H), (const pg8::bf16_t*)(ws + WS_WIN + layer * WIN_BYTES), MROWS, NINP, DM}; pg8::StaticOrder S; S.init(MROWS, NINP, gridDim.x, lz_bid());
            pg8::EpiIn E{(pg8::bf16_t*)(ws + WS_P), (float*)(ws + WS_GATES)};
            pg8::gemm_phase<pg8::EpiIn, pg8::StaticOrder, true, true>(lds, g, S, E);
            gate_gemm((const bf16r*)(ws + WS_H), (const bf16r*)(ws + WS_WG + layer * WG_BYTES), (float*)(ws + WS_GATES));
#ifdef TWICE_IN
            __syncthreads(); pg8::gemm_phase<pg8::EpiIn, pg8::StaticOrder, true, true>(lds, g, S, E);
#endif
        }
        SEAM();
        if (EN(3) && IN(ph)) prep_phase(a, layer, lds);
#ifdef TWICE_INPREP
        if (IN(ph)) { xcd_barrier(xbar);
            { pg8::Gemm g{(const pg8::bf16_t*)(ws + WS_H), (const pg8::bf16_t*)(ws + WS_WIN + layer * WIN_BYTES), MROWS, NINP, DM}; pg8::StaticOrder S; S.init(MROWS, NINP, gridDim.x, lz_bid());
              pg8::EpiIn E{(pg8::bf16_t*)(ws + WS_P), (float*)(ws + WS_GATES)};
              pg8::gemm_phase<pg8::EpiIn, pg8::StaticOrder, true, true>(lds, g, S, E); }
            xcd_barrier(xbar); prep_phase(a, layer, lds); }
#endif
        SEAM();
        PROBE_F32(ws + WS_GATES, (size_t)MROWS * 16, 1 + 10 * layer); PROBE_F32(ws + WS_CNEG, (size_t)NB * 8 * SEQ, 2 + 10 * layer); PROBE_F32(ws + WS_MA, (size_t)3 * NB * 4 * SEQ, 3 + 10 * layer); PROBE_BF16(ws + WS_P, (size_t)56 * MROWS * 128, 4 + 10 * layer); PROBE_BF16(ws + WS_MQC, (size_t)8 * MROWS * 128, 5 + 10 * layer);
        if (IN(ph)) { fox_table_phase(a, layer); if (EN(4)) m1_phase(a, lds);
#if 0
#ifdef TWICE_FOX
            __syncthreads(); fox_phase(a, layer, (char*)lds_raw);
#endif
#endif
#ifdef TWICE_M1
            __syncthreads(); m1_phase(a, lds);
#endif
        }
        SEAM();
#ifdef NANPROBE
        PROBE_BF16(ws + WS_H, (size_t)MROWS * DM, 20 + layer); PROBE_F32(ws + WS_UN, (size_t)NB * 4 * 256 * 128, 22 + layer); PROBE_F32(ws + WS_MPREV, (size_t)NB * 4 * 256, 24 + layer); grid.sync();
#endif
        if (IN(ph)) { if (EN(6)) m2_phase(a, lds); __syncthreads(); if (EN(5)) fox_phase(a, layer, (char*)lds_raw);
#ifdef TWICE_FOX
            __syncthreads(); fox_phase(a, layer, (char*)lds_raw, 1);
#endif
        }
        SEAM();
        if (EN(7) && IN(ph)) m3_phase(a, layer, lds);
#ifdef TWICE_M3
        if (IN(ph)) { __syncthreads(); m3_phase(a, layer, lds); }
#endif
        SEAM();
        PROBE_BF16(ws + WS_H, (size_t)MROWS * DM, 6 + 10 * layer); PROBE_BF16(ws + WS_Y, (size_t)MROWS * DM, 7 + 10 * layer);
        if (EN(8) && IN(ph)) { pg8::Gemm g{(const pg8::bf16_t*)(ws + WS_Y), (const pg8::bf16_t*)(ws + WS_WOUT + layer * WOUT_BYTES), MROWS, DM, DM}; pg8::StaticOrder S; S.init(MROWS, DM, gridDim.x, lz_bid());
            pg8::EpiRes E{xin, a.out, mod + 2 * DM};
            pg8::gemm_phase<pg8::EpiRes, pg8::StaticOrder, true, true>(lds, g, S, E); }
        SEAM();
        PROBE_F32(a.out, (size_t)MROWS * DM, 8 + 10 * layer);
        if (EN(1) && IN(ph)) norm_phase(a.out, (const float*)a.in[6] + (size_t)layer * DM, mod + 3 * DM, mod + 4 * DM, (bf16r*)(ws + WS_H));
#ifdef TWICE_NORM
        if (IN(ph)) norm_phase(a.out, (const float*)a.in[6] + (size_t)layer * DM, mod + 3 * DM, mod + 4 * DM, (bf16r*)(ws + WS_H));
#endif
        SEAM();
        if (EN(9) && IN(ph)) { pg8::Gemm g{(const pg8::bf16_t*)(ws + WS_H), (const pg8::bf16_t*)(ws + WS_WFF1 + layer * WFF_BYTES), MROWS, DFF, DM}; pg8::StaticOrder S; S.init(MROWS, DFF, gridDim.x, lz_bid());
            pg8::EpiRelu2 E{(pg8::bf16_t*)(ws + WS_HID), DFF};
            pg8::gemm_phase<pg8::EpiRelu2, pg8::StaticOrder, true, true>(lds, g, S, E);
#ifdef TWICE_FF1
            __syncthreads(); pg8::gemm_phase<pg8::EpiRelu2, pg8::StaticOrder, true, true>(lds, g, S, E);
#endif
        }
        SEAM();
        if (EN(10) && IN(ph)) { pg8::Gemm g{(const pg8::bf16_t*)(ws + WS_HID), (const pg8::bf16_t*)(ws + WS_WFF2 + layer * WFF_BYTES), MROWS, DM, DFF}; pg8::StaticOrder S; S.init(MROWS, DM, gridDim.x, lz_bid());
            pg8::EpiRes E{a.out, a.out, mod + 5 * DM};
            pg8::gemm_phase<pg8::EpiRes, pg8::StaticOrder, true, true>(lds, g, S, E); }
        SEAM();
        PROBE_F32(a.out, (size_t)MROWS * DM, 9 + 10 * layer);
    }
__global__ void __launch_bounds__(512, 2) trunk_fwd(Args a_unused) {
    extern __shared__ __attribute__((aligned(16))) unsigned char lds_raw[];
    LAS unsigned char* lds = (LAS unsigned char*)lds_raw;
    cg::grid_group grid = cg::this_grid();
    int lo, hi; { CArgs& a0 = *fresh_args(); lo = a0.ph_lo; hi = a0.ph_hi; } int ph = 0;
    volatile LAS unsigned* xst = (volatile LAS unsigned*)(lds + 139264);
    if (lz_tid() < 2) xst[lz_tid()] = 0u;
    __syncthreads();
    if (lz_bid() == 0) { unsigned* z = (unsigned*)ws; for (int i = lz_tid(); i < 4096; i += 512) z[i] = 0u; }
#ifdef NANPROBE
    if (lz_bid() == 0 && lz_tid() < 32) ((unsigned*)(ws + WS_FLAGS))[lz_tid()] = 0u;
#endif
    if (EN(0) && IN(ph)) p0_phase(a, lds);
#ifdef TWICE_P0
    if (IN(ph)) { __syncthreads(); p0_phase(a, lds); }
#endif
    if (IN(ph) && IN(ph + 1)) grid.sync();
    ++ph;
    const XcdBarrier xbar = xcd_barrier_post((unsigned*)ws, xst);
    layer_phases<0>(ph, lo, hi, grid, xbar, lds, lds_raw);
    layer_phases<1>(ph, lo, hi, grid, xbar, lds, lds_raw);
    if (EN(11) && IN(ph)) final_norm_phase(a.out, (const float*)a.in[17]);
#ifdef NANPROBE
    { grid.sync(); float code = 0.f; const unsigned* fl = (const unsigned*)(ws + WS_FLAGS);
      const int order[16] = {1, 2, 3, 4, 5, 24, 20, 22, 6, 7, 8, 9, 11, 12, 13, 14};
      for (int q = 15; q >= 0; --q) if (fl[order[q]]) code = (float)order[q] * 1.0e6f;
      float* o = a.out; for (size_t i = (size_t)lz_bid() * 512 + lz_tid(); i < (size_t)MROWS * DM; i += (size_t)gridDim.x * 512) o[i] = (i == 0) ? code : 0.f; }
#endif
#ifdef DBG_OFF_MIB
    { grid.sync();
      const unsigned short* src = (const unsigned short*)(ws + (size_t)DBG_OFF_MIB * MiB); const size_t n = (size_t)DBG_MIB * MiB / 2; float* o = a.out;
      for (size_t i = (size_t)lz_bid() * 512 + lz_tid(); i < (size_t)MROWS * DM; i += (size_t)gridDim.x * 512) { const size_t k = (4 * i) % n;
          o[i] = (float)src[k] + 3.f * (float)src[k + 1] + 5.f * (float)src[k + 2] + 7.f * (float)src[k + 3]; } }
#endif
#undef IN
#undef SEAM
#undef a
#undef ws
#undef MOD
}

#ifndef MK_PER_PHASE
#define MK_PER_PHASE 0
#endif
extern "C" void kernel_launch(void* const* d_in, const int* in_sizes, int n_in, void* d_out, int out_size, void* d_ws, size_t ws_size, hipStream_t stream) {
    static int grid = 0;
    if (grid == 0) {
        if (n_in != 18 || in_sizes[0] != MROWS * DM || out_size != MROWS * DM || ws_size < WS_END) { fprintf(stderr, "kernel_launch: unexpected shapes (n_in %d, in0 %d, out %d, ws %zu)\n", n_in, n_in > 0 ? in_sizes[0] : -1, out_size, ws_size); grid = -1; return; }
        int dev = 0, cus = 0, per_cu = 0;
        if (hipGetDevice(&dev) != hipSuccess || hipDeviceGetAttribute(&cus, hipDeviceAttributeMultiprocessorCount, dev) != hipSuccess) { grid = -1; return; }
        if (hipFuncSetAttribute((const void*)trunk_fwd, hipFuncAttributeMaxDynamicSharedMemorySize, LDS_BYTES) != hipSuccess) { fprintf(stderr, "kernel_launch: hipFuncSetAttribute failed\n"); grid = -1; return; }
        if (hipOccupancyMaxActiveBlocksPerMultiprocessor(&per_cu, (const void*)trunk_fwd, 512, LDS_BYTES) != hipSuccess || per_cu < 1) { fprintf(stderr, "kernel_launch: occupancy query says %d\n", per_cu); per_cu = 1; }
        (void)hipGetLastError();
        grid = cus;
    }
    if (grid < 0) return;
    Args a{};
    for (int i = 0; i < 18; ++i) a.in[i] = d_in[i];
    a.out = (float*)d_out; a.ws = (unsigned char*)d_ws;
    constexpr int NPH = 1 + 2 * 10 + 1;
#if MK_PER_PHASE
    for (int p = 0; p < NPH; ++p) { a.ph_lo = p; a.ph_hi = p + 1; hipLaunchKernelGGL(trunk_fwd, dim3(grid), dim3(512), LDS_BYTES, stream, a); }
#else
#ifdef DBG_HI
    a.ph_lo = 0; a.ph_hi = DBG_HI;
#else
    a.ph_lo = 0; a.ph_hi = NPH;
#endif
    void* args[] = {&a};
    hipError_t e = hipLaunchCooperativeKernel((const void*)trunk_fwd, dim3(grid), dim3(512), args, LDS_BYTES, stream);
    if (e != hipSuccess) fprintf(stderr, "kernel_launch: cooperative launch failed: %s (grid %d)\n", hipGetErrorString(e), grid);
#endif
}
```
